# Optimizing an MI355X kernel written in HIP

```python
import jax, jax.numpy as jnp
from jax import lax
import numpy as np

D_MODEL = 1024
BATCH = 16
SEQ = 4096
DEPTH = 4

N_A_LAYERS = DEPTH // 2
N_B_LAYERS = DEPTH - N_A_LAYERS
N_DENSE = (DEPTH + 1) // 2
N_MOE = DEPTH // 2

D_RNN = D_MODEL
RNN_BLOCKS = 8
RNN_BLOCK_W = D_RNN // RNN_BLOCKS
CONV_W = 4
LRU_C = 8.0

HEAD_DIM = 64
N_Q_HEADS = D_MODEL // HEAD_DIM
N_KV_HEADS = 4
GROUP = N_Q_HEADS // N_KV_HEADS
WINDOW = 128
BLOCK = 128
ROPE_THETA = 10000.0

D_FF = 3 * D_MODEL
N_EXPERTS = 8
TOP_K = 2
D_FF_EXPERT = 7 * D_MODEL // 2

EPS = 1e-6
F32 = jnp.float32

kernel_name = "hybrid_rglru_yoco_swa_sink_moe"


def rms_norm(x, g):
    x32 = x.astype(F32)
    y = x32 * lax.rsqrt(jnp.mean(x32 * x32, axis=-1, keepdims=True) + EPS)
    return (y * g.astype(F32)).astype(x.dtype)


def modulate(x, g, shift, scale):
    return rms_norm(x, g) * (1 + scale[:, None, :]) + shift[:, None, :]


def rope_tables(positions, dtype):
    inv = ROPE_THETA ** (-jnp.arange(0, HEAD_DIM, 2, dtype=F32) / HEAD_DIM)
    ang = positions.astype(F32)[..., None] * inv
    return jnp.cos(ang)[:, :, None, :].astype(dtype), jnp.sin(ang)[:, :, None, :].astype(dtype)


def rotary(x, cos, sin):
    x1, x2 = jnp.split(x, 2, axis=-1)
    return jnp.concatenate([x1 * cos - x2 * sin, x2 * cos + x1 * sin], axis=-1)


def rglru_mixer(h, w_in, conv_w, conv_b, gx_w, gx_b, ga_w, ga_b, lam, w_out):
    bsz, seq, _ = h.shape
    xb, yb = jnp.split(h @ w_in, 2, axis=-1)
    xp = jnp.pad(xb, ((0, 0), (CONV_W - 1, 0), (0, 0)))
    xc = conv_b + xp[:, 0:seq] * conv_w[0]
    for k in range(1, CONV_W):
        xc = xc + xp[:, k:k + seq] * conv_w[k]
    xblk = xc.reshape(bsz, seq, RNN_BLOCKS, RNN_BLOCK_W)
    r_gate = jax.nn.sigmoid((jnp.einsum('bsnc,ncd->bsnd', xblk, ga_w).reshape(bsz, seq, D_RNN) + ga_b).astype(F32))
    i_gate = jax.nn.sigmoid((jnp.einsum('bsnc,ncd->bsnd', xblk, gx_w).reshape(bsz, seq, D_RNN) + gx_b).astype(F32))
    log_a = -LRU_C * r_gate * jax.nn.softplus(-lam.astype(F32))
    a = jnp.exp(log_a)
    b = jnp.sqrt(-jnp.expm1(2.0 * log_a)) * (i_gate * xc.astype(F32))

    def combine(left, right):
        a1, b1 = left
        a2, b2 = right
        return a1 * a2, a2 * b1 + b2

    _, hs = lax.associative_scan(combine, (a, b), axis=1)
    return (hs.astype(h.dtype) * jax.nn.gelu(yb)) @ w_out


def band_mask(nblk):
    n = jnp.arange(nblk)[:, None, None]
    i = jnp.arange(BLOCK)[None, :, None]
    j = jnp.arange(2 * BLOCK)[None, None, :]
    s = n * BLOCK - BLOCK + j
    d = n * BLOCK + i - s
    return (d >= 0) & (d < WINDOW) & (s >= 0)


def shared_kv(x, c_act, kv_norm, kv_ada_w, kv_ada_b, w_kv, k_norm, cos, sin):
    bsz, seq, _ = x.shape
    shift, scale = jnp.split(c_act @ kv_ada_w + kv_ada_b, 2, axis=-1)
    h = modulate(x, kv_norm, shift, scale)
    k, v = jnp.split(h @ w_kv, 2, axis=-1)
    k = k.reshape(bsz, seq, N_KV_HEADS, HEAD_DIM)
    v = v.reshape(bsz, seq, N_KV_HEADS, HEAD_DIM)
    k = rotary(rms_norm(k, k_norm), cos, sin)
    nblk = seq // BLOCK

    def to_windows(t):
        tb = t.reshape(bsz, nblk, BLOCK, N_KV_HEADS, HEAD_DIM).transpose(1, 0, 2, 3, 4)
        prev = jnp.concatenate([jnp.zeros_like(tb[:1]), tb[:-1]], axis=0)
        return jnp.concatenate([prev, tb], axis=2)

    return to_windows(k), to_windows(v)


def swa_sink_attention(h, w_q, q_norm, sinks, w_o, k_win, v_win, mask, cos, sin):
    bsz, seq, _ = h.shape
    nblk = seq // BLOCK
    q = (h @ w_q).reshape(bsz, seq, N_Q_HEADS, HEAD_DIM)
    q = rotary(rms_norm(q, q_norm), cos, sin)
    qb = q.reshape(bsz, nblk, BLOCK, N_KV_HEADS, GROUP, HEAD_DIM).transpose(1, 0, 2, 3, 4, 5)
    sink = sinks.astype(F32).reshape(N_KV_HEADS, GROUP)
    scale = HEAD_DIM ** -0.5

    def block_attn(args):
        qi, ki, vi, mi = args
        s = jnp.einsum('bqkgd,bskd->bkgqs', qi, ki).astype(F32) * scale
        s = jnp.where(mi[None, None, None], s, -jnp.inf)
        sink_col = jnp.broadcast_to(sink[None, :, :, None, None], s.shape[:-1] + (1,))
        p = jax.nn.softmax(jnp.concatenate([s, sink_col], axis=-1), axis=-1)[..., :-1]
        return jnp.einsum('bkgqs,bskd->bqkgd', p.astype(vi.dtype), vi)

    o = lax.map(block_attn, (qb, k_win, v_win, mask))
    o = o.transpose(1, 0, 2, 3, 4, 5).reshape(bsz, seq, N_Q_HEADS * HEAD_DIM)
    return o @ w_o


def swiglu(h, w_gu, w_down):
    g, u = jnp.split(h @ w_gu, 2, axis=-1)
    return (jax.nn.silu(g) * u) @ w_down


def moe_swiglu(h, w_router, w_gu, w_down):
    bsz, seq, d = h.shape
    t = h.reshape(-1, d)
    logits = (t @ w_router).astype(F32)
    top_v, top_i = lax.top_k(logits, TOP_K)
    top_w = jax.nn.softmax(top_v, axis=-1)
    gates = jnp.sum(jax.nn.one_hot(top_i, N_EXPERTS, dtype=F32) * top_w[..., None], axis=1)
    out = jnp.zeros_like(t)
    for e in range(N_EXPERTS):
        out = out + gates[:, e:e + 1].astype(t.dtype) * swiglu(t, w_gu[e], w_down[e])
    return out.reshape(bsz, seq, d)


def setup_inputs(seed: int = 0) -> dict:
    key = jax.random.key(seed)
    ks = iter(jax.random.split(key, 40))
    nrm = lambda shape, s: jax.random.normal(next(ks), shape, F32) * s
    gain = lambda shape: 1.0 + 0.05 * jax.random.normal(next(ks), shape, F32)
    D = D_MODEL
    x = nrm((BATCH, SEQ, D), 1.0)
    c = nrm((BATCH, D), 1.0)
    offs = jax.random.randint(next(ks), (BATCH, 1), 0, 1024, dtype=jnp.int32)
    positions = (offs + jnp.arange(SEQ, dtype=jnp.int32)[None, :]).astype(jnp.int32)
    ada_w = nrm((DEPTH, D, 6 * D), 0.1 * D ** -0.5)
    ada_b = nrm((DEPTH, 6 * D), 0.02)
    mix_norm = gain((DEPTH, D))
    ffn_norm = gain((DEPTH, D))
    a_w_in = nrm((N_A_LAYERS, D, 2 * D_RNN), D ** -0.5)
    a_conv_w = nrm((N_A_LAYERS, CONV_W, D_RNN), CONV_W ** -0.5)
    a_conv_b = nrm((N_A_LAYERS, D_RNN), 0.02)
    a_gx_w = nrm((N_A_LAYERS, RNN_BLOCKS, RNN_BLOCK_W, RNN_BLOCK_W), RNN_BLOCK_W ** -0.5)
    a_gx_b = nrm((N_A_LAYERS, D_RNN), 0.02)
    a_ga_w = nrm((N_A_LAYERS, RNN_BLOCKS, RNN_BLOCK_W, RNN_BLOCK_W), RNN_BLOCK_W ** -0.5)
    a_ga_b = nrm((N_A_LAYERS, D_RNN), 0.02)
    u = jax.random.uniform(next(ks), (N_A_LAYERS, D_RNN), F32, 0.9, 0.999)
    sig = u ** (1.0 / LRU_C)
    a_lambda = jnp.log(sig) - jnp.log1p(-sig)
    a_w_out = nrm((N_A_LAYERS, D_RNN, D), D_RNN ** -0.5)
    kv_norm = gain((D,))
    kv_ada_w = nrm((D, 2 * D), 0.1 * D ** -0.5)
    kv_ada_b = nrm((2 * D,), 0.02)
    w_kv = nrm((D, 2 * N_KV_HEADS * HEAD_DIM), D ** -0.5)
    k_norm = gain((HEAD_DIM,))
    b_w_q = nrm((N_B_LAYERS, D, N_Q_HEADS * HEAD_DIM), D ** -0.5)
    b_q_norm = gain((N_B_LAYERS, HEAD_DIM))
    b_sinks = nrm((N_B_LAYERS, N_Q_HEADS), 1.0)
    b_w_o = nrm((N_B_LAYERS, N_Q_HEADS * HEAD_DIM, D), (N_Q_HEADS * HEAD_DIM) ** -0.5)
    f_w_gu = nrm((N_DENSE, D, 2 * D_FF), D ** -0.5)
    f_w_down = nrm((N_DENSE, D_FF, D), D_FF ** -0.5)
    m_router = nrm((N_MOE, D, N_EXPERTS), D ** -0.5)
    m_w_gu = nrm((N_MOE, N_EXPERTS, D, 2 * D_FF_EXPERT), D ** -0.5)
    m_w_down = nrm((N_MOE, N_EXPERTS, D_FF_EXPERT, D), D_FF_EXPERT ** -0.5)
    return {"x": x, "c": c, "positions": positions, "ada_w": ada_w, "ada_b": ada_b,
            "mix_norm": mix_norm, "ffn_norm": ffn_norm, "a_w_in": a_w_in, "a_conv_w": a_conv_w,
            "a_conv_b": a_conv_b, "a_gx_w": a_gx_w, "a_gx_b": a_gx_b, "a_ga_w": a_ga_w,
            "a_ga_b": a_ga_b, "a_lambda": a_lambda, "a_w_out": a_w_out, "kv_norm": kv_norm,
            "kv_ada_w": kv_ada_w, "kv_ada_b": kv_ada_b, "w_kv": w_kv, "k_norm": k_norm,
            "b_w_q": b_w_q, "b_q_norm": b_q_norm, "b_sinks": b_sinks, "b_w_o": b_w_o,
            "f_w_gu": f_w_gu, "f_w_down": f_w_down, "m_router": m_router, "m_w_gu": m_w_gu,
            "m_w_down": m_w_down}


def reference(x, c, positions, ada_w, ada_b, mix_norm, ffn_norm, a_w_in, a_conv_w, a_conv_b,
              a_gx_w, a_gx_b, a_ga_w, a_ga_b, a_lambda, a_w_out, kv_norm, kv_ada_w, kv_ada_b,
              w_kv, k_norm, b_w_q, b_q_norm, b_sinks, b_w_o, f_w_gu, f_w_down, m_router,
              m_w_gu, m_w_down):
    cos, sin = rope_tables(positions, x.dtype)
    c_act = jax.nn.silu(c)
    mask = band_mask(x.shape[1] // BLOCK)
    k_win = None
    v_win = None
    for l in range(DEPTH):
        mod = c_act @ ada_w[l] + ada_b[l]
        sh1, sc1, g1, sh2, sc2, g2 = jnp.split(mod, 6, axis=-1)
        if l < N_A_LAYERS:
            h = modulate(x, mix_norm[l], sh1, sc1)
            y = rglru_mixer(h, a_w_in[l], a_conv_w[l], a_conv_b[l], a_gx_w[l], a_gx_b[l],
                            a_ga_w[l], a_ga_b[l], a_lambda[l], a_w_out[l])
        else:
            if l == N_A_LAYERS:
                k_win, v_win = shared_kv(x, c_act, kv_norm, kv_ada_w, kv_ada_b, w_kv, k_norm, cos, sin)
            bi = l - N_A_LAYERS
            h = modulate(x, mix_norm[l], sh1, sc1)
            y = swa_sink_attention(h, b_w_q[bi], b_q_norm[bi], b_sinks[bi], b_w_o[bi],
                                   k_win, v_win, mask, cos, sin)
        x = x + (1 + g1[:, None, :]) * y
        h = modulate(x, ffn_norm[l], sh2, sc2)
        if l % 2 == 0:
            y = swiglu(h, f_w_gu[l // 2], f_w_down[l // 2])
        else:
            y = moe_swiglu(h, m_router[l // 2], m_w_gu[l // 2], m_w_down[l // 2])
        x = x + (1 + g2[:, None, :]) * y
    return x
```

```cpp
#include <hip/hip_runtime.h>
#include <cstdio>
#include <cstdint>

#ifndef FP8MASK
#define FP8MASK 10
#endif
#define FP8_OF(l) (((FP8MASK) >> (l)) & 1)
#ifndef DUPMASK
#define DUPMASK 0
#endif
#ifndef DUP_SCANPAIR
#define DUP_SCANPAIR 0
#endif
#ifndef PHSEL
#define PHSEL 0xFFFFFFFFu
#endif
#ifndef MK_MULTI
#define MK_MULTI 0
#endif

#define LAS __attribute__((address_space(3)))
#define GAS __attribute__((address_space(1)))
typedef unsigned short bf16_t;
typedef short bf16x8 __attribute__((ext_vector_type(8)));
typedef short s16x4 __attribute__((ext_vector_type(4)));
typedef float f32x2 __attribute__((ext_vector_type(2)));
typedef float f32x4 __attribute__((ext_vector_type(4)));
typedef float f32x16 __attribute__((ext_vector_type(16)));
typedef unsigned u32x2 __attribute__((ext_vector_type(2)));
typedef unsigned u32x4 __attribute__((ext_vector_type(4)));
typedef __bf16 bf16x2_t __attribute__((ext_vector_type(2)));
typedef int i32x4 __attribute__((ext_vector_type(4)));
typedef int i32x8 __attribute__((ext_vector_type(8)));
constexpr float SC8_H = 4.0f, SC8_W = 64.0f, SC8_HID = 8.0f;

constexpr int DM = 1024, BATCH = 16, SEQ = 4096, NTOK = BATCH * SEQ;
constexpr int DFF = 3072, NEXP = 8, DFE = 3584;
constexpr int NSLOT = 135168;
constexpr int MAXTILES = NSLOT / 256;
constexpr float EPS = 1e-6f;
constexpr float LOG2E = 1.4426950408889634f;

constexpr size_t MiB = 1u << 20;
constexpr size_t WS_CTL = 0, CTL_ZERO_BYTES = 1 * MiB;
constexpr size_t WS_MODV = 1 * MiB;
constexpr size_t WS_KVMOD = 3 * MiB;
constexpr size_t WS_PAR = 3 * MiB + 512 * 1024;
constexpr int PAR_MIXN = 0, PAR_FFNN = 4096, PAR_CONVW = 8192, PAR_CONVB = 16384, PAR_GXB = 18432, PAR_GAB = 20480, PAR_LAM = 22528, PAR_KVN = 24576, PAR_KN = 25600, PAR_QN = 25664, PAR_SINK = 25792, PAR_ROUTER = 25856, PAR_END = 42240;
constexpr size_t WS_E12 = 4 * MiB;
constexpr size_t WS_W1 = 5 * MiB;
constexpr size_t WS_CNT = 6 * MiB;
constexpr size_t WS_TILE = 6 * MiB + 65536;
constexpr size_t WS_TOS = 7 * MiB;
constexpr size_t WS_WOS = 8 * MiB;
constexpr size_t WS_GW = 9 * MiB;
constexpr size_t WS_COS = 10 * MiB;
constexpr size_t WS_SIN = 18 * MiB;
constexpr size_t WS_WIN = 26 * MiB;
constexpr size_t WS_WOUT = 34 * MiB;
constexpr size_t WS_WKV = 38 * MiB;
constexpr size_t WS_WQ = 39 * MiB;
constexpr size_t WS_WO = 43 * MiB;
constexpr size_t WS_FGU = 47 * MiB;
constexpr size_t WS_FDN = 71 * MiB;
constexpr size_t WS_MGU = 83 * MiB;
constexpr size_t WS_MDN = 307 * MiB;
constexpr size_t WS_H = 419 * MiB;
constexpr size_t WS_HKV = 547 * MiB;
constexpr size_t WS_KB = 675 * MiB;
constexpr size_t WS_VB = 707 * MiB;
constexpr size_t WS_ARENA = 739 * MiB;
constexpr size_t WS_END = WS_ARENA + (size_t)NSLOT * DFE * 2;
static_assert(WS_END <= (size_t)1792 * MiB, "workspace map");
constexpr size_t AR_XB = 0, AR_GY = 128 * MiB, AR_Q = 0, AR_O = 128 * MiB;

constexpr int CW_BAR = 4096;

constexpr int LDS_BYTES = 163840;
constexpr int RING_BYTES = 131072;
constexpr int LDS_TEXP = RING_BYTES;
constexpr int LDS_IDX = RING_BYTES + 4096;
constexpr int LDS_MISC = LDS_BYTES - 256;

__device__ __forceinline__ unsigned cvtpk(float lo, float hi) { f32x2 v = {lo, hi}; bf16x2_t b = __builtin_convertvector(v, bf16x2_t); return __builtin_bit_cast(unsigned, b); }
__device__ __forceinline__ float clamp8(float v) { return __builtin_amdgcn_fmed3f(v, -448.0f, 448.0f); }
__device__ __forceinline__ unsigned cvt4_fp8(float a, float b, float c, float d) { int p = __builtin_amdgcn_cvt_pk_fp8_f32(clamp8(a), clamp8(b), 0, false); p = __builtin_amdgcn_cvt_pk_fp8_f32(clamp8(c), clamp8(d), p, true); return (unsigned)p; }
__device__ __forceinline__ float bf2f(unsigned short b) { return __uint_as_float(((unsigned)b) << 16); }
__device__ __forceinline__ float fast_exp2(float x) { return __builtin_amdgcn_exp2f(x); }
__device__ __forceinline__ float fast_rcp(float x) { return __builtin_amdgcn_rcpf(x); }
__device__ __forceinline__ float sigmoidf_(float x) { return fast_rcp(1.0f + fast_exp2(-x * LOG2E)); }
__device__ __forceinline__ float silu_(float x) { return x * sigmoidf_(x); }
__device__ __forceinline__ float gelu_tanh_(float x) { const float u = 0.7978845608028654f * (x + 0.044715f * x * x * x); return x * sigmoidf_(2.0f * u); }
__device__ __forceinline__ float shflx(float v, int lane, int o) { return __int_as_float(__builtin_amdgcn_ds_bpermute((lane ^ o) << 2, __float_as_int(v))); }
__device__ __forceinline__ float wave_sum(float v, int lane) {
#pragma unroll
    for (int o = 1; o < 64; o <<= 1) v += shflx(v, lane, o);
    return v;
}
__device__ __forceinline__ int lane_id_v() { int l; asm volatile("v_mbcnt_lo_u32_b32 %0, -1, 0\n\tv_mbcnt_hi_u32_b32 %0, -1, %0" : "=v"(l)); return l; }
#define LDS_WAIT() asm volatile("s_waitcnt lgkmcnt(0)" ::: "memory")
#define VM_WAIT() asm volatile("s_waitcnt vmcnt(0)" ::: "memory")

namespace pg8 {
constexpr int BM = 256, BK = 64, HALF = 128, HTB = HALF * BK * 2, STAGE_BYTES = 8 * HTB, NXCD = 8, WGM = 8;
__host__ __device__ __forceinline__ int lds_byte(int r, int c) { const int st = (r >> 4) * 2 + (c >> 5), rr = r & 15, cc = c & 31, ob = rr * 64 + cc * 2; return st * 1024 + (ob ^ (((ob >> 9) & 1) << 5)); }
__host__ __device__ __forceinline__ void stage_rc(int b, int& R, int& C) { const int st = b / 1024, sb = b % 1024, swz = sb ^ (((sb >> 9) & 1) << 5); R = (st >> 1) * 16 + swz / 64; C = (st & 1) * 32 + (swz % 64) / 2; }
__host__ __device__ __forceinline__ int perm32(int rho) { const int n = rho >> 4, i = rho & 15; return 8 * (i >> 2) + 4 * n + (i & 3); }

struct Unit { int pm, pn; };

struct Order {
    int nM, nN, nwg, G, c, tile0;
    __device__ __forceinline__ void init(int nM_, int nN_, int G_, int c_, int tile0_) { nM = nM_; nN = nN_; nwg = nM * nN; G = G_; c = c_; tile0 = tile0_; }
    __device__ __forceinline__ bool next(int i, Unit& u) const {
        const long L = (long)i * G + c; if (L >= nwg) return false;
        int wgid = (int)L; { const int q = nwg / NXCD, r = nwg % NXCD, xcd = wgid % NXCD, off = wgid / NXCD; wgid = (xcd < r ? xcd * (q + 1) : r * (q + 1) + (xcd - r) * q) + off; }
        const int nig = WGM * nN, gid = wgid / nig, fm = gid * WGM, gsz = (nM - fm) < WGM ? (nM - fm) : WGM;
        u.pm = tile0 + fm + ((wgid % nig) % gsz); u.pn = (wgid % nig) / gsz; return true;
    }
};

struct ProbDense {
    const void* A; const void* Bt; int KB;
    __device__ __forceinline__ const char* a_ptr(const Unit& u) const { return (const char*)A + (size_t)u.pm * BM * KB; }
    __device__ __forceinline__ const char* b_ptr(const Unit& u) const { return (const char*)Bt + (size_t)u.pn * BM * KB; }
};
struct ProbGrouped {
    const void* A; const void* Bt; int KB; int N; const LAS int* texp; const int* tos;
    __device__ __forceinline__ const char* a_ptr(const Unit& u) const { return (const char*)A + (size_t)u.pm * BM * KB; }
    __device__ __forceinline__ const char* b_ptr(const Unit& u) const { return (const char*)Bt + ((size_t)texp[u.pm] * N + (size_t)u.pn * BM) * KB; }
};

template <class Epi, class Prob, bool GATHER, bool FP8 = false>
__device__ __forceinline__ void gemm_phase(LAS unsigned char* lds, const int tid, const Prob P, const Order& S, const Epi& E) {
    const int wid = __builtin_amdgcn_readfirstlane(tid >> 6), lane = tid & 63, wr = wid >> 2, wc = wid & 3, fr = lane & 15, fq = lane >> 4;
    const int KB = P.KB, nt = KB / (BK * 2);
    unsigned voffA[2], voffB[2];
#pragma unroll
    for (int i = 0; i < 2; ++i) { int R, C; stage_rc(tid * 16 + i * 8192, R, C); const int Rb = Epi::PERM ? ((R & ~31) + perm32(R & 31)) : R;
        voffA[i] = GATHER ? (unsigned)(C * 2) : (unsigned)(R * KB + C * 2); voffB[i] = (unsigned)(Rb * KB + C * 2); }
    const size_t kstep = (size_t)(BK * 2);
    const size_t hstep = (size_t)HALF * KB;
    const unsigned ldsw = (unsigned)wid * 1024u;
    const int aoff = lds_byte(wr * 64 + fr, fq * 8), boff = lds_byte(wc * 32 + fr, fq * 8);
    LAS int* idxb = (LAS int*)(lds + LDS_IDX);
#define PG8_GIDX(buf) do { int ln_ = lane; asm volatile("" : "+v"(ln_)); _Pragma("unroll") for (int i = 0; i < 2; ++i) { const int R_ = 16 * ((wid + 8 * i) >> 1) + (ln_ >> 2); \
        int t0 = idxb[(buf) * 256 + R_], t1 = idxb[(buf) * 256 + 128 + R_]; t0 = t0 < 0 ? 0 : t0; t1 = t1 < 0 ? 0 : t1; \
        vC0[i] = (unsigned)t0 * (unsigned)KB + voffA[i]; vC1[i] = (unsigned)t1 * (unsigned)KB + voffA[i]; } } while (0)
#define PG8_GDMA(unit, buf) do { if (wid < 4) { int ln_ = lane; asm volatile("" : "+v"(ln_)); \
        __builtin_amdgcn_global_load_lds((const unsigned*)(P.tos + (size_t)(unit).pm * BM + wid * 64) + ln_, (LAS unsigned*)(idxb + (buf) * 256 + wid * 64), 4, 0, 0); } } while (0)
#define PG8_SA(b, h) (((b) * 2 + (h)) * HTB)
#define PG8_SB(b, h) ((4 + (b) * 2 + (h)) * HTB)
#define PG8_STAGE(bufoff, gbase, voff) do { const char* g_ = (const char*)(gbase); asm volatile("" : "+s"(g_)); _Pragma("unroll") for (int _i = 0; _i < 2; ++_i) \
        __builtin_amdgcn_global_load_lds((const unsigned*)(g_ + (voff)[_i]), (LAS unsigned*)(lds + (bufoff) + ldsw + _i * 8192), 16, 0, 0); } while (0)
#define PG8_LDA(dst, b, h) do { _Pragma("unroll") for (int m = 0; m < 4; ++m) _Pragma("unroll") for (int k = 0; k < 2; ++k) dst[m][k] = *(const LAS bf16x8*)(lds + PG8_SA(b, h) + aoff + m * 2048 + k * 1024); } while (0)
#define PG8_LDB(dst, b, h) do { _Pragma("unroll") for (int n = 0; n < 2; ++n) _Pragma("unroll") for (int k = 0; k < 2; ++k) dst[n][k] = *(const LAS bf16x8*)(lds + PG8_SB(b, h) + boff + n * 2048 + k * 1024); } while (0)
#define PG8_CAT8(v) __builtin_shufflevector(__builtin_bit_cast(i32x4, (v)[0]), __builtin_bit_cast(i32x4, (v)[1]), 0, 1, 2, 3, 4, 5, 6, 7)
#define PG8_MMA(ai, bj, At, Bt) do { __builtin_amdgcn_s_setprio(1); if constexpr (FP8) asm volatile("s_nop 1"); _Pragma("unroll") for (int m = 0; m < 4; ++m) _Pragma("unroll") for (int n = 0; n < 2; ++n) { \
        if constexpr (FP8) { const i32x8 b8_ = PG8_CAT8(Bt[n]), a8_ = PG8_CAT8(At[m]);   \
            asm volatile("v_mfma_scale_f32_16x16x128_f8f6f4 %0, %1, %2, %0, %3, %3 op_sel_hi:[0,0,0]" : "+v"(acc[ai][bj][m][n]) : "v"(b8_), "v"(a8_), "v"(sc8)); } \
        else { _Pragma("unroll") for (int k = 0; k < 2; ++k) acc[ai][bj][m][n] = __builtin_amdgcn_mfma_f32_16x16x32_bf16(Bt[n][k], At[m][k], acc[ai][bj][m][n], 0, 0, 0); } } __builtin_amdgcn_s_setprio(0); } while (0)
#define PG8_WAIT_V(n) asm volatile("s_waitcnt vmcnt(" #n ")" ::: "memory")
#define PG8_WAIT_L(n) asm volatile("s_waitcnt lgkmcnt(" #n ")" ::: "memory")
#define PG8_BAR __builtin_amdgcn_s_barrier()
#define PG8_SCHED __builtin_amdgcn_sched_barrier(0)
    Unit cur, nxt; int ui = 0;
    if (!S.next(0, cur)) return;
    f32x4 acc[2][2][4][2];
#pragma unroll
    for (int a = 0; a < 2; ++a)
#pragma unroll
        for (int b = 0; b < 2; ++b)
#pragma unroll
            for (int m = 0; m < 4; ++m)
#pragma unroll
                for (int n = 0; n < 2; ++n) acc[a][b][m][n] = (f32x4){0.f, 0.f, 0.f, 0.f};
    bf16x8 At[4][2], B0[2][2], B1[2][2];
    int sc8 = 0x7F7F7F7F; if constexpr (FP8) asm volatile("" : "+v"(sc8));
    unsigned vC0[2], vC1[2];
    const char* cA; const char* cB = P.b_ptr(cur);
    if constexpr (GATHER) {
        cA = (const char*)P.A;
        PG8_GDMA(cur, 0);
        PG8_WAIT_V(0); PG8_BAR;
        PG8_GIDX(0);
        LDS_WAIT(); PG8_BAR;
    } else {
        cA = P.a_ptr(cur);
#pragma unroll
        for (int i = 0; i < 2; ++i) { vC0[i] = voffA[i]; vC1[i] = voffA[i] + (unsigned)hstep; }
    }
    PG8_STAGE(PG8_SB(0, 0), cB, voffB); PG8_STAGE(PG8_SB(0, 1), cB + hstep, voffB); PG8_STAGE(PG8_SA(0, 0), cA, vC0); PG8_STAGE(PG8_SA(0, 1), cA, vC1);
    if (wr == 1) PG8_BAR;
    PG8_WAIT_V(2); PG8_BAR;
    PG8_STAGE(PG8_SB(1, 0), cB + kstep, voffB); PG8_STAGE(PG8_SA(1, 0), cA + kstep, vC0); PG8_STAGE(PG8_SB(1, 1), cB + hstep + kstep, voffB);
    PG8_WAIT_V(6); PG8_BAR;
    for (;;) {
        const bool has_next = S.next(ui + 1, nxt);
        const char* nA = GATHER ? cA : (has_next ? P.a_ptr(nxt) : cA); const char* nB = has_next ? P.b_ptr(nxt) : cB;
        for (int t = 0; t < nt; t += 2) {
            const bool last = (t == nt - 2);
            if constexpr (GATHER) {
                if (t == 0 && has_next) PG8_GDMA(nxt, (ui + 1) & 1);
            }
            const char* a1 = cA + (size_t)(t + 1) * kstep;
            const char* a2 = last ? nA : cA + (size_t)(t + 2) * kstep; const char* b2 = last ? nB : cB + (size_t)(t + 2) * kstep;
            const char* a3 = a2 + kstep; const char* b3 = b2 + kstep;
            PG8_LDB(B0, 0, 0); PG8_LDB(B1, 0, 1); PG8_SCHED; PG8_LDA(At, 0, 0); PG8_STAGE(PG8_SA(1, 1), a1, vC1);
            if constexpr (GATHER) { if (last && has_next) PG8_GIDX((ui + 1) & 1); }
            PG8_WAIT_V(8); PG8_WAIT_L(0); PG8_BAR; PG8_MMA(0, 0, At, B0); PG8_MMA(0, 1, At, B1); PG8_BAR; PG8_SCHED;
            PG8_LDA(At, 0, 1); PG8_STAGE(PG8_SB(0, 0), b2, voffB); PG8_STAGE(PG8_SB(0, 1), b2 + hstep, voffB); PG8_STAGE(PG8_SA(0, 0), a2, vC0);
            PG8_WAIT_V(8); PG8_WAIT_L(0); PG8_BAR; PG8_MMA(1, 0, At, B0); PG8_MMA(1, 1, At, B1); PG8_BAR; PG8_SCHED;
            PG8_LDB(B0, 1, 0); PG8_LDB(B1, 1, 1); PG8_SCHED; PG8_LDA(At, 1, 0); PG8_STAGE(PG8_SA(0, 1), a2, vC1);
            PG8_WAIT_V(8); PG8_WAIT_L(0); PG8_BAR; PG8_MMA(0, 0, At, B0); PG8_MMA(0, 1, At, B1); PG8_BAR; PG8_SCHED;
            PG8_LDA(At, 1, 1); PG8_STAGE(PG8_SB(1, 0), b3, voffB); PG8_STAGE(PG8_SB(1, 1), b3 + hstep, voffB); PG8_STAGE(PG8_SA(1, 0), a3, vC0);
            PG8_WAIT_V(8); PG8_WAIT_L(0); PG8_BAR; PG8_MMA(1, 0, At, B0); PG8_MMA(1, 1, At, B1); PG8_BAR; PG8_SCHED;
        }
        if constexpr (FP8) { asm volatile("s_nop 15\n\ts_nop 15" ::: "memory"); PG8_SCHED; }
        if (wr == 0) PG8_BAR;
        { int fr_ = fr, fq_ = fq; asm volatile("" : "+v"(fr_), "+v"(fq_)); E(acc, cur, wr, wc, fr_, fq_); }
        if (!has_next) break;
#pragma unroll
        for (int a = 0; a < 2; ++a)
#pragma unroll
            for (int b = 0; b < 2; ++b)
#pragma unroll
                for (int m = 0; m < 4; ++m)
#pragma unroll
                    for (int n = 0; n < 2; ++n) acc[a][b][m][n] = (f32x4){0.f, 0.f, 0.f, 0.f};
        cur = nxt; cA = nA; cB = nB; ++ui;
        if (wr == 1) PG8_BAR;
    }
    PG8_WAIT_V(0);
    PG8_BAR;
#undef PG8_SA
#undef PG8_GIDX
#undef PG8_GDMA
#undef PG8_SB
#undef PG8_STAGE
#undef PG8_LDA
#undef PG8_LDB
#undef PG8_MMA
#undef PG8_CAT8
#undef PG8_WAIT_V
#undef PG8_WAIT_L
#undef PG8_BAR
#undef PG8_SCHED
}

struct EpiResid {
    static constexpr bool PERM = false;
    const float* xin; float* xout; const float* gate; float ascale;
    __device__ __forceinline__ void operator()(const f32x4 (&acc)[2][2][4][2], const Unit& u, int wr, int wc, int fr, int fq) const {
        const int row0 = u.pm * BM + wr * 64 + fr, col0 = u.pn * BM + wc * 32 + 4 * fq;
        const float* gp = gate + (size_t)((u.pm * BM) >> 12) * 6144 + col0;
        f32x4 gv[2][2];
#pragma unroll
        for (int bj = 0; bj < 2; ++bj)
#pragma unroll
            for (int n = 0; n < 2; ++n) gv[bj][n] = (*(const f32x4*)(gp + bj * HALF + n * 16) + 1.0f) * ascale;
#pragma unroll
        for (int ai = 0; ai < 2; ++ai)
#pragma unroll
            for (int m = 0; m < 4; ++m) { const size_t off = (size_t)(row0 + ai * HALF + m * 16) * DM + col0;
#pragma unroll
                for (int bj = 0; bj < 2; ++bj)
#pragma unroll
                    for (int n = 0; n < 2; ++n) { const f32x4 xv = *(const f32x4*)(xin + off + bj * HALF + n * 16); *(f32x4*)(xout + off + bj * HALF + n * 16) = xv + gv[bj][n] * acc[ai][bj][m][n]; }
                asm volatile("" ::: "memory"); }
    }
};
struct EpiMoeDown {
    static constexpr bool PERM = false;
    float* x; const float* gate; const int* tos; const float* wos; float ascale;
    __device__ __forceinline__ void operator()(const f32x4 (&acc)[2][2][4][2], const Unit& u, int wr, int wc, int fr, int fq) const {
        const int slot0 = u.pm * BM + wr * 64 + fr, col0 = u.pn * BM + wc * 32 + 4 * fq;
#pragma unroll
        for (int ai = 0; ai < 2; ++ai)
#pragma unroll
            for (int m = 0; m < 4; ++m) { const int slot = slot0 + ai * HALF + m * 16; const int tok = tos[slot]; const float w = wos[slot] * ascale;
                if (tok >= 0) { const float* gp = gate + (size_t)(tok >> 12) * 6144 + col0; float* xp = x + (size_t)tok * DM + col0;
#pragma unroll
                    for (int bj = 0; bj < 2; ++bj)
#pragma unroll
                        for (int n = 0; n < 2; ++n) { const f32x4 g = (*(const f32x4*)(gp + bj * HALF + n * 16) + 1.0f) * w; const f32x4 xv = *(const f32x4*)(xp + bj * HALF + n * 16);
                            *(f32x4*)(xp + bj * HALF + n * 16) = xv + g * acc[ai][bj][m][n]; } }
                asm volatile("" ::: "memory"); }
    }
};
template <bool OUT8> struct EpiSwiglu {
    static constexpr bool PERM = true;
    void* O; int ldo; float ascale;
    __device__ __forceinline__ void operator()(const f32x4 (&acc)[2][2][4][2], const Unit& u, int wr, int wc, int fr, int fq) const {
        const int row0 = u.pm * BM + wr * 64 + fr, col0 = u.pn * HALF + wc * 32 + 8 * fq;
#pragma unroll
        for (int ai = 0; ai < 2; ++ai)
#pragma unroll
            for (int m = 0; m < 4; ++m) { const size_t eo = (size_t)(row0 + ai * HALF + m * 16) * ldo + col0;
                float v[8];
#pragma unroll
                for (int n = 0; n < 2; ++n)
#pragma unroll
                    for (int j = 0; j < 4; ++j) v[4 * n + j] = silu_(acc[ai][0][m][n][j] * ascale) * (acc[ai][1][m][n][j] * ascale);
                if constexpr (OUT8) { u32x2 w; w.x = cvt4_fp8(v[0] * SC8_HID, v[1] * SC8_HID, v[2] * SC8_HID, v[3] * SC8_HID); w.y = cvt4_fp8(v[4] * SC8_HID, v[5] * SC8_HID, v[6] * SC8_HID, v[7] * SC8_HID);
                    *(u32x2*)((unsigned char*)O + eo) = w; }
                else { u32x4 w; w.x = cvtpk(v[0], v[1]); w.y = cvtpk(v[2], v[3]); w.z = cvtpk(v[4], v[5]); w.w = cvtpk(v[6], v[7]);
                    *(u32x4*)((bf16_t*)O + eo) = w; } }
    }
};
struct EpiWin {
    static constexpr bool PERM = true;
    bf16_t* XB; bf16_t* GY;
    __device__ __forceinline__ void operator()(const f32x4 (&acc)[2][2][4][2], const Unit& u, int wr, int wc, int fr, int fq) const {
        const bool act = u.pn >= 4; bf16_t* base = act ? GY : XB;
        const int row0 = u.pm * BM + wr * 64 + fr, col0 = (u.pn & 3) * BM + wc * 32 + 8 * fq;
#pragma unroll
        for (int ai = 0; ai < 2; ++ai)
#pragma unroll
            for (int m = 0; m < 4; ++m) { bf16_t* rowp = base + (size_t)(row0 + ai * HALF + m * 16) * DM + col0;
#pragma unroll
                for (int bj = 0; bj < 2; ++bj) { f32x4 v0 = acc[ai][bj][m][0], v1 = acc[ai][bj][m][1];
                    if (act) {
#pragma unroll
                        for (int j = 0; j < 4; ++j) { v0[j] = gelu_tanh_(v0[j]); v1[j] = gelu_tanh_(v1[j]); } }
                    u32x4 w; w.x = cvtpk(v0[0], v0[1]); w.y = cvtpk(v0[2], v0[3]); w.z = cvtpk(v1[0], v1[1]); w.w = cvtpk(v1[2], v1[3]);
                    *(u32x4*)(rowp + bj * HALF) = w; } }
    }
};
struct EpiQK {
    static constexpr bool PERM = true;
    bf16_t* O; int ldo; const float* gain; const float* cosT; const float* sinT; float oscale; int vtile; bf16_t* OV;
    __device__ __forceinline__ void operator()(const f32x4 (&acc)[2][2][4][2], const Unit& u, int wr, int wc, int fr, int fq) const {
        const int row0 = u.pm * BM + wr * 64 + fr;
        if (u.pn == vtile) {
            const int col0 = wc * 32 + 8 * fq;
#pragma unroll
            for (int ai = 0; ai < 2; ++ai)
#pragma unroll
                for (int m = 0; m < 4; ++m) { bf16_t* rowp = OV + (size_t)(row0 + ai * HALF + m * 16) * ldo + col0;
#pragma unroll
                    for (int bj = 0; bj < 2; ++bj) { const f32x4 v0 = acc[ai][bj][m][0], v1 = acc[ai][bj][m][1];
                        u32x4 w; w.x = cvtpk(v0[0], v0[1]); w.y = cvtpk(v0[2], v0[3]); w.z = cvtpk(v1[0], v1[1]); w.w = cvtpk(v1[2], v1[3]);
                        *(u32x4*)(rowp + bj * HALF) = w; } }
            return;
        }
        const int colh = (u.pn * 4 + wc) * 64 + 8 * fq;
        f32x4 g1[2], g2[2];
#pragma unroll
        for (int n = 0; n < 2; ++n) { g1[n] = *(const f32x4*)(gain + 8 * fq + 4 * n); g2[n] = *(const f32x4*)(gain + 32 + 8 * fq + 4 * n); }
#pragma unroll
        for (int ai = 0; ai < 2; ++ai)
#pragma unroll
            for (int m = 0; m < 4; ++m) { const int row = row0 + ai * HALF + m * 16;
                float ss = 0.f;
#pragma unroll
                for (int bj = 0; bj < 2; ++bj)
#pragma unroll
                    for (int n = 0; n < 2; ++n) { const f32x4 a = acc[ai][bj][m][n]; ss += (a[0] * a[0] + a[1] * a[1]) + (a[2] * a[2] + a[3] * a[3]); }
                { const int ln_ = fq * 16 + fr; ss += shflx(ss, ln_, 16); ss += shflx(ss, ln_, 32); }
                const float r = __builtin_amdgcn_rsqf(ss * (1.0f / 64.0f) + EPS) * oscale;
                float o1[8], o2[8];
#pragma unroll
                for (int n = 0; n < 2; ++n) { const f32x4 c = *(const f32x4*)(cosT + (size_t)row * 32 + 8 * fq + 4 * n), s = *(const f32x4*)(sinT + (size_t)row * 32 + 8 * fq + 4 * n);
                    const f32x4 x1 = acc[ai][0][m][n] * g1[n] * r, x2 = acc[ai][1][m][n] * g2[n] * r;
                    const f32x4 a = x1 * c - x2 * s, b = x2 * c + x1 * s;
#pragma unroll
                    for (int j = 0; j < 4; ++j) { o1[4 * n + j] = a[j]; o2[4 * n + j] = b[j]; } }
                bf16_t* rowp = O + (size_t)row * ldo + colh;
                u32x4 w; w.x = cvtpk(o1[0], o1[1]); w.y = cvtpk(o1[2], o1[3]); w.z = cvtpk(o1[4], o1[5]); w.w = cvtpk(o1[6], o1[7]);
                *(u32x4*)rowp = w;
                w.x = cvtpk(o2[0], o2[1]); w.y = cvtpk(o2[2], o2[3]); w.z = cvtpk(o2[4], o2[5]); w.w = cvtpk(o2[6], o2[7]);
                *(u32x4*)(rowp + 32) = w;
                asm volatile("" ::: "memory"); }
    }
};
}

#define XB_TMO      128
#define XB_XCNT(j)  (256  + 64 * (j))
#define XB_XSUB(j)  (1280 + 64 * (j))
#define XB_XGEN(j)  (2304 + 64 * (j))
#define XB_TOP      3328
#define XB_TOPGEN   3392
#define XCD_BAR_WORDS 3456
#define XB_SPIN_CAP (1u << 20)
__device__ __forceinline__ unsigned xb_ld(unsigned* p)              { return __hip_atomic_load(p, __ATOMIC_RELAXED, __HIP_MEMORY_SCOPE_AGENT); }
__device__ __forceinline__ unsigned xb_add(unsigned* p, unsigned v) { return __hip_atomic_fetch_add(p, v, __ATOMIC_RELAXED, __HIP_MEMORY_SCOPE_AGENT); }
__device__ __forceinline__ unsigned xb_xcc_id() { return (unsigned)__builtin_amdgcn_s_getreg((3 << 11) | 20) & 0xFu; }
#define XB_SPIN(cond, bar) do { unsigned _sp = 0; while (cond) { __builtin_amdgcn_s_sleep(1); \
    if ((++_sp & 255u) == 0u) { if (xb_ld(&(bar)[XB_TMO])) break; if (_sp > XB_SPIN_CAP) { atomicAdd(&(bar)[XB_TMO], 1u); break; } } } } while (0)
struct XcdBarrier { unsigned* bar; unsigned x; volatile LAS unsigned* st; };
__device__ __forceinline__ XcdBarrier xcd_barrier_post(unsigned* bar, volatile LAS unsigned* st, int wv) {
    XcdBarrier b; b.bar = bar; b.x = xb_xcc_id(); b.st = st;
    if (wv == 0 && lane_id_v() == 0) (void)xb_add(&bar[XB_XCNT(b.x)], 1u);
    return b;
}
__device__ __forceinline__ void xcd_barrier_complete(unsigned* bar, unsigned x, unsigned& nloc, unsigned& nx) {
    const unsigned G = gridDim.x * gridDim.y * gridDim.z;
    unsigned sum, cnt, mine, sp = 0u;
    for (;;) {
        sum = 0u; cnt = 0u; mine = 0u;
#pragma unroll
        for (unsigned j = 0; j < 16; ++j) { const unsigned c = xb_ld(&bar[XB_XCNT(j)]); sum += c; cnt += (c > 0u) ? 1u : 0u; mine = (j == x) ? c : mine; }
        if (sum == G) break;
        __builtin_amdgcn_s_sleep(1);
        if ((++sp & 255u) == 0u) { if (xb_ld(&bar[XB_TMO])) break; if (sp > XB_SPIN_CAP) { atomicAdd(&bar[XB_TMO], 1u); break; } }
    }
    nloc = mine > 0u ? mine : 1u; nx = cnt > 0u ? cnt : 1u;
}
__device__ __forceinline__ void xcd_barrier(const XcdBarrier& b, int wv) {
    asm volatile("s_waitcnt vmcnt(0)" ::: "memory");
    __syncthreads();
    if (wv == 0 && lane_id_v() == 0) {
        unsigned* bar = b.bar;
        __builtin_amdgcn_s_waitcnt(0);
        unsigned nloc = b.st[0], nx = b.st[1];
        if (nloc == 0u) { xcd_barrier_complete(bar, b.x, nloc, nx); b.st[0] = nloc; b.st[1] = nx; }
        const unsigned old = xb_add(&bar[XB_XSUB(b.x)], 1u);
        const unsigned gen = old / nloc;
        if (old + 1u == (gen + 1u) * nloc) {
            __builtin_amdgcn_fence(__ATOMIC_RELEASE, "agent");
            asm volatile("s_waitcnt vmcnt(0)" ::: "memory");
            const unsigned og = xb_add(&bar[XB_TOP], 1u);
            const unsigned tg = og / nx;
            if (og + 1u == (tg + 1u) * nx) xb_add(&bar[XB_TOPGEN], 1u);
            else XB_SPIN(xb_ld(&bar[XB_TOPGEN]) == tg, bar);
            __builtin_amdgcn_fence(__ATOMIC_ACQUIRE, "agent");
            xb_add(&bar[XB_XGEN(b.x)], 1u);
            asm volatile("s_waitcnt vmcnt(0)" ::: "memory");
        } else {
            XB_SPIN(xb_ld(&bar[XB_XGEN(b.x)]) == gen, bar);
            __builtin_amdgcn_fence(__ATOMIC_ACQUIRE, "agent");
            asm volatile("s_waitcnt vmcnt(0)" ::: "memory");
        }
    }
    __syncthreads();
}

struct Args {
    const float* x; const float* c; const int* pos; const float* ada_w; const float* ada_b; const float* mix_norm; const float* ffn_norm;
    const float* a_w_in; const float* a_conv_w; const float* a_conv_b; const float* a_gx_w; const float* a_gx_b; const float* a_ga_w; const float* a_ga_b;
    const float* a_lambda; const float* a_w_out; const float* kv_norm; const float* kv_ada_w; const float* kv_ada_b; const float* w_kv; const float* k_norm;
    const float* b_w_q; const float* b_q_norm; const float* b_sinks; const float* b_w_o; const float* f_w_gu; const float* f_w_down; const float* m_router;
    const float* m_w_gu; const float* m_w_down;
    float* out; unsigned char* ws; int ph_lo, ph_hi;
};

struct Ctx {
    LAS unsigned char* lds; int tid, lane, wave, vcu, G, cid;
};

__device__ __forceinline__ void transpose_item(const float* W, int K, int N, bf16_t* WT, int k0, int n0, int drow0, LAS float* scr, int lane) {
#pragma unroll 8
    for (int i = 0; i < 32; ++i) { const int kk = 2 * i + (lane >> 5); scr[kk * 33 + (lane & 31)] = W[(size_t)(k0 + kk) * N + n0 + (lane & 31)]; }
    LDS_WAIT(); asm volatile("" ::: "memory");
    const int c = lane & 7;
#pragma unroll
    for (int j = 0; j < 4; ++j) { const int n = (lane >> 3) + 8 * j; const LAS float* s = scr + (8 * c) * 33 + n;
        u32x4 o; o.x = cvtpk(s[0 * 33], s[1 * 33]); o.y = cvtpk(s[2 * 33], s[3 * 33]); o.z = cvtpk(s[4 * 33], s[5 * 33]); o.w = cvtpk(s[6 * 33], s[7 * 33]);
        *(u32x4*)(WT + (size_t)(drow0 + n) * K + k0 + 8 * c) = o; }
    LDS_WAIT(); asm volatile("" ::: "memory");
}
__device__ __forceinline__ void transpose_item_fp8(const float* W, int K, int N, unsigned char* WT, int k0, int n0, int drow0, LAS float* scr, int lane, float scale) {
#pragma unroll 8
    for (int i = 0; i < 32; ++i) { const int kk = 2 * i + (lane >> 5); scr[kk * 33 + (lane & 31)] = W[(size_t)(k0 + kk) * N + n0 + (lane & 31)]; }
    LDS_WAIT(); asm volatile("" ::: "memory");
    const int c = lane & 7;
#pragma unroll
    for (int j = 0; j < 4; ++j) { const int n = (lane >> 3) + 8 * j; const LAS float* s = scr + (8 * c) * 33 + n;
        u32x2 o; o.x = cvt4_fp8(s[0 * 33] * scale, s[1 * 33] * scale, s[2 * 33] * scale, s[3 * 33] * scale); o.y = cvt4_fp8(s[4 * 33] * scale, s[5 * 33] * scale, s[6 * 33] * scale, s[7 * 33] * scale);
        *(u32x2*)(WT + (size_t)(drow0 + n) * K + k0 + 8 * c) = o; }
    LDS_WAIT(); asm volatile("" ::: "memory");
}
__device__ __forceinline__ int map_plain(int n) { return n; }
__device__ __forceinline__ int map_head(int n) { const int hd = n >> 6, d = n & 63; return 256 * (hd >> 2) + 128 * (d >> 5) + 32 * (hd & 3) + (d & 31); }
__device__ __forceinline__ int map_gu(int n, int F) { const int u = n >= F, j = u ? n - F : n; return 256 * (j >> 7) + 128 * u + (j & 127); }

__device__ __forceinline__ void p0_prologue(const Ctx& F, const Args& a) {
    unsigned char* ws = a.ws;
    {
        LAS float* cs = (LAS float*)F.lds;
        LAS float* red = (LAS float*)(F.lds + 65536);
        for (int i = F.tid; i < BATCH * DM; i += 512) { const int b = i >> 10, k = i & 1023; const float v = a.c[i]; cs[k * 16 + b] = silu_(v); }
        __syncthreads();
        float* modv = (float*)(ws + WS_MODV); float* kvmod = (float*)(ws + WS_KVMOD);
        constexpr int NC = 4 * 6144 + 2048, CPB = 104;
        for (int cb = F.vcu; cb * CPB < NC; cb += F.G) {
            const int cl = F.tid & 127, kp = F.tid >> 7, j = cb * CPB + cl;
            const bool on = (cl < CPB) && (j < NC);
            float accv[16];
#pragma unroll
            for (int b = 0; b < 16; ++b) accv[b] = 0.f;
            if (on) {
                const float* W; int ldw, jj;
                if (j < 4 * 6144) { const int l = j / 6144; jj = j - l * 6144; W = a.ada_w + (size_t)l * DM * 6144; ldw = 6144; } else { jj = j - 4 * 6144; W = a.kv_ada_w; ldw = 2048; }
                const float* wp = W + (size_t)(kp * 256) * ldw + jj;
#pragma unroll 4
                for (int k = 0; k < 256; ++k) { const float w = wp[(size_t)k * ldw]; const LAS f32x4* cv = (const LAS f32x4*)(cs + (kp * 256 + k) * 16);
#pragma unroll
                    for (int q = 0; q < 4; ++q) { const f32x4 c4 = cv[q]; accv[4 * q] += w * c4[0]; accv[4 * q + 1] += w * c4[1]; accv[4 * q + 2] += w * c4[2]; accv[4 * q + 3] += w * c4[3]; } }
            }
#pragma unroll
            for (int b = 0; b < 16; ++b) red[(kp * 128 + cl) * 16 + b] = accv[b];
            __syncthreads();
            for (int i = F.tid; i < CPB * 16; i += 512) { const int cl2 = i >> 4, b = i & 15, j2 = cb * CPB + cl2;
                if (j2 < NC) { const float s = (red[(0 * 128 + cl2) * 16 + b] + red[(1 * 128 + cl2) * 16 + b]) + (red[(2 * 128 + cl2) * 16 + b] + red[(3 * 128 + cl2) * 16 + b]);
                    if (j2 < 4 * 6144) { const int l = j2 / 6144, jj = j2 - l * 6144; modv[((size_t)l * 16 + b) * 6144 + jj] = s + a.ada_b[l * 6144 + jj]; }
                    else { const int jj = j2 - 4 * 6144; kvmod[(size_t)b * 2048 + jj] = s + a.kv_ada_b[jj]; } } }
            __syncthreads();
        }
    }
    {
        LAS float* scr = (LAS float*)(F.lds + F.wave * 16384);
        const int gw = F.vcu * 8 + F.wave, NGW = F.G * 8;
        constexpr int I_WIN = 16 * 64, I_SQ = 16 * 32, I_KV = 16 * 16, I_FGU = 16 * 192, I_FDN = 48 * 32, I_MGU = 16 * 224, I_MDN = 56 * 32;
        constexpr int NITEMS = 2 * I_WIN + 2 * I_SQ + I_KV + 2 * I_SQ + 2 * I_SQ + 2 * I_FGU + 2 * I_FDN + 16 * I_MGU + 16 * I_MDN;
        for (int it = gw; it < NITEMS; it += NGW) {
            int r = it;
            if (r < 2 * I_WIN) { const int mi = r / I_WIN, rr = r % I_WIN, nb = rr % 64, kb = rr / 64;
                transpose_item(a.a_w_in + (size_t)mi * DM * 2048, DM, 2048, (bf16_t*)(ws + WS_WIN) + (size_t)mi * 2048 * DM, 64 * kb, 32 * nb, map_plain(32 * nb), scr, F.lane); continue; } r -= 2 * I_WIN;
            if (r < 2 * I_SQ) { const int mi = r / I_SQ, rr = r % I_SQ, nb = rr % 32, kb = rr / 32;
                transpose_item(a.a_w_out + (size_t)mi * DM * DM, DM, DM, (bf16_t*)(ws + WS_WOUT) + (size_t)mi * DM * DM, 64 * kb, 32 * nb, map_plain(32 * nb), scr, F.lane); continue; } r -= 2 * I_SQ;
            if (r < I_KV) { const int nb = r % 16, kb = r / 16, n0 = 32 * nb;
                transpose_item(a.w_kv, DM, 512, (bf16_t*)(ws + WS_WKV), 64 * kb, n0, n0 < 256 ? map_head(n0) : n0, scr, F.lane); continue; } r -= I_KV;
            if (r < 2 * I_SQ) { const int mi = r / I_SQ, rr = r % I_SQ, nb = rr % 32, kb = rr / 32;
                transpose_item(a.b_w_q + (size_t)mi * DM * DM, DM, DM, (bf16_t*)(ws + WS_WQ) + (size_t)mi * DM * DM, 64 * kb, 32 * nb, map_head(32 * nb), scr, F.lane); continue; } r -= 2 * I_SQ;
            if (r < 2 * I_SQ) { const int mi = r / I_SQ, rr = r % I_SQ, nb = rr % 32, kb = rr / 32;
                transpose_item(a.b_w_o + (size_t)mi * DM * DM, DM, DM, (bf16_t*)(ws + WS_WO) + (size_t)mi * DM * DM, 64 * kb, 32 * nb, map_plain(32 * nb), scr, F.lane); continue; } r -= 2 * I_SQ;
            if (r < 2 * I_FGU) { const int mi = r / I_FGU, rr = r % I_FGU, nb = rr % 192, kb = rr / 192;
                if (FP8_OF(2 * mi)) transpose_item_fp8(a.f_w_gu + (size_t)mi * DM * 6144, DM, 6144, ws + WS_FGU + (size_t)mi * 6144 * DM * 2, 64 * kb, 32 * nb, map_gu(32 * nb, DFF), scr, F.lane, SC8_W);
                else transpose_item(a.f_w_gu + (size_t)mi * DM * 6144, DM, 6144, (bf16_t*)(ws + WS_FGU) + (size_t)mi * 6144 * DM, 64 * kb, 32 * nb, map_gu(32 * nb, DFF), scr, F.lane); continue; } r -= 2 * I_FGU;
            if (r < 2 * I_FDN) { const int mi = r / I_FDN, rr = r % I_FDN, nb = rr % 32, kb = rr / 32;
                if (FP8_OF(2 * mi)) transpose_item_fp8(a.f_w_down + (size_t)mi * DFF * DM, DFF, DM, ws + WS_FDN + (size_t)mi * DM * DFF * 2, 64 * kb, 32 * nb, map_plain(32 * nb), scr, F.lane, SC8_W);
                else transpose_item(a.f_w_down + (size_t)mi * DFF * DM, DFF, DM, (bf16_t*)(ws + WS_FDN) + (size_t)mi * DM * DFF, 64 * kb, 32 * nb, map_plain(32 * nb), scr, F.lane); continue; } r -= 2 * I_FDN;
            if (r < 16 * I_MGU) { const int mi = r / I_MGU, rr = r % I_MGU, nb = rr % 224, kb = rr / 224;
                if (FP8_OF(2 * (mi >> 3) + 1)) transpose_item_fp8(a.m_w_gu + (size_t)mi * DM * 7168, DM, 7168, ws + WS_MGU + (size_t)(mi >> 3) * 8 * 7168 * DM * 2 + (size_t)(mi & 7) * 7168 * DM, 64 * kb, 32 * nb, map_gu(32 * nb, DFE), scr, F.lane, SC8_W);
                else transpose_item(a.m_w_gu + (size_t)mi * DM * 7168, DM, 7168, (bf16_t*)(ws + WS_MGU) + (size_t)mi * 7168 * DM, 64 * kb, 32 * nb, map_gu(32 * nb, DFE), scr, F.lane); continue; } r -= 16 * I_MGU;
            { const int mi = r / I_MDN, rr = r % I_MDN, nb = rr % 32, kb = rr / 32;
                if (FP8_OF(2 * (mi >> 3) + 1)) transpose_item_fp8(a.m_w_down + (size_t)mi * DFE * DM, DFE, DM, ws + WS_MDN + (size_t)(mi >> 3) * 8 * DM * DFE * 2 + (size_t)(mi & 7) * DM * DFE, 64 * kb, 32 * nb, map_plain(32 * nb), scr, F.lane, SC8_W);
                else transpose_item(a.m_w_down + (size_t)mi * DFE * DM, DFE, DM, (bf16_t*)(ws + WS_MDN) + (size_t)mi * DM * DFE, 64 * kb, 32 * nb, map_plain(32 * nb), scr, F.lane); }
        }
    }
    {
        float* par = (float*)(ws + WS_PAR);
        const size_t gt0 = (size_t)F.vcu * 512 + F.tid, GT0 = (size_t)F.G * 512;
        for (size_t i = gt0; i < (size_t)PAR_END; i += GT0) { const int j = (int)i; float v;
            if (j < PAR_FFNN) v = a.mix_norm[j - PAR_MIXN]; else if (j < PAR_CONVW) v = a.ffn_norm[j - PAR_FFNN]; else if (j < PAR_CONVB) v = a.a_conv_w[j - PAR_CONVW];
            else if (j < PAR_GXB) v = a.a_conv_b[j - PAR_CONVB]; else if (j < PAR_GAB) v = a.a_gx_b[j - PAR_GXB]; else if (j < PAR_LAM) v = a.a_ga_b[j - PAR_GAB];
            else if (j < PAR_KVN) v = a.a_lambda[j - PAR_LAM]; else if (j < PAR_KN) v = a.kv_norm[j - PAR_KVN]; else if (j < PAR_QN) v = a.k_norm[j - PAR_KN];
            else if (j < PAR_SINK) v = a.b_q_norm[j - PAR_QN]; else if (j < PAR_ROUTER) v = a.b_sinks[j - PAR_SINK]; else v = a.m_router[j - PAR_ROUTER];
            par[j] = v; }
    }
    {
        const size_t gt = (size_t)F.vcu * 512 + F.tid, GT = (size_t)F.G * 512;
        bf16_t* gwp = (bf16_t*)(ws + WS_GW);
        for (size_t i = gt; i < (size_t)2 * 8 * 2 * 128 * 128; i += GT) { const int k = (int)(i & 127), j = (int)((i >> 7) & 127), c2 = (int)((i >> 14) & 1), n = (int)((i >> 15) & 7), l = (int)(i >> 18);
            const float* g = (j < 64) ? a.a_ga_w : a.a_gx_w; const float v = g[((size_t)(l * 8 + n) * 128 + k) * 128 + 64 * c2 + (j & 63)];
            gwp[i] = (bf16_t)(cvtpk(v, 0.f) & 0xffffu); }
        float* ct = (float*)(ws + WS_COS); float* st = (float*)(ws + WS_SIN);
        for (size_t i = gt; i < (size_t)NTOK * 32; i += GT) { const int p = (int)(i & 31); const size_t tok = i >> 5;
            const float inv = powf(10000.0f, -(float)(2 * p) / 64.0f); const float ang = (float)a.pos[tok] * inv;
            ct[i] = cosf(ang); st[i] = sinf(ang); }
    }
}

template <bool DUAL, bool ROUTER, bool OUT8 = false>
__device__ __forceinline__ void norm_phase(const Ctx& F, const float* x, const float* gain1, const float* sh1, const float* sc1, void* out1,
                                           const float* gain2, const float* sh2, const float* sc2, bf16_t* out2,
                                           const float* wrouter, int* e12, float* w1o, int* cnt) {
    LAS int* lcnt = (LAS int*)F.lds;
    for (int rb = F.vcu; rb < NTOK / 256; rb += F.G) {
        const int b = rb >> 4;
        if (ROUTER) { if (F.tid < 16) lcnt[F.tid] = 0; __syncthreads(); }
        float ca[16], cs[16], ca2[16], cs2[16];
#pragma unroll
        for (int j = 0; j < 4; ++j) { const int col = 4 * F.lane + 256 * j;
            const f32x4 g = *(const f32x4*)(gain1 + col), s = *(const f32x4*)(sc1 + (size_t)b * 6144 + col), h = *(const f32x4*)(sh1 + (size_t)b * 6144 + col);
#pragma unroll
            for (int q = 0; q < 4; ++q) { ca[4 * j + q] = g[q] * (1.0f + s[q]); cs[4 * j + q] = h[q]; }
            if (DUAL) { const f32x4 g2 = *(const f32x4*)(gain2 + col), s2 = *(const f32x4*)(sc2 + (size_t)b * 2048 + col), h2 = *(const f32x4*)(sh2 + (size_t)b * 2048 + col);
#pragma unroll
                for (int q = 0; q < 4; ++q) { ca2[4 * j + q] = g2[q] * (1.0f + s2[q]); cs2[4 * j + q] = h2[q]; } } }
        float wr_[ROUTER ? 128 : 1];
        if (ROUTER) {
#pragma unroll
            for (int j = 0; j < 4; ++j)
#pragma unroll
                for (int q = 0; q < 4; ++q) { const int col = 4 * F.lane + 256 * j + q; const f32x4 w0 = *(const f32x4*)(wrouter + (size_t)col * 8), w1 = *(const f32x4*)(wrouter + (size_t)col * 8 + 4);
#pragma unroll
                    for (int e = 0; e < 4; ++e) { wr_[(4 * j + q) * 8 + e] = w0[e]; wr_[(4 * j + q) * 8 + 4 + e] = w1[e]; } }
        }
        int me12 = 0; float mw1 = 0.f;
        const int rowb = rb * 256 + F.wave * 32;
        for (int rr = 0; rr < 32; ++rr) {
            const size_t row = (size_t)(rowb + rr);
            const f32x4* xr = (const f32x4*)(x + row * DM) + F.lane;
            f32x4 v[4]; float s = 0.f;
#pragma unroll
            for (int j = 0; j < 4; ++j) { v[j] = xr[64 * j]; s += (v[j][0] * v[j][0] + v[j][1] * v[j][1]) + (v[j][2] * v[j][2] + v[j][3] * v[j][3]); }
            const float r = __builtin_amdgcn_rsqf(wave_sum(s, F.lane) * (1.0f / DM) + EPS);
            float hv[16];
#pragma unroll
            for (int j = 0; j < 4; ++j)
#pragma unroll
                for (int q = 0; q < 4; ++q) hv[4 * j + q] = v[j][q] * r * ca[4 * j + q] + cs[4 * j + q];
            if constexpr (OUT8) { unsigned* o4 = (unsigned*)((unsigned char*)out1 + row * DM) + F.lane;
#pragma unroll
                for (int j = 0; j < 4; ++j) o4[64 * j] = cvt4_fp8(hv[4 * j] * SC8_H, hv[4 * j + 1] * SC8_H, hv[4 * j + 2] * SC8_H, hv[4 * j + 3] * SC8_H); }
            else { u32x2* o8 = (u32x2*)((bf16_t*)out1 + row * DM) + F.lane;
#pragma unroll
                for (int j = 0; j < 4; ++j) { u32x2 w; w.x = cvtpk(hv[4 * j], hv[4 * j + 1]); w.y = cvtpk(hv[4 * j + 2], hv[4 * j + 3]); o8[64 * j] = w; } }
            if (DUAL) { u32x2* p8 = (u32x2*)(out2 + row * DM) + F.lane;
#pragma unroll
                for (int j = 0; j < 4; ++j) { float t[4];
#pragma unroll
                    for (int q = 0; q < 4; ++q) t[q] = v[j][q] * r * ca2[4 * j + q] + cs2[4 * j + q];
                    u32x2 w; w.x = cvtpk(t[0], t[1]); w.y = cvtpk(t[2], t[3]); p8[64 * j] = w; } }
            if (ROUTER) {
                float lg[8];
#pragma unroll
                for (int e = 0; e < 8; ++e) { float p = 0.f;
#pragma unroll
                    for (int c = 0; c < 16; ++c) p += hv[c] * wr_[c * 8 + e];
                    lg[e] = wave_sum(p, F.lane); }
                int i1 = 0; float v1 = lg[0];
#pragma unroll
                for (int e = 1; e < 8; ++e) if (lg[e] > v1) { v1 = lg[e]; i1 = e; }
                int i2 = -1; float v2 = -INFINITY;
#pragma unroll
                for (int e = 0; e < 8; ++e) if (e != i1 && lg[e] > v2) { v2 = lg[e]; i2 = e; }
                const float wt = 1.0f / (1.0f + __expf(v2 - v1));
                if (F.lane == rr) { me12 = i1 | (i2 << 8); mw1 = wt; }
            }
        }
        if (ROUTER) {
            if (F.lane < 32) { e12[rowb + F.lane] = me12; w1o[rowb + F.lane] = mw1; }
            const int e1 = me12 & 255, e2 = me12 >> 8;
#pragma unroll
            for (int e = 0; e < 8; ++e) { const unsigned long long m1 = __ballot(F.lane < 32 && e1 == e), m2 = __ballot(F.lane < 32 && e2 == e);
                if (F.lane == 0) { atomicAdd((int*)&lcnt[e], (int)__popcll(m1)); atomicAdd((int*)&lcnt[8 + e], (int)__popcll(m2)); } }
            __syncthreads();
            if (F.tid < 16) cnt[rb * 16 + F.tid] = lcnt[F.tid];
            __syncthreads();
        }
    }
}

__device__ __forceinline__ void moe_scatter(const Ctx& F, const int* cnt, const int* e12, const float* w1, int* tos, float* wos, int* tile) {
    LAS int* T1 = (LAS int*)F.lds;
    LAS int* T2 = T1 + 512;
    LAS int* tot = T2 + 512;
    LAS int* pre = tot + 16;
    LAS int* seg = pre + 16;
    LAS int* wcn = seg + 32;
    for (int rb = F.vcu; rb < NTOK / 256; rb += F.G) {
        { const int bin = F.tid & 15, part = F.tid >> 4; int st = 0, sp = 0;
#pragma unroll
            for (int j = 0; j < 8; ++j) { const int b2 = part * 8 + j; const int v = cnt[b2 * 16 + bin]; st += v; if (b2 < rb) sp += v; }
            T1[part * 16 + bin] = st; T2[part * 16 + bin] = sp; }
        __syncthreads();
        if (F.tid < 16) { int st = 0, sp = 0; for (int p = 0; p < 32; ++p) { st += T1[p * 16 + F.tid]; sp += T2[p * 16 + F.tid]; } tot[F.tid] = st; pre[F.tid] = sp; }
        __syncthreads();
        if (F.tid == 0) { int s = 0; for (int bin = 0; bin < 16; ++bin) { seg[bin] = s; s += ((tot[bin] + 255) >> 8) << 8; } seg[16] = s; }
        __syncthreads();
        int e1 = -1, e2 = -1; float wt = 0.f; int r1 = 0, r2 = 0;
        const int token = rb * 256 + F.tid;
        if (F.tid < 256) { const int v = e12[token]; e1 = v & 255; e2 = v >> 8; wt = w1[token]; }
        if (F.wave < 4) {
#pragma unroll
            for (int e = 0; e < 8; ++e) { const unsigned long long m1 = __ballot(e1 == e), m2 = __ballot(e2 == e); const unsigned long long lt = (1ull << F.lane) - 1ull;
                if (e1 == e) r1 = (int)__popcll(m1 & lt); if (e2 == e) r2 = (int)__popcll(m2 & lt);
                if (F.lane == 0) { wcn[F.wave * 16 + e] = (int)__popcll(m1); wcn[F.wave * 16 + 8 + e] = (int)__popcll(m2); } }
        }
        __syncthreads();
        if (F.tid < 256) {
            int o1 = seg[e1] + pre[e1] + r1, o2 = seg[8 + e2] + pre[8 + e2] + r2;
            for (int w = 0; w < F.wave; ++w) { o1 += wcn[w * 16 + e1]; o2 += wcn[w * 16 + 8 + e2]; }
            tos[o1] = token; wos[o1] = wt; tos[o2] = token; wos[o2] = 1.0f - wt;
        }
        if (rb < 16) { const int bin = rb; const int s0 = seg[bin] + tot[bin], s1 = seg[bin + 1]; for (int s = s0 + F.tid; s < s1; s += 512) { tos[s] = -1; wos[s] = 0.f; } }
        if (rb == 0) { if (F.tid == 0) { tile[0] = seg[8] >> 8; tile[1] = seg[16] >> 8; }
            for (int t = F.tid; t < MAXTILES; t += 512) { const int s = t << 8; int e = 0;
#pragma unroll
                for (int bin = 1; bin < 16; ++bin) if (s >= seg[bin]) e = bin;
                tile[16 + t] = e & 7; } }
        __syncthreads();
    }
}

constexpr int SC_AT = 0, SC_WT = 34816, SC_AS = 69632, SC_BS = 102400, SC_SEG = 135168, SC_CARRY = 139264, SC_CW = 139776, SC_GB = 142336;
__device__ __forceinline__ void scan_phase(const Ctx& F, const float* par, int l, const bf16_t* XB, bf16_t* GY, const bf16_t* GW) {
    LAS unsigned char* lds = F.lds;
    LAS float* AS = (LAS float*)(lds + SC_AS); LAS float* BS = (LAS float*)(lds + SC_BS);
    LAS float* SEGA = (LAS float*)(lds + SC_SEG); LAS float* SEGB = SEGA + 512;
    LAS float* CARRY = (LAS float*)(lds + SC_CARRY);
    LAS float* CW = (LAS float*)(lds + SC_CW);
    LAS float* GB = (LAS float*)(lds + SC_GB);
    const int tid = F.tid, lane = F.lane, wid = F.wave, r32 = lane & 31, hh = lane >> 5;
    for (int un = F.vcu; un < 256; un += F.G) {
        const int b = un >> 4, n = (un >> 1) & 7, c2 = un & 1;
        __syncthreads();
        for (int i = tid; i < 640; i += 512) { const int ch = i & 127, k = i >> 7; CW[i] = (k < 4) ? par[PAR_CONVW + (l * 4 + k) * DM + 128 * n + ch] : par[PAR_CONVB + l * DM + 128 * n + ch]; }
        if (tid < 64) { const int ch = l * DM + 128 * n + 64 * c2 + tid; GB[tid] = par[PAR_GAB + ch]; GB[64 + tid] = par[PAR_GXB + ch]; GB[128 + tid] = log1pf(expf(-par[PAR_LAM + ch])); CARRY[tid] = 0.f; CARRY[64 + tid] = 0.f; }
        { const bf16_t* gsrc = GW + (size_t)(((l * 8 + n) * 2 + c2) * 128) * 128;
#pragma unroll
            for (int i = 0; i < 4; ++i) { const int p = tid + 512 * i, row = p >> 4, c16 = p & 15; const u32x4 v = *(const u32x4*)(gsrc + (size_t)row * 128 + c16 * 8); *(LAS u32x4*)(lds + SC_WT + row * 272 + c16 * 16) = v; } }
        const int cp = lane, tg = wid;
        const int sc = lane, sg = wid;
        const size_t rowbase = (size_t)b * SEQ;
        const bf16_t* xbp = XB + rowbase * DM + 128 * n + 2 * cp;
        bf16_t* gyp = GY + rowbase * DM + 128 * n + 64 * c2 + sc;
        unsigned xv[19];
#pragma unroll
        for (int k = 0; k < 19; ++k) { const int t = 16 * tg - 3 + k; xv[k] = (t >= 0) ? *(const unsigned*)(xbp + (size_t)t * DM) : 0u; }
        __syncthreads();
        float w[2][4], cb[2];
#pragma unroll
        for (int q = 0; q < 2; ++q) { cb[q] = CW[512 + 2 * cp + q];
#pragma unroll
            for (int k = 0; k < 4; ++k) w[q][k] = CW[k * 128 + 2 * cp + q]; }
        const float gba = GB[32 * (wid & 1) + r32], gbx = GB[64 + 32 * (wid & 1) + r32], spv = GB[128 + 32 * (wid & 1) + r32];
        for (int ci = 0; ci < SEQ / 128; ++ci) {
            const int t0 = ci * 128;
#pragma unroll
            for (int k = 0; k < 16; ++k) {
                float o[2];
#pragma unroll
                for (int q = 0; q < 2; ++q) { float s = cb[q];
#pragma unroll
                    for (int j = 0; j < 4; ++j) { const unsigned pv = xv[k + j]; const float xf = q ? __uint_as_float(pv & 0xffff0000u) : __uint_as_float(pv << 16); s += w[q][j] * xf; }
                    o[q] = s; }
                *(LAS unsigned*)(lds + SC_AT + (16 * tg + k) * 272 + cp * 4) = cvtpk(o[0], o[1]);
            }
            if (ci + 1 < SEQ / 128) {
#pragma unroll
                for (int k = 0; k < 19; ++k) xv[k] = *(const unsigned*)(xbp + (size_t)(t0 + 128 + 16 * tg - 3 + k) * DM);
            }
            __syncthreads();
            f32x16 ga, gx;
#pragma unroll
            for (int i = 0; i < 16; ++i) { ga[i] = 0.f; gx[i] = 0.f; }
            { const int tt = wid >> 1, ct = wid & 1;
                const LAS unsigned char* ap = lds + SC_AT + (32 * tt + r32) * 272 + hh * 16;
                const LAS unsigned char* bpa = lds + SC_WT + (32 * ct + r32) * 272 + hh * 16;
                const LAS unsigned char* bpx = bpa + 64 * 272;
#pragma unroll
                for (int s = 0; s < 8; ++s) { const bf16x8 af = *(const LAS bf16x8*)(ap + s * 32), ba = *(const LAS bf16x8*)(bpa + s * 32), bx = *(const LAS bf16x8*)(bpx + s * 32);
                    ga = __builtin_amdgcn_mfma_f32_32x32x16_bf16(af, ba, ga, 0, 0, 0); gx = __builtin_amdgcn_mfma_f32_32x32x16_bf16(af, bx, gx, 0, 0, 0); }
#pragma unroll
                for (int i = 0; i < 16; ++i) { const int tok = 32 * tt + (i & 3) + 8 * (i >> 2) + 4 * hh, ch = 32 * ct + r32;
                    const float rg = sigmoidf_(ga[i] + gba), ig = sigmoidf_(gx[i] + gbx);
                    const float la = -8.0f * rg * spv; const float av = fast_exp2(la * LOG2E); const float bc = __builtin_amdgcn_sqrtf(fmaxf(1.0f - av * av, 0.f));
                    const float xcv = bf2f(*(const LAS unsigned short*)(lds + SC_AT + tok * 272 + (64 * c2 + ch) * 2));
                    AS[tok * 64 + ch] = av; BS[tok * 64 + ch] = bc * ig * xcv; }
            }
            __syncthreads();
            unsigned short gyv[16];
#pragma unroll
            for (int k = 0; k < 16; ++k) gyv[k] = gyp[(size_t)(t0 + 16 * sg + k) * DM];
            float av[16], bv[16];
#pragma unroll
            for (int k = 0; k < 16; ++k) { av[k] = AS[(16 * sg + k) * 64 + sc]; bv[k] = BS[(16 * sg + k) * 64 + sc]; }
            { float pa = 1.f, pb = 0.f;
#pragma unroll
                for (int k = 0; k < 16; ++k) { pb = av[k] * pb + bv[k]; pa *= av[k]; }
                SEGA[sg * 64 + sc] = pa; SEGB[sg * 64 + sc] = pb; }
            __syncthreads();
            float h = CARRY[(ci & 1) * 64 + sc];
            for (int s = 0; s < sg; ++s) h = SEGA[s * 64 + sc] * h + SEGB[s * 64 + sc];
#pragma unroll
            for (int k = 0; k < 16; ++k) { h = av[k] * h + bv[k]; const float o = h * bf2f(gyv[k]); gyp[(size_t)(t0 + 16 * sg + k) * DM] = (bf16_t)(cvtpk(o, 0.f) & 0xffffu); }
            if (sg == 7) CARRY[((ci + 1) & 1) * 64 + sc] = h;
        }
    }
    __syncthreads();
}

constexpr int AT_K = 0, AT_V = 36864;
__device__ __forceinline__ void attn_phase(const Ctx& F, const bf16_t* Q, const bf16_t* Kb, const bf16_t* Vb, bf16_t* O, const float* sinks) {
    LAS unsigned char* lds = F.lds;
    const int tid = F.tid, lane = F.lane, wid = F.wave, r32 = lane & 31, hh = lane >> 5;
    const int i16 = lane & 15, tq = i16 >> 2, tp = i16 & 3, blk = (lane >> 4) & 1;
    const int g = wid & 3, half = wid >> 2;
    constexpr int NU = BATCH * 32 * 4;
    u32x4 kreg[4], vreg[4]; bf16x8 qreg[2][4];
#define AT_LOADKV(unit) do { const int kh_ = (unit) & 3, n_ = ((unit) >> 2) & 31, b_ = (unit) >> 7; \
        _Pragma("unroll") for (int i = 0; i < 4; ++i) { const int p = tid + 512 * i, row = p >> 3, c16 = p & 7; kreg[i] = (u32x4){0u, 0u, 0u, 0u}; vreg[i] = (u32x4){0u, 0u, 0u, 0u}; \
            if (n_ > 0 || row >= 128) { const size_t tok = (size_t)b_ * SEQ + (size_t)(128 * (n_ - 1) + row); kreg[i] = *(const u32x4*)(Kb + tok * 256 + kh_ * 64 + c16 * 8); vreg[i] = *(const u32x4*)(Vb + tok * 256 + kh_ * 64 + c16 * 8); } } } while (0)
#define AT_LOADQ(unit) do { const int kh_ = (unit) & 3, n_ = ((unit) >> 2) & 31, b_ = (unit) >> 7; \
        _Pragma("unroll") for (int ps = 0; ps < 2; ++ps) { const size_t qt_ = (size_t)b_ * SEQ + (size_t)(128 * n_ + 64 * half + 32 * ps + r32); \
            _Pragma("unroll") for (int s = 0; s < 4; ++s) qreg[ps][s] = *(const bf16x8*)(Q + qt_ * DM + (4 * kh_ + g) * 64 + 16 * s + 8 * hh); } } while (0)
    int un = F.vcu;
    if (un < NU) { AT_LOADKV(un); AT_LOADQ(un); }
    for (; un < NU; un += F.G) {
        const int kh = un & 3, n = (un >> 2) & 31, b = un >> 7;
        __syncthreads();
#pragma unroll
        for (int i = 0; i < 4; ++i) { const int p = tid + 512 * i, row = p >> 3, c16 = p & 7;
            *(LAS u32x4*)(lds + AT_K + row * 144 + c16 * 16) = kreg[i]; *(LAS u32x4*)(lds + AT_V + row * 192 + c16 * 16) = vreg[i]; }
        __syncthreads();
        if (un + F.G < NU) AT_LOADKV(un + F.G);
        const int hq = 4 * kh + g;
        const float sink2 = sinks[hq] * LOG2E;
#pragma unroll 1
        for (int pass = 0; pass < 2; ++pass) {
            const int i0 = 64 * half + 32 * pass, kt0 = i0 >> 5;
            const size_t qtok = (size_t)b * SEQ + (size_t)(128 * n + i0 + r32);
            bf16x8 qf[4];
#pragma unroll
            for (int s = 0; s < 4; ++s) qf[s] = pass ? qreg[1][s] : qreg[0][s];
            f32x16 sacc[5];
#pragma unroll
            for (int t = 0; t < 5; ++t) {
#pragma unroll
                for (int i = 0; i < 16; ++i) sacc[t][i] = 0.f;
#pragma unroll
                for (int s = 0; s < 4; ++s) { const bf16x8 kf = *(const LAS bf16x8*)(lds + AT_K + (32 * (kt0 + t) + r32) * 144 + (16 * s + 8 * hh) * 2);
                    sacc[t] = __builtin_amdgcn_mfma_f32_32x32x16_bf16(kf, qf[s], sacc[t], 0, 0, 0); } }
            const int qi = i0 + r32;
            float mx = sink2;
#pragma unroll
            for (int t = 0; t < 5; ++t)
#pragma unroll
                for (int i = 0; i < 16; ++i) { const int j = 32 * (kt0 + t) + (i & 3) + 8 * (i >> 2) + 4 * hh; const int d = j - qi;
                    const bool ok = (d >= 1) && (d <= 128) && (n > 0 || j >= 128);
                    const float sv = ok ? sacc[t][i] : -INFINITY; sacc[t][i] = sv; mx = fmaxf(mx, sv); }
            mx = fmaxf(mx, shflx(mx, lane, 32));
            float sum = 0.f;
#pragma unroll
            for (int t = 0; t < 5; ++t)
#pragma unroll
                for (int i = 0; i < 16; ++i) { const float p = fast_exp2(sacc[t][i] - mx); sacc[t][i] = p; sum += p; }
            sum += shflx(sum, lane, 32);
            sum += fast_exp2(sink2 - mx);
            const float inv = 1.0f / sum;
            f32x16 oacc[2];
#pragma unroll
            for (int i = 0; i < 16; ++i) { oacc[0][i] = 0.f; oacc[1][i] = 0.f; }
#pragma unroll
            for (int t = 0; t < 5; ++t)
#pragma unroll
                for (int s = 0; s < 2; ++s) {
                    u32x4 pk; pk.x = cvtpk(sacc[t][8 * s], sacc[t][8 * s + 1]); pk.y = cvtpk(sacc[t][8 * s + 2], sacc[t][8 * s + 3]); pk.z = cvtpk(sacc[t][8 * s + 4], sacc[t][8 * s + 5]); pk.w = cvtpk(sacc[t][8 * s + 6], sacc[t][8 * s + 7]);
                    const bf16x8 pb = __builtin_bit_cast(bf16x8, pk);
#pragma unroll
                    for (int dt = 0; dt < 2; ++dt) {
                        const LAS unsigned char* vp = lds + AT_V + (32 * (kt0 + t) + 16 * s + 4 * hh + tq) * 192 + (32 * dt + 16 * blk + 4 * tp) * 2;
                        const s16x4 lo = __builtin_bit_cast(s16x4, __builtin_amdgcn_ds_read_tr16_b64_v4i16((LAS s16x4*)vp));
                        const s16x4 hi = __builtin_bit_cast(s16x4, __builtin_amdgcn_ds_read_tr16_b64_v4i16((LAS s16x4*)(vp + 8 * 192)));
                        const bf16x8 va = __builtin_shufflevector(lo, hi, 0, 1, 2, 3, 4, 5, 6, 7);
                        oacc[dt] = __builtin_amdgcn_mfma_f32_32x32x16_bf16(va, pb, oacc[dt], 0, 0, 0);
                    }
                }
            bf16_t* op = O + qtok * DM + hq * 64;
#pragma unroll
            for (int dt = 0; dt < 2; ++dt)
#pragma unroll
                for (int q4 = 0; q4 < 4; ++q4) { u32x2 w; w.x = cvtpk(oacc[dt][4 * q4] * inv, oacc[dt][4 * q4 + 1] * inv); w.y = cvtpk(oacc[dt][4 * q4 + 2] * inv, oacc[dt][4 * q4 + 3] * inv);
                    *(u32x2*)(op + 32 * dt + 8 * q4 + 4 * hh) = w; }
        }
        if (un + F.G < NU) AT_LOADQ(un + F.G);
    }
#undef AT_LOADKV
#undef AT_LOADQ
    __syncthreads();
}

constexpr int NPHASE = 34 + (DUP_SCANPAIR ? 4 : 0);
__global__ void __launch_bounds__(512, 2) fwd_kernel(Args a) {
    extern __shared__ __attribute__((aligned(16))) unsigned char lds_raw[];
    volatile LAS unsigned* MISC = (volatile LAS unsigned*)((LAS unsigned char*)lds_raw + LDS_MISC);
    const int wv0 = __builtin_amdgcn_readfirstlane((int)threadIdx.x >> 6);
    if (wv0 == 0) MISC[lane_id_v()] = 0u;
    __syncthreads();
    XcdBarrier bar; bar.bar = (unsigned*)(a.ws + WS_CTL) + CW_BAR; bar.x = 0; bar.st = MISC;
    if (!MK_MULTI) bar = xcd_barrier_post((unsigned*)(a.ws + WS_CTL) + CW_BAR, MISC, wv0);
    const int lo = a.ph_lo, hi = a.ph_hi;
    int ph = 0;
#define PH_BEGIN(k) if (((PHSEL >> (k)) & 1) && lo <= ph && ph < hi) { Ctx F; { int t_ = wv0 * 64 + (int)lane_id_v(); asm volatile("" : "+v"(t_)); F.tid = t_; } F.lds = (LAS unsigned char*)lds_raw; F.lane = F.tid & 63; \
        F.wave = __builtin_amdgcn_readfirstlane(F.tid >> 6); F.G = gridDim.x; { int bx = blockIdx.x; asm volatile("" : "+s"(bx)); F.cid = bx; F.vcu = (F.G % 8 == 0) ? (bx % 8) * (F.G / 8) + bx / 8 : bx; } \
        unsigned char GAS* wsg_ = (unsigned char GAS*)a.ws; asm volatile("" : "+s"(wsg_)); unsigned char* ws = (unsigned char*)wsg_; float GAS* xog_ = (float GAS*)a.out; asm volatile("" : "+s"(xog_)); float* xo = (float*)xog_; int l = l_; asm volatile("" : "+s"(l)); (void)xo; (void)l; \
        for (int rep_ = 0; rep_ < (((DUPMASK >> (k)) & 1) ? 2 : 1); ++rep_) {
#define PH_END   } if (!MK_MULTI && ph + 1 < NPHASE) xcd_barrier(bar, wv0); } ++ph;
#define W_PAR    ((const float*)(ws + WS_PAR))
#define W_MODL   ((const float*)(ws + WS_MODV) + (size_t)l * 16 * 6144)
#define W_KVMOD  ((const float*)(ws + WS_KVMOD))
#define W_HB     ((bf16_t*)(ws + WS_H))
#define W_HKV    ((bf16_t*)(ws + WS_HKV))
#define W_KB     ((bf16_t*)(ws + WS_KB))
#define W_VB     ((bf16_t*)(ws + WS_VB))
#define W_XB     ((bf16_t*)(ws + WS_ARENA + AR_XB))
#define W_GY     ((bf16_t*)(ws + WS_ARENA + AR_GY))
#define W_HID    ((bf16_t*)(ws + WS_ARENA))
#define W_Q      ((bf16_t*)(ws + WS_ARENA + AR_Q))
#define W_O      ((bf16_t*)(ws + WS_ARENA + AR_O))
#define W_COS    ((const float*)(ws + WS_COS))
#define W_SIN    ((const float*)(ws + WS_SIN))
#define W_E12    ((int*)(ws + WS_E12))
#define W_W1     ((float*)(ws + WS_W1))
#define W_CNT    ((int*)(ws + WS_CNT))
#define W_TILE   ((int*)(ws + WS_TILE))
#define W_TOS    ((int*)(ws + WS_TOS))
#define W_WOS    ((float*)(ws + WS_WOS))

    { const int l_ = 0; PH_BEGIN(0) p0_prologue(F, a); PH_END }

#pragma unroll 1
    for (int l_ = 0; l_ < 4; ++l_) {
        if (l_ < 2) {
            PH_BEGIN(1) norm_phase<false, false>(F, l == 0 ? a.x : xo, W_PAR + PAR_MIXN + l * DM, W_MODL, W_MODL + 1024, W_HB, nullptr, nullptr, nullptr, nullptr, nullptr, nullptr, nullptr, nullptr); PH_END
#pragma unroll 1
            for (int sp_ = 0; sp_ < (DUP_SCANPAIR ? 2 : 1); ++sp_) {
            PH_BEGIN(2) { pg8::ProbDense P{W_HB, (const bf16_t*)(ws + WS_WIN) + (size_t)l * 2048 * DM, DM * 2}; pg8::Order S; S.init(NTOK / 256, 8, F.G, F.cid, 0);
                pg8::EpiWin E{W_XB, W_GY}; pg8::gemm_phase<pg8::EpiWin, pg8::ProbDense, false>(F.lds, F.tid, P, S, E); } PH_END
            PH_BEGIN(3) scan_phase(F, W_PAR, l, W_XB, W_GY, (const bf16_t*)(ws + WS_GW)); PH_END
            }
            PH_BEGIN(4) { pg8::ProbDense P{W_GY, (const bf16_t*)(ws + WS_WOUT) + (size_t)l * DM * DM, DM * 2}; pg8::Order S; S.init(NTOK / 256, 4, F.G, F.cid, 0);
                pg8::EpiResid E{l == 0 ? a.x : xo, xo, W_MODL + 2048, 1.0f}; pg8::gemm_phase<pg8::EpiResid, pg8::ProbDense, false>(F.lds, F.tid, P, S, E); } PH_END
        } else {
            PH_BEGIN(5) if (l == 2) norm_phase<true, false>(F, xo, W_PAR + PAR_MIXN + l * DM, W_MODL, W_MODL + 1024, W_HB, W_PAR + PAR_KVN, W_KVMOD, W_KVMOD + 1024, W_HKV, nullptr, nullptr, nullptr, nullptr);
                        else norm_phase<false, false>(F, xo, W_PAR + PAR_MIXN + l * DM, W_MODL, W_MODL + 1024, W_HB, nullptr, nullptr, nullptr, nullptr, nullptr, nullptr, nullptr, nullptr); PH_END
            if (l_ == 2) {
                PH_BEGIN(6) { pg8::ProbDense P{W_HKV, (const bf16_t*)(ws + WS_WKV), DM * 2}; pg8::Order S; S.init(NTOK / 256, 2, F.G, F.cid, 0);
                    pg8::EpiQK E{W_KB, 256, W_PAR + PAR_KN, W_COS, W_SIN, 1.0f, 1, W_VB}; pg8::gemm_phase<pg8::EpiQK, pg8::ProbDense, false>(F.lds, F.tid, P, S, E); } PH_END
            }
            PH_BEGIN(6) { pg8::ProbDense P{W_HB, (const bf16_t*)(ws + WS_WQ) + (size_t)(l - 2) * DM * DM, DM * 2}; pg8::Order S; S.init(NTOK / 256, 4, F.G, F.cid, 0);
                pg8::EpiQK E{W_Q, DM, W_PAR + PAR_QN + (l - 2) * 64, W_COS, W_SIN, 0.125f * LOG2E, -1, nullptr}; pg8::gemm_phase<pg8::EpiQK, pg8::ProbDense, false>(F.lds, F.tid, P, S, E); } PH_END
            PH_BEGIN(7) attn_phase(F, W_Q, W_KB, W_VB, W_O, W_PAR + PAR_SINK + (l - 2) * 16); PH_END
            PH_BEGIN(8) { pg8::ProbDense P{W_O, (const bf16_t*)(ws + WS_WO) + (size_t)(l - 2) * DM * DM, DM * 2}; pg8::Order S; S.init(NTOK / 256, 4, F.G, F.cid, 0);
                pg8::EpiResid E{xo, xo, W_MODL + 2048, 1.0f}; pg8::gemm_phase<pg8::EpiResid, pg8::ProbDense, false>(F.lds, F.tid, P, S, E); } PH_END
        }
        if (!(l_ & 1)) {
            PH_BEGIN(9) if (FP8_OF(0) | FP8_OF(2)) { if (FP8_OF(l)) norm_phase<false, false, true>(F, xo, W_PAR + PAR_FFNN + l * DM, W_MODL + 3072, W_MODL + 4096, W_HB, nullptr, nullptr, nullptr, nullptr, nullptr, nullptr, nullptr, nullptr);
                             else norm_phase<false, false, false>(F, xo, W_PAR + PAR_FFNN + l * DM, W_MODL + 3072, W_MODL + 4096, W_HB, nullptr, nullptr, nullptr, nullptr, nullptr, nullptr, nullptr, nullptr); }
                        else norm_phase<false, false, false>(F, xo, W_PAR + PAR_FFNN + l * DM, W_MODL + 3072, W_MODL + 4096, W_HB, nullptr, nullptr, nullptr, nullptr, nullptr, nullptr, nullptr, nullptr); PH_END
            if (FP8_OF(l_)) {
                PH_BEGIN(17) { pg8::ProbDense P{W_HB, ws + WS_FGU + (size_t)(l >> 1) * 6144 * DM * 2, DM}; pg8::Order S; S.init(NTOK / 256, 24, F.G, F.cid, 0);
                    pg8::EpiSwiglu<true> E{W_HID, DFF, 1.0f / (SC8_H * SC8_W)}; pg8::gemm_phase<pg8::EpiSwiglu<true>, pg8::ProbDense, false, true>(F.lds, F.tid, P, S, E); } PH_END
                PH_BEGIN(18) { pg8::ProbDense P{W_HID, ws + WS_FDN + (size_t)(l >> 1) * DM * DFF * 2, DFF}; pg8::Order S; S.init(NTOK / 256, 4, F.G, F.cid, 0);
                    pg8::EpiResid E{xo, xo, W_MODL + 5120, 1.0f / (SC8_HID * SC8_W)}; pg8::gemm_phase<pg8::EpiResid, pg8::ProbDense, false, true>(F.lds, F.tid, P, S, E); } PH_END
            } else {
                PH_BEGIN(10) { pg8::ProbDense P{W_HB, (const bf16_t*)(ws + WS_FGU) + (size_t)(l >> 1) * 6144 * DM, DM * 2}; pg8::Order S; S.init(NTOK / 256, 24, F.G, F.cid, 0);
                    pg8::EpiSwiglu<false> E{W_HID, DFF, 1.0f}; pg8::gemm_phase<pg8::EpiSwiglu<false>, pg8::ProbDense, false>(F.lds, F.tid, P, S, E); } PH_END
                PH_BEGIN(11) { pg8::ProbDense P{W_HID, (const bf16_t*)(ws + WS_FDN) + (size_t)(l >> 1) * DM * DFF, DFF * 2}; pg8::Order S; S.init(NTOK / 256, 4, F.G, F.cid, 0);
                    pg8::EpiResid E{xo, xo, W_MODL + 5120, 1.0f}; pg8::gemm_phase<pg8::EpiResid, pg8::ProbDense, false>(F.lds, F.tid, P, S, E); } PH_END
            }
        } else {
            PH_BEGIN(12) if (FP8_OF(l)) norm_phase<false, true, true>(F, xo, W_PAR + PAR_FFNN + l * DM, W_MODL + 3072, W_MODL + 4096, W_HB, nullptr, nullptr, nullptr, nullptr, W_PAR + PAR_ROUTER + (l >> 1) * DM * 8, W_E12, W_W1, W_CNT);
                         else norm_phase<false, true, false>(F, xo, W_PAR + PAR_FFNN + l * DM, W_MODL + 3072, W_MODL + 4096, W_HB, nullptr, nullptr, nullptr, nullptr, W_PAR + PAR_ROUTER + (l >> 1) * DM * 8, W_E12, W_W1, W_CNT); PH_END
            PH_BEGIN(13) moe_scatter(F, W_CNT, W_E12, W_W1, W_TOS, W_WOS, W_TILE); PH_END
            if (FP8_OF(l_)) {
                PH_BEGIN(16) {
                    LAS int* texp = (LAS int*)(F.lds + LDS_TEXP);
                    for (int i = F.tid; i < MAXTILES + 16; i += 512) texp[i] = W_TILE[i];
                    __syncthreads();
                    const int ntot = texp[1];
                    pg8::Order S; S.init(ntot, 28, F.G, F.cid, 0);
                    pg8::ProbGrouped P{W_HB, ws + WS_MGU + (size_t)(l >> 1) * 8 * 7168 * DM * 2, DM, 7168, texp + 16, W_TOS};
                    pg8::EpiSwiglu<true> E{W_HID, DFE, 1.0f / (SC8_H * SC8_W)}; pg8::gemm_phase<pg8::EpiSwiglu<true>, pg8::ProbGrouped, true, true>(F.lds, F.tid, P, S, E); } PH_END
            } else {
                PH_BEGIN(14) {
                    LAS int* texp = (LAS int*)(F.lds + LDS_TEXP);
                    for (int i = F.tid; i < MAXTILES + 16; i += 512) texp[i] = W_TILE[i];
                    __syncthreads();
                    const int ntot = texp[1];
                    pg8::Order S; S.init(ntot, 28, F.G, F.cid, 0);
                    pg8::ProbGrouped P{W_HB, (const bf16_t*)(ws + WS_MGU) + (size_t)(l >> 1) * 8 * 7168 * DM, DM * 2, 7168, texp + 16, W_TOS};
                    pg8::EpiSwiglu<false> E{W_HID, DFE, 1.0f}; pg8::gemm_phase<pg8::EpiSwiglu<false>, pg8::ProbGrouped, true, false>(F.lds, F.tid, P, S, E); } PH_END
            }
#pragma unroll 1
            for (int pass = 0; pass < 2; ++pass) {
                PH_BEGIN(15) {
                    LAS int* texp = (LAS int*)(F.lds + LDS_TEXP);
                    for (int i = F.tid; i < MAXTILES + 16; i += 512) texp[i] = W_TILE[i];
                    __syncthreads();
                    const int nA = texp[0], ntot = texp[1];
                    pg8::Order S; S.init(pass ? ntot - nA : nA, 4, F.G, F.cid, pass ? nA : 0);
                    if (FP8_OF(l)) { pg8::ProbGrouped P{W_HID, ws + WS_MDN + (size_t)(l >> 1) * 8 * DM * DFE * 2, DFE, DM, texp + 16, W_TOS};
                        pg8::EpiMoeDown E{xo, W_MODL + 5120, W_TOS, W_WOS, 1.0f / (SC8_HID * SC8_W)}; pg8::gemm_phase<pg8::EpiMoeDown, pg8::ProbGrouped, false, true>(F.lds, F.tid, P, S, E); }
                    else { pg8::ProbGrouped P{W_HID, (const bf16_t*)(ws + WS_MDN) + (size_t)(l >> 1) * 8 * DM * DFE, DFE * 2, DM, texp + 16, W_TOS};
                        pg8::EpiMoeDown E{xo, W_MODL + 5120, W_TOS, W_WOS, 1.0f}; pg8::gemm_phase<pg8::EpiMoeDown, pg8::ProbGrouped, false, false>(F.lds, F.tid, P, S, E); } } PH_END
            }
        }
    }
#undef PH_BEGIN
#undef PH_END
}

extern "C" void kernel_launch(void* const* d_in, const int* in_sizes, int n_in, void* d_out, int out_size, void* d_ws, size_t ws_size, hipStream_t stream) {
    static int grid = 0;
    if (grid == 0) {
        if (n_in != 30 || in_sizes[0] != NTOK * DM || out_size != NTOK * DM || ws_size < WS_END) { fprintf(stderr, "kernel_launch: unexpected shapes (n_in %d, in0 %d, out %d, ws %zu < %zu)\n", n_in, n_in > 0 ? in_sizes[0] : -1, out_size, ws_size, (size_t)WS_END); grid = -1; return; }
        int dev = 0, cus = 0, per_cu = 0;
        if (hipGetDevice(&dev) != hipSuccess || hipDeviceGetAttribute(&cus, hipDeviceAttributeMultiprocessorCount, dev) != hipSuccess) { grid = -1; return; }
        if (hipFuncSetAttribute((const void*)fwd_kernel, hipFuncAttributeMaxDynamicSharedMemorySize, LDS_BYTES) != hipSuccess) { fprintf(stderr, "kernel_launch: hipFuncSetAttribute failed\n"); grid = -1; return; }
        if (hipOccupancyMaxActiveBlocksPerMultiprocessor(&per_cu, (const void*)fwd_kernel, 512, LDS_BYTES) != hipSuccess || per_cu < 1) fprintf(stderr, "kernel_launch: occupancy query reports %d\n", per_cu);
        (void)hipGetLastError();
        grid = cus;
    }
    if (grid < 0) return;
    if (hipMemsetAsync((char*)d_ws + WS_CTL, 0, CTL_ZERO_BYTES, stream) != hipSuccess) return;
    Args a{};
    const float** fp = (const float**)&a;
    for (int i = 0; i < 30; ++i) fp[i] = (const float*)d_in[i];
    a.out = (float*)d_out; a.ws = (unsigned char*)d_ws;
#if MK_MULTI
    for (int p = 0; p < NPHASE; ++p) { a.ph_lo = p; a.ph_hi = p + 1; hipLaunchKernelGGL(fwd_kernel, dim3(grid), dim3(512), LDS_BYTES, stream, a); }
#else
    a.ph_lo = 0; a.ph_hi = NPHASE; hipLaunchKernelGGL(fwd_kernel, dim3(grid), dim3(512), LDS_BYTES, stream, a);
#endif
}
```

```cpp
#include <hip/hip_runtime.h>
#include <cstdio>
#include <cstdint>

#ifndef FP8MASK
#define FP8MASK 10
#endif
#define FP8_OF(l) (((FP8MASK) >> (l)) & 1)
#ifndef DUPMASK
#define DUPMASK 0
#endif
#ifndef DUP_SCANPAIR
#define DUP_SCANPAIR 0
#endif
#ifndef PHSEL
#define PHSEL 0xFFFFFFFFu
#endif
#ifndef MK_MULTI
#define MK_MULTI 0
#endif

#define LAS __attribute__((address_space(3)))
#define GAS __attribute__((address_space(1)))
typedef unsigned short bf16_t;
typedef short bf16x8 __attribute__((ext_vector_type(8)));
typedef short s16x4 __attribute__((ext_vector_type(4)));
typedef float f32x2 __attribute__((ext_vector_type(2)));
typedef float f32x4 __attribute__((ext_vector_type(4)));
typedef float f32x16 __attribute__((ext_vector_type(16)));
typedef unsigned u32x2 __attribute__((ext_vector_type(2)));
typedef unsigned u32x4 __attribute__((ext_vector_type(4)));
typedef __bf16 bf16x2_t __attribute__((ext_vector_type(2)));
typedef int i32x4 __attribute__((ext_vector_type(4)));
typedef int i32x8 __attribute__((ext_vector_type(8)));
constexpr float SC8_H = 4.0f, SC8_W = 64.0f, SC8_HID = 8.0f;

constexpr int DM = 1024, BATCH = 16, SEQ = 4096, NTOK = BATCH * SEQ;
constexpr int DFF = 3072, NEXP = 8, DFE = 3584;
constexpr int NSLOT = 135168;
constexpr int MAXTILES = NSLOT / 256;
constexpr float EPS = 1e-6f;
constexpr float LOG2E = 1.4426950408889634f;

constexpr size_t MiB = 1u << 20;
constexpr size_t WS_CTL = 0, CTL_ZERO_BYTES = 1 * MiB;
constexpr size_t WS_MODV = 1 * MiB;
constexpr size_t WS_KVMOD = 3 * MiB;
constexpr size_t WS_PAR = 3 * MiB + 512 * 1024;
constexpr int PAR_MIXN = 0, PAR_FFNN = 4096, PAR_CONVW = 8192, PAR_CONVB = 16384, PAR_GXB = 18432, PAR_GAB = 20480, PAR_LAM = 22528, PAR_KVN = 24576, PAR_KN = 25600, PAR_QN = 25664, PAR_SINK = 25792, PAR_ROUTER = 25856, PAR_END = 42240;
constexpr size_t WS_E12 = 4 * MiB;
constexpr size_t WS_W1 = 5 * MiB;
constexpr size_t WS_CNT = 6 * MiB;
constexpr size_t WS_TILE = 6 * MiB + 65536;
constexpr size_t WS_TOS = 7 * MiB;
constexpr size_t WS_WOS = 8 * MiB;
constexpr size_t WS_GW = 9 * MiB;
constexpr size_t WS_COS = 10 * MiB;
constexpr size_t WS_SIN = 18 * MiB;
constexpr size_t WS_WIN = 26 * MiB;
constexpr size_t WS_WOUT = 34 * MiB;
constexpr size_t WS_WKV = 38 * MiB;
constexpr size_t WS_WQ = 39 * MiB;
constexpr size_t WS_WO = 43 * MiB;
constexpr size_t WS_FGU = 47 * MiB;
constexpr size_t WS_FDN = 71 * MiB;
constexpr size_t WS_MGU = 83 * MiB;
constexpr size_t WS_MDN = 307 * MiB;
constexpr size_t WS_H = 419 * MiB;
constexpr size_t WS_HKV = 547 * MiB;
constexpr size_t WS_KB = 675 * MiB;
constexpr size_t WS_VB = 707 * MiB;
constexpr size_t WS_ARENA = 739 * MiB;
constexpr size_t WS_END = WS_ARENA + (size_t)NSLOT * DFE * 2;
static_assert(WS_END <= (size_t)1792 * MiB, "workspace map");
constexpr size_t AR_XB = 0, AR_GY = 128 * MiB, AR_Q = 0, AR_O = 128 * MiB;

constexpr int CW_BAR = 4096;

constexpr int LDS_BYTES = 163840;
constexpr int RING_BYTES = 131072;
constexpr int LDS_TEXP = RING_BYTES;
constexpr int LDS_IDX = RING_BYTES + 4096;
constexpr int LDS_MISC = LDS_BYTES - 256;

__device__ __forceinline__ unsigned cvtpk(float lo, float hi) { f32x2 v = {lo, hi}; bf16x2_t b = __builtin_convertvector(v, bf16x2_t); return __builtin_bit_cast(unsigned, b); }
__device__ __forceinline__ float clamp8(float v) { return __builtin_amdgcn_fmed3f(v, -448.0f, 448.0f); }
__device__ __forceinline__ unsigned cvt4_fp8(float a, float b, float c, float d) { int p = __builtin_amdgcn_cvt_pk_fp8_f32(clamp8(a), clamp8(b), 0, false); p = __builtin_amdgcn_cvt_pk_fp8_f32(clamp8(c), clamp8(d), p, true); return (unsigned)p; }
__device__ __forceinline__ float bf2f(unsigned short b) { return __uint_as_float(((unsigned)b) << 16); }
__device__ __forceinline__ float fast_exp2(float x) { return __builtin_amdgcn_exp2f(x); }
__device__ __forceinline__ float fast_rcp(float x) { return __builtin_amdgcn_rcpf(x); }
__device__ __forceinline__ float sigmoidf_(float x) { return fast_rcp(1.0f + fast_exp2(-x * LOG2E)); }
__device__ __forceinline__ float silu_(float x) { return x * sigmoidf_(x); }
__device__ __forceinline__ float gelu_tanh_(float x) { const float u = 0.7978845608028654f * (x + 0.044715f * x * x * x); return x * sigmoidf_(2.0f * u); }
__device__ __forceinline__ float shflx(float v, int lane, int o) { return __int_as_float(__builtin_amdgcn_ds_bpermute((lane ^ o) << 2, __float_as_int(v))); }
__device__ __forceinline__ float wave_sum(float v, int lane) {
#pragma unroll
    for (int o = 1; o < 64; o <<= 1) v += shflx(v, lane, o);
    return v;
}
__device__ __forceinline__ int lane_id_v() { int l; asm volatile("v_mbcnt_lo_u32_b32 %0, -1, 0\n\tv_mbcnt_hi_u32_b32 %0, -1, %0" : "=v"(l)); return l; }
#define LDS_WAIT() asm volatile("s_waitcnt lgkmcnt(0)" ::: "memory")
#define VM_WAIT() asm volatile("s_waitcnt vmcnt(0)" ::: "memory")

namespace pg8 {
constexpr int BM = 256, BK = 64, HALF = 128, HTB = HALF * BK * 2, STAGE_BYTES = 8 * HTB, NXCD = 8, WGM = 8;
__host__ __device__ __forceinline__ int lds_byte(int r, int c) { const int st = (r >> 4) * 2 + (c >> 5), rr = r & 15, cc = c & 31, ob = rr * 64 + cc * 2; return st * 1024 + (ob ^ (((ob >> 9) & 1) << 5)); }
__host__ __device__ __forceinline__ void stage_rc(int b, int& R, int& C) { const int st = b / 1024, sb = b % 1024, swz = sb ^ (((sb >> 9) & 1) << 5); R = (st >> 1) * 16 + swz / 64; C = (st & 1) * 32 + (swz % 64) / 2; }
__host__ __device__ __forceinline__ int perm32(int rho) { const int n = rho >> 4, i = rho & 15; return 8 * (i >> 2) + 4 * n + (i & 3); }

struct Unit { int pm, pn; };

struct Order {
    int nM, nN, nwg, G, c, tile0;
    __device__ __forceinline__ void init(int nM_, int nN_, int G_, int c_, int tile0_) { nM = nM_; nN = nN_; nwg = nM * nN; G = G_; c = c_; tile0 = tile0_; }
    __device__ __forceinline__ bool next(int i, Unit& u) const {
        const long L = (long)i * G + c; if (L >= nwg) return false;
        int wgid = (int)L; { const int q = nwg / NXCD, r = nwg % NXCD, xcd = wgid % NXCD, off = wgid / NXCD; wgid = (xcd < r ? xcd * (q + 1) : r * (q + 1) + (xcd - r) * q) + off; }
        const int nig = WGM * nN, gid = wgid / nig, fm = gid * WGM, gsz = (nM - fm) < WGM ? (nM - fm) : WGM;
        u.pm = tile0 + fm + ((wgid % nig) % gsz); u.pn = (wgid % nig) / gsz; return true;
    }
};

struct ProbDense {
    const void* A; const void* Bt; int KB;
    __device__ __forceinline__ const char* a_ptr(const Unit& u) const { return (const char*)A + (size_t)u.pm * BM * KB; }
    __device__ __forceinline__ const char* b_ptr(const Unit& u) const { return (const char*)Bt + (size_t)u.pn * BM * KB; }
};
struct ProbGrouped {
    const void* A; const void* Bt; int KB; int N; const LAS int* texp; const int* tos;
    __device__ __forceinline__ const char* a_ptr(const Unit& u) const { return (const char*)A + (size_t)u.pm * BM * KB; }
    __device__ __forceinline__ const char* b_ptr(const Unit& u) const { return (const char*)Bt + ((size_t)texp[u.pm] * N + (size_t)u.pn * BM) * KB; }
};

template <class Epi, class Prob, bool GATHER, bool FP8 = false>
__device__ __forceinline__ void gemm_phase(LAS unsigned char* lds, const int tid, const Prob P, const Order& S, const Epi& E) {
    const int wid = __builtin_amdgcn_readfirstlane(tid >> 6), lane = tid & 63, wr = wid >> 2, wc = wid & 3, fr = lane & 15, fq = lane >> 4;
    const int KB = P.KB, nt = KB / (BK * 2);
    unsigned voffA[2], voffB[2];
#pragma unroll
    for (int i = 0; i < 2; ++i) { int R, C; stage_rc(tid * 16 + i * 8192, R, C); const int Rb = Epi::PERM ? ((R & ~31) + perm32(R & 31)) : R;
        voffA[i] = GATHER ? (unsigned)(C * 2) : (unsigned)(R * KB + C * 2); voffB[i] = (unsigned)(Rb * KB + C * 2); }
    const size_t kstep = (size_t)(BK * 2);
    const size_t hstep = (size_t)HALF * KB;
    const unsigned ldsw = (unsigned)wid * 1024u;
    const int aoff = lds_byte(wr * 64 + fr, fq * 8), boff = lds_byte(wc * 32 + fr, fq * 8);
    LAS int* idxb = (LAS int*)(lds + LDS_IDX);
#define PG8_GIDX(buf) do { int ln_ = lane; asm volatile("" : "+v"(ln_)); _Pragma("unroll") for (int i = 0; i < 2; ++i) { const int R_ = 16 * ((wid + 8 * i) >> 1) + (ln_ >> 2); \
        int t0 = idxb[(buf) * 256 + R_], t1 = idxb[(buf) * 256 + 128 + R_]; t0 = t0 < 0 ? 0 : t0; t1 = t1 < 0 ? 0 : t1; \
        vC0[i] = (unsigned)t0 * (unsigned)KB + voffA[i]; vC1[i] = (unsigned)t1 * (unsigned)KB + voffA[i]; } } while (0)
#define PG8_GDMA(unit, buf) do { if (wid < 4) { int ln_ = lane; asm volatile("" : "+v"(ln_)); \
        __builtin_amdgcn_global_load_lds((const unsigned*)(P.tos + (size_t)(unit).pm * BM + wid * 64) + ln_, (LAS unsigned*)(idxb + (buf) * 256 + wid * 64), 4, 0, 0); } } while (0)
#define PG8_SA(b, h) (((b) * 2 + (h)) * HTB)
#define PG8_SB(b, h) ((4 + (b) * 2 + (h)) * HTB)
#define PG8_STAGE(bufoff, gbase, voff) do { const char* g_ = (const char*)(gbase); asm volatile("" : "+s"(g_)); _Pragma("unroll") for (int _i = 0; _i < 2; ++_i) \
        __builtin_amdgcn_global_load_lds((const unsigned*)(g_ + (voff)[_i]), (LAS unsigned*)(lds + (bufoff) + ldsw + _i * 8192), 16, 0, 0); } while (0)
#define PG8_LDA(dst, b, h) do { _Pragma("unroll") for (int m = 0; m < 4; ++m) _Pragma("unroll") for (int k = 0; k < 2; ++k) dst[m][k] = *(const LAS bf16x8*)(lds + PG8_SA(b, h) + aoff + m * 2048 + k * 1024); } while (0)
#define PG8_LDB(dst, b, h) do { _Pragma("unroll") for (int n = 0; n < 2; ++n) _Pragma("unroll") for (int k = 0; k < 2; ++k) dst[n][k] = *(const LAS bf16x8*)(lds + PG8_SB(b, h) + boff + n * 2048 + k * 1024); } while (0)
#define PG8_CAT8(v) __builtin_shufflevector(__builtin_bit_cast(i32x4, (v)[0]), __builtin_bit_cast(i32x4, (v)[1]), 0, 1, 2, 3, 4, 5, 6, 7)
#define PG8_MMA(ai, bj, At, Bt) do { __builtin_amdgcn_s_setprio(1); if constexpr (FP8) asm volatile("s_nop 1"); _Pragma("unroll") for (int m = 0; m < 4; ++m) _Pragma("unroll") for (int n = 0; n < 2; ++n) { \
        if constexpr (FP8) { const i32x8 b8_ = PG8_CAT8(Bt[n]), a8_ = PG8_CAT8(At[m]);   \
            asm volatile("v_mfma_scale_f32_16x16x128_f8f6f4 %0, %1, %2, %0, %3, %3 op_sel_hi:[0,0,0]" : "+v"(acc[ai][bj][m][n]) : "v"(b8_), "v"(a8_), "v"(sc8)); } \
        else { _Pragma("unroll") for (int k = 0; k < 2; ++k) acc[ai][bj][m][n] = __builtin_amdgcn_mfma_f32_16x16x32_bf16(Bt[n][k], At[m][k], acc[ai][bj][m][n], 0, 0, 0); } } __builtin_amdgcn_s_setprio(0); } while (0)
#define PG8_WAIT_V(n) asm volatile("s_waitcnt vmcnt(" #n ")" ::: "memory")
#define PG8_WAIT_L(n) asm volatile("s_waitcnt lgkmcnt(" #n ")" ::: "memory")
#define PG8_BAR __builtin_amdgcn_s_barrier()
#define PG8_SCHED __builtin_amdgcn_sched_barrier(0)
    Unit cur, nxt; int ui = 0;
    if (!S.next(0, cur)) return;
    f32x4 acc[2][2][4][2];
#pragma unroll
    for (int a = 0; a < 2; ++a)
#pragma unroll
        for (int b = 0; b < 2; ++b)
#pragma unroll
            for (int m = 0; m < 4; ++m)
#pragma unroll
                for (int n = 0; n < 2; ++n) acc[a][b][m][n] = (f32x4){0.f, 0.f, 0.f, 0.f};
    bf16x8 At[4][2], B0[2][2], B1[2][2];
    int sc8 = 0x7F7F7F7F; if constexpr (FP8) asm volatile("" : "+v"(sc8));
    unsigned vC0[2], vC1[2];
    const char* cA; const char* cB = P.b_ptr(cur);
    if constexpr (GATHER) {
        cA = (const char*)P.A;
        PG8_GDMA(cur, 0);
        PG8_WAIT_V(0); PG8_BAR;
        PG8_GIDX(0);
        LDS_WAIT(); PG8_BAR;
    } else {
        cA = P.a_ptr(cur);
#pragma unroll
        for (int i = 0; i < 2; ++i) { vC0[i] = voffA[i]; vC1[i] = voffA[i] + (unsigned)hstep; }
    }
    PG8_STAGE(PG8_SB(0, 0), cB, voffB); PG8_STAGE(PG8_SB(0, 1), cB + hstep, voffB); PG8_STAGE(PG8_SA(0, 0), cA, vC0); PG8_STAGE(PG8_SA(0, 1), cA, vC1);
    if (wr == 1) PG8_BAR;
    PG8_WAIT_V(2); PG8_BAR;
    PG8_STAGE(PG8_SB(1, 0), cB + kstep, voffB); PG8_STAGE(PG8_SA(1, 0), cA + kstep, vC0); PG8_STAGE(PG8_SB(1, 1), cB + hstep + kstep, voffB);
    PG8_WAIT_V(6); PG8_BAR;
    for (;;) {
        const bool has_next = S.next(ui + 1, nxt);
        const char* nA = GATHER ? cA : (has_next ? P.a_ptr(nxt) : cA); const char* nB = has_next ? P.b_ptr(nxt) : cB;
        for (int t = 0; t < nt; t += 2) {
            const bool last = (t == nt - 2);
            if constexpr (GATHER) {
                if (t == 0 && has_next) PG8_GDMA(nxt, (ui + 1) & 1);
            }
            const char* a1 = cA + (size_t)(t + 1) * kstep;
            const char* a2 = last ? nA : cA + (size_t)(t + 2) * kstep; const char* b2 = last ? nB : cB + (size_t)(t + 2) * kstep;
            const char* a3 = a2 + kstep; const char* b3 = b2 + kstep;
            PG8_LDB(B0, 0, 0); PG8_LDB(B1, 0, 1); PG8_SCHED; PG8_LDA(At, 0, 0); PG8_STAGE(PG8_SA(1, 1), a1, vC1);
            if constexpr (GATHER) { if (last && has_next) PG8_GIDX((ui + 1) & 1); }
            PG8_WAIT_V(8); PG8_WAIT_L(0); PG8_BAR; PG8_MMA(0, 0, At, B0); PG8_MMA(0, 1, At, B1); PG8_BAR; PG8_SCHED;
            PG8_LDA(At, 0, 1); PG8_STAGE(PG8_SB(0, 0), b2, voffB); PG8_STAGE(PG8_SB(0, 1), b2 + hstep, voffB); PG8_STAGE(PG8_SA(0, 0), a2, vC0);
            PG8_WAIT_V(8); PG8_WAIT_L(0); PG8_BAR; PG8_MMA(1, 0, At, B0); PG8_MMA(1, 1, At, B1); PG8_BAR; PG8_SCHED;
            PG8_LDB(B0, 1, 0); PG8_LDB(B1, 1, 1); PG8_SCHED; PG8_LDA(At, 1, 0); PG8_STAGE(PG8_SA(0, 1), a2, vC1);
            PG8_WAIT_V(8); PG8_WAIT_L(0); PG8_BAR; PG8_MMA(0, 0, At, B0); PG8_MMA(0, 1, At, B1); PG8_BAR; PG8_SCHED;
            PG8_LDA(At, 1, 1); PG8_STAGE(PG8_SB(1, 0), b3, voffB); PG8_STAGE(PG8_SB(1, 1), b3 + hstep, voffB); PG8_STAGE(PG8_SA(1, 0), a3, vC0);
            PG8_WAIT_V(8); PG8_WAIT_L(0); PG8_BAR; PG8_MMA(1, 0, At, B0); PG8_MMA(1, 1, At, B1); PG8_BAR; PG8_SCHED;
        }
        if constexpr (FP8) { asm volatile("s_nop 15\n\ts_nop 15" ::: "memory"); PG8_SCHED; }
        if (wr == 0) PG8_BAR;
        { int fr_ = fr, fq_ = fq; asm volatile("" : "+v"(fr_), "+v"(fq_)); E(acc, cur, wr, wc, fr_, fq_); }
        if (!has_next) break;
#pragma unroll
        for (int a = 0; a < 2; ++a)
#pragma unroll
            for (int b = 0; b < 2; ++b)
#pragma unroll
                for (int m = 0; m < 4; ++m)
#pragma unroll
                    for (int n = 0; n < 2; ++n) acc[a][b][m][n] = (f32x4){0.f, 0.f, 0.f, 0.f};
        cur = nxt; cA = nA; cB = nB; ++ui;
        if (wr == 1) PG8_BAR;
    }
    PG8_WAIT_V(0);
    PG8_BAR;
#undef PG8_SA
#undef PG8_GIDX
#undef PG8_GDMA
#undef PG8_SB
#undef PG8_STAGE
#undef PG8_LDA
#undef PG8_LDB
#undef PG8_MMA
#undef PG8_CAT8
#undef PG8_WAIT_V
#undef PG8_WAIT_L
#undef PG8_BAR
#undef PG8_SCHED
}

struct EpiResid {
    static constexpr bool PERM = false;
    const float* xin; float* xout; const float* gate; float ascale;
    __device__ __forceinline__ void operator()(const f32x4 (&acc)[2][2][4][2], const Unit& u, int wr, int wc, int fr, int fq) const {
        const int row0 = u.pm * BM + wr * 64 + fr, col0 = u.pn * BM + wc * 32 + 4 * fq;
        const float* gp = gate + (size_t)((u.pm * BM) >> 12) * 6144 + col0;
        f32x4 gv[2][2];
#pragma unroll
        for (int bj = 0; bj < 2; ++bj)
#pragma unroll
            for (int n = 0; n < 2; ++n) gv[bj][n] = (*(const f32x4*)(gp + bj * HALF + n * 16) + 1.0f) * ascale;
#pragma unroll
        for (int ai = 0; ai < 2; ++ai) {
            f32x4 xv[4][2][2];
#pragma unroll
            for (int m = 0; m < 4; ++m) { const size_t off = (size_t)(row0 + ai * HALF + m * 16) * DM + col0;
#pragma unroll
                for (int bj = 0; bj < 2; ++bj)
#pragma unroll
                    for (int n = 0; n < 2; ++n) xv[m][bj][n] = *(const f32x4*)(xin + off + bj * HALF + n * 16); }
#pragma unroll
            for (int m = 0; m < 4; ++m) { const size_t off = (size_t)(row0 + ai * HALF + m * 16) * DM + col0;
#pragma unroll
                for (int bj = 0; bj < 2; ++bj)
#pragma unroll
                    for (int n = 0; n < 2; ++n) *(f32x4*)(xout + off + bj * HALF + n * 16) = xv[m][bj][n] + gv[bj][n] * acc[ai][bj][m][n]; }
            asm volatile("" ::: "memory"); }
    }
};
struct EpiMoeDown {
    static constexpr bool PERM = false;
    float* x; const float* gate; const int* tos; const float* wos; float ascale;
    __device__ __forceinline__ void operator()(const f32x4 (&acc)[2][2][4][2], const Unit& u, int wr, int wc, int fr, int fq) const {
        const int slot0 = u.pm * BM + wr * 64 + fr, col0 = u.pn * BM + wc * 32 + 4 * fq;
        int tok[2][4]; float w[2][4];
#pragma unroll
        for (int ai = 0; ai < 2; ++ai)
#pragma unroll
            for (int m = 0; m < 4; ++m) { const int slot = slot0 + ai * HALF + m * 16; tok[ai][m] = tos[slot]; w[ai][m] = wos[slot] * ascale; }
#pragma unroll
        for (int ai = 0; ai < 2; ++ai) {
            f32x4 xv[4][2][2];
#pragma unroll
            for (int m = 0; m < 4; ++m) { const int t = tok[ai][m] < 0 ? 0 : tok[ai][m]; const float* xp = x + (size_t)t * DM + col0;
#pragma unroll
                for (int bj = 0; bj < 2; ++bj)
#pragma unroll
                    for (int n = 0; n < 2; ++n) xv[m][bj][n] = *(const f32x4*)(xp + bj * HALF + n * 16); }
#pragma unroll
            for (int m = 0; m < 4; ++m) { const int t = tok[ai][m];
                if (t >= 0) { const float* gp = gate + (size_t)(t >> 12) * 6144 + col0; float* xp = x + (size_t)t * DM + col0;
#pragma unroll
                    for (int bj = 0; bj < 2; ++bj)
#pragma unroll
                        for (int n = 0; n < 2; ++n) { const f32x4 g = (*(const f32x4*)(gp + bj * HALF + n * 16) + 1.0f) * w[ai][m];
                            *(f32x4*)(xp + bj * HALF + n * 16) = xv[m][bj][n] + g * acc[ai][bj][m][n]; } } }
            asm volatile("" ::: "memory"); }
    }
};
template <bool OUT8> struct EpiSwiglu {
    static constexpr bool PERM = true;
    void* O; int ldo; float ascale;
    __device__ __forceinline__ void operator()(const f32x4 (&acc)[2][2][4][2], const Unit& u, int wr, int wc, int fr, int fq) const {
        const int row0 = u.pm * BM + wr * 64 + fr, col0 = u.pn * HALF + wc * 32 + 8 * fq;
#pragma unroll
        for (int ai = 0; ai < 2; ++ai)
#pragma unroll
            for (int m = 0; m < 4; ++m) { const size_t eo = (size_t)(row0 + ai * HALF + m * 16) * ldo + col0;
                float v[8];
#pragma unroll
                for (int n = 0; n < 2; ++n)
#pragma unroll
                    for (int j = 0; j < 4; ++j) v[4 * n + j] = silu_(acc[ai][0][m][n][j] * ascale) * (acc[ai][1][m][n][j] * ascale);
                if constexpr (OUT8) { u32x2 w; w.x = cvt4_fp8(v[0] * SC8_HID, v[1] * SC8_HID, v[2] * SC8_HID, v[3] * SC8_HID); w.y = cvt4_fp8(v[4] * SC8_HID, v[5] * SC8_HID, v[6] * SC8_HID, v[7] * SC8_HID);
                    *(u32x2*)((unsigned char*)O + eo) = w; }
                else { u32x4 w; w.x = cvtpk(v[0], v[1]); w.y = cvtpk(v[2], v[3]); w.z = cvtpk(v[4], v[5]); w.w = cvtpk(v[6], v[7]);
                    *(u32x4*)((bf16_t*)O + eo) = w; } }
    }
};
struct EpiWin {
    static constexpr bool PERM = true;
    bf16_t* XB; bf16_t* GY;
    __device__ __forceinline__ void operator()(const f32x4 (&acc)[2][2][4][2], const Unit& u, int wr, int wc, int fr, int fq) const {
        const bool act = u.pn >= 4; bf16_t* base = act ? GY : XB;
        const int row0 = u.pm * BM + wr * 64 + fr, col0 = (u.pn & 3) * BM + wc * 32 + 8 * fq;
#pragma unroll
        for (int ai = 0; ai < 2; ++ai)
#pragma unroll
            for (int m = 0; m < 4; ++m) { bf16_t* rowp = base + (size_t)(row0 + ai * HALF + m * 16) * DM + col0;
#pragma unroll
                for (int bj = 0; bj < 2; ++bj) { f32x4 v0 = acc[ai][bj][m][0], v1 = acc[ai][bj][m][1];
                    if (act) {
#pragma unroll
                        for (int j = 0; j < 4; ++j) { v0[j] = gelu_tanh_(v0[j]); v1[j] = gelu_tanh_(v1[j]); } }
                    u32x4 w; w.x = cvtpk(v0[0], v0[1]); w.y = cvtpk(v0[2], v0[3]); w.z = cvtpk(v1[0], v1[1]); w.w = cvtpk(v1[2], v1[3]);
                    *(u32x4*)(rowp + bj * HALF) = w; } }
    }
};
struct EpiQK {
    static constexpr bool PERM = true;
    bf16_t* O; int ldo; const float* gain; const float* cosT; const float* sinT; float oscale; int vtile; bf16_t* OV;
    __device__ __forceinline__ void operator()(const f32x4 (&acc)[2][2][4][2], const Unit& u, int wr, int wc, int fr, int fq) const {
        const int row0 = u.pm * BM + wr * 64 + fr;
        if (u.pn == vtile) {
            const int col0 = wc * 32 + 8 * fq;
#pragma unroll
            for (int ai = 0; ai < 2; ++ai)
#pragma unroll
                for (int m = 0; m < 4; ++m) { bf16_t* rowp = OV + (size_t)(row0 + ai * HALF + m * 16) * ldo + col0;
#pragma unroll
                    for (int bj = 0; bj < 2; ++bj) { const f32x4 v0 = acc[ai][bj][m][0], v1 = acc[ai][bj][m][1];
                        u32x4 w; w.x = cvtpk(v0[0], v0[1]); w.y = cvtpk(v0[2], v0[3]); w.z = cvtpk(v1[0], v1[1]); w.w = cvtpk(v1[2], v1[3]);
                        *(u32x4*)(rowp + bj * HALF) = w; } }
            return;
        }
        const int colh = (u.pn * 4 + wc) * 64 + 8 * fq;
        f32x4 g1[2], g2[2];
#pragma unroll
        for (int n = 0; n < 2; ++n) { g1[n] = *(const f32x4*)(gain + 8 * fq + 4 * n); g2[n] = *(const f32x4*)(gain + 32 + 8 * fq + 4 * n); }
#pragma unroll
        for (int aim = 0; aim < 4; ++aim) { const int ai = aim >> 1;
            f32x4 cv[4][2], sv[4][2];
#pragma unroll
            for (int m = 2 * (aim & 1); m < 2 * (aim & 1) + 2; ++m) { const int row = row0 + ai * HALF + m * 16;
#pragma unroll
                for (int n = 0; n < 2; ++n) { cv[m][n] = *(const f32x4*)(cosT + (size_t)row * 32 + 8 * fq + 4 * n); sv[m][n] = *(const f32x4*)(sinT + (size_t)row * 32 + 8 * fq + 4 * n); } }
#pragma unroll
            for (int m = 2 * (aim & 1); m < 2 * (aim & 1) + 2; ++m) { const int row = row0 + ai * HALF + m * 16;
                float ss = 0.f;
#pragma unroll
                for (int bj = 0; bj < 2; ++bj)
#pragma unroll
                    for (int n = 0; n < 2; ++n) { const f32x4 a = acc[ai][bj][m][n]; ss += (a[0] * a[0] + a[1] * a[1]) + (a[2] * a[2] + a[3] * a[3]); }
                { const int ln_ = fq * 16 + fr; ss += shflx(ss, ln_, 16); ss += shflx(ss, ln_, 32); }
                const float r = __builtin_amdgcn_rsqf(ss * (1.0f / 64.0f) + EPS) * oscale;
                float o1[8], o2[8];
#pragma unroll
                for (int n = 0; n < 2; ++n) { const f32x4 c = cv[m][n], s = sv[m][n];
                    const f32x4 x1 = acc[ai][0][m][n] * g1[n] * r, x2 = acc[ai][1][m][n] * g2[n] * r;
                    const f32x4 a = x1 * c - x2 * s, b = x2 * c + x1 * s;
#pragma unroll
                    for (int j = 0; j < 4; ++j) { o1[4 * n + j] = a[j]; o2[4 * n + j] = b[j]; } }
                bf16_t* rowp = O + (size_t)row * ldo + colh;
                u32x4 w; w.x = cvtpk(o1[0], o1[1]); w.y = cvtpk(o1[2], o1[3]); w.z = cvtpk(o1[4], o1[5]); w.w = cvtpk(o1[6], o1[7]);
                *(u32x4*)rowp = w;
                w.x = cvtpk(o2[0], o2[1]); w.y = cvtpk(o2[2], o2[3]); w.z = cvtpk(o2[4], o2[5]); w.w = cvtpk(o2[6], o2[7]);
                *(u32x4*)(rowp + 32) = w; }
            asm volatile("" ::: "memory"); }
    }
};
}

#define XB_TMO      128
#define XB_XCNT(j)  (256  + 64 * (j))
#define XB_XSUB(j)  (1280 + 64 * (j))
#define XB_XGEN(j)  (2304 + 64 * (j))
#define XB_TOP      3328
#define XB_TOPGEN   3392
#define XCD_BAR_WORDS 3456
#define XB_SPIN_CAP (1u << 20)
__device__ __forceinline__ unsigned xb_ld(unsigned* p)              { return __hip_atomic_load(p, __ATOMIC_RELAXED, __HIP_MEMORY_SCOPE_AGENT); }
__device__ __forceinline__ unsigned xb_add(unsigned* p, unsigned v) { return __hip_atomic_fetch_add(p, v, __ATOMIC_RELAXED, __HIP_MEMORY_SCOPE_AGENT); }
__device__ __forceinline__ unsigned xb_xcc_id() { return (unsigned)__builtin_amdgcn_s_getreg((3 << 11) | 20) & 0xFu; }
#define XB_SPIN(cond, bar) do { unsigned _sp = 0; while (cond) { __builtin_amdgcn_s_sleep(1); \
    if ((++_sp & 255u) == 0u) { if (xb_ld(&(bar)[XB_TMO])) break; if (_sp > XB_SPIN_CAP) { atomicAdd(&(bar)[XB_TMO], 1u); break; } } } } while (0)
struct XcdBarrier { unsigned* bar; unsigned x; volatile LAS unsigned* st; };
__device__ __forceinline__ XcdBarrier xcd_barrier_post(unsigned* bar, volatile LAS unsigned* st, int wv) {
    XcdBarrier b; b.bar = bar; b.x = xb_xcc_id(); b.st = st;
    if (wv == 0 && lane_id_v() == 0) (void)xb_add(&bar[XB_XCNT(b.x)], 1u);
    return b;
}
__device__ __forceinline__ void xcd_barrier_complete(unsigned* bar, unsigned x, unsigned& nloc, unsigned& nx) {
    const unsigned G = gridDim.x * gridDim.y * gridDim.z;
    unsigned sum, cnt, mine, sp = 0u;
    for (;;) {
        sum = 0u; cnt = 0u; mine = 0u;
#pragma unroll
        for (unsigned j = 0; j < 16; ++j) { const unsigned c = xb_ld(&bar[XB_XCNT(j)]); sum += c; cnt += (c > 0u) ? 1u : 0u; mine = (j == x) ? c : mine; }
        if (sum == G) break;
        __builtin_amdgcn_s_sleep(1);
        if ((++sp & 255u) == 0u) { if (xb_ld(&bar[XB_TMO])) break; if (sp > XB_SPIN_CAP) { atomicAdd(&bar[XB_TMO], 1u); break; } }
    }
    nloc = mine > 0u ? mine : 1u; nx = cnt > 0u ? cnt : 1u;
}
__device__ __forceinline__ void xcd_barrier(const XcdBarrier& b, int wv) {
    asm volatile("s_waitcnt vmcnt(0)" ::: "memory");
    __syncthreads();
    if (wv == 0 && lane_id_v() == 0) {
        unsigned* bar = b.bar;
        __builtin_amdgcn_s_waitcnt(0);
        unsigned nloc = b.st[0], nx = b.st[1];
        if (nloc == 0u) { xcd_barrier_complete(bar, b.x, nloc, nx); b.st[0] = nloc; b.st[1] = nx; }
        const unsigned old = xb_add(&bar[XB_XSUB(b.x)], 1u);
        const unsigned gen = old / nloc;
        if (old + 1u == (gen + 1u) * nloc) {
            __builtin_amdgcn_fence(__ATOMIC_RELEASE, "agent");
            asm volatile("s_waitcnt vmcnt(0)" ::: "memory");
            const unsigned og = xb_add(&bar[XB_TOP], 1u);
            const unsigned tg = og / nx;
            if (og + 1u == (tg + 1u) * nx) xb_add(&bar[XB_TOPGEN], 1u);
            else XB_SPIN(xb_ld(&bar[XB_TOPGEN]) == tg, bar);
            __builtin_amdgcn_fence(__ATOMIC_ACQUIRE, "agent");
            xb_add(&bar[XB_XGEN(b.x)], 1u);
            asm volatile("s_waitcnt vmcnt(0)" ::: "memory");
        } else {
            XB_SPIN(xb_ld(&bar[XB_XGEN(b.x)]) == gen, bar);
            __builtin_amdgcn_fence(__ATOMIC_ACQUIRE, "agent");
            asm volatile("s_waitcnt vmcnt(0)" ::: "memory");
        }
    }
    __syncthreads();
}

struct Args {
    const float* x; const float* c; const int* pos; const float* ada_w; const float* ada_b; const float* mix_norm; const float* ffn_norm;
    const float* a_w_in; const float* a_conv_w; const float* a_conv_b; const float* a_gx_w; const float* a_gx_b; const float* a_ga_w; const float* a_ga_b;
    const float* a_lambda; const float* a_w_out; const float* kv_norm; const float* kv_ada_w; const float* kv_ada_b; const float* w_kv; const float* k_norm;
    const float* b_w_q; const float* b_q_norm; const float* b_sinks; const float* b_w_o; const float* f_w_gu; const float* f_w_down; const float* m_router;
    const float* m_w_gu; const float* m_w_down;
    float* out; unsigned char* ws; int ph_lo, ph_hi;
};

struct Ctx {
    LAS unsigned char* lds; int tid, lane, wave, vcu, G, cid;
};

template <bool F8>
__device__ __forceinline__ void transpose_item(const float* W, int K, int N, void* WT, int k0, int n0, int d0, int d1, LAS float* scr, int lane, float scale) {
    const int kr = lane >> 4, nq = lane & 15;
#pragma unroll 8
    for (int i = 0; i < 16; ++i) { const int k = 4 * i + kr; const f32x4 v = *(const f32x4*)(W + (size_t)(k0 + k) * N + n0 + 4 * nq);
        *(LAS f32x4*)(scr + k * 68 + ((4 * nq) ^ (4 * ((k >> 3) & 7)))) = v; }
    LDS_WAIT(); asm volatile("" ::: "memory");
    const int c = lane & 7, r = lane >> 3;
#pragma unroll
    for (int j = 0; j < 8; ++j) { const int n = 8 * j + r; const LAS float* s = scr + (8 * c) * 68 + (n ^ (4 * c));
        const int drow = ((n & 32) ? d1 : d0) + (n & 31);
        if constexpr (F8) { u32x2 o; o.x = cvt4_fp8(s[0 * 68] * scale, s[1 * 68] * scale, s[2 * 68] * scale, s[3 * 68] * scale); o.y = cvt4_fp8(s[4 * 68] * scale, s[5 * 68] * scale, s[6 * 68] * scale, s[7 * 68] * scale);
            *(u32x2*)((unsigned char*)WT + (size_t)drow * K + k0 + 8 * c) = o; }
        else { u32x4 o; o.x = cvtpk(s[0 * 68], s[1 * 68]); o.y = cvtpk(s[2 * 68], s[3 * 68]); o.z = cvtpk(s[4 * 68], s[5 * 68]); o.w = cvtpk(s[6 * 68], s[7 * 68]);
            *(u32x4*)((bf16_t*)WT + (size_t)drow * K + k0 + 8 * c) = o; } }
    LDS_WAIT(); asm volatile("" ::: "memory");
}
__device__ __forceinline__ int map_plain(int n) { return n; }
__device__ __forceinline__ int map_head(int n) { const int hd = n >> 6, d = n & 63; return 256 * (hd >> 2) + 128 * (d >> 5) + 32 * (hd & 3) + (d & 31); }
__device__ __forceinline__ int map_gu(int n, int F) { const int u = n >= F, j = u ? n - F : n; return 256 * (j >> 7) + 128 * u + (j & 127); }

__device__ __forceinline__ void p0_prologue(const Ctx& F, const Args& a) {
    unsigned char* ws = a.ws;
    {
        LAS float* cs = (LAS float*)F.lds;
        LAS float* red = (LAS float*)(F.lds + 65536);
        for (int i = F.tid; i < BATCH * DM; i += 512) { const int b = i >> 10, k = i & 1023; const float v = a.c[i]; cs[k * 16 + b] = silu_(v); }
        __syncthreads();
        float* modv = (float*)(ws + WS_MODV); float* kvmod = (float*)(ws + WS_KVMOD);
        constexpr int NC = 4 * 6144 + 2048, CPB = 104;
        for (int cb = F.vcu; cb * CPB < NC; cb += F.G) {
            const int cl = F.tid & 127, kp = F.tid >> 7, j = cb * CPB + cl;
            const bool on = (cl < CPB) && (j < NC);
            float accv[16];
#pragma unroll
            for (int b = 0; b < 16; ++b) accv[b] = 0.f;
            if (on) {
                const float* W; int ldw, jj;
                if (j < 4 * 6144) { const int l = j / 6144; jj = j - l * 6144; W = a.ada_w + (size_t)l * DM * 6144; ldw = 6144; } else { jj = j - 4 * 6144; W = a.kv_ada_w; ldw = 2048; }
                const float* wp = W + (size_t)(kp * 256) * ldw + jj;
#pragma unroll 4
                for (int k = 0; k < 256; ++k) { const float w = wp[(size_t)k * ldw]; const LAS f32x4* cv = (const LAS f32x4*)(cs + (kp * 256 + k) * 16);
#pragma unroll
                    for (int q = 0; q < 4; ++q) { const f32x4 c4 = cv[q]; accv[4 * q] += w * c4[0]; accv[4 * q + 1] += w * c4[1]; accv[4 * q + 2] += w * c4[2]; accv[4 * q + 3] += w * c4[3]; } }
            }
#pragma unroll
            for (int b = 0; b < 16; ++b) red[(kp * 128 + cl) * 16 + b] = accv[b];
            __syncthreads();
            for (int i = F.tid; i < CPB * 16; i += 512) { const int cl2 = i >> 4, b = i & 15, j2 = cb * CPB + cl2;
                if (j2 < NC) { const float s = (red[(0 * 128 + cl2) * 16 + b] + red[(1 * 128 + cl2) * 16 + b]) + (red[(2 * 128 + cl2) * 16 + b] + red[(3 * 128 + cl2) * 16 + b]);
                    if (j2 < 4 * 6144) { const int l = j2 / 6144, jj = j2 - l * 6144; modv[((size_t)l * 16 + b) * 6144 + jj] = s + a.ada_b[l * 6144 + jj]; }
                    else { const int jj = j2 - 4 * 6144; kvmod[(size_t)b * 2048 + jj] = s + a.kv_ada_b[jj]; } } }
            __syncthreads();
        }
    }
    {
        LAS float* scr = (LAS float*)(F.lds + F.wave * 17408);
        const int gw = F.vcu * 8 + F.wave, NGW = F.G * 8;
        constexpr int I_WIN = 16 * 32, I_SQ = 16 * 16, I_KV = 16 * 8, I_FGU = 16 * 96, I_FDN = 48 * 16, I_MGU = 16 * 112, I_MDN = 56 * 16;
        constexpr int NITEMS = 2 * I_WIN + 2 * I_SQ + I_KV + 2 * I_SQ + 2 * I_SQ + 2 * I_FGU + 2 * I_FDN + 16 * I_MGU + 16 * I_MDN;
        for (int it = gw; it < NITEMS; it += NGW) {
            int r = it;
            if (r < 2 * I_WIN) { const int mi = r / I_WIN, rr = r % I_WIN, nb = rr % 32, kb = rr / 32, n0 = 64 * nb;
                transpose_item<false>(a.a_w_in + (size_t)mi * DM * 2048, DM, 2048, (bf16_t*)(ws + WS_WIN) + (size_t)mi * 2048 * DM, 64 * kb, n0, n0, n0 + 32, scr, F.lane, 1.f); continue; } r -= 2 * I_WIN;
            if (r < 2 * I_SQ) { const int mi = r / I_SQ, rr = r % I_SQ, nb = rr % 16, kb = rr / 16, n0 = 64 * nb;
                transpose_item<false>(a.a_w_out + (size_t)mi * DM * DM, DM, DM, (bf16_t*)(ws + WS_WOUT) + (size_t)mi * DM * DM, 64 * kb, n0, n0, n0 + 32, scr, F.lane, 1.f); continue; } r -= 2 * I_SQ;
            if (r < I_KV) { const int nb = r % 8, kb = r / 8, n0 = 64 * nb;
                transpose_item<false>(a.w_kv, DM, 512, (bf16_t*)(ws + WS_WKV), 64 * kb, n0, n0 < 256 ? map_head(n0) : n0, n0 < 256 ? map_head(n0 + 32) : n0 + 32, scr, F.lane, 1.f); continue; } r -= I_KV;
            if (r < 2 * I_SQ) { const int mi = r / I_SQ, rr = r % I_SQ, nb = rr % 16, kb = rr / 16, n0 = 64 * nb;
                transpose_item<false>(a.b_w_q + (size_t)mi * DM * DM, DM, DM, (bf16_t*)(ws + WS_WQ) + (size_t)mi * DM * DM, 64 * kb, n0, map_head(n0), map_head(n0 + 32), scr, F.lane, 1.f); continue; } r -= 2 * I_SQ;
            if (r < 2 * I_SQ) { const int mi = r / I_SQ, rr = r % I_SQ, nb = rr % 16, kb = rr / 16, n0 = 64 * nb;
                transpose_item<false>(a.b_w_o + (size_t)mi * DM * DM, DM, DM, (bf16_t*)(ws + WS_WO) + (size_t)mi * DM * DM, 64 * kb, n0, n0, n0 + 32, scr, F.lane, 1.f); continue; } r -= 2 * I_SQ;
            if (r < 2 * I_FGU) { const int mi = r / I_FGU, rr = r % I_FGU, nb = rr % 96, kb = rr / 96, n0 = 64 * nb;
                if (FP8_OF(2 * mi)) transpose_item<true>(a.f_w_gu + (size_t)mi * DM * 6144, DM, 6144, ws + WS_FGU + (size_t)mi * 6144 * DM * 2, 64 * kb, n0, map_gu(n0, DFF), map_gu(n0 + 32, DFF), scr, F.lane, SC8_W);
                else transpose_item<false>(a.f_w_gu + (size_t)mi * DM * 6144, DM, 6144, (bf16_t*)(ws + WS_FGU) + (size_t)mi * 6144 * DM, 64 * kb, n0, map_gu(n0, DFF), map_gu(n0 + 32, DFF), scr, F.lane, 1.f); continue; } r -= 2 * I_FGU;
            if (r < 2 * I_FDN) { const int mi = r / I_FDN, rr = r % I_FDN, nb = rr % 16, kb = rr / 16, n0 = 64 * nb;
                if (FP8_OF(2 * mi)) transpose_item<true>(a.f_w_down + (size_t)mi * DFF * DM, DFF, DM, ws + WS_FDN + (size_t)mi * DM * DFF * 2, 64 * kb, n0, n0, n0 + 32, scr, F.lane, SC8_W);
                else transpose_item<false>(a.f_w_down + (size_t)mi * DFF * DM, DFF, DM, (bf16_t*)(ws + WS_FDN) + (size_t)mi * DM * DFF, 64 * kb, n0, n0, n0 + 32, scr, F.lane, 1.f); continue; } r -= 2 * I_FDN;
            if (r < 16 * I_MGU) { const int mi = r / I_MGU, rr = r % I_MGU, nb = rr % 112, kb = rr / 112, n0 = 64 * nb;
                if (FP8_OF(2 * (mi >> 3) + 1)) transpose_item<true>(a.m_w_gu + (size_t)mi * DM * 7168, DM, 7168, ws + WS_MGU + (size_t)(mi >> 3) * 8 * 7168 * DM * 2 + (size_t)(mi & 7) * 7168 * DM, 64 * kb, n0, map_gu(n0, DFE), map_gu(n0 + 32, DFE), scr, F.lane, SC8_W);
                else transpose_item<false>(a.m_w_gu + (size_t)mi * DM * 7168, DM, 7168, (bf16_t*)(ws + WS_MGU) + (size_t)mi * 7168 * DM, 64 * kb, n0, map_gu(n0, DFE), map_gu(n0 + 32, DFE), scr, F.lane, 1.f); continue; } r -= 16 * I_MGU;
            { const int mi = r / I_MDN, rr = r % I_MDN, nb = rr % 16, kb = rr / 16, n0 = 64 * nb;
                if (FP8_OF(2 * (mi >> 3) + 1)) transpose_item<true>(a.m_w_down + (size_t)mi * DFE * DM, DFE, DM, ws + WS_MDN + (size_t)(mi >> 3) * 8 * DM * DFE * 2 + (size_t)(mi & 7) * DM * DFE, 64 * kb, n0, n0, n0 + 32, scr, F.lane, SC8_W);
                else transpose_item<false>(a.m_w_down + (size_t)mi * DFE * DM, DFE, DM, (bf16_t*)(ws + WS_MDN) + (size_t)mi * DM * DFE, 64 * kb, n0, n0, n0 + 32, scr, F.lane, 1.f); }
        }
        __syncthreads();
    }
    {
        float* par = (float*)(ws + WS_PAR);
        const size_t gt0 = (size_t)F.vcu * 512 + F.tid, GT0 = (size_t)F.G * 512;
        for (size_t i = gt0; i < (size_t)PAR_END; i += GT0) { const int j = (int)i; float v;
            if (j < PAR_FFNN) v = a.mix_norm[j - PAR_MIXN]; else if (j < PAR_CONVW) v = a.ffn_norm[j - PAR_FFNN]; else if (j < PAR_CONVB) v = a.a_conv_w[j - PAR_CONVW];
            else if (j < PAR_GXB) v = a.a_conv_b[j - PAR_CONVB]; else if (j < PAR_GAB) v = a.a_gx_b[j - PAR_GXB]; else if (j < PAR_LAM) v = a.a_ga_b[j - PAR_GAB];
            else if (j < PAR_KVN) v = a.a_lambda[j - PAR_LAM]; else if (j < PAR_KN) v = a.kv_norm[j - PAR_KVN]; else if (j < PAR_QN) v = a.k_norm[j - PAR_KN];
            else if (j < PAR_SINK) v = a.b_q_norm[j - PAR_QN]; else if (j < PAR_ROUTER) v = a.b_sinks[j - PAR_SINK]; else v = a.m_router[j - PAR_ROUTER];
            par[j] = v; }
    }
    {
        const size_t gt = (size_t)F.vcu * 512 + F.tid, GT = (size_t)F.G * 512;
        bf16_t* gwp = (bf16_t*)(ws + WS_GW);
        for (size_t i = gt; i < (size_t)2 * 8 * 2 * 128 * 128; i += GT) { const int k = (int)(i & 127), j = (int)((i >> 7) & 127), c2 = (int)((i >> 14) & 1), n = (int)((i >> 15) & 7), l = (int)(i >> 18);
            const float* g = (j < 64) ? a.a_ga_w : a.a_gx_w; const float v = g[((size_t)(l * 8 + n) * 128 + k) * 128 + 64 * c2 + (j & 63)];
            gwp[i] = (bf16_t)(cvtpk(v, 0.f) & 0xffffu); }
        float* ct = (float*)(ws + WS_COS); float* st = (float*)(ws + WS_SIN);
        for (size_t i = gt; i < (size_t)NTOK * 32; i += GT) { const int p = (int)(i & 31); const size_t tok = i >> 5;
            const float inv = powf(10000.0f, -(float)(2 * p) / 64.0f); const float ang = (float)a.pos[tok] * inv;
            ct[i] = cosf(ang); st[i] = sinf(ang); }
    }
}

template <bool DUAL, bool ROUTER, bool OUT8 = false>
__device__ __forceinline__ void norm_phase(const Ctx& F, const float* x, const float* gain1, const float* sh1, const float* sc1, void* out1,
                                           const float* gain2, const float* sh2, const float* sc2, bf16_t* out2,
                                           const float* wrouter, int* e12, float* w1o, int* cnt) {
    LAS int* lcnt = (LAS int*)F.lds;
    for (int rb = F.vcu; rb < NTOK / 256; rb += F.G) {
        const int b = rb >> 4;
        if (ROUTER) { if (F.tid < 16) lcnt[F.tid] = 0; __syncthreads(); }
        float ca[16], cs[16], ca2[16], cs2[16];
#pragma unroll
        for (int j = 0; j < 4; ++j) { const int col = 4 * F.lane + 256 * j;
            const f32x4 g = *(const f32x4*)(gain1 + col), s = *(const f32x4*)(sc1 + (size_t)b * 6144 + col), h = *(const f32x4*)(sh1 + (size_t)b * 6144 + col);
#pragma unroll
            for (int q = 0; q < 4; ++q) { ca[4 * j + q] = g[q] * (1.0f + s[q]); cs[4 * j + q] = h[q]; }
            if (DUAL) { const f32x4 g2 = *(const f32x4*)(gain2 + col), s2 = *(const f32x4*)(sc2 + (size_t)b * 2048 + col), h2 = *(const f32x4*)(sh2 + (size_t)b * 2048 + col);
#pragma unroll
                for (int q = 0; q < 4; ++q) { ca2[4 * j + q] = g2[q] * (1.0f + s2[q]); cs2[4 * j + q] = h2[q]; } } }
        float wr_[ROUTER ? 128 : 1];
        if (ROUTER) {
#pragma unroll
            for (int j = 0; j < 4; ++j)
#pragma unroll
                for (int q = 0; q < 4; ++q) { const int col = 4 * F.lane + 256 * j + q; const f32x4 w0 = *(const f32x4*)(wrouter + (size_t)col * 8), w1 = *(const f32x4*)(wrouter + (size_t)col * 8 + 4);
#pragma unroll
                    for (int e = 0; e < 4; ++e) { wr_[(4 * j + q) * 8 + e] = w0[e]; wr_[(4 * j + q) * 8 + 4 + e] = w1[e]; } }
        }
        int me12 = 0; float mw1 = 0.f;
        const int rowb = rb * 256 + F.wave * 32;
        for (int rr = 0; rr < 32; ++rr) {
            const size_t row = (size_t)(rowb + rr);
            const f32x4* xr = (const f32x4*)(x + row * DM) + F.lane;
            f32x4 v[4]; float s = 0.f;
#pragma unroll
            for (int j = 0; j < 4; ++j) { v[j] = xr[64 * j]; s += (v[j][0] * v[j][0] + v[j][1] * v[j][1]) + (v[j][2] * v[j][2] + v[j][3] * v[j][3]); }
            const float r = __builtin_amdgcn_rsqf(wave_sum(s, F.lane) * (1.0f / DM) + EPS);
            float hv[16];
#pragma unroll
            for (int j = 0; j < 4; ++j)
#pragma unroll
                for (int q = 0; q < 4; ++q) hv[4 * j + q] = v[j][q] * r * ca[4 * j + q] + cs[4 * j + q];
            if constexpr (OUT8) { unsigned* o4 = (unsigned*)((unsigned char*)out1 + row * DM) + F.lane;
#pragma unroll
                for (int j = 0; j < 4; ++j) o4[64 * j] = cvt4_fp8(hv[4 * j] * SC8_H, hv[4 * j + 1] * SC8_H, hv[4 * j + 2] * SC8_H, hv[4 * j + 3] * SC8_H); }
            else { u32x2* o8 = (u32x2*)((bf16_t*)out1 + row * DM) + F.lane;
#pragma unroll
                for (int j = 0; j < 4; ++j) { u32x2 w; w.x = cvtpk(hv[4 * j], hv[4 * j + 1]); w.y = cvtpk(hv[4 * j + 2], hv[4 * j + 3]); o8[64 * j] = w; } }
            if (DUAL) { u32x2* p8 = (u32x2*)(out2 + row * DM) + F.lane;
#pragma unroll
                for (int j = 0; j < 4; ++j) { float t[4];
#pragma unroll
                    for (int q = 0; q < 4; ++q) t[q] = v[j][q] * r * ca2[4 * j + q] + cs2[4 * j + q];
                    u32x2 w; w.x = cvtpk(t[0], t[1]); w.y = cvtpk(t[2], t[3]); p8[64 * j] = w; } }
            if (ROUTER) {
                float lg[8];
#pragma unroll
                for (int e = 0; e < 8; ++e) { float p = 0.f;
#pragma unroll
                    for (int c = 0; c < 16; ++c) p += hv[c] * wr_[c * 8 + e];
                    lg[e] = wave_sum(p, F.lane); }
                int i1 = 0; float v1 = lg[0];
#pragma unroll
                for (int e = 1; e < 8; ++e) if (lg[e] > v1) { v1 = lg[e]; i1 = e; }
                int i2 = -1; float v2 = -INFINITY;
#pragma unroll
                for (int e = 0; e < 8; ++e) if (e != i1 && lg[e] > v2) { v2 = lg[e]; i2 = e; }
                const float wt = 1.0f / (1.0f + __expf(v2 - v1));
                if (F.lane == rr) { me12 = i1 | (i2 << 8); mw1 = wt; }
            }
        }
        if (ROUTER) {
            if (F.lane < 32) { e12[rowb + F.lane] = me12; w1o[rowb + F.lane] = mw1; }
            const int e1 = me12 & 255, e2 = me12 >> 8;
#pragma unroll
            for (int e = 0; e < 8; ++e) { const unsigned long long m1 = __ballot(F.lane < 32 && e1 == e), m2 = __ballot(F.lane < 32 && e2 == e);
                if (F.lane == 0) { atomicAdd((int*)&lcnt[e], (int)__popcll(m1)); atomicAdd((int*)&lcnt[8 + e], (int)__popcll(m2)); } }
            __syncthreads();
            if (F.tid < 16) cnt[rb * 16 + F.tid] = lcnt[F.tid];
            __syncthreads();
        }
    }
}

__device__ __forceinline__ void moe_scatter(const Ctx& F, const int* cnt, const int* e12, const float* w1, int* tos, float* wos, int* tile) {
    LAS int* T1 = (LAS int*)F.lds;
    LAS int* T2 = T1 + 512;
    LAS int* tot = T2 + 512;
    LAS int* pre = tot + 16;
    LAS int* seg = pre + 16;
    LAS int* wcn = seg + 32;
    for (int rb = F.vcu; rb < NTOK / 256; rb += F.G) {
        { const int bin = F.tid & 15, part = F.tid >> 4; int st = 0, sp = 0;
#pragma unroll
            for (int j = 0; j < 8; ++j) { const int b2 = part * 8 + j; const int v = cnt[b2 * 16 + bin]; st += v; if (b2 < rb) sp += v; }
            T1[part * 16 + bin] = st; T2[part * 16 + bin] = sp; }
        __syncthreads();
        if (F.tid < 16) { int st = 0, sp = 0; for (int p = 0; p < 32; ++p) { st += T1[p * 16 + F.tid]; sp += T2[p * 16 + F.tid]; } tot[F.tid] = st; pre[F.tid] = sp; }
        __syncthreads();
        if (F.tid == 0) { int s = 0; for (int bin = 0; bin < 16; ++bin) { seg[bin] = s; s += ((tot[bin] + 255) >> 8) << 8; } seg[16] = s; }
        __syncthreads();
        int e1 = -1, e2 = -1; float wt = 0.f; int r1 = 0, r2 = 0;
        const int token = rb * 256 + F.tid;
        if (F.tid < 256) { const int v = e12[token]; e1 = v & 255; e2 = v >> 8; wt = w1[token]; }
        if (F.wave < 4) {
#pragma unroll
            for (int e = 0; e < 8; ++e) { const unsigned long long m1 = __ballot(e1 == e), m2 = __ballot(e2 == e); const unsigned long long lt = (1ull << F.lane) - 1ull;
                if (e1 == e) r1 = (int)__popcll(m1 & lt); if (e2 == e) r2 = (int)__popcll(m2 & lt);
                if (F.lane == 0) { wcn[F.wave * 16 + e] = (int)__popcll(m1); wcn[F.wave * 16 + 8 + e] = (int)__popcll(m2); } }
        }
        __syncthreads();
        if (F.tid < 256) {
            int o1 = seg[e1] + pre[e1] + r1, o2 = seg[8 + e2] + pre[8 + e2] + r2;
            for (int w = 0; w < F.wave; ++w) { o1 += wcn[w * 16 + e1]; o2 += wcn[w * 16 + 8 + e2]; }
            tos[o1] = token; wos[o1] = wt; tos[o2] = token; wos[o2] = 1.0f - wt;
        }
        if (rb < 16) { const int bin = rb; const int s0 = seg[bin] + tot[bin], s1 = seg[bin + 1]; for (int s = s0 + F.tid; s < s1; s += 512) { tos[s] = -1; wos[s] = 0.f; } }
        if (rb == 0) { if (F.tid == 0) { tile[0] = seg[8] >> 8; tile[1] = seg[16] >> 8; }
            for (int t = F.tid; t < MAXTILES; t += 512) { const int s = t << 8; int e = 0;
#pragma unroll
                for (int bin = 1; bin < 16; ++bin) if (s >= seg[bin]) e = bin;
                tile[16 + t] = e & 7; } }
        __syncthreads();
    }
}

constexpr int SC_AT = 0, SC_WT = 34816, SC_AS = 69632, SC_BS = 102400, SC_SEG = 135168, SC_CARRY = 139264, SC_CW = 139776, SC_GB = 142336;
__device__ __forceinline__ void scan_phase(const Ctx& F, const float* par, int l, const bf16_t* XB, bf16_t* GY, const bf16_t* GW) {
    LAS unsigned char* lds = F.lds;
    LAS float* AS = (LAS float*)(lds + SC_AS); LAS float* BS = (LAS float*)(lds + SC_BS);
    LAS float* SEGA = (LAS float*)(lds + SC_SEG); LAS float* SEGB = SEGA + 512;
    LAS float* CARRY = (LAS float*)(lds + SC_CARRY);
    LAS float* CW = (LAS float*)(lds + SC_CW);
    LAS float* GB = (LAS float*)(lds + SC_GB);
    const int tid = F.tid, lane = F.lane, wid = F.wave, r32 = lane & 31, hh = lane >> 5;
    for (int un = F.vcu; un < 256; un += F.G) {
        const int b = un >> 4, n = (un >> 1) & 7, c2 = un & 1;
        __syncthreads();
        for (int i = tid; i < 640; i += 512) { const int ch = i & 127, k = i >> 7; CW[i] = (k < 4) ? par[PAR_CONVW + (l * 4 + k) * DM + 128 * n + ch] : par[PAR_CONVB + l * DM + 128 * n + ch]; }
        if (tid < 64) { const int ch = l * DM + 128 * n + 64 * c2 + tid; GB[tid] = par[PAR_GAB + ch]; GB[64 + tid] = par[PAR_GXB + ch]; GB[128 + tid] = log1pf(expf(-par[PAR_LAM + ch])); CARRY[tid] = 0.f; CARRY[64 + tid] = 0.f; }
        { const bf16_t* gsrc = GW + (size_t)(((l * 8 + n) * 2 + c2) * 128) * 128;
#pragma unroll
            for (int i = 0; i < 4; ++i) { const int p = tid + 512 * i, row = p >> 4, c16 = p & 15; const u32x4 v = *(const u32x4*)(gsrc + (size_t)row * 128 + c16 * 8); *(LAS u32x4*)(lds + SC_WT + row * 272 + c16 * 16) = v; } }
        const int cp = lane, tg = wid;
        const int sc = lane, sg = wid;
        const size_t rowbase = (size_t)b * SEQ;
        const bf16_t* xbp = XB + rowbase * DM + 128 * n + 2 * cp;
        bf16_t* gyp = GY + rowbase * DM + 128 * n + 64 * c2 + sc;
        unsigned xv[19];
#pragma unroll
        for (int k = 0; k < 19; ++k) { const int t = 16 * tg - 3 + k; xv[k] = (t >= 0) ? *(const unsigned*)(xbp + (size_t)t * DM) : 0u; }
        __syncthreads();
        float w[2][4], cb[2];
#pragma unroll
        for (int q = 0; q < 2; ++q) { cb[q] = CW[512 + 2 * cp + q];
#pragma unroll
            for (int k = 0; k < 4; ++k) w[q][k] = CW[k * 128 + 2 * cp + q]; }
        const float gba = GB[32 * (wid & 1) + r32], gbx = GB[64 + 32 * (wid & 1) + r32], spv = GB[128 + 32 * (wid & 1) + r32];
        for (int ci = 0; ci < SEQ / 128; ++ci) {
            const int t0 = ci * 128;
#pragma unroll
            for (int k = 0; k < 16; ++k) {
                float o[2];
#pragma unroll
                for (int q = 0; q < 2; ++q) { float s = cb[q];
#pragma unroll
                    for (int j = 0; j < 4; ++j) { const unsigned pv = xv[k + j]; const float xf = q ? __uint_as_float(pv & 0xffff0000u) : __uint_as_float(pv << 16); s += w[q][j] * xf; }
                    o[q] = s; }
                *(LAS unsigned*)(lds + SC_AT + (16 * tg + k) * 272 + cp * 4) = cvtpk(o[0], o[1]);
            }
            if (ci + 1 < SEQ / 128) {
#pragma unroll
                for (int k = 0; k < 19; ++k) xv[k] = *(const unsigned*)(xbp + (size_t)(t0 + 128 + 16 * tg - 3 + k) * DM);
            }
            __syncthreads();
            f32x16 ga, gx;
#pragma unroll
            for (int i = 0; i < 16; ++i) { ga[i] = 0.f; gx[i] = 0.f; }
            { const int tt = wid >> 1, ct = wid & 1;
                const LAS unsigned char* ap = lds + SC_AT + (32 * tt + r32) * 272 + hh * 16;
                const LAS unsigned char* bpa = lds + SC_WT + (32 * ct + r32) * 272 + hh * 16;
                const LAS unsigned char* bpx = bpa + 64 * 272;
#pragma unroll
                for (int s = 0; s < 8; ++s) { const bf16x8 af = *(const LAS bf16x8*)(ap + s * 32), ba = *(const LAS bf16x8*)(bpa + s * 32), bx = *(const LAS bf16x8*)(bpx + s * 32);
                    ga = __builtin_amdgcn_mfma_f32_32x32x16_bf16(af, ba, ga, 0, 0, 0); gx = __builtin_amdgcn_mfma_f32_32x32x16_bf16(af, bx, gx, 0, 0, 0); }
#pragma unroll
                for (int i = 0; i < 16; ++i) { const int tok = 32 * tt + (i & 3) + 8 * (i >> 2) + 4 * hh, ch = 32 * ct + r32;
                    const float rg = sigmoidf_(ga[i] + gba), ig = sigmoidf_(gx[i] + gbx);
                    const float la = -8.0f * rg * spv; const float av = fast_exp2(la * LOG2E); const float bc = __builtin_amdgcn_sqrtf(fmaxf(1.0f - av * av, 0.f));
                    const float xcv = bf2f(*(const LAS unsigned short*)(lds + SC_AT + tok * 272 + (64 * c2 + ch) * 2));
                    AS[tok * 64 + ch] = av; BS[tok * 64 + ch] = bc * ig * xcv; }
            }
            __syncthreads();
            unsigned short gyv[16];
#pragma unroll
            for (int k = 0; k < 16; ++k) gyv[k] = gyp[(size_t)(t0 + 16 * sg + k) * DM];
            float av[16], bv[16];
#pragma unroll
            for (int k = 0; k < 16; ++k) { av[k] = AS[(16 * sg + k) * 64 + sc]; bv[k] = BS[(16 * sg + k) * 64 + sc]; }
            { float pa = 1.f, pb = 0.f;
#pragma unroll
                for (int k = 0; k < 16; ++k) { pb = av[k] * pb + bv[k]; pa *= av[k]; }
                SEGA[sg * 64 + sc] = pa; SEGB[sg * 64 + sc] = pb; }
            __syncthreads();
            float h = CARRY[(ci & 1) * 64 + sc];
            for (int s = 0; s < sg; ++s) h = SEGA[s * 64 + sc] * h + SEGB[s * 64 + sc];
#pragma unroll
            for (int k = 0; k < 16; ++k) { h = av[k] * h + bv[k]; const float o = h * bf2f(gyv[k]); gyp[(size_t)(t0 + 16 * sg + k) * DM] = (bf16_t)(cvtpk(o, 0.f) & 0xffffu); }
            if (sg == 7) CARRY[((ci + 1) & 1) * 64 + sc] = h;
        }
    }
    __syncthreads();
}

constexpr int AT_K = 0, AT_V = 36864;
__device__ __forceinline__ void attn_phase(const Ctx& F, const bf16_t* Q, const bf16_t* Kb, const bf16_t* Vb, bf16_t* O, const float* sinks) {
    LAS unsigned char* lds = F.lds;
    const int tid = F.tid, lane = F.lane, wid = F.wave, r32 = lane & 31, hh = lane >> 5;
    const int i16 = lane & 15, tq = i16 >> 2, tp = i16 & 3, blk = (lane >> 4) & 1;
    const int g = wid & 3, half = wid >> 2;
    constexpr int NU = BATCH * 32 * 4;
    u32x4 kreg[4], vreg[4]; bf16x8 qreg[2][4];
#define AT_LOADKV(unit) do { const int kh_ = (unit) & 3, n_ = ((unit) >> 2) & 31, b_ = (unit) >> 7; \
        _Pragma("unroll") for (int i = 0; i < 4; ++i) { const int p = tid + 512 * i, row = p >> 3, c16 = p & 7; kreg[i] = (u32x4){0u, 0u, 0u, 0u}; vreg[i] = (u32x4){0u, 0u, 0u, 0u}; \
            if (n_ > 0 || row >= 128) { const size_t tok = (size_t)b_ * SEQ + (size_t)(128 * (n_ - 1) + row); kreg[i] = *(const u32x4*)(Kb + tok * 256 + kh_ * 64 + c16 * 8); vreg[i] = *(const u32x4*)(Vb + tok * 256 + kh_ * 64 + c16 * 8); } } } while (0)
#define AT_LOADQ(unit) do { const int kh_ = (unit) & 3, n_ = ((unit) >> 2) & 31, b_ = (unit) >> 7; \
        _Pragma("unroll") for (int ps = 0; ps < 2; ++ps) { const size_t qt_ = (size_t)b_ * SEQ + (size_t)(128 * n_ + 64 * half + 32 * ps + r32); \
            _Pragma("unroll") for (int s = 0; s < 4; ++s) qreg[ps][s] = *(const bf16x8*)(Q + qt_ * DM + (4 * kh_ + g) * 64 + 16 * s + 8 * hh); } } while (0)
    int un = F.vcu;
    if (un < NU) { AT_LOADKV(un); AT_LOADQ(un); }
    for (; un < NU; un += F.G) {
        const int kh = un & 3, n = (un >> 2) & 31, b = un >> 7;
        __syncthreads();
#pragma unroll
        for (int i = 0; i < 4; ++i) { const int p = tid + 512 * i, row = p >> 3, c16 = p & 7;
            *(LAS u32x4*)(lds + AT_K + row * 144 + c16 * 16) = kreg[i]; *(LAS u32x4*)(lds + AT_V + row * 192 + c16 * 16) = vreg[i]; }
        __syncthreads();
        if (un + F.G < NU) AT_LOADKV(un + F.G);
        const int hq = 4 * kh + g;
        const float sink2 = sinks[hq] * LOG2E;
#pragma unroll 1
        for (int pass = 0; pass < 2; ++pass) {
            const int i0 = 64 * half + 32 * pass, kt0 = i0 >> 5;
            const size_t qtok = (size_t)b * SEQ + (size_t)(128 * n + i0 + r32);
            bf16x8 qf[4];
#pragma unroll
            for (int s = 0; s < 4; ++s) qf[s] = pass ? qreg[1][s] : qreg[0][s];
            f32x16 sacc[5];
#pragma unroll
            for (int t = 0; t < 5; ++t) {
#pragma unroll
                for (int i = 0; i < 16; ++i) sacc[t][i] = 0.f;
#pragma unroll
                for (int s = 0; s < 4; ++s) { const bf16x8 kf = *(const LAS bf16x8*)(lds + AT_K + (32 * (kt0 + t) + r32) * 144 + (16 * s + 8 * hh) * 2);
                    sacc[t] = __builtin_amdgcn_mfma_f32_32x32x16_bf16(kf, qf[s], sacc[t], 0, 0, 0); } }
            const int qi = i0 + r32;
            float mx = sink2;
#pragma unroll
            for (int t = 0; t < 5; ++t)
#pragma unroll
                for (int i = 0; i < 16; ++i) { const int j = 32 * (kt0 + t) + (i & 3) + 8 * (i >> 2) + 4 * hh; const int d = j - qi;
                    const bool ok = (d >= 1) && (d <= 128) && (n > 0 || j >= 128);
                    const float sv = ok ? sacc[t][i] : -INFINITY; sacc[t][i] = sv; mx = fmaxf(mx, sv); }
            mx = fmaxf(mx, shflx(mx, lane, 32));
            float sum = 0.f;
#pragma unroll
            for (int t = 0; t < 5; ++t)
#pragma unroll
                for (int i = 0; i < 16; ++i) { const float p = fast_exp2(sacc[t][i] - mx); sacc[t][i] = p; sum += p; }
            sum += shflx(sum, lane, 32);
            sum += fast_exp2(sink2 - mx);
            const float inv = 1.0f / sum;
            f32x16 oacc[2];
#pragma unroll
            for (int i = 0; i < 16; ++i) { oacc[0][i] = 0.f; oacc[1][i] = 0.f; }
#pragma unroll
            for (int t = 0; t < 5; ++t)
#pragma unroll
                for (int s = 0; s < 2; ++s) {
                    u32x4 pk; pk.x = cvtpk(sacc[t][8 * s], sacc[t][8 * s + 1]); pk.y = cvtpk(sacc[t][8 * s + 2], sacc[t][8 * s + 3]); pk.z = cvtpk(sacc[t][8 * s + 4], sacc[t][8 * s + 5]); pk.w = cvtpk(sacc[t][8 * s + 6], sacc[t][8 * s + 7]);
                    const bf16x8 pb = __builtin_bit_cast(bf16x8, pk);
#pragma unroll
                    for (int dt = 0; dt < 2; ++dt) {
                        const LAS unsigned char* vp = lds + AT_V + (32 * (kt0 + t) + 16 * s + 4 * hh + tq) * 192 + (32 * dt + 16 * blk + 4 * tp) * 2;
                        const s16x4 lo = __builtin_bit_cast(s16x4, __builtin_amdgcn_ds_read_tr16_b64_v4i16((LAS s16x4*)vp));
                        const s16x4 hi = __builtin_bit_cast(s16x4, __builtin_amdgcn_ds_read_tr16_b64_v4i16((LAS s16x4*)(vp + 8 * 192)));
                        const bf16x8 va = __builtin_shufflevector(lo, hi, 0, 1, 2, 3, 4, 5, 6, 7);
                        oacc[dt] = __builtin_amdgcn_mfma_f32_32x32x16_bf16(va, pb, oacc[dt], 0, 0, 0);
                    }
                }
            bf16_t* op = O + qtok * DM + hq * 64;
#pragma unroll
            for (int dt = 0; dt < 2; ++dt)
#pragma unroll
                for (int q4 = 0; q4 < 4; ++q4) { u32x2 w; w.x = cvtpk(oacc[dt][4 * q4] * inv, oacc[dt][4 * q4 + 1] * inv); w.y = cvtpk(oacc[dt][4 * q4 + 2] * inv, oacc[dt][4 * q4 + 3] * inv);
                    *(u32x2*)(op + 32 * dt + 8 * q4 + 4 * hh) = w; }
        }
        if (un + F.G < NU) AT_LOADQ(un + F.G);
    }
#undef AT_LOADKV
#undef AT_LOADQ
    __syncthreads();
}

constexpr int NPHASE = 34 + (DUP_SCANPAIR ? 4 : 0);
__global__ void __launch_bounds__(512, 2) fwd_kernel(Args a) {
    extern __shared__ __attribute__((aligned(16))) unsigned char lds_raw[];
    volatile LAS unsigned* MISC = (volatile LAS unsigned*)((LAS unsigned char*)lds_raw + LDS_MISC);
    const int wv0 = __builtin_amdgcn_readfirstlane((int)threadIdx.x >> 6);
    if (wv0 == 0) MISC[lane_id_v()] = 0u;
    __syncthreads();
    XcdBarrier bar; bar.bar = (unsigned*)(a.ws + WS_CTL) + CW_BAR; bar.x = 0; bar.st = MISC;
    if (!MK_MULTI) bar = xcd_barrier_post((unsigned*)(a.ws + WS_CTL) + CW_BAR, MISC, wv0);
    const int lo = a.ph_lo, hi = a.ph_hi;
    int ph = 0;
#define PH_BEGIN(k) if (((PHSEL >> (k)) & 1) && lo <= ph && ph < hi) { Ctx F; { int t_ = wv0 * 64 + (int)lane_id_v(); asm volatile("" : "+v"(t_)); F.tid = t_; } F.lds = (LAS unsigned char*)lds_raw; F.lane = F.tid & 63; \
        F.wave = __builtin_amdgcn_readfirstlane(F.tid >> 6); F.G = gridDim.x; { int bx = blockIdx.x; asm volatile("" : "+s"(bx)); F.cid = bx; F.vcu = (F.G % 8 == 0) ? (bx % 8) * (F.G / 8) + bx / 8 : bx; } \
        unsigned char GAS* wsg_ = (unsigned char GAS*)a.ws; asm volatile("" : "+s"(wsg_)); unsigned char* ws = (unsigned char*)wsg_; float GAS* xog_ = (float GAS*)a.out; asm volatile("" : "+s"(xog_)); float* xo = (float*)xog_; int l = l_; asm volatile("" : "+s"(l)); (void)xo; (void)l; \
        for (int rep_ = 0; rep_ < (((DUPMASK >> (k)) & 1) ? 2 : 1); ++rep_) {
#define PH_END   } if (!MK_MULTI && ph + 1 < NPHASE) xcd_barrier(bar, wv0); } ++ph;
#define W_PAR    ((const float*)(ws + WS_PAR))
#define W_MODL   ((const float*)(ws + WS_MODV) + (size_t)l * 16 * 6144)
#define W_KVMOD  ((const float*)(ws + WS_KVMOD))
#define W_HB     ((bf16_t*)(ws + WS_H))
#define W_HKV    ((bf16_t*)(ws + WS_HKV))
#define W_KB     ((bf16_t*)(ws + WS_KB))
#define W_VB     ((bf16_t*)(ws + WS_VB))
#define W_XB     ((bf16_t*)(ws + WS_ARENA + AR_XB))
#define W_GY     ((bf16_t*)(ws + WS_ARENA + AR_GY))
#define W_HID    ((bf16_t*)(ws + WS_ARENA))
#define W_Q      ((bf16_t*)(ws + WS_ARENA + AR_Q))
#define W_O      ((bf16_t*)(ws + WS_ARENA + AR_O))
#define W_COS    ((const float*)(ws + WS_COS))
#define W_SIN    ((const float*)(ws + WS_SIN))
#define W_E12    ((int*)(ws + WS_E12))
#define W_W1     ((float*)(ws + WS_W1))
#define W_CNT    ((int*)(ws + WS_CNT))
#define W_TILE   ((int*)(ws + WS_TILE))
#define W_TOS    ((int*)(ws + WS_TOS))
#define W_WOS    ((float*)(ws + WS_WOS))

    { const int l_ = 0; PH_BEGIN(0) p0_prologue(F, a); PH_END }

#pragma unroll 1
    for (int l_ = 0; l_ < 4; ++l_) {
        if (l_ < 2) {
            PH_BEGIN(1) norm_phase<false, false>(F, l == 0 ? a.x : xo, W_PAR + PAR_MIXN + l * DM, W_MODL, W_MODL + 1024, W_HB, nullptr, nullptr, nullptr, nullptr, nullptr, nullptr, nullptr, nullptr); PH_END
#pragma unroll 1
            for (int sp_ = 0; sp_ < (DUP_SCANPAIR ? 2 : 1); ++sp_) {
            PH_BEGIN(2) { pg8::ProbDense P{W_HB, (const bf16_t*)(ws + WS_WIN) + (size_t)l * 2048 * DM, DM * 2}; pg8::Order S; S.init(NTOK / 256, 8, F.G, F.cid, 0);
                pg8::EpiWin E{W_XB, W_GY}; pg8::gemm_phase<pg8::EpiWin, pg8::ProbDense, false>(F.lds, F.tid, P, S, E); } PH_END
            PH_BEGIN(3) scan_phase(F, W_PAR, l, W_XB, W_GY, (const bf16_t*)(ws + WS_GW)); PH_END
            }
            PH_BEGIN(4) { pg8::ProbDense P{W_GY, (const bf16_t*)(ws + WS_WOUT) + (size_t)l * DM * DM, DM * 2}; pg8::Order S; S.init(NTOK / 256, 4, F.G, F.cid, 0);
                pg8::EpiResid E{l == 0 ? a.x : xo, xo, W_MODL + 2048, 1.0f}; pg8::gemm_phase<pg8::EpiResid, pg8::ProbDense, false>(F.lds, F.tid, P, S, E); } PH_END
        } else {
            PH_BEGIN(5) if (l == 2) norm_phase<true, false>(F, xo, W_PAR + PAR_MIXN + l * DM, W_MODL, W_MODL + 1024, W_HB, W_PAR + PAR_KVN, W_KVMOD, W_KVMOD + 1024, W_HKV, nullptr, nullptr, nullptr, nullptr);
                        else norm_phase<false, false>(F, xo, W_PAR + PAR_MIXN + l * DM, W_MODL, W_MODL + 1024, W_HB, nullptr, nullptr, nullptr, nullptr, nullptr, nullptr, nullptr, nullptr); PH_END
            if (l_ == 2) {
                PH_BEGIN(6) { pg8::ProbDense P{W_HKV, (const bf16_t*)(ws + WS_WKV), DM * 2}; pg8::Order S; S.init(NTOK / 256, 2, F.G, F.cid, 0);
                    pg8::EpiQK E{W_KB, 256, W_PAR + PAR_KN, W_COS, W_SIN, 1.0f, 1, W_VB}; pg8::gemm_phase<pg8::EpiQK, pg8::ProbDense, false>(F.lds, F.tid, P, S, E); } PH_END
            }
            PH_BEGIN(6) { pg8::ProbDense P{W_HB, (const bf16_t*)(ws + WS_WQ) + (size_t)(l - 2) * DM * DM, DM * 2}; pg8::Order S; S.init(NTOK / 256, 4, F.G, F.cid, 0);
                pg8::EpiQK E{W_Q, DM, W_PAR + PAR_QN + (l - 2) * 64, W_COS, W_SIN, 0.125f * LOG2E, -1, nullptr}; pg8::gemm_phase<pg8::EpiQK, pg8::ProbDense, false>(F.lds, F.tid, P, S, E); } PH_END
            PH_BEGIN(7) attn_phase(F, W_Q, W_KB, W_VB, W_O, W_PAR + PAR_SINK + (l - 2) * 16); PH_END
            PH_BEGIN(8) { pg8::ProbDense P{W_O, (const bf16_t*)(ws + WS_WO) + (size_t)(l - 2) * DM * DM, DM * 2}; pg8::Order S; S.init(NTOK / 256, 4, F.G, F.cid, 0);
                pg8::EpiResid E{xo, xo, W_MODL + 2048, 1.0f}; pg8::gemm_phase<pg8::EpiResid, pg8::ProbDense, false>(F.lds, F.tid, P, S, E); } PH_END
        }
        if (!(l_ & 1)) {
            PH_BEGIN(9) if (FP8_OF(0) | FP8_OF(2)) { if (FP8_OF(l)) norm_phase<false, false, true>(F, xo, W_PAR + PAR_FFNN + l * DM, W_MODL + 3072, W_MODL + 4096, W_HB, nullptr, nullptr, nullptr, nullptr, nullptr, nullptr, nullptr, nullptr);
                             else norm_phase<false, false, false>(F, xo, W_PAR + PAR_FFNN + l * DM, W_MODL + 3072, W_MODL + 4096, W_HB, nullptr, nullptr, nullptr, nullptr, nullptr, nullptr, nullptr, nullptr); }
                        else norm_phase<false, false, false>(F, xo, W_PAR + PAR_FFNN + l * DM, W_MODL + 3072, W_MODL + 4096, W_HB, nullptr, nullptr, nullptr, nullptr, nullptr, nullptr, nullptr, nullptr); PH_END
            if (FP8_OF(l_)) {
                PH_BEGIN(17) { pg8::ProbDense P{W_HB, ws + WS_FGU + (size_t)(l >> 1) * 6144 * DM * 2, DM}; pg8::Order S; S.init(NTOK / 256, 24, F.G, F.cid, 0);
                    pg8::EpiSwiglu<true> E{W_HID, DFF, 1.0f / (SC8_H * SC8_W)}; pg8::gemm_phase<pg8::EpiSwiglu<true>, pg8::ProbDense, false, true>(F.lds, F.tid, P, S, E); } PH_END
                PH_BEGIN(18) { pg8::ProbDense P{W_HID, ws + WS_FDN + (size_t)(l >> 1) * DM * DFF * 2, DFF}; pg8::Order S; S.init(NTOK / 256, 4, F.G, F.cid, 0);
                    pg8::EpiResid E{xo, xo, W_MODL + 5120, 1.0f / (SC8_HID * SC8_W)}; pg8::gemm_phase<pg8::EpiResid, pg8::ProbDense, false, true>(F.lds, F.tid, P, S, E); } PH_END
            } else {
                PH_BEGIN(10) { pg8::ProbDense P{W_HB, (const bf16_t*)(ws + WS_FGU) + (size_t)(l >> 1) * 6144 * DM, DM * 2}; pg8::Order S; S.init(NTOK / 256, 24, F.G, F.cid, 0);
                    pg8::EpiSwiglu<false> E{W_HID, DFF, 1.0f}; pg8::gemm_phase<pg8::EpiSwiglu<false>, pg8::ProbDense, false>(F.lds, F.tid, P, S, E); } PH_END
                PH_BEGIN(11) { pg8::ProbDense P{W_HID, (const bf16_t*)(ws + WS_FDN) + (size_t)(l >> 1) * DM * DFF, DFF * 2}; pg8::Order S; S.init(NTOK / 256, 4, F.G, F.cid, 0);
                    pg8::EpiResid E{xo, xo, W_MODL + 5120, 1.0f}; pg8::gemm_phase<pg8::EpiResid, pg8::ProbDense, false>(F.lds, F.tid, P, S, E); } PH_END
            }
        } else {
            PH_BEGIN(12) if (FP8_OF(l)) norm_phase<false, true, true>(F, xo, W_PAR + PAR_FFNN + l * DM, W_MODL + 3072, W_MODL + 4096, W_HB, nullptr, nullptr, nullptr, nullptr, W_PAR + PAR_ROUTER + (l >> 1) * DM * 8, W_E12, W_W1, W_CNT);
                         else norm_phase<false, true, false>(F, xo, W_PAR + PAR_FFNN + l * DM, W_MODL + 3072, W_MODL + 4096, W_HB, nullptr, nullptr, nullptr, nullptr, W_PAR + PAR_ROUTER + (l >> 1) * DM * 8, W_E12, W_W1, W_CNT); PH_END
            PH_BEGIN(13) moe_scatter(F, W_CNT, W_E12, W_W1, W_TOS, W_WOS, W_TILE); PH_END
            if (FP8_OF(l_)) {
                PH_BEGIN(16) {
                    LAS int* texp = (LAS int*)(F.lds + LDS_TEXP);
                    for (int i = F.tid; i < MAXTILES + 16; i += 512) texp[i] = W_TILE[i];
                    __syncthreads();
                    const int ntot = texp[1];
                    pg8::Order S; S.init(ntot, 28, F.G, F.cid, 0);
                    pg8::ProbGrouped P{W_HB, ws + WS_MGU + (size_t)(l >> 1) * 8 * 7168 * DM * 2, DM, 7168, texp + 16, W_TOS};
                    pg8::EpiSwiglu<true> E{W_HID, DFE, 1.0f / (SC8_H * SC8_W)}; pg8::gemm_phase<pg8::EpiSwiglu<true>, pg8::ProbGrouped, true, true>(F.lds, F.tid, P, S, E); } PH_END
            } else {
                PH_BEGIN(14) {
                    LAS int* texp = (LAS int*)(F.lds + LDS_TEXP);
                    for (int i = F.tid; i < MAXTILES + 16; i += 512) texp[i] = W_TILE[i];
                    __syncthreads();
                    const int ntot = texp[1];
                    pg8::Order S; S.init(ntot, 28, F.G, F.cid, 0);
                    pg8::ProbGrouped P{W_HB, (const bf16_t*)(ws + WS_MGU) + (size_t)(l >> 1) * 8 * 7168 * DM, DM * 2, 7168, texp + 16, W_TOS};
                    pg8::EpiSwiglu<false> E{W_HID, DFE, 1.0f}; pg8::gemm_phase<pg8::EpiSwiglu<false>, pg8::ProbGrouped, true, false>(F.lds, F.tid, P, S, E); } PH_END
            }
#pragma unroll 1
            for (int pass = 0; pass < 2; ++pass) {
                PH_BEGIN(15) {
                    LAS int* texp = (LAS int*)(F.lds + LDS_TEXP);
                    for (int i = F.tid; i < MAXTILES + 16; i += 512) texp[i] = W_TILE[i];
                    __syncthreads();
                    const int nA = texp[0], ntot = texp[1];
                    pg8::Order S; S.init(pass ? ntot - nA : nA, 4, F.G, F.cid, pass ? nA : 0);
                    if (FP8_OF(l)) { pg8::ProbGrouped P{W_HID, ws + WS_MDN + (size_t)(l >> 1) * 8 * DM * DFE * 2, DFE, DM, texp + 16, W_TOS};
                        pg8::EpiMoeDown E{xo, W_MODL + 5120, W_TOS, W_WOS, 1.0f / (SC8_HID * SC8_W)}; pg8::gemm_phase<pg8::EpiMoeDown, pg8::ProbGrouped, false, true>(F.lds, F.tid, P, S, E); }
                    else { pg8::ProbGrouped P{W_HID, (const bf16_t*)(ws + WS_MDN) + (size_t)(l >> 1) * 8 * DM * DFE, DFE * 2, DM, texp + 16, W_TOS};
                        pg8::EpiMoeDown E{xo, W_MODL + 5120, W_TOS, W_WOS, 1.0f}; pg8::gemm_phase<pg8::EpiMoeDown, pg8::ProbGrouped, false, false>(F.lds, F.tid, P, S, E); } } PH_END
            }
        }
    }
#undef PH_BEGIN
#undef PH_END
}

extern "C" void kernel_launch(void* const* d_in, const int* in_sizes, int n_in, void* d_out, int out_size, void* d_ws, size_t ws_size, hipStream_t stream) {
    static int grid = 0;
    if (grid == 0) {
        if (n_in != 30 || in_sizes[0] != NTOK * DM || out_size != NTOK * DM || ws_size < WS_END) { fprintf(stderr, "kernel_launch: unexpected shapes (n_in %d, in0 %d, out %d, ws %zu < %zu)\n", n_in, n_in > 0 ? in_sizes[0] : -1, out_size, ws_size, (size_t)WS_END); grid = -1; return; }
        int dev = 0, cus = 0, per_cu = 0;
        if (hipGetDevice(&dev) != hipSuccess || hipDeviceGetAttribute(&cus, hipDeviceAttributeMultiprocessorCount, dev) != hipSuccess) { grid = -1; return; }
        if (hipFuncSetAttribute((const void*)fwd_kernel, hipFuncAttributeMaxDynamicSharedMemorySize, LDS_BYTES) != hipSuccess) { fprintf(stderr, "kernel_launch: hipFuncSetAttribute failed\n"); grid = -1; return; }
        if (hipOccupancyMaxActiveBlocksPerMultiprocessor(&per_cu, (const void*)fwd_kernel, 512, LDS_BYTES) != hipSuccess || per_cu < 1) fprintf(stderr, "kernel_launch: occupancy query reports %d\n", per_cu);
        (void)hipGetLastError();
        grid = cus;
    }
    if (grid < 0) return;
    if (hipMemsetAsync((char*)d_ws + WS_CTL, 0, CTL_ZERO_BYTES, stream) != hipSuccess) return;
    Args a{};
    const float** fp = (const float**)&a;
    for (int i = 0; i < 30; ++i) fp[i] = (const float*)d_in[i];
    a.out = (float*)d_out; a.ws = (unsigned char*)d_ws;
#if MK_MULTI
    for (int p = 0; p < NPHASE; ++p) { a.ph_lo = p; a.ph_hi = p + 1; hipLaunchKernelGGL(fwd_kernel, dim3(grid), dim3(512), LDS_BYTES, stream, a); }
#else
    a.ph_lo = 0; a.ph_hi = NPHASE; hipLaunchKernelGGL(fwd_kernel, dim3(grid), dim3(512), LDS_BYTES, stream, a);
#endif
}
```

```cpp
#include <hip/hip_runtime.h>
#include <cstdio>
#include <cstdint>

#ifndef FP8MASK
#define FP8MASK 10
#endif
#define FP8_OF(l) (((FP8MASK) >> (l)) & 1)
#ifndef DUPMASK
#define DUPMASK 0
#endif
#ifndef DUP_SCANPAIR
#define DUP_SCANPAIR 0
#endif
#ifndef PHSEL
#define PHSEL 0xFFFFFFFFu
#endif
#ifndef MK_MULTI
#define MK_MULTI 0
#endif

#define LAS __attribute__((address_space(3)))
#define GAS __attribute__((address_space(1)))
typedef unsigned short bf16_t;
typedef short bf16x8 __attribute__((ext_vector_type(8)));
typedef short s16x4 __attribute__((ext_vector_type(4)));
typedef float f32x2 __attribute__((ext_vector_type(2)));
typedef float f32x4 __attribute__((ext_vector_type(4)));
typedef float f32x16 __attribute__((ext_vector_type(16)));
typedef unsigned u32x2 __attribute__((ext_vector_type(2)));
typedef unsigned u32x4 __attribute__((ext_vector_type(4)));
typedef __bf16 bf16x2_t __attribute__((ext_vector_type(2)));
typedef int i32x4 __attribute__((ext_vector_type(4)));
typedef int i32x8 __attribute__((ext_vector_type(8)));
constexpr float SC8_H = 4.0f, SC8_W = 64.0f, SC8_HID = 8.0f;

constexpr int DM = 1024, BATCH = 16, SEQ = 4096, NTOK = BATCH * SEQ;
constexpr int DFF = 3072, NEXP = 8, DFE = 3584;
constexpr int NSLOT = 135168;
constexpr int MAXTILES = NSLOT / 256;
constexpr float EPS = 1e-6f;
constexpr float LOG2E = 1.4426950408889634f;

constexpr size_t MiB = 1u << 20;
constexpr size_t WS_CTL = 0, CTL_ZERO_BYTES = 1 * MiB;
constexpr size_t WS_MODV = 1 * MiB;
constexpr size_t WS_KVMOD = 3 * MiB;
constexpr size_t WS_PAR = 3 * MiB + 512 * 1024;
constexpr int PAR_MIXN = 0, PAR_FFNN = 4096, PAR_CONVW = 8192, PAR_CONVB = 16384, PAR_GXB = 18432, PAR_GAB = 20480, PAR_LAM = 22528, PAR_KVN = 24576, PAR_KN = 25600, PAR_QN = 25664, PAR_SINK = 25792, PAR_ROUTER = 25856, PAR_END = 42240;
constexpr size_t WS_E12 = 4 * MiB;
constexpr size_t WS_W1 = 5 * MiB;
constexpr size_t WS_CNT = 6 * MiB;
constexpr size_t WS_TILE = 6 * MiB + 65536;
constexpr size_t WS_TOS = 7 * MiB;
constexpr size_t WS_WOS = 8 * MiB;
constexpr size_t WS_GW = 9 * MiB;
constexpr size_t WS_COS = 10 * MiB;
constexpr size_t WS_SIN = 18 * MiB;
constexpr size_t WS_WIN = 26 * MiB;
constexpr size_t WS_WOUT = 34 * MiB;
constexpr size_t WS_WKV = 38 * MiB;
constexpr size_t WS_WQ = 39 * MiB;
constexpr size_t WS_WO = 43 * MiB;
constexpr size_t WS_FGU = 47 * MiB;
constexpr size_t WS_FDN = 71 * MiB;
constexpr size_t WS_MGU = 83 * MiB;
constexpr size_t WS_MDN = 307 * MiB;
constexpr size_t WS_H = 419 * MiB;
constexpr size_t WS_HKV = 547 * MiB;
constexpr size_t WS_KB = 675 * MiB;
constexpr size_t WS_VB = 707 * MiB;
constexpr size_t WS_ARENA = 739 * MiB;
constexpr size_t WS_XS = WS_ARENA + (size_t)NSLOT * DFE * 2;
constexpr size_t WS_END = WS_XS + (size_t)NTOK * DM * 2;
static_assert(WS_END <= (size_t)1792 * MiB, "workspace map");
constexpr size_t AR_XB = 0, AR_GY = 128 * MiB, AR_Q = 0, AR_O = 128 * MiB;

constexpr int CW_BAR = 4096;

constexpr int LDS_BYTES = 163840;
constexpr int RING_BYTES = 131072;
constexpr int LDS_TEXP = RING_BYTES;
constexpr int LDS_IDX = RING_BYTES + 4096;
constexpr int LDS_MISC = LDS_BYTES - 256;

__device__ __forceinline__ unsigned cvtpk(float lo, float hi) { f32x2 v = {lo, hi}; bf16x2_t b = __builtin_convertvector(v, bf16x2_t); return __builtin_bit_cast(unsigned, b); }
__device__ __forceinline__ float clamp8(float v) { return __builtin_amdgcn_fmed3f(v, -448.0f, 448.0f); }
__device__ __forceinline__ unsigned cvt4_fp8(float a, float b, float c, float d) { int p = __builtin_amdgcn_cvt_pk_fp8_f32(clamp8(a), clamp8(b), 0, false); p = __builtin_amdgcn_cvt_pk_fp8_f32(clamp8(c), clamp8(d), p, true); return (unsigned)p; }
__device__ __forceinline__ float bflo(unsigned p) { return __uint_as_float(p << 16); }
__device__ __forceinline__ float bfhi(unsigned p) { return __uint_as_float(p & 0xffff0000u); }
__device__ __forceinline__ float bf2f(unsigned short b) { return __uint_as_float(((unsigned)b) << 16); }
__device__ __forceinline__ float fast_exp2(float x) { return __builtin_amdgcn_exp2f(x); }
__device__ __forceinline__ float fast_rcp(float x) { return __builtin_amdgcn_rcpf(x); }
__device__ __forceinline__ float sigmoidf_(float x) { return fast_rcp(1.0f + fast_exp2(-x * LOG2E)); }
__device__ __forceinline__ float silu_(float x) { return x * sigmoidf_(x); }
__device__ __forceinline__ float gelu_tanh_(float x) { const float u = 0.7978845608028654f * (x + 0.044715f * x * x * x); return x * sigmoidf_(2.0f * u); }
__device__ __forceinline__ float shflx(float v, int lane, int o) { return __int_as_float(__builtin_amdgcn_ds_bpermute((lane ^ o) << 2, __float_as_int(v))); }
__device__ __forceinline__ float wave_sum(float v, int lane) {
#pragma unroll
    for (int o = 1; o < 64; o <<= 1) v += shflx(v, lane, o);
    return v;
}
__device__ __forceinline__ int lane_id_v() { int l; asm volatile("v_mbcnt_lo_u32_b32 %0, -1, 0\n\tv_mbcnt_hi_u32_b32 %0, -1, %0" : "=v"(l)); return l; }
#define LDS_WAIT() asm volatile("s_waitcnt lgkmcnt(0)" ::: "memory")
#define VM_WAIT() asm volatile("s_waitcnt vmcnt(0)" ::: "memory")

namespace pg8 {
constexpr int BM = 256, BK = 64, HALF = 128, HTB = HALF * BK * 2, STAGE_BYTES = 8 * HTB, NXCD = 8, WGM = 8;
__host__ __device__ __forceinline__ int lds_byte(int r, int c) { const int st = (r >> 4) * 2 + (c >> 5), rr = r & 15, cc = c & 31, ob = rr * 64 + cc * 2; return st * 1024 + (ob ^ (((ob >> 9) & 1) << 5)); }
__host__ __device__ __forceinline__ void stage_rc(int b, int& R, int& C) { const int st = b / 1024, sb = b % 1024, swz = sb ^ (((sb >> 9) & 1) << 5); R = (st >> 1) * 16 + swz / 64; C = (st & 1) * 32 + (swz % 64) / 2; }
__host__ __device__ __forceinline__ int perm32(int rho) { const int n = rho >> 4, i = rho & 15; return 8 * (i >> 2) + 4 * n + (i & 3); }

struct Unit { int pm, pn; };

struct Order {
    int nM, nN, nwg, G, c, tile0;
    __device__ __forceinline__ void init(int nM_, int nN_, int G_, int c_, int tile0_) { nM = nM_; nN = nN_; nwg = nM * nN; G = G_; c = c_; tile0 = tile0_; }
    __device__ __forceinline__ bool next(int i, Unit& u) const {
        const long L = (long)i * G + c; if (L >= nwg) return false;
        int wgid = (int)L; { const int q = nwg / NXCD, r = nwg % NXCD, xcd = wgid % NXCD, off = wgid / NXCD; wgid = (xcd < r ? xcd * (q + 1) : r * (q + 1) + (xcd - r) * q) + off; }
        const int nig = WGM * nN, gid = wgid / nig, fm = gid * WGM, gsz = (nM - fm) < WGM ? (nM - fm) : WGM;
        u.pm = tile0 + fm + ((wgid % nig) % gsz); u.pn = (wgid % nig) / gsz; return true;
    }
};

struct ProbDense {
    const void* A; const void* Bt; int KB;
    __device__ __forceinline__ const char* a_ptr(const Unit& u) const { return (const char*)A + (size_t)u.pm * BM * KB; }
    __device__ __forceinline__ const char* b_ptr(const Unit& u) const { return (const char*)Bt + (size_t)u.pn * BM * KB; }
};
struct ProbGrouped {
    const void* A; const void* Bt; int KB; int N; const LAS int* texp; const int* tos;
    __device__ __forceinline__ const char* a_ptr(const Unit& u) const { return (const char*)A + (size_t)u.pm * BM * KB; }
    __device__ __forceinline__ const char* b_ptr(const Unit& u) const { return (const char*)Bt + ((size_t)texp[u.pm] * N + (size_t)u.pn * BM) * KB; }
};

template <class Epi, class Prob, bool GATHER, bool FP8 = false>
__device__ __forceinline__ void gemm_phase(LAS unsigned char* lds, const int tid, const Prob P, const Order& S, const Epi& E) {
    const int wid = __builtin_amdgcn_readfirstlane(tid >> 6), lane = tid & 63, wr = wid >> 2, wc = wid & 3, fr = lane & 15, fq = lane >> 4;
    const int KB = P.KB, nt = KB / (BK * 2);
    unsigned voffA[2], voffB[2];
#pragma unroll
    for (int i = 0; i < 2; ++i) { int R, C; stage_rc(tid * 16 + i * 8192, R, C); const int Rb = Epi::PERM ? ((R & ~31) + perm32(R & 31)) : R;
        voffA[i] = GATHER ? (unsigned)(C * 2) : (unsigned)(R * KB + C * 2); voffB[i] = (unsigned)(Rb * KB + C * 2); }
    const size_t kstep = (size_t)(BK * 2);
    const size_t hstep = (size_t)HALF * KB;
    const unsigned ldsw = (unsigned)wid * 1024u;
    const int aoff = lds_byte(wr * 64 + fr, fq * 8), boff = lds_byte(wc * 32 + fr, fq * 8);
    LAS int* idxb = (LAS int*)(lds + LDS_IDX);
#define PG8_GIDX(buf) do { int ln_ = lane; asm volatile("" : "+v"(ln_)); _Pragma("unroll") for (int i = 0; i < 2; ++i) { const int R_ = 16 * ((wid + 8 * i) >> 1) + (ln_ >> 2); \
        int t0 = idxb[(buf) * 256 + R_], t1 = idxb[(buf) * 256 + 128 + R_]; t0 = t0 < 0 ? 0 : t0; t1 = t1 < 0 ? 0 : t1; \
        vC0[i] = (unsigned)t0 * (unsigned)KB + voffA[i]; vC1[i] = (unsigned)t1 * (unsigned)KB + voffA[i]; } } while (0)
#define PG8_GDMA(unit, buf) do { if (wid < 4) { int ln_ = lane; asm volatile("" : "+v"(ln_)); \
        __builtin_amdgcn_global_load_lds((const unsigned*)(P.tos + (size_t)(unit).pm * BM + wid * 64) + ln_, (LAS unsigned*)(idxb + (buf) * 256 + wid * 64), 4, 0, 0); } } while (0)
#define PG8_SA(b, h) (((b) * 2 + (h)) * HTB)
#define PG8_SB(b, h) ((4 + (b) * 2 + (h)) * HTB)
#define PG8_STAGE(bufoff, gbase, voff) do { const char* g_ = (const char*)(gbase); asm volatile("" : "+s"(g_)); _Pragma("unroll") for (int _i = 0; _i < 2; ++_i) \
        __builtin_amdgcn_global_load_lds((const unsigned*)(g_ + (voff)[_i]), (LAS unsigned*)(lds + (bufoff) + ldsw + _i * 8192), 16, 0, 0); } while (0)
#define PG8_LDA(dst, b, h) do { _Pragma("unroll") for (int m = 0; m < 4; ++m) _Pragma("unroll") for (int k = 0; k < 2; ++k) dst[m][k] = *(const LAS bf16x8*)(lds + PG8_SA(b, h) + aoff + m * 2048 + k * 1024); } while (0)
#define PG8_LDB(dst, b, h) do { _Pragma("unroll") for (int n = 0; n < 2; ++n) _Pragma("unroll") for (int k = 0; k < 2; ++k) dst[n][k] = *(const LAS bf16x8*)(lds + PG8_SB(b, h) + boff + n * 2048 + k * 1024); } while (0)
#define PG8_CAT8(v) __builtin_shufflevector(__builtin_bit_cast(i32x4, (v)[0]), __builtin_bit_cast(i32x4, (v)[1]), 0, 1, 2, 3, 4, 5, 6, 7)
#define PG8_MMA(ai, bj, At, Bt) do { __builtin_amdgcn_s_setprio(1); if constexpr (FP8) asm volatile("s_nop 1"); _Pragma("unroll") for (int m = 0; m < 4; ++m) _Pragma("unroll") for (int n = 0; n < 2; ++n) { \
        if constexpr (FP8) { const i32x8 b8_ = PG8_CAT8(Bt[n]), a8_ = PG8_CAT8(At[m]);   \
            asm volatile("v_mfma_scale_f32_16x16x128_f8f6f4 %0, %1, %2, %0, %3, %3 op_sel_hi:[0,0,0]" : "+v"(acc[ai][bj][m][n]) : "v"(b8_), "v"(a8_), "v"(sc8)); } \
        else { _Pragma("unroll") for (int k = 0; k < 2; ++k) acc[ai][bj][m][n] = __builtin_amdgcn_mfma_f32_16x16x32_bf16(Bt[n][k], At[m][k], acc[ai][bj][m][n], 0, 0, 0); } } __builtin_amdgcn_s_setprio(0); } while (0)
#define PG8_WAIT_V(n) asm volatile("s_waitcnt vmcnt(" #n ")" ::: "memory")
#define PG8_WAIT_L(n) asm volatile("s_waitcnt lgkmcnt(" #n ")" ::: "memory")
#define PG8_BAR __builtin_amdgcn_s_barrier()
#define PG8_SCHED __builtin_amdgcn_sched_barrier(0)
    Unit cur, nxt; int ui = 0;
    if (!S.next(0, cur)) return;
    f32x4 acc[2][2][4][2];
#pragma unroll
    for (int a = 0; a < 2; ++a)
#pragma unroll
        for (int b = 0; b < 2; ++b)
#pragma unroll
            for (int m = 0; m < 4; ++m)
#pragma unroll
                for (int n = 0; n < 2; ++n) acc[a][b][m][n] = (f32x4){0.f, 0.f, 0.f, 0.f};
    bf16x8 At[4][2], B0[2][2], B1[2][2];
    int sc8 = 0x7F7F7F7F; if constexpr (FP8) asm volatile("" : "+v"(sc8));
    unsigned vC0[2], vC1[2];
    const char* cA; const char* cB = P.b_ptr(cur);
    if constexpr (GATHER) {
        cA = (const char*)P.A;
        PG8_GDMA(cur, 0);
        PG8_WAIT_V(0); PG8_BAR;
        PG8_GIDX(0);
        LDS_WAIT(); PG8_BAR;
    } else {
        cA = P.a_ptr(cur);
#pragma unroll
        for (int i = 0; i < 2; ++i) { vC0[i] = voffA[i]; vC1[i] = voffA[i] + (unsigned)hstep; }
    }
    PG8_STAGE(PG8_SB(0, 0), cB, voffB); PG8_STAGE(PG8_SB(0, 1), cB + hstep, voffB); PG8_STAGE(PG8_SA(0, 0), cA, vC0); PG8_STAGE(PG8_SA(0, 1), cA, vC1);
    if (wr == 1) PG8_BAR;
    PG8_WAIT_V(2); PG8_BAR;
    PG8_STAGE(PG8_SB(1, 0), cB + kstep, voffB); PG8_STAGE(PG8_SA(1, 0), cA + kstep, vC0); PG8_STAGE(PG8_SB(1, 1), cB + hstep + kstep, voffB);
    PG8_WAIT_V(6); PG8_BAR;
    for (;;) {
        const bool has_next = S.next(ui + 1, nxt);
        const char* nA = GATHER ? cA : (has_next ? P.a_ptr(nxt) : cA); const char* nB = has_next ? P.b_ptr(nxt) : cB;
        for (int t = 0; t < nt; t += 2) {
            const bool last = (t == nt - 2);
            if constexpr (GATHER) {
                if (t == 0 && has_next) PG8_GDMA(nxt, (ui + 1) & 1);
            }
            const char* a1 = cA + (size_t)(t + 1) * kstep;
            const char* a2 = last ? nA : cA + (size_t)(t + 2) * kstep; const char* b2 = last ? nB : cB + (size_t)(t + 2) * kstep;
            const char* a3 = a2 + kstep; const char* b3 = b2 + kstep;
            PG8_LDB(B0, 0, 0); PG8_LDB(B1, 0, 1); PG8_SCHED; PG8_LDA(At, 0, 0); PG8_STAGE(PG8_SA(1, 1), a1, vC1);
            if constexpr (GATHER) { if (last && has_next) PG8_GIDX((ui + 1) & 1); }
            PG8_WAIT_V(8); PG8_WAIT_L(0); PG8_BAR; PG8_MMA(0, 0, At, B0); PG8_MMA(0, 1, At, B1); PG8_BAR; PG8_SCHED;
            PG8_LDA(At, 0, 1); PG8_STAGE(PG8_SB(0, 0), b2, voffB); PG8_STAGE(PG8_SB(0, 1), b2 + hstep, voffB); PG8_STAGE(PG8_SA(0, 0), a2, vC0);
            PG8_WAIT_V(8); PG8_WAIT_L(0); PG8_BAR; PG8_MMA(1, 0, At, B0); PG8_MMA(1, 1, At, B1); PG8_BAR; PG8_SCHED;
            PG8_LDB(B0, 1, 0); PG8_LDB(B1, 1, 1); PG8_SCHED; PG8_LDA(At, 1, 0); PG8_STAGE(PG8_SA(0, 1), a2, vC1);
            PG8_WAIT_V(8); PG8_WAIT_L(0); PG8_BAR; PG8_MMA(0, 0, At, B0); PG8_MMA(0, 1, At, B1); PG8_BAR; PG8_SCHED;
            PG8_LDA(At, 1, 1); PG8_STAGE(PG8_SB(1, 0), b3, voffB); PG8_STAGE(PG8_SB(1, 1), b3 + hstep, voffB); PG8_STAGE(PG8_SA(1, 0), a3, vC0);
            PG8_WAIT_V(8); PG8_WAIT_L(0); PG8_BAR; PG8_MMA(1, 0, At, B0); PG8_MMA(1, 1, At, B1); PG8_BAR; PG8_SCHED;
        }
        if constexpr (FP8) { asm volatile("s_nop 15\n\ts_nop 15" ::: "memory"); PG8_SCHED; }
        if (wr == 0) PG8_BAR;
        { int fr_ = fr, fq_ = fq; asm volatile("" : "+v"(fr_), "+v"(fq_)); E(acc, cur, wr, wc, fr_, fq_); }
        if (!has_next) break;
#pragma unroll
        for (int a = 0; a < 2; ++a)
#pragma unroll
            for (int b = 0; b < 2; ++b)
#pragma unroll
                for (int m = 0; m < 4; ++m)
#pragma unroll
                    for (int n = 0; n < 2; ++n) acc[a][b][m][n] = (f32x4){0.f, 0.f, 0.f, 0.f};
        cur = nxt; cA = nA; cB = nB; ++ui;
        if (wr == 1) PG8_BAR;
    }
    PG8_WAIT_V(0);
    PG8_BAR;
#undef PG8_SA
#undef PG8_GIDX
#undef PG8_GDMA
#undef PG8_SB
#undef PG8_STAGE
#undef PG8_LDA
#undef PG8_LDB
#undef PG8_MMA
#undef PG8_CAT8
#undef PG8_WAIT_V
#undef PG8_WAIT_L
#undef PG8_BAR
#undef PG8_SCHED
}

template <bool INF32> struct EpiResid {
    static constexpr bool PERM = true;
    const void* xin; bf16_t* xout; const float* gate; float ascale;
    __device__ __forceinline__ void operator()(const f32x4 (&acc)[2][2][4][2], const Unit& u, int wr, int wc, int fr, int fq) const {
        const int row0 = u.pm * BM + wr * 64 + fr, col0 = u.pn * BM + wc * 32 + 8 * fq;
        const float* gp = gate + (size_t)((u.pm * BM) >> 12) * 6144 + col0;
        f32x4 gv[2][2];
#pragma unroll
        for (int bj = 0; bj < 2; ++bj)
#pragma unroll
            for (int n = 0; n < 2; ++n) gv[bj][n] = (*(const f32x4*)(gp + bj * HALF + 4 * n) + 1.0f) * ascale;
#pragma unroll
        for (int ai = 0; ai < 2; ++ai) {
            f32x4 xv[4][2][2];
#pragma unroll
            for (int m = 0; m < 4; ++m) { const size_t off = (size_t)(row0 + ai * HALF + m * 16) * DM + col0;
#pragma unroll
                for (int bj = 0; bj < 2; ++bj) {
                    if constexpr (INF32) { xv[m][bj][0] = *(const f32x4*)((const float*)xin + off + bj * HALF); xv[m][bj][1] = *(const f32x4*)((const float*)xin + off + bj * HALF + 4); }
                    else { const u32x4 p = *(const u32x4*)((const bf16_t*)xin + off + bj * HALF);
                        xv[m][bj][0] = (f32x4){bflo(p.x), bfhi(p.x), bflo(p.y), bfhi(p.y)}; xv[m][bj][1] = (f32x4){bflo(p.z), bfhi(p.z), bflo(p.w), bfhi(p.w)}; } } }
#pragma unroll
            for (int m = 0; m < 4; ++m) { const size_t off = (size_t)(row0 + ai * HALF + m * 16) * DM + col0;
#pragma unroll
                for (int bj = 0; bj < 2; ++bj) { const f32x4 o0 = xv[m][bj][0] + gv[bj][0] * acc[ai][bj][m][0], o1 = xv[m][bj][1] + gv[bj][1] * acc[ai][bj][m][1];
                    u32x4 w; w.x = cvtpk(o0[0], o0[1]); w.y = cvtpk(o0[2], o0[3]); w.z = cvtpk(o1[0], o1[1]); w.w = cvtpk(o1[2], o1[3]);
                    *(u32x4*)(xout + off + bj * HALF) = w; } }
            asm volatile("" ::: "memory"); }
    }
};
template <bool OUTF32> struct EpiMoeDown {
    static constexpr bool PERM = true;
    const bf16_t* xs; void* xo; const float* gate; const int* tos; const float* wos; float ascale;
    __device__ __forceinline__ void operator()(const f32x4 (&acc)[2][2][4][2], const Unit& u, int wr, int wc, int fr, int fq) const {
        const int slot0 = u.pm * BM + wr * 64 + fr, col0 = u.pn * BM + wc * 32 + 8 * fq;
        int tok[2][4]; float w[2][4];
#pragma unroll
        for (int ai = 0; ai < 2; ++ai)
#pragma unroll
            for (int m = 0; m < 4; ++m) { const int slot = slot0 + ai * HALF + m * 16; tok[ai][m] = tos[slot]; w[ai][m] = wos[slot] * ascale; }
#pragma unroll
        for (int ai = 0; ai < 2; ++ai) {
            u32x4 xv[4][2];
#pragma unroll
            for (int m = 0; m < 4; ++m) { const int t = tok[ai][m] < 0 ? 0 : tok[ai][m]; const bf16_t* xp = xs + (size_t)t * DM + col0;
#pragma unroll
                for (int bj = 0; bj < 2; ++bj) xv[m][bj] = *(const u32x4*)(xp + bj * HALF); }
#pragma unroll
            for (int m = 0; m < 4; ++m) { const int t = tok[ai][m];
                if (t >= 0) { const float* gp = gate + (size_t)(t >> 12) * 6144 + col0; const size_t off = (size_t)t * DM + col0;
#pragma unroll
                    for (int bj = 0; bj < 2; ++bj) { const u32x4 p = xv[m][bj];
                        const f32x4 g0 = (*(const f32x4*)(gp + bj * HALF) + 1.0f) * w[ai][m], g1 = (*(const f32x4*)(gp + bj * HALF + 4) + 1.0f) * w[ai][m];
                        const f32x4 o0 = (f32x4){bflo(p.x), bfhi(p.x), bflo(p.y), bfhi(p.y)} + g0 * acc[ai][bj][m][0], o1 = (f32x4){bflo(p.z), bfhi(p.z), bflo(p.w), bfhi(p.w)} + g1 * acc[ai][bj][m][1];
                        if constexpr (OUTF32) { *(f32x4*)((float*)xo + off + bj * HALF) = o0; *(f32x4*)((float*)xo + off + bj * HALF + 4) = o1; }
                        else { u32x4 q; q.x = cvtpk(o0[0], o0[1]); q.y = cvtpk(o0[2], o0[3]); q.z = cvtpk(o1[0], o1[1]); q.w = cvtpk(o1[2], o1[3]); *(u32x4*)((bf16_t*)xo + off + bj * HALF) = q; } } } }
            asm volatile("" ::: "memory"); }
    }
};
template <bool OUT8> struct EpiSwiglu {
    static constexpr bool PERM = true;
    void* O; int ldo; float ascale;
    __device__ __forceinline__ void operator()(const f32x4 (&acc)[2][2][4][2], const Unit& u, int wr, int wc, int fr, int fq) const {
        const int row0 = u.pm * BM + wr * 64 + fr, col0 = u.pn * HALF + wc * 32 + 8 * fq;
#pragma unroll
        for (int ai = 0; ai < 2; ++ai)
#pragma unroll
            for (int m = 0; m < 4; ++m) { const size_t eo = (size_t)(row0 + ai * HALF + m * 16) * ldo + col0;
                float v[8];
#pragma unroll
                for (int n = 0; n < 2; ++n)
#pragma unroll
                    for (int j = 0; j < 4; ++j) v[4 * n + j] = silu_(acc[ai][0][m][n][j] * ascale) * (acc[ai][1][m][n][j] * ascale);
                if constexpr (OUT8) { u32x2 w; w.x = cvt4_fp8(v[0] * SC8_HID, v[1] * SC8_HID, v[2] * SC8_HID, v[3] * SC8_HID); w.y = cvt4_fp8(v[4] * SC8_HID, v[5] * SC8_HID, v[6] * SC8_HID, v[7] * SC8_HID);
                    *(u32x2*)((unsigned char*)O + eo) = w; }
                else { u32x4 w; w.x = cvtpk(v[0], v[1]); w.y = cvtpk(v[2], v[3]); w.z = cvtpk(v[4], v[5]); w.w = cvtpk(v[6], v[7]);
                    *(u32x4*)((bf16_t*)O + eo) = w; } }
    }
};
struct EpiWin {
    static constexpr bool PERM = true;
    bf16_t* XB; bf16_t* GY;
    __device__ __forceinline__ void operator()(const f32x4 (&acc)[2][2][4][2], const Unit& u, int wr, int wc, int fr, int fq) const {
        const bool act = u.pn >= 4; bf16_t* base = act ? GY : XB;
        const int row0 = u.pm * BM + wr * 64 + fr, col0 = (u.pn & 3) * BM + wc * 32 + 8 * fq;
#pragma unroll
        for (int ai = 0; ai < 2; ++ai)
#pragma unroll
            for (int m = 0; m < 4; ++m) { bf16_t* rowp = base + (size_t)(row0 + ai * HALF + m * 16) * DM + col0;
#pragma unroll
                for (int bj = 0; bj < 2; ++bj) { f32x4 v0 = acc[ai][bj][m][0], v1 = acc[ai][bj][m][1];
                    if (act) {
#pragma unroll
                        for (int j = 0; j < 4; ++j) { v0[j] = gelu_tanh_(v0[j]); v1[j] = gelu_tanh_(v1[j]); } }
                    u32x4 w; w.x = cvtpk(v0[0], v0[1]); w.y = cvtpk(v0[2], v0[3]); w.z = cvtpk(v1[0], v1[1]); w.w = cvtpk(v1[2], v1[3]);
                    *(u32x4*)(rowp + bj * HALF) = w; } }
    }
};
struct EpiQK {
    static constexpr bool PERM = true;
    bf16_t* O; int ldo; const float* gain; const float* cosT; const float* sinT; float oscale; int vtile; bf16_t* OV;
    __device__ __forceinline__ void operator()(const f32x4 (&acc)[2][2][4][2], const Unit& u, int wr, int wc, int fr, int fq) const {
        const int row0 = u.pm * BM + wr * 64 + fr;
        if (u.pn == vtile) {
            const int col0 = wc * 32 + 8 * fq;
#pragma unroll
            for (int ai = 0; ai < 2; ++ai)
#pragma unroll
                for (int m = 0; m < 4; ++m) { bf16_t* rowp = OV + (size_t)(row0 + ai * HALF + m * 16) * ldo + col0;
#pragma unroll
                    for (int bj = 0; bj < 2; ++bj) { const f32x4 v0 = acc[ai][bj][m][0], v1 = acc[ai][bj][m][1];
                        u32x4 w; w.x = cvtpk(v0[0], v0[1]); w.y = cvtpk(v0[2], v0[3]); w.z = cvtpk(v1[0], v1[1]); w.w = cvtpk(v1[2], v1[3]);
                        *(u32x4*)(rowp + bj * HALF) = w; } }
            return;
        }
        const int colh = (u.pn * 4 + wc) * 64 + 8 * fq;
        f32x4 g1[2], g2[2];
#pragma unroll
        for (int n = 0; n < 2; ++n) { g1[n] = *(const f32x4*)(gain + 8 * fq + 4 * n); g2[n] = *(const f32x4*)(gain + 32 + 8 * fq + 4 * n); }
#pragma unroll
        for (int aim = 0; aim < 4; ++aim) { const int ai = aim >> 1;
            f32x4 cv[4][2], sv[4][2];
#pragma unroll
            for (int m = 2 * (aim & 1); m < 2 * (aim & 1) + 2; ++m) { const int row = row0 + ai * HALF + m * 16;
#pragma unroll
                for (int n = 0; n < 2; ++n) { cv[m][n] = *(const f32x4*)(cosT + (size_t)row * 32 + 8 * fq + 4 * n); sv[m][n] = *(const f32x4*)(sinT + (size_t)row * 32 + 8 * fq + 4 * n); } }
#pragma unroll
            for (int m = 2 * (aim & 1); m < 2 * (aim & 1) + 2; ++m) { const int row = row0 + ai * HALF + m * 16;
                float ss = 0.f;
#pragma unroll
                for (int bj = 0; bj < 2; ++bj)
#pragma unroll
                    for (int n = 0; n < 2; ++n) { const f32x4 a = acc[ai][bj][m][n]; ss += (a[0] * a[0] + a[1] * a[1]) + (a[2] * a[2] + a[3] * a[3]); }
                { const int ln_ = fq * 16 + fr; ss += shflx(ss, ln_, 16); ss += shflx(ss, ln_, 32); }
                const float r = __builtin_amdgcn_rsqf(ss * (1.0f / 64.0f) + EPS) * oscale;
                float o1[8], o2[8];
#pragma unroll
                for (int n = 0; n < 2; ++n) { const f32x4 c = cv[m][n], s = sv[m][n];
                    const f32x4 x1 = acc[ai][0][m][n] * g1[n] * r, x2 = acc[ai][1][m][n] * g2[n] * r;
                    const f32x4 a = x1 * c - x2 * s, b = x2 * c + x1 * s;
#pragma unroll
                    for (int j = 0; j < 4; ++j) { o1[4 * n + j] = a[j]; o2[4 * n + j] = b[j]; } }
                bf16_t* rowp = O + (size_t)row * ldo + colh;
                u32x4 w; w.x = cvtpk(o1[0], o1[1]); w.y = cvtpk(o1[2], o1[3]); w.z = cvtpk(o1[4], o1[5]); w.w = cvtpk(o1[6], o1[7]);
                *(u32x4*)rowp = w;
                w.x = cvtpk(o2[0], o2[1]); w.y = cvtpk(o2[2], o2[3]); w.z = cvtpk(o2[4], o2[5]); w.w = cvtpk(o2[6], o2[7]);
                *(u32x4*)(rowp + 32) = w; }
            asm volatile("" ::: "memory"); }
    }
};
}

#define XB_TMO      128
#define XB_XCNT(j)  (256  + 64 * (j))
#define XB_XSUB(j)  (1280 + 64 * (j))
#define XB_XGEN(j)  (2304 + 64 * (j))
#define XB_TOP      3328
#define XB_TOPGEN   3392
#define XCD_BAR_WORDS 3456
#define XB_SPIN_CAP (1u << 20)
__device__ __forceinline__ unsigned xb_ld(unsigned* p)              { return __hip_atomic_load(p, __ATOMIC_RELAXED, __HIP_MEMORY_SCOPE_AGENT); }
__device__ __forceinline__ unsigned xb_add(unsigned* p, unsigned v) { return __hip_atomic_fetch_add(p, v, __ATOMIC_RELAXED, __HIP_MEMORY_SCOPE_AGENT); }
__device__ __forceinline__ unsigned xb_xcc_id() { return (unsigned)__builtin_amdgcn_s_getreg((3 << 11) | 20) & 0xFu; }
#define XB_SPIN(cond, bar) do { unsigned _sp = 0; while (cond) { __builtin_amdgcn_s_sleep(1); \
    if ((++_sp & 255u) == 0u) { if (xb_ld(&(bar)[XB_TMO])) break; if (_sp > XB_SPIN_CAP) { atomicAdd(&(bar)[XB_TMO], 1u); break; } } } } while (0)
struct XcdBarrier { unsigned* bar; unsigned x; volatile LAS unsigned* st; };
__device__ __forceinline__ XcdBarrier xcd_barrier_post(unsigned* bar, volatile LAS unsigned* st, int wv) {
    XcdBarrier b; b.bar = bar; b.x = xb_xcc_id(); b.st = st;
    if (wv == 0 && lane_id_v() == 0) (void)xb_add(&bar[XB_XCNT(b.x)], 1u);
    return b;
}
__device__ __forceinline__ void xcd_barrier_complete(unsigned* bar, unsigned x, unsigned& nloc, unsigned& nx) {
    const unsigned G = gridDim.x * gridDim.y * gridDim.z;
    unsigned sum, cnt, mine, sp = 0u;
    for (;;) {
        sum = 0u; cnt = 0u; mine = 0u;
#pragma unroll
        for (unsigned j = 0; j < 16; ++j) { const unsigned c = xb_ld(&bar[XB_XCNT(j)]); sum += c; cnt += (c > 0u) ? 1u : 0u; mine = (j == x) ? c : mine; }
        if (sum == G) break;
        __builtin_amdgcn_s_sleep(1);
        if ((++sp & 255u) == 0u) { if (xb_ld(&bar[XB_TMO])) break; if (sp > XB_SPIN_CAP) { atomicAdd(&bar[XB_TMO], 1u); break; } }
    }
    nloc = mine > 0u ? mine : 1u; nx = cnt > 0u ? cnt : 1u;
}
__device__ __forceinline__ void xcd_barrier(const XcdBarrier& b, int wv) {
    asm volatile("s_waitcnt vmcnt(0)" ::: "memory");
    __syncthreads();
    if (wv == 0 && lane_id_v() == 0) {
        unsigned* bar = b.bar;
        __builtin_amdgcn_s_waitcnt(0);
        unsigned nloc = b.st[0], nx = b.st[1];
        if (nloc == 0u) { xcd_barrier_complete(bar, b.x, nloc, nx); b.st[0] = nloc; b.st[1] = nx; }
        const unsigned old = xb_add(&bar[XB_XSUB(b.x)], 1u);
        const unsigned gen = old / nloc;
        if (old + 1u == (gen + 1u) * nloc) {
            __builtin_amdgcn_fence(__ATOMIC_RELEASE, "agent");
            asm volatile("s_waitcnt vmcnt(0)" ::: "memory");
            const unsigned og = xb_add(&bar[XB_TOP], 1u);
            const unsigned tg = og / nx;
            if (og + 1u == (tg + 1u) * nx) xb_add(&bar[XB_TOPGEN], 1u);
            else XB_SPIN(xb_ld(&bar[XB_TOPGEN]) == tg, bar);
            __builtin_amdgcn_fence(__ATOMIC_ACQUIRE, "agent");
            xb_add(&bar[XB_XGEN(b.x)], 1u);
            asm volatile("s_waitcnt vmcnt(0)" ::: "memory");
        } else {
            XB_SPIN(xb_ld(&bar[XB_XGEN(b.x)]) == gen, bar);
            __builtin_amdgcn_fence(__ATOMIC_ACQUIRE, "agent");
            asm volatile("s_waitcnt vmcnt(0)" ::: "memory");
        }
    }
    __syncthreads();
}

struct Args {
    const float* x; const float* c; const int* pos; const float* ada_w; const float* ada_b; const float* mix_norm; const float* ffn_norm;
    const float* a_w_in; const float* a_conv_w; const float* a_conv_b; const float* a_gx_w; const float* a_gx_b; const float* a_ga_w; const float* a_ga_b;
    const float* a_lambda; const float* a_w_out; const float* kv_norm; const float* kv_ada_w; const float* kv_ada_b; const float* w_kv; const float* k_norm;
    const float* b_w_q; const float* b_q_norm; const float* b_sinks; const float* b_w_o; const float* f_w_gu; const float* f_w_down; const float* m_router;
    const float* m_w_gu; const float* m_w_down;
    float* out; unsigned char* ws; int ph_lo, ph_hi;
};

struct Ctx {
    LAS unsigned char* lds; int tid, lane, wave, vcu, G, cid;
};

template <bool F8>
__device__ __forceinline__ void transpose_item(const float* W, int K, int N, void* WT, int k0, int n0, int d0, int d1, LAS float* scr, int lane, float scale) {
    const int kr = lane >> 4, nq = lane & 15;
#pragma unroll 8
    for (int i = 0; i < 16; ++i) { const int k = 4 * i + kr; const f32x4 v = *(const f32x4*)(W + (size_t)(k0 + k) * N + n0 + 4 * nq);
        *(LAS f32x4*)(scr + k * 68 + ((4 * nq) ^ (4 * ((k >> 3) & 7)))) = v; }
    LDS_WAIT(); asm volatile("" ::: "memory");
    const int c = lane & 7, r = lane >> 3;
#pragma unroll
    for (int j = 0; j < 8; ++j) { const int n = 8 * j + r; const LAS float* s = scr + (8 * c) * 68 + (n ^ (4 * c));
        const int drow = ((n & 32) ? d1 : d0) + (n & 31);
        if constexpr (F8) { u32x2 o; o.x = cvt4_fp8(s[0 * 68] * scale, s[1 * 68] * scale, s[2 * 68] * scale, s[3 * 68] * scale); o.y = cvt4_fp8(s[4 * 68] * scale, s[5 * 68] * scale, s[6 * 68] * scale, s[7 * 68] * scale);
            *(u32x2*)((unsigned char*)WT + (size_t)drow * K + k0 + 8 * c) = o; }
        else { u32x4 o; o.x = cvtpk(s[0 * 68], s[1 * 68]); o.y = cvtpk(s[2 * 68], s[3 * 68]); o.z = cvtpk(s[4 * 68], s[5 * 68]); o.w = cvtpk(s[6 * 68], s[7 * 68]);
            *(u32x4*)((bf16_t*)WT + (size_t)drow * K + k0 + 8 * c) = o; } }
    LDS_WAIT(); asm volatile("" ::: "memory");
}
__device__ __forceinline__ int map_plain(int n) { return n; }
__device__ __forceinline__ int map_head(int n) { const int hd = n >> 6, d = n & 63; return 256 * (hd >> 2) + 128 * (d >> 5) + 32 * (hd & 3) + (d & 31); }
__device__ __forceinline__ int map_gu(int n, int F) { const int u = n >= F, j = u ? n - F : n; return 256 * (j >> 7) + 128 * u + (j & 127); }

__device__ __forceinline__ void p0_prologue(const Ctx& F, const Args& a) {
    unsigned char* ws = a.ws;
    {
        LAS float* cs = (LAS float*)F.lds;
        LAS float* red = (LAS float*)(F.lds + 65536);
        for (int i = F.tid; i < BATCH * DM; i += 512) { const int b = i >> 10, k = i & 1023; const float v = a.c[i]; cs[k * 16 + b] = silu_(v); }
        __syncthreads();
        float* modv = (float*)(ws + WS_MODV); float* kvmod = (float*)(ws + WS_KVMOD);
        constexpr int NC = 4 * 6144 + 2048, CPB = 104;
        for (int cb = F.vcu; cb * CPB < NC; cb += F.G) {
            const int cl = F.tid & 127, kp = F.tid >> 7, j = cb * CPB + cl;
            const bool on = (cl < CPB) && (j < NC);
            float accv[16];
#pragma unroll
            for (int b = 0; b < 16; ++b) accv[b] = 0.f;
            if (on) {
                const float* W; int ldw, jj;
                if (j < 4 * 6144) { const int l = j / 6144; jj = j - l * 6144; W = a.ada_w + (size_t)l * DM * 6144; ldw = 6144; } else { jj = j - 4 * 6144; W = a.kv_ada_w; ldw = 2048; }
                const float* wp = W + (size_t)(kp * 256) * ldw + jj;
#pragma unroll 4
                for (int k = 0; k < 256; ++k) { const float w = wp[(size_t)k * ldw]; const LAS f32x4* cv = (const LAS f32x4*)(cs + (kp * 256 + k) * 16);
#pragma unroll
                    for (int q = 0; q < 4; ++q) { const f32x4 c4 = cv[q]; accv[4 * q] += w * c4[0]; accv[4 * q + 1] += w * c4[1]; accv[4 * q + 2] += w * c4[2]; accv[4 * q + 3] += w * c4[3]; } }
            }
#pragma unroll
            for (int b = 0; b < 16; ++b) red[(kp * 128 + cl) * 16 + b] = accv[b];
            __syncthreads();
            for (int i = F.tid; i < CPB * 16; i += 512) { const int cl2 = i >> 4, b = i & 15, j2 = cb * CPB + cl2;
                if (j2 < NC) { const float s = (red[(0 * 128 + cl2) * 16 + b] + red[(1 * 128 + cl2) * 16 + b]) + (red[(2 * 128 + cl2) * 16 + b] + red[(3 * 128 + cl2) * 16 + b]);
                    if (j2 < 4 * 6144) { const int l = j2 / 6144, jj = j2 - l * 6144; modv[((size_t)l * 16 + b) * 6144 + jj] = s + a.ada_b[l * 6144 + jj]; }
                    else { const int jj = j2 - 4 * 6144; kvmod[(size_t)b * 2048 + jj] = s + a.kv_ada_b[jj]; } } }
            __syncthreads();
        }
    }
    {
        LAS float* scr = (LAS float*)(F.lds + F.wave * 17408);
        const int gw = F.vcu * 8 + F.wave, NGW = F.G * 8;
        constexpr int I_WIN = 16 * 32, I_SQ = 16 * 16, I_KV = 16 * 8, I_FGU = 16 * 96, I_FDN = 48 * 16, I_MGU = 16 * 112, I_MDN = 56 * 16;
        constexpr int NITEMS = 2 * I_WIN + 2 * I_SQ + I_KV + 2 * I_SQ + 2 * I_SQ + 2 * I_FGU + 2 * I_FDN + 16 * I_MGU + 16 * I_MDN;
        for (int it = gw; it < NITEMS; it += NGW) {
            int r = it;
            if (r < 2 * I_WIN) { const int mi = r / I_WIN, rr = r % I_WIN, nb = rr % 32, kb = rr / 32, n0 = 64 * nb;
                transpose_item<false>(a.a_w_in + (size_t)mi * DM * 2048, DM, 2048, (bf16_t*)(ws + WS_WIN) + (size_t)mi * 2048 * DM, 64 * kb, n0, n0, n0 + 32, scr, F.lane, 1.f); continue; } r -= 2 * I_WIN;
            if (r < 2 * I_SQ) { const int mi = r / I_SQ, rr = r % I_SQ, nb = rr % 16, kb = rr / 16, n0 = 64 * nb;
                transpose_item<false>(a.a_w_out + (size_t)mi * DM * DM, DM, DM, (bf16_t*)(ws + WS_WOUT) + (size_t)mi * DM * DM, 64 * kb, n0, n0, n0 + 32, scr, F.lane, 1.f); continue; } r -= 2 * I_SQ;
            if (r < I_KV) { const int nb = r % 8, kb = r / 8, n0 = 64 * nb;
                transpose_item<false>(a.w_kv, DM, 512, (bf16_t*)(ws + WS_WKV), 64 * kb, n0, n0 < 256 ? map_head(n0) : n0, n0 < 256 ? map_head(n0 + 32) : n0 + 32, scr, F.lane, 1.f); continue; } r -= I_KV;
            if (r < 2 * I_SQ) { const int mi = r / I_SQ, rr = r % I_SQ, nb = rr % 16, kb = rr / 16, n0 = 64 * nb;
                transpose_item<false>(a.b_w_q + (size_t)mi * DM * DM, DM, DM, (bf16_t*)(ws + WS_WQ) + (size_t)mi * DM * DM, 64 * kb, n0, map_head(n0), map_head(n0 + 32), scr, F.lane, 1.f); continue; } r -= 2 * I_SQ;
            if (r < 2 * I_SQ) { const int mi = r / I_SQ, rr = r % I_SQ, nb = rr % 16, kb = rr / 16, n0 = 64 * nb;
                transpose_item<false>(a.b_w_o + (size_t)mi * DM * DM, DM, DM, (bf16_t*)(ws + WS_WO) + (size_t)mi * DM * DM, 64 * kb, n0, n0, n0 + 32, scr, F.lane, 1.f); continue; } r -= 2 * I_SQ;
            if (r < 2 * I_FGU) { const int mi = r / I_FGU, rr = r % I_FGU, nb = rr % 96, kb = rr / 96, n0 = 64 * nb;
                if (FP8_OF(2 * mi)) transpose_item<true>(a.f_w_gu + (size_t)mi * DM * 6144, DM, 6144, ws + WS_FGU + (size_t)mi * 6144 * DM * 2, 64 * kb, n0, map_gu(n0, DFF), map_gu(n0 + 32, DFF), scr, F.lane, SC8_W);
                else transpose_item<false>(a.f_w_gu + (size_t)mi * DM * 6144, DM, 6144, (bf16_t*)(ws + WS_FGU) + (size_t)mi * 6144 * DM, 64 * kb, n0, map_gu(n0, DFF), map_gu(n0 + 32, DFF), scr, F.lane, 1.f); continue; } r -= 2 * I_FGU;
            if (r < 2 * I_FDN) { const int mi = r / I_FDN, rr = r % I_FDN, nb = rr % 16, kb = rr / 16, n0 = 64 * nb;
                if (FP8_OF(2 * mi)) transpose_item<true>(a.f_w_down + (size_t)mi * DFF * DM, DFF, DM, ws + WS_FDN + (size_t)mi * DM * DFF * 2, 64 * kb, n0, n0, n0 + 32, scr, F.lane, SC8_W);
                else transpose_item<false>(a.f_w_down + (size_t)mi * DFF * DM, DFF, DM, (bf16_t*)(ws + WS_FDN) + (size_t)mi * DM * DFF, 64 * kb, n0, n0, n0 + 32, scr, F.lane, 1.f); continue; } r -= 2 * I_FDN;
            if (r < 16 * I_MGU) { const int mi = r / I_MGU, rr = r % I_MGU, nb = rr % 112, kb = rr / 112, n0 = 64 * nb;
                if (FP8_OF(2 * (mi >> 3) + 1)) transpose_item<true>(a.m_w_gu + (size_t)mi * DM * 7168, DM, 7168, ws + WS_MGU + (size_t)(mi >> 3) * 8 * 7168 * DM * 2 + (size_t)(mi & 7) * 7168 * DM, 64 * kb, n0, map_gu(n0, DFE), map_gu(n0 + 32, DFE), scr, F.lane, SC8_W);
                else transpose_item<false>(a.m_w_gu + (size_t)mi * DM * 7168, DM, 7168, (bf16_t*)(ws + WS_MGU) + (size_t)mi * 7168 * DM, 64 * kb, n0, map_gu(n0, DFE), map_gu(n0 + 32, DFE), scr, F.lane, 1.f); continue; } r -= 16 * I_MGU;
            { const int mi = r / I_MDN, rr = r % I_MDN, nb = rr % 16, kb = rr / 16, n0 = 64 * nb;
                if (FP8_OF(2 * (mi >> 3) + 1)) transpose_item<true>(a.m_w_down + (size_t)mi * DFE * DM, DFE, DM, ws + WS_MDN + (size_t)(mi >> 3) * 8 * DM * DFE * 2 + (size_t)(mi & 7) * DM * DFE, 64 * kb, n0, n0, n0 + 32, scr, F.lane, SC8_W);
                else transpose_item<false>(a.m_w_down + (size_t)mi * DFE * DM, DFE, DM, (bf16_t*)(ws + WS_MDN) + (size_t)mi * DM * DFE, 64 * kb, n0, n0, n0 + 32, scr, F.lane, 1.f); }
        }
        __syncthreads();
    }
    {
        float* par = (float*)(ws + WS_PAR);
        const size_t gt0 = (size_t)F.vcu * 512 + F.tid, GT0 = (size_t)F.G * 512;
        for (size_t i = gt0; i < (size_t)PAR_END; i += GT0) { const int j = (int)i; float v;
            if (j < PAR_FFNN) v = a.mix_norm[j - PAR_MIXN]; else if (j < PAR_CONVW) v = a.ffn_norm[j - PAR_FFNN]; else if (j < PAR_CONVB) v = a.a_conv_w[j - PAR_CONVW];
            else if (j < PAR_GXB) v = a.a_conv_b[j - PAR_CONVB]; else if (j < PAR_GAB) v = a.a_gx_b[j - PAR_GXB]; else if (j < PAR_LAM) v = a.a_ga_b[j - PAR_GAB];
            else if (j < PAR_KVN) v = a.a_lambda[j - PAR_LAM]; else if (j < PAR_KN) v = a.kv_norm[j - PAR_KVN]; else if (j < PAR_QN) v = a.k_norm[j - PAR_KN];
            else if (j < PAR_SINK) v = a.b_q_norm[j - PAR_QN]; else if (j < PAR_ROUTER) v = a.b_sinks[j - PAR_SINK]; else v = a.m_router[j - PAR_ROUTER];
            par[j] = v; }
    }
    {
        const size_t gt = (size_t)F.vcu * 512 + F.tid, GT = (size_t)F.G * 512;
        bf16_t* gwp = (bf16_t*)(ws + WS_GW);
        for (size_t i = gt; i < (size_t)2 * 8 * 2 * 128 * 128; i += GT) { const int k = (int)(i & 127), j = (int)((i >> 7) & 127), c2 = (int)((i >> 14) & 1), n = (int)((i >> 15) & 7), l = (int)(i >> 18);
            const float* g = (j < 64) ? a.a_ga_w : a.a_gx_w; const float v = g[((size_t)(l * 8 + n) * 128 + k) * 128 + 64 * c2 + (j & 63)];
            gwp[i] = (bf16_t)(cvtpk(v, 0.f) & 0xffffu); }
        float* ct = (float*)(ws + WS_COS); float* st = (float*)(ws + WS_SIN);
        for (size_t i = gt; i < (size_t)NTOK * 32; i += GT) { const int p = (int)(i & 31); const size_t tok = i >> 5;
            const float inv = powf(10000.0f, -(float)(2 * p) / 64.0f); const float ang = (float)a.pos[tok] * inv;
            ct[i] = cosf(ang); st[i] = sinf(ang); }
    }
}

template <bool DUAL, bool ROUTER, bool OUT8 = false, bool INF32 = false>
__device__ __forceinline__ void norm_phase(const Ctx& F, const void* x, const float* gain1, const float* sh1, const float* sc1, void* out1,
                                           const float* gain2, const float* sh2, const float* sc2, bf16_t* out2,
                                           const float* wrouter, int* e12, float* w1o, int* cnt) {
    LAS int* lcnt = (LAS int*)F.lds;
    for (int rb = F.vcu; rb < NTOK / 256; rb += F.G) {
        const int b = rb >> 4;
        if (ROUTER) { if (F.tid < 16) lcnt[F.tid] = 0; __syncthreads(); }
        float ca[16], cs[16], ca2[16], cs2[16];
#pragma unroll
        for (int j = 0; j < 4; ++j) { const int col = 4 * F.lane + 256 * j;
            const f32x4 g = *(const f32x4*)(gain1 + col), s = *(const f32x4*)(sc1 + (size_t)b * 6144 + col), h = *(const f32x4*)(sh1 + (size_t)b * 6144 + col);
#pragma unroll
            for (int q = 0; q < 4; ++q) { ca[4 * j + q] = g[q] * (1.0f + s[q]); cs[4 * j + q] = h[q]; }
            if (DUAL) { const f32x4 g2 = *(const f32x4*)(gain2 + col), s2 = *(const f32x4*)(sc2 + (size_t)b * 2048 + col), h2 = *(const f32x4*)(sh2 + (size_t)b * 2048 + col);
#pragma unroll
                for (int q = 0; q < 4; ++q) { ca2[4 * j + q] = g2[q] * (1.0f + s2[q]); cs2[4 * j + q] = h2[q]; } } }
        float wr_[ROUTER ? 128 : 1];
        if (ROUTER) {
#pragma unroll
            for (int j = 0; j < 4; ++j)
#pragma unroll
                for (int q = 0; q < 4; ++q) { const int col = 4 * F.lane + 256 * j + q; const f32x4 w0 = *(const f32x4*)(wrouter + (size_t)col * 8), w1 = *(const f32x4*)(wrouter + (size_t)col * 8 + 4);
#pragma unroll
                    for (int e = 0; e < 4; ++e) { wr_[(4 * j + q) * 8 + e] = w0[e]; wr_[(4 * j + q) * 8 + 4 + e] = w1[e]; } }
        }
        int me12 = 0; float mw1 = 0.f;
        const int rowb = rb * 256 + F.wave * 32;
        for (int rr = 0; rr < 32; ++rr) {
            const size_t row = (size_t)(rowb + rr);
            f32x4 v[4]; float s = 0.f;
            if constexpr (INF32) { const f32x4* xr = (const f32x4*)((const float*)x + row * DM) + F.lane;
#pragma unroll
                for (int j = 0; j < 4; ++j) v[j] = xr[64 * j]; }
            else { const u32x2* xr = (const u32x2*)((const bf16_t*)x + row * DM) + F.lane;
#pragma unroll
                for (int j = 0; j < 4; ++j) { const u32x2 p = xr[64 * j]; v[j] = (f32x4){bflo(p.x), bfhi(p.x), bflo(p.y), bfhi(p.y)}; } }
#pragma unroll
            for (int j = 0; j < 4; ++j) s += (v[j][0] * v[j][0] + v[j][1] * v[j][1]) + (v[j][2] * v[j][2] + v[j][3] * v[j][3]);
            const float r = __builtin_amdgcn_rsqf(wave_sum(s, F.lane) * (1.0f / DM) + EPS);
            float hv[16];
#pragma unroll
            for (int j = 0; j < 4; ++j)
#pragma unroll
                for (int q = 0; q < 4; ++q) hv[4 * j + q] = v[j][q] * r * ca[4 * j + q] + cs[4 * j + q];
            if constexpr (OUT8) { unsigned* o4 = (unsigned*)((unsigned char*)out1 + row * DM) + F.lane;
#pragma unroll
                for (int j = 0; j < 4; ++j) o4[64 * j] = cvt4_fp8(hv[4 * j] * SC8_H, hv[4 * j + 1] * SC8_H, hv[4 * j + 2] * SC8_H, hv[4 * j + 3] * SC8_H); }
            else { u32x2* o8 = (u32x2*)((bf16_t*)out1 + row * DM) + F.lane;
#pragma unroll
                for (int j = 0; j < 4; ++j) { u32x2 w; w.x = cvtpk(hv[4 * j], hv[4 * j + 1]); w.y = cvtpk(hv[4 * j + 2], hv[4 * j + 3]); o8[64 * j] = w; } }
            if (DUAL) { u32x2* p8 = (u32x2*)(out2 + row * DM) + F.lane;
#pragma unroll
                for (int j = 0; j < 4; ++j) { float t[4];
#pragma unroll
                    for (int q = 0; q < 4; ++q) t[q] = v[j][q] * r * ca2[4 * j + q] + cs2[4 * j + q];
                    u32x2 w; w.x = cvtpk(t[0], t[1]); w.y = cvtpk(t[2], t[3]); p8[64 * j] = w; } }
            if (ROUTER) {
                float lg[8];
#pragma unroll
                for (int e = 0; e < 8; ++e) { float p = 0.f;
#pragma unroll
                    for (int c = 0; c < 16; ++c) p += hv[c] * wr_[c * 8 + e];
                    lg[e] = wave_sum(p, F.lane); }
                int i1 = 0; float v1 = lg[0];
#pragma unroll
                for (int e = 1; e < 8; ++e) if (lg[e] > v1) { v1 = lg[e]; i1 = e; }
                int i2 = -1; float v2 = -INFINITY;
#pragma unroll
                for (int e = 0; e < 8; ++e) if (e != i1 && lg[e] > v2) { v2 = lg[e]; i2 = e; }
                const float wt = 1.0f / (1.0f + __expf(v2 - v1));
                if (F.lane == rr) { me12 = i1 | (i2 << 8); mw1 = wt; }
            }
        }
        if (ROUTER) {
            if (F.lane < 32) { e12[rowb + F.lane] = me12; w1o[rowb + F.lane] = mw1; }
            const int e1 = me12 & 255, e2 = me12 >> 8;
#pragma unroll
            for (int e = 0; e < 8; ++e) { const unsigned long long m1 = __ballot(F.lane < 32 && e1 == e), m2 = __ballot(F.lane < 32 && e2 == e);
                if (F.lane == 0) { atomicAdd((int*)&lcnt[e], (int)__popcll(m1)); atomicAdd((int*)&lcnt[8 + e], (int)__popcll(m2)); } }
            __syncthreads();
            if (F.tid < 16) cnt[rb * 16 + F.tid] = lcnt[F.tid];
            __syncthreads();
        }
    }
}

__device__ __forceinline__ void moe_scatter(const Ctx& F, const int* cnt, const int* e12, const float* w1, int* tos, float* wos, int* tile) {
    LAS int* T1 = (LAS int*)F.lds;
    LAS int* T2 = T1 + 512;
    LAS int* tot = T2 + 512;
    LAS int* pre = tot + 16;
    LAS int* seg = pre + 16;
    LAS int* wcn = seg + 32;
    for (int rb = F.vcu; rb < NTOK / 256; rb += F.G) {
        { const int bin = F.tid & 15, part = F.tid >> 4; int st = 0, sp = 0;
#pragma unroll
            for (int j = 0; j < 8; ++j) { const int b2 = part * 8 + j; const int v = cnt[b2 * 16 + bin]; st += v; if (b2 < rb) sp += v; }
            T1[part * 16 + bin] = st; T2[part * 16 + bin] = sp; }
        __syncthreads();
        if (F.tid < 16) { int st = 0, sp = 0; for (int p = 0; p < 32; ++p) { st += T1[p * 16 + F.tid]; sp += T2[p * 16 + F.tid]; } tot[F.tid] = st; pre[F.tid] = sp; }
        __syncthreads();
        if (F.tid == 0) { int s = 0; for (int bin = 0; bin < 16; ++bin) { seg[bin] = s; s += ((tot[bin] + 255) >> 8) << 8; } seg[16] = s; }
        __syncthreads();
        int e1 = -1, e2 = -1; float wt = 0.f; int r1 = 0, r2 = 0;
        const int token = rb * 256 + F.tid;
        if (F.tid < 256) { const int v = e12[token]; e1 = v & 255; e2 = v >> 8; wt = w1[token]; }
        if (F.wave < 4) {
#pragma unroll
            for (int e = 0; e < 8; ++e) { const unsigned long long m1 = __ballot(e1 == e), m2 = __ballot(e2 == e); const unsigned long long lt = (1ull << F.lane) - 1ull;
                if (e1 == e) r1 = (int)__popcll(m1 & lt); if (e2 == e) r2 = (int)__popcll(m2 & lt);
                if (F.lane == 0) { wcn[F.wave * 16 + e] = (int)__popcll(m1); wcn[F.wave * 16 + 8 + e] = (int)__popcll(m2); } }
        }
        __syncthreads();
        if (F.tid < 256) {
            int o1 = seg[e1] + pre[e1] + r1, o2 = seg[8 + e2] + pre[8 + e2] + r2;
            for (int w = 0; w < F.wave; ++w) { o1 += wcn[w * 16 + e1]; o2 += wcn[w * 16 + 8 + e2]; }
            tos[o1] = token; wos[o1] = wt; tos[o2] = token; wos[o2] = 1.0f - wt;
        }
        if (rb < 16) { const int bin = rb; const int s0 = seg[bin] + tot[bin], s1 = seg[bin + 1]; for (int s = s0 + F.tid; s < s1; s += 512) { tos[s] = -1; wos[s] = 0.f; } }
        if (rb == 0) { if (F.tid == 0) { tile[0] = seg[8] >> 8; tile[1] = seg[16] >> 8; }
            for (int t = F.tid; t < MAXTILES; t += 512) { const int s = t << 8; int e = 0;
#pragma unroll
                for (int bin = 1; bin < 16; ++bin) if (s >= seg[bin]) e = bin;
                tile[16 + t] = e & 7; } }
        __syncthreads();
    }
}

constexpr int SC_AT = 0, SC_WT = 34816, SC_AS = 69632, SC_BS = 102400, SC_SEG = 135168, SC_CARRY = 139264, SC_CW = 139776, SC_GB = 142336;
__device__ __forceinline__ void scan_phase(const Ctx& F, const float* par, int l, const bf16_t* XB, bf16_t* GY, const bf16_t* GW) {
    LAS unsigned char* lds = F.lds;
    LAS float* AS = (LAS float*)(lds + SC_AS); LAS float* BS = (LAS float*)(lds + SC_BS);
    LAS float* SEGA = (LAS float*)(lds + SC_SEG); LAS float* SEGB = SEGA + 512;
    LAS float* CARRY = (LAS float*)(lds + SC_CARRY);
    LAS float* CW = (LAS float*)(lds + SC_CW);
    LAS float* GB = (LAS float*)(lds + SC_GB);
    const int tid = F.tid, lane = F.lane, wid = F.wave, r32 = lane & 31, hh = lane >> 5;
    for (int un = F.vcu; un < 256; un += F.G) {
        const int b = un >> 4, n = (un >> 1) & 7, c2 = un & 1;
        __syncthreads();
        for (int i = tid; i < 640; i += 512) { const int ch = i & 127, k = i >> 7; CW[i] = (k < 4) ? par[PAR_CONVW + (l * 4 + k) * DM + 128 * n + ch] : par[PAR_CONVB + l * DM + 128 * n + ch]; }
        if (tid < 64) { const int ch = l * DM + 128 * n + 64 * c2 + tid; GB[tid] = par[PAR_GAB + ch]; GB[64 + tid] = par[PAR_GXB + ch]; GB[128 + tid] = log1pf(expf(-par[PAR_LAM + ch])); CARRY[tid] = 0.f; CARRY[64 + tid] = 0.f; }
        { const bf16_t* gsrc = GW + (size_t)(((l * 8 + n) * 2 + c2) * 128) * 128;
#pragma unroll
            for (int i = 0; i < 4; ++i) { const int p = tid + 512 * i, row = p >> 4, c16 = p & 15; const u32x4 v = *(const u32x4*)(gsrc + (size_t)row * 128 + c16 * 8); *(LAS u32x4*)(lds + SC_WT + row * 272 + c16 * 16) = v; } }
        const int cp = lane, tg = wid;
        const int sc = lane, sg = wid;
        const size_t rowbase = (size_t)b * SEQ;
        const bf16_t* xbp = XB + rowbase * DM + 128 * n + 2 * cp;
        bf16_t* gyp = GY + rowbase * DM + 128 * n + 64 * c2 + sc;
        unsigned xv[19];
#pragma unroll
        for (int k = 0; k < 19; ++k) { const int t = 16 * tg - 3 + k; xv[k] = (t >= 0) ? *(const unsigned*)(xbp + (size_t)t * DM) : 0u; }
        __syncthreads();
        float w[2][4], cb[2];
#pragma unroll
        for (int q = 0; q < 2; ++q) { cb[q] = CW[512 + 2 * cp + q];
#pragma unroll
            for (int k = 0; k < 4; ++k) w[q][k] = CW[k * 128 + 2 * cp + q]; }
        const float gba = GB[32 * (wid & 1) + r32], gbx = GB[64 + 32 * (wid & 1) + r32], spv = GB[128 + 32 * (wid & 1) + r32];
        for (int ci = 0; ci < SEQ / 128; ++ci) {
            const int t0 = ci * 128;
#pragma unroll
            for (int k = 0; k < 16; ++k) {
                float o[2];
#pragma unroll
                for (int q = 0; q < 2; ++q) { float s = cb[q];
#pragma unroll
                    for (int j = 0; j < 4; ++j) { const unsigned pv = xv[k + j]; const float xf = q ? __uint_as_float(pv & 0xffff0000u) : __uint_as_float(pv << 16); s += w[q][j] * xf; }
                    o[q] = s; }
                *(LAS unsigned*)(lds + SC_AT + (16 * tg + k) * 272 + cp * 4) = cvtpk(o[0], o[1]);
            }
            if (ci + 1 < SEQ / 128) {
#pragma unroll
                for (int k = 0; k < 19; ++k) xv[k] = *(const unsigned*)(xbp + (size_t)(t0 + 128 + 16 * tg - 3 + k) * DM);
            }
            __syncthreads();
            f32x16 ga, gx;
#pragma unroll
            for (int i = 0; i < 16; ++i) { ga[i] = 0.f; gx[i] = 0.f; }
            { const int tt = wid >> 1, ct = wid & 1;
                const LAS unsigned char* ap = lds + SC_AT + (32 * tt + r32) * 272 + hh * 16;
                const LAS unsigned char* bpa = lds + SC_WT + (32 * ct + r32) * 272 + hh * 16;
                const LAS unsigned char* bpx = bpa + 64 * 272;
#pragma unroll
                for (int s = 0; s < 8; ++s) { const bf16x8 af = *(const LAS bf16x8*)(ap + s * 32), ba = *(const LAS bf16x8*)(bpa + s * 32), bx = *(const LAS bf16x8*)(bpx + s * 32);
                    ga = __builtin_amdgcn_mfma_f32_32x32x16_bf16(af, ba, ga, 0, 0, 0); gx = __builtin_amdgcn_mfma_f32_32x32x16_bf16(af, bx, gx, 0, 0, 0); }
#pragma unroll
                for (int i = 0; i < 16; ++i) { const int tok = 32 * tt + (i & 3) + 8 * (i >> 2) + 4 * hh, ch = 32 * ct + r32;
                    const float rg = sigmoidf_(ga[i] + gba), ig = sigmoidf_(gx[i] + gbx);
                    const float la = -8.0f * rg * spv; const float av = fast_exp2(la * LOG2E); const float bc = __builtin_amdgcn_sqrtf(fmaxf(1.0f - av * av, 0.f));
                    const float xcv = bf2f(*(const LAS unsigned short*)(lds + SC_AT + tok * 272 + (64 * c2 + ch) * 2));
                    AS[tok * 64 + ch] = av; BS[tok * 64 + ch] = bc * ig * xcv; }
            }
            __syncthreads();
            unsigned short gyv[16];
#pragma unroll
            for (int k = 0; k < 16; ++k) gyv[k] = gyp[(size_t)(t0 + 16 * sg + k) * DM];
            float av[16], bv[16];
#pragma unroll
            for (int k = 0; k < 16; ++k) { av[k] = AS[(16 * sg + k) * 64 + sc]; bv[k] = BS[(16 * sg + k) * 64 + sc]; }
            { float pa = 1.f, pb = 0.f;
#pragma unroll
                for (int k = 0; k < 16; ++k) { pb = av[k] * pb + bv[k]; pa *= av[k]; }
                SEGA[sg * 64 + sc] = pa; SEGB[sg * 64 + sc] = pb; }
            __syncthreads();
            float h = CARRY[(ci & 1) * 64 + sc];
            for (int s = 0; s < sg; ++s) h = SEGA[s * 64 + sc] * h + SEGB[s * 64 + sc];
#pragma unroll
            for (int k = 0; k < 16; ++k) { h = av[k] * h + bv[k]; const float o = h * bf2f(gyv[k]); gyp[(size_t)(t0 + 16 * sg + k) * DM] = (bf16_t)(cvtpk(o, 0.f) & 0xffffu); }
            if (sg == 7) CARRY[((ci + 1) & 1) * 64 + sc] = h;
        }
    }
    __syncthreads();
}

constexpr int AT_K = 0, AT_V = 36864;
__device__ __forceinline__ void attn_phase(const Ctx& F, const bf16_t* Q, const bf16_t* Kb, const bf16_t* Vb, bf16_t* O, const float* sinks) {
    LAS unsigned char* lds = F.lds;
    const int tid = F.tid, lane = F.lane, wid = F.wave, r32 = lane & 31, hh = lane >> 5;
    const int i16 = lane & 15, tq = i16 >> 2, tp = i16 & 3, blk = (lane >> 4) & 1;
    const int g = wid & 3, half = wid >> 2;
    constexpr int NU = BATCH * 32 * 4;
    u32x4 kreg[4], vreg[4]; bf16x8 qreg[2][4];
#define AT_LOADKV(unit) do { const int kh_ = (unit) & 3, n_ = ((unit) >> 2) & 31, b_ = (unit) >> 7; \
        _Pragma("unroll") for (int i = 0; i < 4; ++i) { const int p = tid + 512 * i, row = p >> 3, c16 = p & 7; kreg[i] = (u32x4){0u, 0u, 0u, 0u}; vreg[i] = (u32x4){0u, 0u, 0u, 0u}; \
            if (n_ > 0 || row >= 128) { const size_t tok = (size_t)b_ * SEQ + (size_t)(128 * (n_ - 1) + row); kreg[i] = *(const u32x4*)(Kb + tok * 256 + kh_ * 64 + c16 * 8); vreg[i] = *(const u32x4*)(Vb + tok * 256 + kh_ * 64 + c16 * 8); } } } while (0)
#define AT_LOADQ(unit) do { const int kh_ = (unit) & 3, n_ = ((unit) >> 2) & 31, b_ = (unit) >> 7; \
        _Pragma("unroll") for (int ps = 0; ps < 2; ++ps) { const size_t qt_ = (size_t)b_ * SEQ + (size_t)(128 * n_ + 64 * half + 32 * ps + r32); \
            _Pragma("unroll") for (int s = 0; s < 4; ++s) qreg[ps][s] = *(const bf16x8*)(Q + qt_ * DM + (4 * kh_ + g) * 64 + 16 * s + 8 * hh); } } while (0)
    int un = F.vcu;
    if (un < NU) { AT_LOADKV(un); AT_LOADQ(un); }
    for (; un < NU; un += F.G) {
        const int kh = un & 3, n = (un >> 2) & 31, b = un >> 7;
        __syncthreads();
#pragma unroll
        for (int i = 0; i < 4; ++i) { const int p = tid + 512 * i, row = p >> 3, c16 = p & 7;
            *(LAS u32x4*)(lds + AT_K + row * 144 + c16 * 16) = kreg[i]; *(LAS u32x4*)(lds + AT_V + row * 192 + c16 * 16) = vreg[i]; }
        __syncthreads();
        if (un + F.G < NU) AT_LOADKV(un + F.G);
        const int hq = 4 * kh + g;
        const float sink2 = sinks[hq] * LOG2E;
#pragma unroll 1
        for (int pass = 0; pass < 2; ++pass) {
            const int i0 = 64 * half + 32 * pass, kt0 = i0 >> 5;
            const size_t qtok = (size_t)b * SEQ + (size_t)(128 * n + i0 + r32);
            bf16x8 qf[4];
#pragma unroll
            for (int s = 0; s < 4; ++s) qf[s] = pass ? qreg[1][s] : qreg[0][s];
            f32x16 sacc[5];
#pragma unroll
            for (int t = 0; t < 5; ++t) {
#pragma unroll
                for (int i = 0; i < 16; ++i) sacc[t][i] = 0.f;
#pragma unroll
                for (int s = 0; s < 4; ++s) { const bf16x8 kf = *(const LAS bf16x8*)(lds + AT_K + (32 * (kt0 + t) + r32) * 144 + (16 * s + 8 * hh) * 2);
                    sacc[t] = __builtin_amdgcn_mfma_f32_32x32x16_bf16(kf, qf[s], sacc[t], 0, 0, 0); } }
            const int qi = i0 + r32;
            float mx = sink2;
#pragma unroll
            for (int t = 0; t < 5; ++t)
#pragma unroll
                for (int i = 0; i < 16; ++i) { const int j = 32 * (kt0 + t) + (i & 3) + 8 * (i >> 2) + 4 * hh; const int d = j - qi;
                    const bool ok = (d >= 1) && (d <= 128) && (n > 0 || j >= 128);
                    const float sv = ok ? sacc[t][i] : -INFINITY; sacc[t][i] = sv; mx = fmaxf(mx, sv); }
            mx = fmaxf(mx, shflx(mx, lane, 32));
            float sum = 0.f;
#pragma unroll
            for (int t = 0; t < 5; ++t)
#pragma unroll
                for (int i = 0; i < 16; ++i) { const float p = fast_exp2(sacc[t][i] - mx); sacc[t][i] = p; sum += p; }
            sum += shflx(sum, lane, 32);
            sum += fast_exp2(sink2 - mx);
            const float inv = 1.0f / sum;
            f32x16 oacc[2];
#pragma unroll
            for (int i = 0; i < 16; ++i) { oacc[0][i] = 0.f; oacc[1][i] = 0.f; }
#pragma unroll
            for (int t = 0; t < 5; ++t)
#pragma unroll
                for (int s = 0; s < 2; ++s) {
                    u32x4 pk; pk.x = cvtpk(sacc[t][8 * s], sacc[t][8 * s + 1]); pk.y = cvtpk(sacc[t][8 * s + 2], sacc[t][8 * s + 3]); pk.z = cvtpk(sacc[t][8 * s + 4], sacc[t][8 * s + 5]); pk.w = cvtpk(sacc[t][8 * s + 6], sacc[t][8 * s + 7]);
                    const bf16x8 pb = __builtin_bit_cast(bf16x8, pk);
#pragma unroll
                    for (int dt = 0; dt < 2; ++dt) {
                        const LAS unsigned char* vp = lds + AT_V + (32 * (kt0 + t) + 16 * s + 4 * hh + tq) * 192 + (32 * dt + 16 * blk + 4 * tp) * 2;
                        const s16x4 lo = __builtin_bit_cast(s16x4, __builtin_amdgcn_ds_read_tr16_b64_v4i16((LAS s16x4*)vp));
                        const s16x4 hi = __builtin_bit_cast(s16x4, __builtin_amdgcn_ds_read_tr16_b64_v4i16((LAS s16x4*)(vp + 8 * 192)));
                        const bf16x8 va = __builtin_shufflevector(lo, hi, 0, 1, 2, 3, 4, 5, 6, 7);
                        oacc[dt] = __builtin_amdgcn_mfma_f32_32x32x16_bf16(va, pb, oacc[dt], 0, 0, 0);
                    }
                }
            bf16_t* op = O + qtok * DM + hq * 64;
#pragma unroll
            for (int dt = 0; dt < 2; ++dt)
#pragma unroll
                for (int q4 = 0; q4 < 4; ++q4) { u32x2 w; w.x = cvtpk(oacc[dt][4 * q4] * inv, oacc[dt][4 * q4 + 1] * inv); w.y = cvtpk(oacc[dt][4 * q4 + 2] * inv, oacc[dt][4 * q4 + 3] * inv);
                    *(u32x2*)(op + 32 * dt + 8 * q4 + 4 * hh) = w; }
        }
        if (un + F.G < NU) AT_LOADQ(un + F.G);
    }
#undef AT_LOADKV
#undef AT_LOADQ
    __syncthreads();
}

constexpr int NPHASE = 34 + (DUP_SCANPAIR ? 4 : 0);
__global__ void __launch_bounds__(512, 2) fwd_kernel(Args a) {
    extern __shared__ __attribute__((aligned(16))) unsigned char lds_raw[];
    volatile LAS unsigned* MISC = (volatile LAS unsigned*)((LAS unsigned char*)lds_raw + LDS_MISC);
    const int wv0 = __builtin_amdgcn_readfirstlane((int)threadIdx.x >> 6);
    if (wv0 == 0) MISC[lane_id_v()] = 0u;
    __syncthreads();
    XcdBarrier bar; bar.bar = (unsigned*)(a.ws + WS_CTL) + CW_BAR; bar.x = 0; bar.st = MISC;
    if (!MK_MULTI) bar = xcd_barrier_post((unsigned*)(a.ws + WS_CTL) + CW_BAR, MISC, wv0);
    const int lo = a.ph_lo, hi = a.ph_hi;
    int ph = 0;
#define PH_BEGIN(k) if (((PHSEL >> (k)) & 1) && lo <= ph && ph < hi) { Ctx F; { int t_ = wv0 * 64 + (int)lane_id_v(); asm volatile("" : "+v"(t_)); F.tid = t_; } F.lds = (LAS unsigned char*)lds_raw; F.lane = F.tid & 63; \
        F.wave = __builtin_amdgcn_readfirstlane(F.tid >> 6); F.G = gridDim.x; { int bx = blockIdx.x; asm volatile("" : "+s"(bx)); F.cid = bx; F.vcu = (F.G % 8 == 0) ? (bx % 8) * (F.G / 8) + bx / 8 : bx; } \
        unsigned char GAS* wsg_ = (unsigned char GAS*)a.ws; asm volatile("" : "+s"(wsg_)); unsigned char* ws = (unsigned char*)wsg_; float GAS* xog_ = (float GAS*)a.out; asm volatile("" : "+s"(xog_)); float* xo = (float*)xog_; int l = l_; asm volatile("" : "+s"(l)); (void)xo; (void)l; \
        for (int rep_ = 0; rep_ < (((DUPMASK >> (k)) & 1) ? 2 : 1); ++rep_) {
#define PH_END   } if (!MK_MULTI && ph + 1 < NPHASE) xcd_barrier(bar, wv0); } ++ph;
#define W_PAR    ((const float*)(ws + WS_PAR))
#define W_XS     ((bf16_t*)(ws + WS_XS))
#define W_MODL   ((const float*)(ws + WS_MODV) + (size_t)l * 16 * 6144)
#define W_KVMOD  ((const float*)(ws + WS_KVMOD))
#define W_HB     ((bf16_t*)(ws + WS_H))
#define W_HKV    ((bf16_t*)(ws + WS_HKV))
#define W_KB     ((bf16_t*)(ws + WS_KB))
#define W_VB     ((bf16_t*)(ws + WS_VB))
#define W_XB     ((bf16_t*)(ws + WS_ARENA + AR_XB))
#define W_GY     ((bf16_t*)(ws + WS_ARENA + AR_GY))
#define W_HID    ((bf16_t*)(ws + WS_ARENA))
#define W_Q      ((bf16_t*)(ws + WS_ARENA + AR_Q))
#define W_O      ((bf16_t*)(ws + WS_ARENA + AR_O))
#define W_COS    ((const float*)(ws + WS_COS))
#define W_SIN    ((const float*)(ws + WS_SIN))
#define W_E12    ((int*)(ws + WS_E12))
#define W_W1     ((float*)(ws + WS_W1))
#define W_CNT    ((int*)(ws + WS_CNT))
#define W_TILE   ((int*)(ws + WS_TILE))
#define W_TOS    ((int*)(ws + WS_TOS))
#define W_WOS    ((float*)(ws + WS_WOS))

    { const int l_ = 0; PH_BEGIN(0) p0_prologue(F, a); PH_END }

#pragma unroll 1
    for (int l_ = 0; l_ < 4; ++l_) {
        if (l_ < 2) {
            PH_BEGIN(1) if (l == 0) norm_phase<false, false, false, true>(F, a.x, W_PAR + PAR_MIXN + l * DM, W_MODL, W_MODL + 1024, W_HB, nullptr, nullptr, nullptr, nullptr, nullptr, nullptr, nullptr, nullptr);
                        else norm_phase<false, false>(F, W_XS, W_PAR + PAR_MIXN + l * DM, W_MODL, W_MODL + 1024, W_HB, nullptr, nullptr, nullptr, nullptr, nullptr, nullptr, nullptr, nullptr); PH_END
#pragma unroll 1
            for (int sp_ = 0; sp_ < (DUP_SCANPAIR ? 2 : 1); ++sp_) {
            PH_BEGIN(2) { pg8::ProbDense P{W_HB, (const bf16_t*)(ws + WS_WIN) + (size_t)l * 2048 * DM, DM * 2}; pg8::Order S; S.init(NTOK / 256, 8, F.G, F.cid, 0);
                pg8::EpiWin E{W_XB, W_GY}; pg8::gemm_phase<pg8::EpiWin, pg8::ProbDense, false>(F.lds, F.tid, P, S, E); } PH_END
            PH_BEGIN(3) scan_phase(F, W_PAR, l, W_XB, W_GY, (const bf16_t*)(ws + WS_GW)); PH_END
            }
            PH_BEGIN(4) { pg8::ProbDense P{W_GY, (const bf16_t*)(ws + WS_WOUT) + (size_t)l * DM * DM, DM * 2}; pg8::Order S; S.init(NTOK / 256, 4, F.G, F.cid, 0);
                if (l == 0) { pg8::EpiResid<true> E{a.x, W_XS, W_MODL + 2048, 1.0f}; pg8::gemm_phase<pg8::EpiResid<true>, pg8::ProbDense, false>(F.lds, F.tid, P, S, E); }
                else { pg8::EpiResid<false> E{W_XS, W_XS, W_MODL + 2048, 1.0f}; pg8::gemm_phase<pg8::EpiResid<false>, pg8::ProbDense, false>(F.lds, F.tid, P, S, E); } } PH_END
        } else {
            PH_BEGIN(5) if (l == 2) norm_phase<true, false>(F, W_XS, W_PAR + PAR_MIXN + l * DM, W_MODL, W_MODL + 1024, W_HB, W_PAR + PAR_KVN, W_KVMOD, W_KVMOD + 1024, W_HKV, nullptr, nullptr, nullptr, nullptr);
                        else norm_phase<false, false>(F, W_XS, W_PAR + PAR_MIXN + l * DM, W_MODL, W_MODL + 1024, W_HB, nullptr, nullptr, nullptr, nullptr, nullptr, nullptr, nullptr, nullptr); PH_END
            if (l_ == 2) {
                PH_BEGIN(6) { pg8::ProbDense P{W_HKV, (const bf16_t*)(ws + WS_WKV), DM * 2}; pg8::Order S; S.init(NTOK / 256, 2, F.G, F.cid, 0);
                    pg8::EpiQK E{W_KB, 256, W_PAR + PAR_KN, W_COS, W_SIN, 1.0f, 1, W_VB}; pg8::gemm_phase<pg8::EpiQK, pg8::ProbDense, false>(F.lds, F.tid, P, S, E); } PH_END
            }
            PH_BEGIN(6) { pg8::ProbDense P{W_HB, (const bf16_t*)(ws + WS_WQ) + (size_t)(l - 2) * DM * DM, DM * 2}; pg8::Order S; S.init(NTOK / 256, 4, F.G, F.cid, 0);
                pg8::EpiQK E{W_Q, DM, W_PAR + PAR_QN + (l - 2) * 64, W_COS, W_SIN, 0.125f * LOG2E, -1, nullptr}; pg8::gemm_phase<pg8::EpiQK, pg8::ProbDense, false>(F.lds, F.tid, P, S, E); } PH_END
            PH_BEGIN(7) attn_phase(F, W_Q, W_KB, W_VB, W_O, W_PAR + PAR_SINK + (l - 2) * 16); PH_END
            PH_BEGIN(8) { pg8::ProbDense P{W_O, (const bf16_t*)(ws + WS_WO) + (size_t)(l - 2) * DM * DM, DM * 2}; pg8::Order S; S.init(NTOK / 256, 4, F.G, F.cid, 0);
                pg8::EpiResid<false> E{W_XS, W_XS, W_MODL + 2048, 1.0f}; pg8::gemm_phase<pg8::EpiResid<false>, pg8::ProbDense, false>(F.lds, F.tid, P, S, E); } PH_END
        }
        if (!(l_ & 1)) {
            PH_BEGIN(9) if (FP8_OF(0) | FP8_OF(2)) { if (FP8_OF(l)) norm_phase<false, false, true>(F, W_XS, W_PAR + PAR_FFNN + l * DM, W_MODL + 3072, W_MODL + 4096, W_HB, nullptr, nullptr, nullptr, nullptr, nullptr, nullptr, nullptr, nullptr);
                             else norm_phase<false, false, false>(F, W_XS, W_PAR + PAR_FFNN + l * DM, W_MODL + 3072, W_MODL + 4096, W_HB, nullptr, nullptr, nullptr, nullptr, nullptr, nullptr, nullptr, nullptr); }
                        else norm_phase<false, false, false>(F, W_XS, W_PAR + PAR_FFNN + l * DM, W_MODL + 3072, W_MODL + 4096, W_HB, nullptr, nullptr, nullptr, nullptr, nullptr, nullptr, nullptr, nullptr); PH_END
            if (FP8_OF(l_)) {
                PH_BEGIN(17) { pg8::ProbDense P{W_HB, ws + WS_FGU + (size_t)(l >> 1) * 6144 * DM * 2, DM}; pg8::Order S; S.init(NTOK / 256, 24, F.G, F.cid, 0);
                    pg8::EpiSwiglu<true> E{W_HID, DFF, 1.0f / (SC8_H * SC8_W)}; pg8::gemm_phase<pg8::EpiSwiglu<true>, pg8::ProbDense, false, true>(F.lds, F.tid, P, S, E); } PH_END
                PH_BEGIN(18) { pg8::ProbDense P{W_HID, ws + WS_FDN + (size_t)(l >> 1) * DM * DFF * 2, DFF}; pg8::Order S; S.init(NTOK / 256, 4, F.G, F.cid, 0);
                    pg8::EpiResid<false> E{W_XS, W_XS, W_MODL + 5120, 1.0f / (SC8_HID * SC8_W)}; pg8::gemm_phase<pg8::EpiResid<false>, pg8::ProbDense, false, true>(F.lds, F.tid, P, S, E); } PH_END
            } else {
                PH_BEGIN(10) { pg8::ProbDense P{W_HB, (const bf16_t*)(ws + WS_FGU) + (size_t)(l >> 1) * 6144 * DM, DM * 2}; pg8::Order S; S.init(NTOK / 256, 24, F.G, F.cid, 0);
                    pg8::EpiSwiglu<false> E{W_HID, DFF, 1.0f}; pg8::gemm_phase<pg8::EpiSwiglu<false>, pg8::ProbDense, false>(F.lds, F.tid, P, S, E); } PH_END
                PH_BEGIN(11) { pg8::ProbDense P{W_HID, (const bf16_t*)(ws + WS_FDN) + (size_t)(l >> 1) * DM * DFF, DFF * 2}; pg8::Order S; S.init(NTOK / 256, 4, F.G, F.cid, 0);
                    pg8::EpiResid<false> E{W_XS, W_XS, W_MODL + 5120, 1.0f}; pg8::gemm_phase<pg8::EpiResid<false>, pg8::ProbDense, false>(F.lds, F.tid, P, S, E); } PH_END
            }
        } else {
            PH_BEGIN(12) if (FP8_OF(l)) norm_phase<false, true, true>(F, W_XS, W_PAR + PAR_FFNN + l * DM, W_MODL + 3072, W_MODL + 4096, W_HB, nullptr, nullptr, nullptr, nullptr, W_PAR + PAR_ROUTER + (l >> 1) * DM * 8, W_E12, W_W1, W_CNT);
                         else norm_phase<false, true, false>(F, W_XS, W_PAR + PAR_FFNN + l * DM, W_MODL + 3072, W_MODL + 4096, W_HB, nullptr, nullptr, nullptr, nullptr, W_PAR + PAR_ROUTER + (l >> 1) * DM * 8, W_E12, W_W1, W_CNT); PH_END
            PH_BEGIN(13) moe_scatter(F, W_CNT, W_E12, W_W1, W_TOS, W_WOS, W_TILE); PH_END
            if (FP8_OF(l_)) {
                PH_BEGIN(16) {
                    LAS int* texp = (LAS int*)(F.lds + LDS_TEXP);
                    for (int i = F.tid; i < MAXTILES + 16; i += 512) texp[i] = W_TILE[i];
                    __syncthreads();
                    const int ntot = texp[1];
                    pg8::Order S; S.init(ntot, 28, F.G, F.cid, 0);
                    pg8::ProbGrouped P{W_HB, ws + WS_MGU + (size_t)(l >> 1) * 8 * 7168 * DM * 2, DM, 7168, texp + 16, W_TOS};
                    pg8::EpiSwiglu<true> E{W_HID, DFE, 1.0f / (SC8_H * SC8_W)}; pg8::gemm_phase<pg8::EpiSwiglu<true>, pg8::ProbGrouped, true, true>(F.lds, F.tid, P, S, E); } PH_END
            } else {
                PH_BEGIN(14) {
                    LAS int* texp = (LAS int*)(F.lds + LDS_TEXP);
                    for (int i = F.tid; i < MAXTILES + 16; i += 512) texp[i] = W_TILE[i];
                    __syncthreads();
                    const int ntot = texp[1];
                    pg8::Order S; S.init(ntot, 28, F.G, F.cid, 0);
                    pg8::ProbGrouped P{W_HB, (const bf16_t*)(ws + WS_MGU) + (size_t)(l >> 1) * 8 * 7168 * DM, DM * 2, 7168, texp + 16, W_TOS};
                    pg8::EpiSwiglu<false> E{W_HID, DFE, 1.0f}; pg8::gemm_phase<pg8::EpiSwiglu<false>, pg8::ProbGrouped, true, false>(F.lds, F.tid, P, S, E); } PH_END
            }
#pragma unroll 1
            for (int pass = 0; pass < 2; ++pass) {
                if (l_ == 3 && pass == 1) {
                    PH_BEGIN(19) {
                        LAS int* texp = (LAS int*)(F.lds + LDS_TEXP);
                        for (int i = F.tid; i < MAXTILES + 16; i += 512) texp[i] = W_TILE[i];
                        __syncthreads();
                        const int nA = texp[0], ntot = texp[1];
                        pg8::Order S; S.init(ntot - nA, 4, F.G, F.cid, nA);
                        if (FP8_OF(3)) { pg8::ProbGrouped P{W_HID, ws + WS_MDN + (size_t)8 * DM * DFE * 2, DFE, DM, texp + 16, W_TOS};
                            pg8::EpiMoeDown<true> E{W_XS, xo, W_MODL + 5120, W_TOS, W_WOS, 1.0f / (SC8_HID * SC8_W)}; pg8::gemm_phase<pg8::EpiMoeDown<true>, pg8::ProbGrouped, false, true>(F.lds, F.tid, P, S, E); }
                        else { pg8::ProbGrouped P{W_HID, (const bf16_t*)(ws + WS_MDN) + (size_t)8 * DM * DFE, DFE * 2, DM, texp + 16, W_TOS};
                            pg8::EpiMoeDown<true> E{W_XS, xo, W_MODL + 5120, W_TOS, W_WOS, 1.0f}; pg8::gemm_phase<pg8::EpiMoeDown<true>, pg8::ProbGrouped, false, false>(F.lds, F.tid, P, S, E); } } PH_END
                } else {
                    PH_BEGIN(15) {
                        LAS int* texp = (LAS int*)(F.lds + LDS_TEXP);
                        for (int i = F.tid; i < MAXTILES + 16; i += 512) texp[i] = W_TILE[i];
                        __syncthreads();
                        const int nA = texp[0], ntot = texp[1];
                        pg8::Order S; S.init(pass ? ntot - nA : nA, 4, F.G, F.cid, pass ? nA : 0);
                        if (FP8_OF(l)) { pg8::ProbGrouped P{W_HID, ws + WS_MDN + (size_t)(l >> 1) * 8 * DM * DFE * 2, DFE, DM, texp + 16, W_TOS};
                            pg8::EpiMoeDown<false> E{W_XS, W_XS, W_MODL + 5120, W_TOS, W_WOS, 1.0f / (SC8_HID * SC8_W)}; pg8::gemm_phase<pg8::EpiMoeDown<false>, pg8::ProbGrouped, false, true>(F.lds, F.tid, P, S, E); }
                        else { pg8::ProbGrouped P{W_HID, (const bf16_t*)(ws + WS_MDN) + (size_t)(l >> 1) * 8 * DM * DFE, DFE * 2, DM, texp + 16, W_TOS};
                            pg8::EpiMoeDown<false> E{W_XS, W_XS, W_MODL + 5120, W_TOS, W_WOS, 1.0f}; pg8::gemm_phase<pg8::EpiMoeDown<false>, pg8::ProbGrouped, false, false>(F.lds, F.tid, P, S, E); } } PH_END
                }
            }
        }
    }
#undef PH_BEGIN
#undef PH_END
}

extern "C" void kernel_launch(void* const* d_in, const int* in_sizes, int n_in, void* d_out, int out_size, void* d_ws, size_t ws_size, hipStream_t stream) {
    static int grid = 0;
    if (grid == 0) {
        if (n_in != 30 || in_sizes[0] != NTOK * DM || out_size != NTOK * DM || ws_size < WS_END) { fprintf(stderr, "kernel_launch: unexpected shapes (n_in %d, in0 %d, out %d, ws %zu < %zu)\n", n_in, n_in > 0 ? in_sizes[0] : -1, out_size, ws_size, (size_t)WS_END); grid = -1; return; }
        int dev = 0, cus = 0, per_cu = 0;
        if (hipGetDevice(&dev) != hipSuccess || hipDeviceGetAttribute(&cus, hipDeviceAttributeMultiprocessorCount, dev) != hipSuccess) { grid = -1; return; }
        if (hipFuncSetAttribute((const void*)fwd_kernel, hipFuncAttributeMaxDynamicSharedMemorySize, LDS_BYTES) != hipSuccess) { fprintf(stderr, "kernel_launch: hipFuncSetAttribute failed\n"); grid = -1; return; }
        if (hipOccupancyMaxActiveBlocksPerMultiprocessor(&per_cu, (const void*)fwd_kernel, 512, LDS_BYTES) != hipSuccess || per_cu < 1) fprintf(stderr, "kernel_launch: occupancy query reports %d\n", per_cu);
        (void)hipGetLastError();
        grid = cus;
    }
    if (grid < 0) return;
    if (hipMemsetAsync((char*)d_ws + WS_CTL, 0, CTL_ZERO_BYTES, stream) != hipSuccess) return;
    Args a{};
    const float** fp = (const float**)&a;
    for (int i = 0; i < 30; ++i) fp[i] = (const float*)d_in[i];
    a.out = (float*)d_out; a.ws = (unsigned char*)d_ws;
#if MK_MULTI
    for (int p = 0; p < NPHASE; ++p) { a.ph_lo = p; a.ph_hi = p + 1; hipLaunchKernelGGL(fwd_kernel, dim3(grid), dim3(512), LDS_BYTES, stream, a); }
#else
    a.ph_lo = 0; a.ph_hi = NPHASE; hipLaunchKernelGGL(fwd_kernel, dim3(grid), dim3(512), LDS_BYTES, stream, a);
#endif
}
```

```cpp
#include <hip/hip_runtime.h>
#include <cstdio>
#include <cstdint>

#ifndef FP8MASK
#define FP8MASK 10
#endif
#define FP8_OF(l) (((FP8MASK) >> (l)) & 1)
#ifndef DUPMASK
#define DUPMASK 0
#endif
#ifndef DUP_SCANPAIR
#define DUP_SCANPAIR 0
#endif
#ifndef PHSEL
#define PHSEL 0xFFFFFFFFu
#endif
#ifndef MK_MULTI
#define MK_MULTI 0
#endif

#define LAS __attribute__((address_space(3)))
#define GAS __attribute__((address_space(1)))
typedef unsigned short bf16_t;
typedef short bf16x8 __attribute__((ext_vector_type(8)));
typedef short s16x4 __attribute__((ext_vector_type(4)));
typedef float f32x2 __attribute__((ext_vector_type(2)));
typedef float f32x4 __attribute__((ext_vector_type(4)));
typedef float f32x16 __attribute__((ext_vector_type(16)));
typedef unsigned u32x2 __attribute__((ext_vector_type(2)));
typedef unsigned u32x4 __attribute__((ext_vector_type(4)));
typedef __bf16 bf16x2_t __attribute__((ext_vector_type(2)));
typedef int i32x4 __attribute__((ext_vector_type(4)));
typedef int i32x8 __attribute__((ext_vector_type(8)));
constexpr float SC8_H = 4.0f, SC8_W = 64.0f, SC8_HID = 8.0f;

constexpr int DM = 1024, BATCH = 16, SEQ = 4096, NTOK = BATCH * SEQ;
constexpr int DFF = 3072, NEXP = 8, DFE = 3584;
constexpr int NSLOT = 135168;
constexpr int MAXTILES = NSLOT / 256;
constexpr float EPS = 1e-6f;
constexpr float LOG2E = 1.4426950408889634f;

constexpr size_t MiB = 1u << 20;
constexpr size_t WS_CTL = 0, CTL_ZERO_BYTES = 1 * MiB;
constexpr size_t WS_MODV = 1 * MiB;
constexpr size_t WS_KVMOD = 3 * MiB;
constexpr size_t WS_PAR = 3 * MiB + 512 * 1024;
constexpr int PAR_MIXN = 0, PAR_FFNN = 4096, PAR_CONVW = 8192, PAR_CONVB = 16384, PAR_GXB = 18432, PAR_GAB = 20480, PAR_LAM = 22528, PAR_KVN = 24576, PAR_KN = 25600, PAR_QN = 25664, PAR_SINK = 25792, PAR_ROUTER = 25856, PAR_END = 42240;
constexpr size_t WS_E12 = 4 * MiB;
constexpr size_t WS_W1 = 5 * MiB;
constexpr size_t WS_CNT = 6 * MiB;
constexpr size_t WS_TILE = 6 * MiB + 65536;
constexpr size_t WS_TOS = 7 * MiB;
constexpr size_t WS_WOS = 8 * MiB;
constexpr size_t WS_GW = 9 * MiB;
constexpr size_t WS_COS = 10 * MiB;
constexpr size_t WS_SIN = 18 * MiB;
constexpr size_t WS_WIN = 26 * MiB;
constexpr size_t WS_WOUT = 34 * MiB;
constexpr size_t WS_WKV = 38 * MiB;
constexpr size_t WS_WQ = 39 * MiB;
constexpr size_t WS_WO = 43 * MiB;
constexpr size_t WS_FGU = 47 * MiB;
constexpr size_t WS_FDN = 71 * MiB;
constexpr size_t WS_MGU = 83 * MiB;
constexpr size_t WS_MDN = 307 * MiB;
constexpr size_t WS_H = 419 * MiB;
constexpr size_t WS_HKV = 547 * MiB;
constexpr size_t WS_KB = 675 * MiB;
constexpr size_t WS_VB = 707 * MiB;
constexpr size_t WS_ARENA = 739 * MiB;
constexpr size_t WS_XS = WS_ARENA + (size_t)NSLOT * DFE * 2;
constexpr size_t WS_END = WS_XS + (size_t)NTOK * DM * 2;
static_assert(WS_END <= (size_t)1792 * MiB, "workspace map");
constexpr size_t AR_XB = 0, AR_GY = 128 * MiB, AR_Q = 0, AR_O = 128 * MiB;

constexpr int CW_BAR = 4096;

constexpr int LDS_BYTES = 163840;
constexpr int RING_BYTES = 131072;
constexpr int LDS_TEXP = RING_BYTES;
constexpr int LDS_IDX = RING_BYTES + 4096;
constexpr int LDS_MISC = LDS_BYTES - 256;

__device__ __forceinline__ unsigned cvtpk(float lo, float hi) { f32x2 v = {lo, hi}; bf16x2_t b = __builtin_convertvector(v, bf16x2_t); return __builtin_bit_cast(unsigned, b); }
__device__ __forceinline__ float clamp8(float v) { return __builtin_amdgcn_fmed3f(v, -448.0f, 448.0f); }
__device__ __forceinline__ unsigned cvt4_fp8(float a, float b, float c, float d) { int p = __builtin_amdgcn_cvt_pk_fp8_f32(clamp8(a), clamp8(b), 0, false); p = __builtin_amdgcn_cvt_pk_fp8_f32(clamp8(c), clamp8(d), p, true); return (unsigned)p; }
__device__ __forceinline__ float bflo(unsigned p) { return __uint_as_float(p << 16); }
__device__ __forceinline__ float bfhi(unsigned p) { return __uint_as_float(p & 0xffff0000u); }
__device__ __forceinline__ float bf2f(unsigned short b) { return __uint_as_float(((unsigned)b) << 16); }
__device__ __forceinline__ float fast_exp2(float x) { return __builtin_amdgcn_exp2f(x); }
__device__ __forceinline__ float fast_rcp(float x) { return __builtin_amdgcn_rcpf(x); }
__device__ __forceinline__ float sigmoidf_(float x) { return fast_rcp(1.0f + fast_exp2(-x * LOG2E)); }
__device__ __forceinline__ float silu_(float x) { return x * sigmoidf_(x); }
__device__ __forceinline__ float gelu_tanh_(float x) { const float u = 0.7978845608028654f * (x + 0.044715f * x * x * x); return x * sigmoidf_(2.0f * u); }
__device__ __forceinline__ float shflx(float v, int lane, int o) { return __int_as_float(__builtin_amdgcn_ds_bpermute((lane ^ o) << 2, __float_as_int(v))); }
__device__ __forceinline__ float wave_sum(float v, int lane) {
#pragma unroll
    for (int o = 1; o < 64; o <<= 1) v += shflx(v, lane, o);
    return v;
}
__device__ __forceinline__ int lane_id_v() { int l; asm volatile("v_mbcnt_lo_u32_b32 %0, -1, 0\n\tv_mbcnt_hi_u32_b32 %0, -1, %0" : "=v"(l)); return l; }
#define LDS_WAIT() asm volatile("s_waitcnt lgkmcnt(0)" ::: "memory")
#define VM_WAIT() asm volatile("s_waitcnt vmcnt(0)" ::: "memory")

namespace pg8 {
constexpr int BM = 256, BK = 64, HALF = 128, HTB = HALF * BK * 2, STAGE_BYTES = 8 * HTB, NXCD = 8, WGM = 8;
__host__ __device__ __forceinline__ int lds_byte(int r, int c) { const int st = (r >> 4) * 2 + (c >> 5), rr = r & 15, cc = c & 31, ob = rr * 64 + cc * 2; return st * 1024 + (ob ^ (((ob >> 9) & 1) << 5)); }
__host__ __device__ __forceinline__ void stage_rc(int b, int& R, int& C) { const int st = b / 1024, sb = b % 1024, swz = sb ^ (((sb >> 9) & 1) << 5); R = (st >> 1) * 16 + swz / 64; C = (st & 1) * 32 + (swz % 64) / 2; }
__host__ __device__ __forceinline__ int perm32(int rho) { const int n = rho >> 4, i = rho & 15; return 8 * (i >> 2) + 4 * n + (i & 3); }

struct Unit { int pm, pn; };

struct Order {
    int nM, nN, nwg, G, c, tile0;
    __device__ __forceinline__ void init(int nM_, int nN_, int G_, int c_, int tile0_) { nM = nM_; nN = nN_; nwg = nM * nN; G = G_; c = c_; tile0 = tile0_; }
    __device__ __forceinline__ bool next(int i, Unit& u) const {
        const long L = (long)i * G + c; if (L >= nwg) return false;
        int wgid = (int)L; { const int q = nwg / NXCD, r = nwg % NXCD, xcd = wgid % NXCD, off = wgid / NXCD; wgid = (xcd < r ? xcd * (q + 1) : r * (q + 1) + (xcd - r) * q) + off; }
        const int nig = WGM * nN, gid = wgid / nig, fm = gid * WGM, gsz = (nM - fm) < WGM ? (nM - fm) : WGM;
        u.pm = tile0 + fm + ((wgid % nig) % gsz); u.pn = (wgid % nig) / gsz; return true;
    }
};

struct ProbDense {
    const void* A; const void* Bt; int KB;
    __device__ __forceinline__ const char* a_ptr(const Unit& u) const { return (const char*)A + (size_t)u.pm * BM * KB; }
    __device__ __forceinline__ const char* b_ptr(const Unit& u) const { return (const char*)Bt + (size_t)u.pn * BM * KB; }
};
struct ProbGrouped {
    const void* A; const void* Bt; int KB; int N; const LAS int* texp; const int* tos;
    __device__ __forceinline__ const char* a_ptr(const Unit& u) const { return (const char*)A + (size_t)u.pm * BM * KB; }
    __device__ __forceinline__ const char* b_ptr(const Unit& u) const { return (const char*)Bt + ((size_t)texp[u.pm] * N + (size_t)u.pn * BM) * KB; }
};

template <class Epi, class Prob, bool GATHER, bool FP8 = false>
__device__ __forceinline__ void gemm_phase(LAS unsigned char* lds, const int tid, const Prob P, const Order& S, const Epi& E) {
    const int wid = __builtin_amdgcn_readfirstlane(tid >> 6), lane = tid & 63, wr = wid >> 2, wc = wid & 3, fr = lane & 15, fq = lane >> 4;
    const int KB = P.KB, nt = KB / (BK * 2);
    unsigned voffA[2], voffB[2];
#pragma unroll
    for (int i = 0; i < 2; ++i) { int R, C; stage_rc(tid * 16 + i * 8192, R, C); const int Rb = Epi::PERM ? ((R & ~31) + perm32(R & 31)) : R;
        voffA[i] = GATHER ? (unsigned)(C * 2) : (unsigned)(R * KB + C * 2); voffB[i] = (unsigned)(Rb * KB + C * 2); }
    const size_t kstep = (size_t)(BK * 2);
    const size_t hstep = (size_t)HALF * KB;
    const unsigned ldsw = (unsigned)wid * 1024u;
    const int aoff = lds_byte(wr * 64 + fr, fq * 8), boff = lds_byte(wc * 32 + fr, fq * 8);
    LAS int* idxb = (LAS int*)(lds + LDS_IDX);
#define PG8_GIDX(buf) do { int ln_ = lane; asm volatile("" : "+v"(ln_)); _Pragma("unroll") for (int i = 0; i < 2; ++i) { const int R_ = 16 * ((wid + 8 * i) >> 1) + (ln_ >> 2); \
        int t0 = idxb[(buf) * 256 + R_], t1 = idxb[(buf) * 256 + 128 + R_]; t0 = t0 < 0 ? 0 : t0; t1 = t1 < 0 ? 0 : t1; \
        vC0[i] = (unsigned)t0 * (unsigned)KB + voffA[i]; vC1[i] = (unsigned)t1 * (unsigned)KB + voffA[i]; } } while (0)
#define PG8_GDMA(unit, buf) do { if (wid < 4) { int ln_ = lane; asm volatile("" : "+v"(ln_)); \
        __builtin_amdgcn_global_load_lds((const unsigned*)(P.tos + (size_t)(unit).pm * BM + wid * 64) + ln_, (LAS unsigned*)(idxb + (buf) * 256 + wid * 64), 4, 0, 0); } } while (0)
#define PG8_SA(b, h) (((b) * 2 + (h)) * HTB)
#define PG8_SB(b, h) ((4 + (b) * 2 + (h)) * HTB)
#define PG8_STAGE(bufoff, gbase, voff) do { const char* g_ = (const char*)(gbase); asm volatile("" : "+s"(g_)); _Pragma("unroll") for (int _i = 0; _i < 2; ++_i) \
        __builtin_amdgcn_global_load_lds((const unsigned*)(g_ + (voff)[_i]), (LAS unsigned*)(lds + (bufoff) + ldsw + _i * 8192), 16, 0, 0); } while (0)
#define PG8_LDA(dst, b, h) do { _Pragma("unroll") for (int m = 0; m < 4; ++m) _Pragma("unroll") for (int k = 0; k < 2; ++k) dst[m][k] = *(const LAS bf16x8*)(lds + PG8_SA(b, h) + aoff + m * 2048 + k * 1024); } while (0)
#define PG8_LDB(dst, b, h) do { _Pragma("unroll") for (int n = 0; n < 2; ++n) _Pragma("unroll") for (int k = 0; k < 2; ++k) dst[n][k] = *(const LAS bf16x8*)(lds + PG8_SB(b, h) + boff + n * 2048 + k * 1024); } while (0)
#define PG8_CAT8(v) __builtin_shufflevector(__builtin_bit_cast(i32x4, (v)[0]), __builtin_bit_cast(i32x4, (v)[1]), 0, 1, 2, 3, 4, 5, 6, 7)
#define PG8_MMA(ai, bj, At, Bt) do { __builtin_amdgcn_s_setprio(1); if constexpr (FP8) asm volatile("s_nop 1"); _Pragma("unroll") for (int m = 0; m < 4; ++m) _Pragma("unroll") for (int n = 0; n < 2; ++n) { \
        if constexpr (FP8) { const i32x8 b8_ = PG8_CAT8(Bt[n]), a8_ = PG8_CAT8(At[m]);   \
            asm volatile("v_mfma_scale_f32_16x16x128_f8f6f4 %0, %1, %2, %0, %3, %3 op_sel_hi:[0,0,0]" : "+v"(acc[ai][bj][m][n]) : "v"(b8_), "v"(a8_), "v"(sc8)); } \
        else { _Pragma("unroll") for (int k = 0; k < 2; ++k) acc[ai][bj][m][n] = __builtin_amdgcn_mfma_f32_16x16x32_bf16(Bt[n][k], At[m][k], acc[ai][bj][m][n], 0, 0, 0); } } __builtin_amdgcn_s_setprio(0); } while (0)
#define PG8_WAIT_V(n) asm volatile("s_waitcnt vmcnt(" #n ")" ::: "memory")
#define PG8_WAIT_L(n) asm volatile("s_waitcnt lgkmcnt(" #n ")" ::: "memory")
#define PG8_BAR __builtin_amdgcn_s_barrier()
#define PG8_SCHED __builtin_amdgcn_sched_barrier(0)
    Unit cur, nxt; int ui = 0;
    if (!S.next(0, cur)) return;
    f32x4 acc[2][2][4][2];
#pragma unroll
    for (int a = 0; a < 2; ++a)
#pragma unroll
        for (int b = 0; b < 2; ++b)
#pragma unroll
            for (int m = 0; m < 4; ++m)
#pragma unroll
                for (int n = 0; n < 2; ++n) acc[a][b][m][n] = (f32x4){0.f, 0.f, 0.f, 0.f};
    bf16x8 At[4][2], B0[2][2], B1[2][2];
    int sc8 = 0x7F7F7F7F; if constexpr (FP8) asm volatile("" : "+v"(sc8));
    unsigned vC0[2], vC1[2];
    const char* cA; const char* cB = P.b_ptr(cur);
    if constexpr (GATHER) {
        cA = (const char*)P.A;
        PG8_GDMA(cur, 0);
        PG8_WAIT_V(0); PG8_BAR;
        PG8_GIDX(0);
        LDS_WAIT(); PG8_BAR;
    } else {
        cA = P.a_ptr(cur);
#pragma unroll
        for (int i = 0; i < 2; ++i) { vC0[i] = voffA[i]; vC1[i] = voffA[i] + (unsigned)hstep; }
    }
    PG8_STAGE(PG8_SB(0, 0), cB, voffB); PG8_STAGE(PG8_SB(0, 1), cB + hstep, voffB); PG8_STAGE(PG8_SA(0, 0), cA, vC0); PG8_STAGE(PG8_SA(0, 1), cA, vC1);
    if (wr == 1) PG8_BAR;
    PG8_WAIT_V(2); PG8_BAR;
    PG8_STAGE(PG8_SB(1, 0), cB + kstep, voffB); PG8_STAGE(PG8_SA(1, 0), cA + kstep, vC0); PG8_STAGE(PG8_SB(1, 1), cB + hstep + kstep, voffB);
    PG8_WAIT_V(6); PG8_BAR;
    for (;;) {
        const bool has_next = S.next(ui + 1, nxt);
        const char* nA = GATHER ? cA : (has_next ? P.a_ptr(nxt) : cA); const char* nB = has_next ? P.b_ptr(nxt) : cB;
        for (int t = 0; t < nt; t += 2) {
            const bool last = (t == nt - 2);
            if constexpr (GATHER) {
                if (t == 0 && has_next) PG8_GDMA(nxt, (ui + 1) & 1);
            }
            const char* a1 = cA + (size_t)(t + 1) * kstep;
            const char* a2 = last ? nA : cA + (size_t)(t + 2) * kstep; const char* b2 = last ? nB : cB + (size_t)(t + 2) * kstep;
            const char* a3 = a2 + kstep; const char* b3 = b2 + kstep;
            PG8_LDB(B0, 0, 0); PG8_LDB(B1, 0, 1); PG8_SCHED; PG8_LDA(At, 0, 0); PG8_STAGE(PG8_SA(1, 1), a1, vC1);
            if constexpr (GATHER) { if (last && has_next) PG8_GIDX((ui + 1) & 1); }
            PG8_WAIT_V(8); PG8_WAIT_L(0); PG8_BAR; PG8_MMA(0, 0, At, B0); PG8_MMA(0, 1, At, B1); PG8_BAR; PG8_SCHED;
            PG8_LDA(At, 0, 1); PG8_STAGE(PG8_SB(0, 0), b2, voffB); PG8_STAGE(PG8_SB(0, 1), b2 + hstep, voffB); PG8_STAGE(PG8_SA(0, 0), a2, vC0);
            PG8_WAIT_V(8); PG8_WAIT_L(0); PG8_BAR; PG8_MMA(1, 0, At, B0); PG8_MMA(1, 1, At, B1); PG8_BAR; PG8_SCHED;
            PG8_LDB(B0, 1, 0); PG8_LDB(B1, 1, 1); PG8_SCHED; PG8_LDA(At, 1, 0); PG8_STAGE(PG8_SA(0, 1), a2, vC1);
            PG8_WAIT_V(8); PG8_WAIT_L(0); PG8_BAR; PG8_MMA(0, 0, At, B0); PG8_MMA(0, 1, At, B1); PG8_BAR; PG8_SCHED;
            PG8_LDA(At, 1, 1); PG8_STAGE(PG8_SB(1, 0), b3, voffB); PG8_STAGE(PG8_SB(1, 1), b3 + hstep, voffB); PG8_STAGE(PG8_SA(1, 0), a3, vC0);
            PG8_WAIT_V(8); PG8_WAIT_L(0); PG8_BAR; PG8_MMA(1, 0, At, B0); PG8_MMA(1, 1, At, B1); PG8_BAR; PG8_SCHED;
        }
        if constexpr (FP8) { asm volatile("s_nop 15\n\ts_nop 15" ::: "memory"); PG8_SCHED; }
        if (wr == 0) PG8_BAR;
        { int fr_ = fr, fq_ = fq; asm volatile("" : "+v"(fr_), "+v"(fq_)); E(acc, cur, wr, wc, fr_, fq_); }
        if (!has_next) break;
#pragma unroll
        for (int a = 0; a < 2; ++a)
#pragma unroll
            for (int b = 0; b < 2; ++b)
#pragma unroll
                for (int m = 0; m < 4; ++m)
#pragma unroll
                    for (int n = 0; n < 2; ++n) acc[a][b][m][n] = (f32x4){0.f, 0.f, 0.f, 0.f};
        cur = nxt; cA = nA; cB = nB; ++ui;
        if (wr == 1) PG8_BAR;
    }
    PG8_WAIT_V(0);
    PG8_BAR;
#undef PG8_SA
#undef PG8_GIDX
#undef PG8_GDMA
#undef PG8_SB
#undef PG8_STAGE
#undef PG8_LDA
#undef PG8_LDB
#undef PG8_MMA
#undef PG8_CAT8
#undef PG8_WAIT_V
#undef PG8_WAIT_L
#undef PG8_BAR
#undef PG8_SCHED
}

template <bool INF32> struct EpiResid {
    static constexpr bool PERM = true;
    const void* xin; bf16_t* xout; const float* gate; float ascale;
    __device__ __forceinline__ void operator()(const f32x4 (&acc)[2][2][4][2], const Unit& u, int wr, int wc, int fr, int fq) const {
        const int row0 = u.pm * BM + wr * 64 + fr, col0 = u.pn * BM + wc * 32 + 8 * fq;
        const float* gp = gate + (size_t)((u.pm * BM) >> 12) * 6144 + col0;
        f32x4 gv[2][2];
#pragma unroll
        for (int bj = 0; bj < 2; ++bj)
#pragma unroll
            for (int n = 0; n < 2; ++n) gv[bj][n] = (*(const f32x4*)(gp + bj * HALF + 4 * n) + 1.0f) * ascale;
#pragma unroll
        for (int ai = 0; ai < 2; ++ai) {
            f32x4 xv[4][2][2];
#pragma unroll
            for (int m = 0; m < 4; ++m) { const size_t off = (size_t)(row0 + ai * HALF + m * 16) * DM + col0;
#pragma unroll
                for (int bj = 0; bj < 2; ++bj) {
                    if constexpr (INF32) { xv[m][bj][0] = *(const f32x4*)((const float*)xin + off + bj * HALF); xv[m][bj][1] = *(const f32x4*)((const float*)xin + off + bj * HALF + 4); }
                    else { const u32x4 p = *(const u32x4*)((const bf16_t*)xin + off + bj * HALF);
                        xv[m][bj][0] = (f32x4){bflo(p.x), bfhi(p.x), bflo(p.y), bfhi(p.y)}; xv[m][bj][1] = (f32x4){bflo(p.z), bfhi(p.z), bflo(p.w), bfhi(p.w)}; } } }
#pragma unroll
            for (int m = 0; m < 4; ++m) { const size_t off = (size_t)(row0 + ai * HALF + m * 16) * DM + col0;
#pragma unroll
                for (int bj = 0; bj < 2; ++bj) { const f32x4 o0 = xv[m][bj][0] + gv[bj][0] * acc[ai][bj][m][0], o1 = xv[m][bj][1] + gv[bj][1] * acc[ai][bj][m][1];
                    u32x4 w; w.x = cvtpk(o0[0], o0[1]); w.y = cvtpk(o0[2], o0[3]); w.z = cvtpk(o1[0], o1[1]); w.w = cvtpk(o1[2], o1[3]);
                    *(u32x4*)(xout + off + bj * HALF) = w; } }
            asm volatile("" ::: "memory"); }
    }
};
template <bool OUTF32> struct EpiMoeDown {
    static constexpr bool PERM = true;
    const bf16_t* xs; void* xo; const float* gate; const int* tos; const float* wos; float ascale;
    __device__ __forceinline__ void operator()(const f32x4 (&acc)[2][2][4][2], const Unit& u, int wr, int wc, int fr, int fq) const {
        const int slot0 = u.pm * BM + wr * 64 + fr, col0 = u.pn * BM + wc * 32 + 8 * fq;
        int tok[2][4]; float w[2][4];
#pragma unroll
        for (int ai = 0; ai < 2; ++ai)
#pragma unroll
            for (int m = 0; m < 4; ++m) { const int slot = slot0 + ai * HALF + m * 16; tok[ai][m] = tos[slot]; w[ai][m] = wos[slot] * ascale; }
#pragma unroll
        for (int ai = 0; ai < 2; ++ai) {
            u32x4 xv[4][2];
#pragma unroll
            for (int m = 0; m < 4; ++m) { const int t = tok[ai][m] < 0 ? 0 : tok[ai][m]; const bf16_t* xp = xs + (size_t)t * DM + col0;
#pragma unroll
                for (int bj = 0; bj < 2; ++bj) xv[m][bj] = *(const u32x4*)(xp + bj * HALF); }
#pragma unroll
            for (int m = 0; m < 4; ++m) { const int t = tok[ai][m];
                if (t >= 0) { const float* gp = gate + (size_t)(t >> 12) * 6144 + col0; const size_t off = (size_t)t * DM + col0;
#pragma unroll
                    for (int bj = 0; bj < 2; ++bj) { const u32x4 p = xv[m][bj];
                        const f32x4 g0 = (*(const f32x4*)(gp + bj * HALF) + 1.0f) * w[ai][m], g1 = (*(const f32x4*)(gp + bj * HALF + 4) + 1.0f) * w[ai][m];
                        const f32x4 o0 = (f32x4){bflo(p.x), bfhi(p.x), bflo(p.y), bfhi(p.y)} + g0 * acc[ai][bj][m][0], o1 = (f32x4){bflo(p.z), bfhi(p.z), bflo(p.w), bfhi(p.w)} + g1 * acc[ai][bj][m][1];
                        if constexpr (OUTF32) { *(f32x4*)((float*)xo + off + bj * HALF) = o0; *(f32x4*)((float*)xo + off + bj * HALF + 4) = o1; }
                        else { u32x4 q; q.x = cvtpk(o0[0], o0[1]); q.y = cvtpk(o0[2], o0[3]); q.z = cvtpk(o1[0], o1[1]); q.w = cvtpk(o1[2], o1[3]); *(u32x4*)((bf16_t*)xo + off + bj * HALF) = q; } } } }
            asm volatile("" ::: "memory"); }
    }
};
template <bool OUT8> struct EpiSwiglu {
    static constexpr bool PERM = true;
    void* O; int ldo; float ascale;
    __device__ __forceinline__ void operator()(const f32x4 (&acc)[2][2][4][2], const Unit& u, int wr, int wc, int fr, int fq) const {
        const int row0 = u.pm * BM + wr * 64 + fr, col0 = u.pn * HALF + wc * 32 + 8 * fq;
#pragma unroll
        for (int ai = 0; ai < 2; ++ai)
#pragma unroll
            for (int m = 0; m < 4; ++m) { const size_t eo = (size_t)(row0 + ai * HALF + m * 16) * ldo + col0;
                float v[8];
#pragma unroll
                for (int n = 0; n < 2; ++n)
#pragma unroll
                    for (int j = 0; j < 4; ++j) v[4 * n + j] = silu_(acc[ai][0][m][n][j] * ascale) * (acc[ai][1][m][n][j] * ascale);
                if constexpr (OUT8) { u32x2 w; w.x = cvt4_fp8(v[0] * SC8_HID, v[1] * SC8_HID, v[2] * SC8_HID, v[3] * SC8_HID); w.y = cvt4_fp8(v[4] * SC8_HID, v[5] * SC8_HID, v[6] * SC8_HID, v[7] * SC8_HID);
                    *(u32x2*)((unsigned char*)O + eo) = w; }
                else { u32x4 w; w.x = cvtpk(v[0], v[1]); w.y = cvtpk(v[2], v[3]); w.z = cvtpk(v[4], v[5]); w.w = cvtpk(v[6], v[7]);
                    *(u32x4*)((bf16_t*)O + eo) = w; } }
    }
};
struct EpiWin {
    static constexpr bool PERM = true;
    bf16_t* XB; bf16_t* GY;
    __device__ __forceinline__ void operator()(const f32x4 (&acc)[2][2][4][2], const Unit& u, int wr, int wc, int fr, int fq) const {
        const bool act = u.pn >= 4; bf16_t* base = act ? GY : XB;
        const int row0 = u.pm * BM + wr * 64 + fr, col0 = (u.pn & 3) * BM + wc * 32 + 8 * fq;
#pragma unroll
        for (int ai = 0; ai < 2; ++ai)
#pragma unroll
            for (int m = 0; m < 4; ++m) { bf16_t* rowp = base + (size_t)(row0 + ai * HALF + m * 16) * DM + col0;
#pragma unroll
                for (int bj = 0; bj < 2; ++bj) { f32x4 v0 = acc[ai][bj][m][0], v1 = acc[ai][bj][m][1];
                    if (act) {
#pragma unroll
                        for (int j = 0; j < 4; ++j) { v0[j] = gelu_tanh_(v0[j]); v1[j] = gelu_tanh_(v1[j]); } }
                    u32x4 w; w.x = cvtpk(v0[0], v0[1]); w.y = cvtpk(v0[2], v0[3]); w.z = cvtpk(v1[0], v1[1]); w.w = cvtpk(v1[2], v1[3]);
                    *(u32x4*)(rowp + bj * HALF) = w; } }
    }
};
struct EpiQK {
    static constexpr bool PERM = true;
    bf16_t* O; int ldo; const float* gain; const float* cosT; const float* sinT; float oscale; int vtile; bf16_t* OV;
    __device__ __forceinline__ void operator()(const f32x4 (&acc)[2][2][4][2], const Unit& u, int wr, int wc, int fr, int fq) const {
        const int row0 = u.pm * BM + wr * 64 + fr;
        if (u.pn == vtile) {
            const int col0 = wc * 32 + 8 * fq;
#pragma unroll
            for (int ai = 0; ai < 2; ++ai)
#pragma unroll
                for (int m = 0; m < 4; ++m) { bf16_t* rowp = OV + (size_t)(row0 + ai * HALF + m * 16) * ldo + col0;
#pragma unroll
                    for (int bj = 0; bj < 2; ++bj) { const f32x4 v0 = acc[ai][bj][m][0], v1 = acc[ai][bj][m][1];
                        u32x4 w; w.x = cvtpk(v0[0], v0[1]); w.y = cvtpk(v0[2], v0[3]); w.z = cvtpk(v1[0], v1[1]); w.w = cvtpk(v1[2], v1[3]);
                        *(u32x4*)(rowp + bj * HALF) = w; } }
            return;
        }
        const int colh = (u.pn * 4 + wc) * 64 + 8 * fq;
        f32x4 g1[2], g2[2];
#pragma unroll
        for (int n = 0; n < 2; ++n) { g1[n] = *(const f32x4*)(gain + 8 * fq + 4 * n); g2[n] = *(const f32x4*)(gain + 32 + 8 * fq + 4 * n); }
#pragma unroll
        for (int aim = 0; aim < 4; ++aim) { const int ai = aim >> 1;
            f32x4 cv[4][2], sv[4][2];
#pragma unroll
            for (int m = 2 * (aim & 1); m < 2 * (aim & 1) + 2; ++m) { const int row = row0 + ai * HALF + m * 16;
#pragma unroll
                for (int n = 0; n < 2; ++n) { cv[m][n] = *(const f32x4*)(cosT + (size_t)row * 32 + 8 * fq + 4 * n); sv[m][n] = *(const f32x4*)(sinT + (size_t)row * 32 + 8 * fq + 4 * n); } }
#pragma unroll
            for (int m = 2 * (aim & 1); m < 2 * (aim & 1) + 2; ++m) { const int row = row0 + ai * HALF + m * 16;
                float ss = 0.f;
#pragma unroll
                for (int bj = 0; bj < 2; ++bj)
#pragma unroll
                    for (int n = 0; n < 2; ++n) { const f32x4 a = acc[ai][bj][m][n]; ss += (a[0] * a[0] + a[1] * a[1]) + (a[2] * a[2] + a[3] * a[3]); }
                { const int ln_ = fq * 16 + fr; ss += shflx(ss, ln_, 16); ss += shflx(ss, ln_, 32); }
                const float r = __builtin_amdgcn_rsqf(ss * (1.0f / 64.0f) + EPS) * oscale;
                float o1[8], o2[8];
#pragma unroll
                for (int n = 0; n < 2; ++n) { const f32x4 c = cv[m][n], s = sv[m][n];
                    const f32x4 x1 = acc[ai][0][m][n] * g1[n] * r, x2 = acc[ai][1][m][n] * g2[n] * r;
                    const f32x4 a = x1 * c - x2 * s, b = x2 * c + x1 * s;
#pragma unroll
                    for (int j = 0; j < 4; ++j) { o1[4 * n + j] = a[j]; o2[4 * n + j] = b[j]; } }
                bf16_t* rowp = O + (size_t)row * ldo + colh;
                u32x4 w; w.x = cvtpk(o1[0], o1[1]); w.y = cvtpk(o1[2], o1[3]); w.z = cvtpk(o1[4], o1[5]); w.w = cvtpk(o1[6], o1[7]);
                *(u32x4*)rowp = w;
                w.x = cvtpk(o2[0], o2[1]); w.y = cvtpk(o2[2], o2[3]); w.z = cvtpk(o2[4], o2[5]); w.w = cvtpk(o2[6], o2[7]);
                *(u32x4*)(rowp + 32) = w; }
            asm volatile("" ::: "memory"); }
    }
};
}

#define XB_TMO      128
#define XB_XCNT(j)  (256  + 64 * (j))
#define XB_XSUB(j)  (1280 + 64 * (j))
#define XB_XGEN(j)  (2304 + 64 * (j))
#define XB_TOP      3328
#define XB_TOPGEN   3392
#define XCD_BAR_WORDS 3456
#define XB_SPIN_CAP (1u << 20)
__device__ __forceinline__ unsigned xb_ld(unsigned* p)              { return __hip_atomic_load(p, __ATOMIC_RELAXED, __HIP_MEMORY_SCOPE_AGENT); }
__device__ __forceinline__ unsigned xb_add(unsigned* p, unsigned v) { return __hip_atomic_fetch_add(p, v, __ATOMIC_RELAXED, __HIP_MEMORY_SCOPE_AGENT); }
__device__ __forceinline__ unsigned xb_xcc_id() { return (unsigned)__builtin_amdgcn_s_getreg((3 << 11) | 20) & 0xFu; }
#define XB_SPIN(cond, bar) do { unsigned _sp = 0; while (cond) { __builtin_amdgcn_s_sleep(1); \
    if ((++_sp & 255u) == 0u) { if (xb_ld(&(bar)[XB_TMO])) break; if (_sp > XB_SPIN_CAP) { atomicAdd(&(bar)[XB_TMO], 1u); break; } } } } while (0)
struct XcdBarrier { unsigned* bar; unsigned x; volatile LAS unsigned* st; };
__device__ __forceinline__ XcdBarrier xcd_barrier_post(unsigned* bar, volatile LAS unsigned* st, int wv) {
    XcdBarrier b; b.bar = bar; b.x = xb_xcc_id(); b.st = st;
    if (wv == 0 && lane_id_v() == 0) (void)xb_add(&bar[XB_XCNT(b.x)], 1u);
    return b;
}
__device__ __forceinline__ void xcd_barrier_complete(unsigned* bar, unsigned x, unsigned& nloc, unsigned& nx) {
    const unsigned G = gridDim.x * gridDim.y * gridDim.z;
    unsigned sum, cnt, mine, sp = 0u;
    for (;;) {
        sum = 0u; cnt = 0u; mine = 0u;
#pragma unroll
        for (unsigned j = 0; j < 16; ++j) { const unsigned c = xb_ld(&bar[XB_XCNT(j)]); sum += c; cnt += (c > 0u) ? 1u : 0u; mine = (j == x) ? c : mine; }
        if (sum == G) break;
        __builtin_amdgcn_s_sleep(1);
        if ((++sp & 255u) == 0u) { if (xb_ld(&bar[XB_TMO])) break; if (sp > XB_SPIN_CAP) { atomicAdd(&bar[XB_TMO], 1u); break; } }
    }
    nloc = mine > 0u ? mine : 1u; nx = cnt > 0u ? cnt : 1u;
}
__device__ __forceinline__ void xcd_barrier(const XcdBarrier& b, int wv) {
    asm volatile("s_waitcnt vmcnt(0)" ::: "memory");
    __syncthreads();
    if (wv == 0 && lane_id_v() == 0) {
        unsigned* bar = b.bar;
        __builtin_amdgcn_s_waitcnt(0);
        unsigned nloc = b.st[0], nx = b.st[1];
        if (nloc == 0u) { xcd_barrier_complete(bar, b.x, nloc, nx); b.st[0] = nloc; b.st[1] = nx; }
        const unsigned old = xb_add(&bar[XB_XSUB(b.x)], 1u);
        const unsigned gen = old / nloc;
        if (old + 1u == (gen + 1u) * nloc) {
            __builtin_amdgcn_fence(__ATOMIC_RELEASE, "agent");
            asm volatile("s_waitcnt vmcnt(0)" ::: "memory");
            const unsigned og = xb_add(&bar[XB_TOP], 1u);
            const unsigned tg = og / nx;
            if (og + 1u == (tg + 1u) * nx) xb_add(&bar[XB_TOPGEN], 1u);
            else XB_SPIN(xb_ld(&bar[XB_TOPGEN]) == tg, bar);
            __builtin_amdgcn_fence(__ATOMIC_ACQUIRE, "agent");
            xb_add(&bar[XB_XGEN(b.x)], 1u);
            asm volatile("s_waitcnt vmcnt(0)" ::: "memory");
        } else {
            XB_SPIN(xb_ld(&bar[XB_XGEN(b.x)]) == gen, bar);
            __builtin_amdgcn_fence(__ATOMIC_ACQUIRE, "agent");
            asm volatile("s_waitcnt vmcnt(0)" ::: "memory");
        }
    }
    __syncthreads();
}

struct Args {
    const float* x; const float* c; const int* pos; const float* ada_w; const float* ada_b; const float* mix_norm; const float* ffn_norm;
    const float* a_w_in; const float* a_conv_w; const float* a_conv_b; const float* a_gx_w; const float* a_gx_b; const float* a_ga_w; const float* a_ga_b;
    const float* a_lambda; const float* a_w_out; const float* kv_norm; const float* kv_ada_w; const float* kv_ada_b; const float* w_kv; const float* k_norm;
    const float* b_w_q; const float* b_q_norm; const float* b_sinks; const float* b_w_o; const float* f_w_gu; const float* f_w_down; const float* m_router;
    const float* m_w_gu; const float* m_w_down;
    float* out; unsigned char* ws; int ph_lo, ph_hi;
};

struct Ctx {
    LAS unsigned char* lds; int tid, lane, wave, vcu, G, cid;
};

template <bool F8>
__device__ __forceinline__ void transpose_item(const float* W, int K, int N, void* WT, int k0, int n0, int d0, int d1, LAS float* scr, int lane, float scale) {
    const int kr = lane >> 4, nq = lane & 15;
#pragma unroll 8
    for (int i = 0; i < 16; ++i) { const int k = 4 * i + kr; const f32x4 v = *(const f32x4*)(W + (size_t)(k0 + k) * N + n0 + 4 * nq);
        *(LAS f32x4*)(scr + k * 68 + ((4 * nq) ^ (4 * ((k >> 3) & 7)))) = v; }
    LDS_WAIT(); asm volatile("" ::: "memory");
    const int c = lane & 7, r = lane >> 3;
#pragma unroll
    for (int j = 0; j < 8; ++j) { const int n = 8 * j + r; const LAS float* s = scr + (8 * c) * 68 + (n ^ (4 * c));
        const int drow = ((n & 32) ? d1 : d0) + (n & 31);
        if constexpr (F8) { u32x2 o; o.x = cvt4_fp8(s[0 * 68] * scale, s[1 * 68] * scale, s[2 * 68] * scale, s[3 * 68] * scale); o.y = cvt4_fp8(s[4 * 68] * scale, s[5 * 68] * scale, s[6 * 68] * scale, s[7 * 68] * scale);
            *(u32x2*)((unsigned char*)WT + (size_t)drow * K + k0 + 8 * c) = o; }
        else { u32x4 o; o.x = cvtpk(s[0 * 68], s[1 * 68]); o.y = cvtpk(s[2 * 68], s[3 * 68]); o.z = cvtpk(s[4 * 68], s[5 * 68]); o.w = cvtpk(s[6 * 68], s[7 * 68]);
            *(u32x4*)((bf16_t*)WT + (size_t)drow * K + k0 + 8 * c) = o; } }
    LDS_WAIT(); asm volatile("" ::: "memory");
}
__device__ __forceinline__ int map_plain(int n) { return n; }
__device__ __forceinline__ int map_head(int n) { const int hd = n >> 6, d = n & 63; return 256 * (hd >> 2) + 128 * (d >> 5) + 32 * (hd & 3) + (d & 31); }
__device__ __forceinline__ int map_gu(int n, int F) { const int u = n >= F, j = u ? n - F : n; return 256 * (j >> 7) + 128 * u + (j & 127); }

__device__ __forceinline__ void p0_prologue(const Ctx& F, const Args& a) {
    unsigned char* ws = a.ws;
    {
        LAS float* cs = (LAS float*)F.lds;
        LAS float* red = (LAS float*)(F.lds + 65536);
        for (int i = F.tid; i < BATCH * DM; i += 512) { const int b = i >> 10, k = i & 1023; const float v = a.c[i]; cs[k * 16 + b] = silu_(v); }
        __syncthreads();
        float* modv = (float*)(ws + WS_MODV); float* kvmod = (float*)(ws + WS_KVMOD);
        constexpr int NC = 4 * 6144 + 2048, CPB = 104;
        for (int cb = F.vcu; cb * CPB < NC; cb += F.G) {
            const int cl = F.tid & 127, kp = F.tid >> 7, j = cb * CPB + cl;
            const bool on = (cl < CPB) && (j < NC);
            float accv[16];
#pragma unroll
            for (int b = 0; b < 16; ++b) accv[b] = 0.f;
            if (on) {
                const float* W; int ldw, jj;
                if (j < 4 * 6144) { const int l = j / 6144; jj = j - l * 6144; W = a.ada_w + (size_t)l * DM * 6144; ldw = 6144; } else { jj = j - 4 * 6144; W = a.kv_ada_w; ldw = 2048; }
                const float* wp = W + (size_t)(kp * 256) * ldw + jj;
#pragma unroll 4
                for (int k = 0; k < 256; ++k) { const float w = wp[(size_t)k * ldw]; const LAS f32x4* cv = (const LAS f32x4*)(cs + (kp * 256 + k) * 16);
#pragma unroll
                    for (int q = 0; q < 4; ++q) { const f32x4 c4 = cv[q]; accv[4 * q] += w * c4[0]; accv[4 * q + 1] += w * c4[1]; accv[4 * q + 2] += w * c4[2]; accv[4 * q + 3] += w * c4[3]; } }
            }
#pragma unroll
            for (int b = 0; b < 16; ++b) red[(kp * 128 + cl) * 16 + b] = accv[b];
            __syncthreads();
            for (int i = F.tid; i < CPB * 16; i += 512) { const int cl2 = i >> 4, b = i & 15, j2 = cb * CPB + cl2;
                if (j2 < NC) { const float s = (red[(0 * 128 + cl2) * 16 + b] + red[(1 * 128 + cl2) * 16 + b]) + (red[(2 * 128 + cl2) * 16 + b] + red[(3 * 128 + cl2) * 16 + b]);
                    if (j2 < 4 * 6144) { const int l = j2 / 6144, jj = j2 - l * 6144; modv[((size_t)l * 16 + b) * 6144 + jj] = s + a.ada_b[l * 6144 + jj]; }
                    else { const int jj = j2 - 4 * 6144; kvmod[(size_t)b * 2048 + jj] = s + a.kv_ada_b[jj]; } } }
            __syncthreads();
        }
    }
    {
        LAS float* scr = (LAS float*)(F.lds + F.wave * 17408);
        const int gw = F.vcu * 8 + F.wave, NGW = F.G * 8;
        constexpr int I_WIN = 16 * 32, I_SQ = 16 * 16, I_KV = 16 * 8, I_FGU = 16 * 96, I_FDN = 48 * 16, I_MGU = 16 * 112, I_MDN = 56 * 16;
        constexpr int NITEMS = 2 * I_WIN + 2 * I_SQ + I_KV + 2 * I_SQ + 2 * I_SQ + 2 * I_FGU + 2 * I_FDN + 16 * I_MGU + 16 * I_MDN;
        for (int it = gw; it < NITEMS; it += NGW) {
            int r = it;
            if (r < 2 * I_WIN) { const int mi = r / I_WIN, rr = r % I_WIN, nb = rr % 32, kb = rr / 32, n0 = 64 * nb;
                transpose_item<false>(a.a_w_in + (size_t)mi * DM * 2048, DM, 2048, (bf16_t*)(ws + WS_WIN) + (size_t)mi * 2048 * DM, 64 * kb, n0, n0, n0 + 32, scr, F.lane, 1.f); continue; } r -= 2 * I_WIN;
            if (r < 2 * I_SQ) { const int mi = r / I_SQ, rr = r % I_SQ, nb = rr % 16, kb = rr / 16, n0 = 64 * nb;
                transpose_item<false>(a.a_w_out + (size_t)mi * DM * DM, DM, DM, (bf16_t*)(ws + WS_WOUT) + (size_t)mi * DM * DM, 64 * kb, n0, n0, n0 + 32, scr, F.lane, 1.f); continue; } r -= 2 * I_SQ;
            if (r < I_KV) { const int nb = r % 8, kb = r / 8, n0 = 64 * nb;
                transpose_item<false>(a.w_kv, DM, 512, (bf16_t*)(ws + WS_WKV), 64 * kb, n0, n0 < 256 ? map_head(n0) : n0, n0 < 256 ? map_head(n0 + 32) : n0 + 32, scr, F.lane, 1.f); continue; } r -= I_KV;
            if (r < 2 * I_SQ) { const int mi = r / I_SQ, rr = r % I_SQ, nb = rr % 16, kb = rr / 16, n0 = 64 * nb;
                transpose_item<false>(a.b_w_q + (size_t)mi * DM * DM, DM, DM, (bf16_t*)(ws + WS_WQ) + (size_t)mi * DM * DM, 64 * kb, n0, map_head(n0), map_head(n0 + 32), scr, F.lane, 1.f); continue; } r -= 2 * I_SQ;
            if (r < 2 * I_SQ) { const int mi = r / I_SQ, rr = r % I_SQ, nb = rr % 16, kb = rr / 16, n0 = 64 * nb;
                transpose_item<false>(a.b_w_o + (size_t)mi * DM * DM, DM, DM, (bf16_t*)(ws + WS_WO) + (size_t)mi * DM * DM, 64 * kb, n0, n0, n0 + 32, scr, F.lane, 1.f); continue; } r -= 2 * I_SQ;
            if (r < 2 * I_FGU) { const int mi = r / I_FGU, rr = r % I_FGU, nb = rr % 96, kb = rr / 96, n0 = 64 * nb;
                if (FP8_OF(2 * mi)) transpose_item<true>(a.f_w_gu + (size_t)mi * DM * 6144, DM, 6144, ws + WS_FGU + (size_t)mi * 6144 * DM * 2, 64 * kb, n0, map_gu(n0, DFF), map_gu(n0 + 32, DFF), scr, F.lane, SC8_W);
                else transpose_item<false>(a.f_w_gu + (size_t)mi * DM * 6144, DM, 6144, (bf16_t*)(ws + WS_FGU) + (size_t)mi * 6144 * DM, 64 * kb, n0, map_gu(n0, DFF), map_gu(n0 + 32, DFF), scr, F.lane, 1.f); continue; } r -= 2 * I_FGU;
            if (r < 2 * I_FDN) { const int mi = r / I_FDN, rr = r % I_FDN, nb = rr % 16, kb = rr / 16, n0 = 64 * nb;
                if (FP8_OF(2 * mi)) transpose_item<true>(a.f_w_down + (size_t)mi * DFF * DM, DFF, DM, ws + WS_FDN + (size_t)mi * DM * DFF * 2, 64 * kb, n0, n0, n0 + 32, scr, F.lane, SC8_W);
                else transpose_item<false>(a.f_w_down + (size_t)mi * DFF * DM, DFF, DM, (bf16_t*)(ws + WS_FDN) + (size_t)mi * DM * DFF, 64 * kb, n0, n0, n0 + 32, scr, F.lane, 1.f); continue; } r -= 2 * I_FDN;
            if (r < 16 * I_MGU) { const int mi = r / I_MGU, rr = r % I_MGU, nb = rr % 112, kb = rr / 112, n0 = 64 * nb;
                if (FP8_OF(2 * (mi >> 3) + 1)) transpose_item<true>(a.m_w_gu + (size_t)mi * DM * 7168, DM, 7168, ws + WS_MGU + (size_t)(mi >> 3) * 8 * 7168 * DM * 2 + (size_t)(mi & 7) * 7168 * DM, 64 * kb, n0, map_gu(n0, DFE), map_gu(n0 + 32, DFE), scr, F.lane, SC8_W);
                else transpose_item<false>(a.m_w_gu + (size_t)mi * DM * 7168, DM, 7168, (bf16_t*)(ws + WS_MGU) + (size_t)mi * 7168 * DM, 64 * kb, n0, map_gu(n0, DFE), map_gu(n0 + 32, DFE), scr, F.lane, 1.f); continue; } r -= 16 * I_MGU;
            { const int mi = r / I_MDN, rr = r % I_MDN, nb = rr % 16, kb = rr / 16, n0 = 64 * nb;
                if (FP8_OF(2 * (mi >> 3) + 1)) transpose_item<true>(a.m_w_down + (size_t)mi * DFE * DM, DFE, DM, ws + WS_MDN + (size_t)(mi >> 3) * 8 * DM * DFE * 2 + (size_t)(mi & 7) * DM * DFE, 64 * kb, n0, n0, n0 + 32, scr, F.lane, SC8_W);
                else transpose_item<false>(a.m_w_down + (size_t)mi * DFE * DM, DFE, DM, (bf16_t*)(ws + WS_MDN) + (size_t)mi * DM * DFE, 64 * kb, n0, n0, n0 + 32, scr, F.lane, 1.f); }
        }
        __syncthreads();
    }
    {
        float* par = (float*)(ws + WS_PAR);
        const size_t gt0 = (size_t)F.vcu * 512 + F.tid, GT0 = (size_t)F.G * 512;
        for (size_t i = gt0; i < (size_t)PAR_END; i += GT0) { const int j = (int)i; float v;
            if (j < PAR_FFNN) v = a.mix_norm[j - PAR_MIXN]; else if (j < PAR_CONVW) v = a.ffn_norm[j - PAR_FFNN]; else if (j < PAR_CONVB) v = a.a_conv_w[j - PAR_CONVW];
            else if (j < PAR_GXB) v = a.a_conv_b[j - PAR_CONVB]; else if (j < PAR_GAB) v = a.a_gx_b[j - PAR_GXB]; else if (j < PAR_LAM) v = a.a_ga_b[j - PAR_GAB];
            else if (j < PAR_KVN) v = a.a_lambda[j - PAR_LAM]; else if (j < PAR_KN) v = a.kv_norm[j - PAR_KVN]; else if (j < PAR_QN) v = a.k_norm[j - PAR_KN];
            else if (j < PAR_SINK) v = a.b_q_norm[j - PAR_QN]; else if (j < PAR_ROUTER) v = a.b_sinks[j - PAR_SINK]; else v = a.m_router[j - PAR_ROUTER];
            par[j] = v; }
    }
    {
        const size_t gt = (size_t)F.vcu * 512 + F.tid, GT = (size_t)F.G * 512;
        bf16_t* gwp = (bf16_t*)(ws + WS_GW);
        for (size_t i = gt; i < (size_t)2 * 8 * 2 * 128 * 128; i += GT) { const int k = (int)(i & 127), j = (int)((i >> 7) & 127), c2 = (int)((i >> 14) & 1), n = (int)((i >> 15) & 7), l = (int)(i >> 18);
            const float* g = (j < 64) ? a.a_ga_w : a.a_gx_w; const float v = g[((size_t)(l * 8 + n) * 128 + k) * 128 + 64 * c2 + (j & 63)];
            gwp[i] = (bf16_t)(cvtpk(v, 0.f) & 0xffffu); }
        float* ct = (float*)(ws + WS_COS); float* st = (float*)(ws + WS_SIN);
        for (size_t i = gt; i < (size_t)NTOK * 32; i += GT) { const int p = (int)(i & 31); const size_t tok = i >> 5;
            const float inv = powf(10000.0f, -(float)(2 * p) / 64.0f); const float ang = (float)a.pos[tok] * inv;
            ct[i] = cosf(ang); st[i] = sinf(ang); }
    }
}

template <bool DUAL, bool ROUTER, bool OUT8 = false, bool INF32 = false>
__device__ __forceinline__ void norm_phase(const Ctx& F, const void* x, const float* gain1, const float* sh1, const float* sc1, void* out1,
                                           const float* gain2, const float* sh2, const float* sc2, bf16_t* out2,
                                           const float* wrouter, int* e12, float* w1o, int* cnt) {
    LAS int* lcnt = (LAS int*)F.lds;
    for (int rb = F.vcu; rb < NTOK / 256; rb += F.G) {
        const int b = rb >> 4;
        if (ROUTER) { if (F.tid < 16) lcnt[F.tid] = 0; __syncthreads(); }
        float ca[16], cs[16], ca2[16], cs2[16];
#pragma unroll
        for (int j = 0; j < 4; ++j) { const int col = 4 * F.lane + 256 * j;
            const f32x4 g = *(const f32x4*)(gain1 + col), s = *(const f32x4*)(sc1 + (size_t)b * 6144 + col), h = *(const f32x4*)(sh1 + (size_t)b * 6144 + col);
#pragma unroll
            for (int q = 0; q < 4; ++q) { ca[4 * j + q] = g[q] * (1.0f + s[q]); cs[4 * j + q] = h[q]; }
            if (DUAL) { const f32x4 g2 = *(const f32x4*)(gain2 + col), s2 = *(const f32x4*)(sc2 + (size_t)b * 2048 + col), h2 = *(const f32x4*)(sh2 + (size_t)b * 2048 + col);
#pragma unroll
                for (int q = 0; q < 4; ++q) { ca2[4 * j + q] = g2[q] * (1.0f + s2[q]); cs2[4 * j + q] = h2[q]; } } }
        float wr_[ROUTER ? 128 : 1];
        if (ROUTER) {
#pragma unroll
            for (int j = 0; j < 4; ++j)
#pragma unroll
                for (int q = 0; q < 4; ++q) { const int col = 4 * F.lane + 256 * j + q; const f32x4 w0 = *(const f32x4*)(wrouter + (size_t)col * 8), w1 = *(const f32x4*)(wrouter + (size_t)col * 8 + 4);
#pragma unroll
                    for (int e = 0; e < 4; ++e) { wr_[(4 * j + q) * 8 + e] = w0[e]; wr_[(4 * j + q) * 8 + 4 + e] = w1[e]; } }
        }
        int me12 = 0; float mw1 = 0.f;
        const int rowb = rb * 256 + F.wave * 32;
        for (int rr = 0; rr < 32; ++rr) {
            const size_t row = (size_t)(rowb + rr);
            f32x4 v[4]; float s = 0.f;
            if constexpr (INF32) { const f32x4* xr = (const f32x4*)((const float*)x + row * DM) + F.lane;
#pragma unroll
                for (int j = 0; j < 4; ++j) v[j] = xr[64 * j]; }
            else { const u32x2* xr = (const u32x2*)((const bf16_t*)x + row * DM) + F.lane;
#pragma unroll
                for (int j = 0; j < 4; ++j) { const u32x2 p = xr[64 * j]; v[j] = (f32x4){bflo(p.x), bfhi(p.x), bflo(p.y), bfhi(p.y)}; } }
#pragma unroll
            for (int j = 0; j < 4; ++j) s += (v[j][0] * v[j][0] + v[j][1] * v[j][1]) + (v[j][2] * v[j][2] + v[j][3] * v[j][3]);
            const float r = __builtin_amdgcn_rsqf(wave_sum(s, F.lane) * (1.0f / DM) + EPS);
            float hv[16];
#pragma unroll
            for (int j = 0; j < 4; ++j)
#pragma unroll
                for (int q = 0; q < 4; ++q) hv[4 * j + q] = v[j][q] * r * ca[4 * j + q] + cs[4 * j + q];
            if constexpr (OUT8) { unsigned* o4 = (unsigned*)((unsigned char*)out1 + row * DM) + F.lane;
#pragma unroll
                for (int j = 0; j < 4; ++j) o4[64 * j] = cvt4_fp8(hv[4 * j] * SC8_H, hv[4 * j + 1] * SC8_H, hv[4 * j + 2] * SC8_H, hv[4 * j + 3] * SC8_H); }
            else { u32x2* o8 = (u32x2*)((bf16_t*)out1 + row * DM) + F.lane;
#pragma unroll
                for (int j = 0; j < 4; ++j) { u32x2 w; w.x = cvtpk(hv[4 * j], hv[4 * j + 1]); w.y = cvtpk(hv[4 * j + 2], hv[4 * j + 3]); o8[64 * j] = w; } }
            if (DUAL) { u32x2* p8 = (u32x2*)(out2 + row * DM) + F.lane;
#pragma unroll
                for (int j = 0; j < 4; ++j) { float t[4];
#pragma unroll
                    for (int q = 0; q < 4; ++q) t[q] = v[j][q] * r * ca2[4 * j + q] + cs2[4 * j + q];
                    u32x2 w; w.x = cvtpk(t[0], t[1]); w.y = cvtpk(t[2], t[3]); p8[64 * j] = w; } }
            if (ROUTER) {
                float lg[8];
#pragma unroll
                for (int e = 0; e < 8; ++e) { float p = 0.f;
#pragma unroll
                    for (int c = 0; c < 16; ++c) p += hv[c] * wr_[c * 8 + e];
                    lg[e] = wave_sum(p, F.lane); }
                int i1 = 0; float v1 = lg[0];
#pragma unroll
                for (int e = 1; e < 8; ++e) if (lg[e] > v1) { v1 = lg[e]; i1 = e; }
                int i2 = -1; float v2 = -INFINITY;
#pragma unroll
                for (int e = 0; e < 8; ++e) if (e != i1 && lg[e] > v2) { v2 = lg[e]; i2 = e; }
                const float wt = 1.0f / (1.0f + __expf(v2 - v1));
                if (F.lane == rr) { me12 = i1 | (i2 << 8); mw1 = wt; }
            }
        }
        if (ROUTER) {
            if (F.lane < 32) { e12[rowb + F.lane] = me12; w1o[rowb + F.lane] = mw1; }
            const int e1 = me12 & 255, e2 = me12 >> 8;
#pragma unroll
            for (int e = 0; e < 8; ++e) { const unsigned long long m1 = __ballot(F.lane < 32 && e1 == e), m2 = __ballot(F.lane < 32 && e2 == e);
                if (F.lane == 0) { atomicAdd((int*)&lcnt[e], (int)__popcll(m1)); atomicAdd((int*)&lcnt[8 + e], (int)__popcll(m2)); } }
            __syncthreads();
            if (F.tid < 16) cnt[rb * 16 + F.tid] = lcnt[F.tid];
            __syncthreads();
        }
    }
}

__device__ __forceinline__ void moe_scatter(const Ctx& F, const int* cnt, const int* e12, const float* w1, int* tos, float* wos, int* tile) {
    LAS int* T1 = (LAS int*)F.lds;
    LAS int* T2 = T1 + 512;
    LAS int* tot = T2 + 512;
    LAS int* pre = tot + 16;
    LAS int* seg = pre + 16;
    LAS int* wcn = seg + 32;
    for (int rb = F.vcu; rb < NTOK / 256; rb += F.G) {
        { const int bin = F.tid & 15, part = F.tid >> 4; int st = 0, sp = 0;
#pragma unroll
            for (int j = 0; j < 8; ++j) { const int b2 = part * 8 + j; const int v = cnt[b2 * 16 + bin]; st += v; if (b2 < rb) sp += v; }
            T1[part * 16 + bin] = st; T2[part * 16 + bin] = sp; }
        __syncthreads();
        if (F.tid < 16) { int st = 0, sp = 0; for (int p = 0; p < 32; ++p) { st += T1[p * 16 + F.tid]; sp += T2[p * 16 + F.tid]; } tot[F.tid] = st; pre[F.tid] = sp; }
        __syncthreads();
        if (F.tid == 0) { int s = 0; for (int bin = 0; bin < 16; ++bin) { seg[bin] = s; s += ((tot[bin] + 255) >> 8) << 8; } seg[16] = s; }
        __syncthreads();
        int e1 = -1, e2 = -1; float wt = 0.f; int r1 = 0, r2 = 0;
        const int token = rb * 256 + F.tid;
        if (F.tid < 256) { const int v = e12[token]; e1 = v & 255; e2 = v >> 8; wt = w1[token]; }
        if (F.wave < 4) {
#pragma unroll
            for (int e = 0; e < 8; ++e) { const unsigned long long m1 = __ballot(e1 == e), m2 = __ballot(e2 == e); const unsigned long long lt = (1ull << F.lane) - 1ull;
                if (e1 == e) r1 = (int)__popcll(m1 & lt); if (e2 == e) r2 = (int)__popcll(m2 & lt);
                if (F.lane == 0) { wcn[F.wave * 16 + e] = (int)__popcll(m1); wcn[F.wave * 16 + 8 + e] = (int)__popcll(m2); } }
        }
        __syncthreads();
        if (F.tid < 256) {
            int o1 = seg[e1] + pre[e1] + r1, o2 = seg[8 + e2] + pre[8 + e2] + r2;
            for (int w = 0; w < F.wave; ++w) { o1 += wcn[w * 16 + e1]; o2 += wcn[w * 16 + 8 + e2]; }
            tos[o1] = token; wos[o1] = wt; tos[o2] = token; wos[o2] = 1.0f - wt;
        }
        if (rb < 16) { const int bin = rb; const int s0 = seg[bin] + tot[bin], s1 = seg[bin + 1]; for (int s = s0 + F.tid; s < s1; s += 512) { tos[s] = -1; wos[s] = 0.f; } }
        if (rb == 0) { if (F.tid == 0) { tile[0] = seg[8] >> 8; tile[1] = seg[16] >> 8; }
            for (int t = F.tid; t < MAXTILES; t += 512) { const int s = t << 8; int e = 0;
#pragma unroll
                for (int bin = 1; bin < 16; ++bin) if (s >= seg[bin]) e = bin;
                tile[16 + t] = e & 7; } }
        __syncthreads();
    }
}

constexpr int SC_AT = 0, SC_WT = 34816, SC_AS = 69632, SC_BS = 102400, SC_SEG = 135168, SC_CARRY = 139264, SC_CW = 139776, SC_GB = 142336;
__device__ __forceinline__ void scan_phase(const Ctx& F, const float* par, int l, const bf16_t* XB, bf16_t* GY, const bf16_t* GW) {
    LAS unsigned char* lds = F.lds;
    LAS float* AS = (LAS float*)(lds + SC_AS); LAS float* BS = (LAS float*)(lds + SC_BS);
    LAS float* SEGA = (LAS float*)(lds + SC_SEG); LAS float* SEGB = SEGA + 512;
    LAS float* CARRY = (LAS float*)(lds + SC_CARRY);
    LAS float* CW = (LAS float*)(lds + SC_CW);
    LAS float* GB = (LAS float*)(lds + SC_GB);
    const int tid = F.tid, lane = F.lane, wid = F.wave, r32 = lane & 31, hh = lane >> 5;
    for (int un = F.vcu; un < 256; un += F.G) {
        const int b = un >> 4, n = (un >> 1) & 7, c2 = un & 1;
        __syncthreads();
        for (int i = tid; i < 640; i += 512) { const int ch = i & 127, k = i >> 7; CW[i] = (k < 4) ? par[PAR_CONVW + (l * 4 + k) * DM + 128 * n + ch] : par[PAR_CONVB + l * DM + 128 * n + ch]; }
        if (tid < 64) { const int ch = l * DM + 128 * n + 64 * c2 + tid; GB[tid] = par[PAR_GAB + ch]; GB[64 + tid] = par[PAR_GXB + ch]; GB[128 + tid] = log1pf(expf(-par[PAR_LAM + ch])); CARRY[tid] = 0.f; CARRY[64 + tid] = 0.f; }
        { const bf16_t* gsrc = GW + (size_t)(((l * 8 + n) * 2 + c2) * 128) * 128;
#pragma unroll
            for (int i = 0; i < 4; ++i) { const int p = tid + 512 * i, row = p >> 4, c16 = p & 15; const u32x4 v = *(const u32x4*)(gsrc + (size_t)row * 128 + c16 * 8); *(LAS u32x4*)(lds + SC_WT + row * 272 + c16 * 16) = v; } }
        const int cp = lane, tg = wid;
        const int sc = lane, sg = wid;
        const size_t rowbase = (size_t)b * SEQ;
        const bf16_t* xbp = XB + rowbase * DM + 128 * n + 2 * cp;
        bf16_t* gyp = GY + rowbase * DM + 128 * n + 64 * c2 + sc;
        unsigned xv[19];
#pragma unroll
        for (int k = 0; k < 19; ++k) { const int t = 16 * tg - 3 + k; xv[k] = (t >= 0) ? *(const unsigned*)(xbp + (size_t)t * DM) : 0u; }
        __syncthreads();
        float w[2][4], cb[2];
#pragma unroll
        for (int q = 0; q < 2; ++q) { cb[q] = CW[512 + 2 * cp + q];
#pragma unroll
            for (int k = 0; k < 4; ++k) w[q][k] = CW[k * 128 + 2 * cp + q]; }
        const float gba = GB[32 * (wid & 1) + r32], gbx = GB[64 + 32 * (wid & 1) + r32], spv = GB[128 + 32 * (wid & 1) + r32];
        for (int ci = 0; ci < SEQ / 128; ++ci) {
            const int t0 = ci * 128;
#pragma unroll
            for (int k = 0; k < 16; ++k) {
                float o[2];
#pragma unroll
                for (int q = 0; q < 2; ++q) { float s = cb[q];
#pragma unroll
                    for (int j = 0; j < 4; ++j) { const unsigned pv = xv[k + j]; const float xf = q ? __uint_as_float(pv & 0xffff0000u) : __uint_as_float(pv << 16); s += w[q][j] * xf; }
                    o[q] = s; }
                *(LAS unsigned*)(lds + SC_AT + (16 * tg + k) * 272 + cp * 4) = cvtpk(o[0], o[1]);
            }
            if (ci + 1 < SEQ / 128) {
#pragma unroll
                for (int k = 0; k < 19; ++k) xv[k] = *(const unsigned*)(xbp + (size_t)(t0 + 128 + 16 * tg - 3 + k) * DM);
            }
            __syncthreads();
            f32x16 ga, gx;
#pragma unroll
            for (int i = 0; i < 16; ++i) { ga[i] = 0.f; gx[i] = 0.f; }
            { const int tt = wid >> 1, ct = wid & 1;
                const LAS unsigned char* ap = lds + SC_AT + (32 * tt + r32) * 272 + hh * 16;
                const LAS unsigned char* bpa = lds + SC_WT + (32 * ct + r32) * 272 + hh * 16;
                const LAS unsigned char* bpx = bpa + 64 * 272;
#pragma unroll
                for (int s = 0; s < 8; ++s) { const bf16x8 af = *(const LAS bf16x8*)(ap + s * 32), ba = *(const LAS bf16x8*)(bpa + s * 32), bx = *(const LAS bf16x8*)(bpx + s * 32);
                    ga = __builtin_amdgcn_mfma_f32_32x32x16_bf16(af, ba, ga, 0, 0, 0); gx = __builtin_amdgcn_mfma_f32_32x32x16_bf16(af, bx, gx, 0, 0, 0); }
#pragma unroll
                for (int i = 0; i < 16; ++i) { const int tok = 32 * tt + (i & 3) + 8 * (i >> 2) + 4 * hh, ch = 32 * ct + r32;
                    const float rg = sigmoidf_(ga[i] + gba), ig = sigmoidf_(gx[i] + gbx);
                    const float la = -8.0f * rg * spv; const float av = fast_exp2(la * LOG2E); const float bc = __builtin_amdgcn_sqrtf(fmaxf(1.0f - av * av, 0.f));
                    const float xcv = bf2f(*(const LAS unsigned short*)(lds + SC_AT + tok * 272 + (64 * c2 + ch) * 2));
                    AS[tok * 64 + ch] = av; BS[tok * 64 + ch] = bc * ig * xcv; }
            }
            __syncthreads();
            unsigned short gyv[16];
#pragma unroll
            for (int k = 0; k < 16; ++k) gyv[k] = gyp[(size_t)(t0 + 16 * sg + k) * DM];
            float av[16], bv[16];
#pragma unroll
            for (int k = 0; k < 16; ++k) { av[k] = AS[(16 * sg + k) * 64 + sc]; bv[k] = BS[(16 * sg + k) * 64 + sc]; }
            { float pa = 1.f, pb = 0.f;
#pragma unroll
                for (int k = 0; k < 16; ++k) { pb = av[k] * pb + bv[k]; pa *= av[k]; }
                SEGA[sg * 64 + sc] = pa; SEGB[sg * 64 + sc] = pb; }
            __syncthreads();
            float h = CARRY[(ci & 1) * 64 + sc];
            for (int s = 0; s < sg; ++s) h = SEGA[s * 64 + sc] * h + SEGB[s * 64 + sc];
#pragma unroll
            for (int k = 0; k < 16; ++k) { h = av[k] * h + bv[k]; const float o = h * bf2f(gyv[k]); gyp[(size_t)(t0 + 16 * sg + k) * DM] = (bf16_t)(cvtpk(o, 0.f) & 0xffffu); }
            if (sg == 7) CARRY[((ci + 1) & 1) * 64 + sc] = h;
        }
    }
    __syncthreads();
}

constexpr int AT_K = 0, AT_V = 36864;
__device__ __forceinline__ void attn_phase(const Ctx& F, const bf16_t* Q, const bf16_t* Kb, const bf16_t* Vb, bf16_t* O, const float* sinks) {
    LAS unsigned char* lds = F.lds;
    const int tid = F.tid, lane = F.lane, wid = F.wave, r32 = lane & 31, hh = lane >> 5;
    const int i16 = lane & 15, tq = i16 >> 2, tp = i16 & 3, blk = (lane >> 4) & 1;
    const int g = wid & 3, half = wid >> 2;
    constexpr int NU = BATCH * 32 * 4;
    u32x4 kreg[4], vreg[4]; bf16x8 qreg[2][4];
#define AT_LOADKV(unit) do { const int kh_ = (unit) & 3, n_ = ((unit) >> 2) & 31, b_ = (unit) >> 7; \
        _Pragma("unroll") for (int i = 0; i < 4; ++i) { const int p = tid + 512 * i, row = p >> 3, c16 = p & 7; kreg[i] = (u32x4){0u, 0u, 0u, 0u}; vreg[i] = (u32x4){0u, 0u, 0u, 0u}; \
            if (n_ > 0 || row >= 128) { const size_t tok = (size_t)b_ * SEQ + (size_t)(128 * (n_ - 1) + row); kreg[i] = *(const u32x4*)(Kb + tok * 256 + kh_ * 64 + c16 * 8); vreg[i] = *(const u32x4*)(Vb + tok * 256 + kh_ * 64 + c16 * 8); } } } while (0)
#define AT_LOADQ(unit) do { const int kh_ = (unit) & 3, n_ = ((unit) >> 2) & 31, b_ = (unit) >> 7; \
        _Pragma("unroll") for (int ps = 0; ps < 2; ++ps) { const size_t qt_ = (size_t)b_ * SEQ + (size_t)(128 * n_ + 64 * half + 32 * ps + r32); \
            _Pragma("unroll") for (int s = 0; s < 4; ++s) qreg[ps][s] = *(const bf16x8*)(Q + qt_ * DM + (4 * kh_ + g) * 64 + 16 * s + 8 * hh); } } while (0)
    int un = F.vcu;
    if (un < NU) { AT_LOADKV(un); AT_LOADQ(un); }
    for (; un < NU; un += F.G) {
        const int kh = un & 3, n = (un >> 2) & 31, b = un >> 7;
        __syncthreads();
#pragma unroll
        for (int i = 0; i < 4; ++i) { const int p = tid + 512 * i, row = p >> 3, c16 = p & 7;
            *(LAS u32x4*)(lds + AT_K + row * 144 + c16 * 16) = kreg[i]; *(LAS u32x4*)(lds + AT_V + row * 192 + c16 * 16) = vreg[i]; }
        __syncthreads();
        if (un + F.G < NU) AT_LOADKV(un + F.G);
        const int hq = 4 * kh + g;
        const float sink2 = sinks[hq] * LOG2E;
#pragma unroll 1
        for (int pass = 0; pass < 2; ++pass) {
            const int i0 = 64 * half + 32 * pass, kt0 = i0 >> 5;
            const size_t qtok = (size_t)b * SEQ + (size_t)(128 * n + i0 + r32);
            bf16x8 qf[4];
#pragma unroll
            for (int s = 0; s < 4; ++s) qf[s] = pass ? qreg[1][s] : qreg[0][s];
            f32x16 sacc[5];
#pragma unroll
            for (int t = 0; t < 5; ++t) {
#pragma unroll
                for (int i = 0; i < 16; ++i) sacc[t][i] = 0.f;
#pragma unroll
                for (int s = 0; s < 4; ++s) { const bf16x8 kf = *(const LAS bf16x8*)(lds + AT_K + (32 * (kt0 + t) + r32) * 144 + (16 * s + 8 * hh) * 2);
                    sacc[t] = __builtin_amdgcn_mfma_f32_32x32x16_bf16(kf, qf[s], sacc[t], 0, 0, 0); } }
            float mx = sink2;
#pragma unroll
            for (int t = 0; t < 5; ++t) {
                const bool dead = (n == 0) && (32 * (kt0 + t) < 128);
#pragma unroll
                for (int i = 0; i < 16; ++i) { float sv = sacc[t][i];
                    if (t == 0 || t == 4) { const int d = 32 * t + (i & 3) + 8 * (i >> 2) + 4 * hh - r32; sv = ((d >= 1) && (d <= 128)) ? sv : -INFINITY; }
                    sv = dead ? -INFINITY : sv; sacc[t][i] = sv; mx = fmaxf(mx, sv); } }
            mx = fmaxf(mx, shflx(mx, lane, 32));
            float sum = 0.f;
#pragma unroll
            for (int t = 0; t < 5; ++t)
#pragma unroll
                for (int i = 0; i < 16; ++i) { const float p = fast_exp2(sacc[t][i] - mx); sacc[t][i] = p; sum += p; }
            sum += shflx(sum, lane, 32);
            sum += fast_exp2(sink2 - mx);
            const float inv = 1.0f / sum;
            f32x16 oacc[2];
#pragma unroll
            for (int i = 0; i < 16; ++i) { oacc[0][i] = 0.f; oacc[1][i] = 0.f; }
#pragma unroll
            for (int t = 0; t < 5; ++t)
#pragma unroll
                for (int s = 0; s < 2; ++s) {
                    u32x4 pk; pk.x = cvtpk(sacc[t][8 * s], sacc[t][8 * s + 1]); pk.y = cvtpk(sacc[t][8 * s + 2], sacc[t][8 * s + 3]); pk.z = cvtpk(sacc[t][8 * s + 4], sacc[t][8 * s + 5]); pk.w = cvtpk(sacc[t][8 * s + 6], sacc[t][8 * s + 7]);
                    const bf16x8 pb = __builtin_bit_cast(bf16x8, pk);
#pragma unroll
                    for (int dt = 0; dt < 2; ++dt) {
                        const LAS unsigned char* vp = lds + AT_V + (32 * (kt0 + t) + 16 * s + 4 * hh + tq) * 192 + (32 * dt + 16 * blk + 4 * tp) * 2;
                        const s16x4 lo = __builtin_bit_cast(s16x4, __builtin_amdgcn_ds_read_tr16_b64_v4i16((LAS s16x4*)vp));
                        const s16x4 hi = __builtin_bit_cast(s16x4, __builtin_amdgcn_ds_read_tr16_b64_v4i16((LAS s16x4*)(vp + 8 * 192)));
                        const bf16x8 va = __builtin_shufflevector(lo, hi, 0, 1, 2, 3, 4, 5, 6, 7);
                        oacc[dt] = __builtin_amdgcn_mfma_f32_32x32x16_bf16(va, pb, oacc[dt], 0, 0, 0);
                    }
                }
            bf16_t* op = O + qtok * DM + hq * 64;
#pragma unroll
            for (int dt = 0; dt < 2; ++dt)
#pragma unroll
                for (int q4 = 0; q4 < 4; ++q4) { u32x2 w; w.x = cvtpk(oacc[dt][4 * q4] * inv, oacc[dt][4 * q4 + 1] * inv); w.y = cvtpk(oacc[dt][4 * q4 + 2] * inv, oacc[dt][4 * q4 + 3] * inv);
                    *(u32x2*)(op + 32 * dt + 8 * q4 + 4 * hh) = w; }
        }
        if (un + F.G < NU) AT_LOADQ(un + F.G);
    }
#undef AT_LOADKV
#undef AT_LOADQ
    __syncthreads();
}

constexpr int NPHASE = 34 + (DUP_SCANPAIR ? 4 : 0);
__global__ void __launch_bounds__(512, 2) fwd_kernel(Args a) {
    extern __shared__ __attribute__((aligned(16))) unsigned char lds_raw[];
    volatile LAS unsigned* MISC = (volatile LAS unsigned*)((LAS unsigned char*)lds_raw + LDS_MISC);
    const int wv0 = __builtin_amdgcn_readfirstlane((int)threadIdx.x >> 6);
    if (wv0 == 0) MISC[lane_id_v()] = 0u;
    __syncthreads();
    XcdBarrier bar; bar.bar = (unsigned*)(a.ws + WS_CTL) + CW_BAR; bar.x = 0; bar.st = MISC;
    if (!MK_MULTI) bar = xcd_barrier_post((unsigned*)(a.ws + WS_CTL) + CW_BAR, MISC, wv0);
    const int lo = a.ph_lo, hi = a.ph_hi;
    int ph = 0;
#define PH_BEGIN(k) if (((PHSEL >> (k)) & 1) && lo <= ph && ph < hi) { Ctx F; { int t_ = wv0 * 64 + (int)lane_id_v(); asm volatile("" : "+v"(t_)); F.tid = t_; } F.lds = (LAS unsigned char*)lds_raw; F.lane = F.tid & 63; \
        F.wave = __builtin_amdgcn_readfirstlane(F.tid >> 6); F.G = gridDim.x; { int bx = blockIdx.x; asm volatile("" : "+s"(bx)); F.cid = bx; F.vcu = (F.G % 8 == 0) ? (bx % 8) * (F.G / 8) + bx / 8 : bx; } \
        unsigned char GAS* wsg_ = (unsigned char GAS*)a.ws; asm volatile("" : "+s"(wsg_)); unsigned char* ws = (unsigned char*)wsg_; float GAS* xog_ = (float GAS*)a.out; asm volatile("" : "+s"(xog_)); float* xo = (float*)xog_; int l = l_; asm volatile("" : "+s"(l)); (void)xo; (void)l; \
        for (int rep_ = 0; rep_ < (((DUPMASK >> (k)) & 1) ? 2 : 1); ++rep_) {
#define PH_END   } if (!MK_MULTI && ph + 1 < NPHASE) xcd_barrier(bar, wv0); } ++ph;
#define W_PAR    ((const float*)(ws + WS_PAR))
#define W_XS     ((bf16_t*)(ws + WS_XS))
#define W_MODL   ((const float*)(ws + WS_MODV) + (size_t)l * 16 * 6144)
#define W_KVMOD  ((const float*)(ws + WS_KVMOD))
#define W_HB     ((bf16_t*)(ws + WS_H))
#define W_HKV    ((bf16_t*)(ws + WS_HKV))
#define W_KB     ((bf16_t*)(ws + WS_KB))
#define W_VB     ((bf16_t*)(ws + WS_VB))
#define W_XB     ((bf16_t*)(ws + WS_ARENA + AR_XB))
#define W_GY     ((bf16_t*)(ws + WS_ARENA + AR_GY))
#define W_HID    ((bf16_t*)(ws + WS_ARENA))
#define W_Q      ((bf16_t*)(ws + WS_ARENA + AR_Q))
#define W_O      ((bf16_t*)(ws + WS_ARENA + AR_O))
#define W_COS    ((const float*)(ws + WS_COS))
#define W_SIN    ((const float*)(ws + WS_SIN))
#define W_E12    ((int*)(ws + WS_E12))
#define W_W1     ((float*)(ws + WS_W1))
#define W_CNT    ((int*)(ws + WS_CNT))
#define W_TILE   ((int*)(ws + WS_TILE))
#define W_TOS    ((int*)(ws + WS_TOS))
#define W_WOS    ((float*)(ws + WS_WOS))

    { const int l_ = 0; PH_BEGIN(0) p0_prologue(F, a); PH_END }

#pragma unroll 1
    for (int l_ = 0; l_ < 4; ++l_) {
        if (l_ < 2) {
            PH_BEGIN(1) if (l == 0) norm_phase<false, false, false, true>(F, a.x, W_PAR + PAR_MIXN + l * DM, W_MODL, W_MODL + 1024, W_HB, nullptr, nullptr, nullptr, nullptr, nullptr, nullptr, nullptr, nullptr);
                        else norm_phase<false, false>(F, W_XS, W_PAR + PAR_MIXN + l * DM, W_MODL, W_MODL + 1024, W_HB, nullptr, nullptr, nullptr, nullptr, nullptr, nullptr, nullptr, nullptr); PH_END
#pragma unroll 1
            for (int sp_ = 0; sp_ < (DUP_SCANPAIR ? 2 : 1); ++sp_) {
            PH_BEGIN(2) { pg8::ProbDense P{W_HB, (const bf16_t*)(ws + WS_WIN) + (size_t)l * 2048 * DM, DM * 2}; pg8::Order S; S.init(NTOK / 256, 8, F.G, F.cid, 0);
                pg8::EpiWin E{W_XB, W_GY}; pg8::gemm_phase<pg8::EpiWin, pg8::ProbDense, false>(F.lds, F.tid, P, S, E); } PH_END
            PH_BEGIN(3) scan_phase(F, W_PAR, l, W_XB, W_GY, (const bf16_t*)(ws + WS_GW)); PH_END
            }
            PH_BEGIN(4) { pg8::ProbDense P{W_GY, (const bf16_t*)(ws + WS_WOUT) + (size_t)l * DM * DM, DM * 2}; pg8::Order S; S.init(NTOK / 256, 4, F.G, F.cid, 0);
                if (l == 0) { pg8::EpiResid<true> E{a.x, W_XS, W_MODL + 2048, 1.0f}; pg8::gemm_phase<pg8::EpiResid<true>, pg8::ProbDense, false>(F.lds, F.tid, P, S, E); }
                else { pg8::EpiResid<false> E{W_XS, W_XS, W_MODL + 2048, 1.0f}; pg8::gemm_phase<pg8::EpiResid<false>, pg8::ProbDense, false>(F.lds, F.tid, P, S, E); } } PH_END
        } else {
            PH_BEGIN(5) if (l == 2) norm_phase<true, false>(F, W_XS, W_PAR + PAR_MIXN + l * DM, W_MODL, W_MODL + 1024, W_HB, W_PAR + PAR_KVN, W_KVMOD, W_KVMOD + 1024, W_HKV, nullptr, nullptr, nullptr, nullptr);
                        else norm_phase<false, false>(F, W_XS, W_PAR + PAR_MIXN + l * DM, W_MODL, W_MODL + 1024, W_HB, nullptr, nullptr, nullptr, nullptr, nullptr, nullptr, nullptr, nullptr); PH_END
            if (l_ == 2) {
                PH_BEGIN(6) { pg8::ProbDense P{W_HKV, (const bf16_t*)(ws + WS_WKV), DM * 2}; pg8::Order S; S.init(NTOK / 256, 2, F.G, F.cid, 0);
                    pg8::EpiQK E{W_KB, 256, W_PAR + PAR_KN, W_COS, W_SIN, 1.0f, 1, W_VB}; pg8::gemm_phase<pg8::EpiQK, pg8::ProbDense, false>(F.lds, F.tid, P, S, E); } PH_END
            }
            PH_BEGIN(6) { pg8::ProbDense P{W_HB, (const bf16_t*)(ws + WS_WQ) + (size_t)(l - 2) * DM * DM, DM * 2}; pg8::Order S; S.init(NTOK / 256, 4, F.G, F.cid, 0);
                pg8::EpiQK E{W_Q, DM, W_PAR + PAR_QN + (l - 2) * 64, W_COS, W_SIN, 0.125f * LOG2E, -1, nullptr}; pg8::gemm_phase<pg8::EpiQK, pg8::ProbDense, false>(F.lds, F.tid, P, S, E); } PH_END
            PH_BEGIN(7) attn_phase(F, W_Q, W_KB, W_VB, W_O, W_PAR + PAR_SINK + (l - 2) * 16); PH_END
            PH_BEGIN(8) { pg8::ProbDense P{W_O, (const bf16_t*)(ws + WS_WO) + (size_t)(l - 2) * DM * DM, DM * 2}; pg8::Order S; S.init(NTOK / 256, 4, F.G, F.cid, 0);
                pg8::EpiResid<false> E{W_XS, W_XS, W_MODL + 2048, 1.0f}; pg8::gemm_phase<pg8::EpiResid<false>, pg8::ProbDense, false>(F.lds, F.tid, P, S, E); } PH_END
        }
        if (!(l_ & 1)) {
            PH_BEGIN(9) if (FP8_OF(0) | FP8_OF(2)) { if (FP8_OF(l)) norm_phase<false, false, true>(F, W_XS, W_PAR + PAR_FFNN + l * DM, W_MODL + 3072, W_MODL + 4096, W_HB, nullptr, nullptr, nullptr, nullptr, nullptr, nullptr, nullptr, nullptr);
                             else norm_phase<false, false, false>(F, W_XS, W_PAR + PAR_FFNN + l * DM, W_MODL + 3072, W_MODL + 4096, W_HB, nullptr, nullptr, nullptr, nullptr, nullptr, nullptr, nullptr, nullptr); }
                        else norm_phase<false, false, false>(F, W_XS, W_PAR + PAR_FFNN + l * DM, W_MODL + 3072, W_MODL + 4096, W_HB, nullptr, nullptr, nullptr, nullptr, nullptr, nullptr, nullptr, nullptr); PH_END
            if (FP8_OF(l_)) {
                PH_BEGIN(17) { pg8::ProbDense P{W_HB, ws + WS_FGU + (size_t)(l >> 1) * 6144 * DM * 2, DM}; pg8::Order S; S.init(NTOK / 256, 24, F.G, F.cid, 0);
                    pg8::EpiSwiglu<true> E{W_HID, DFF, 1.0f / (SC8_H * SC8_W)}; pg8::gemm_phase<pg8::EpiSwiglu<true>, pg8::ProbDense, false, true>(F.lds, F.tid, P, S, E); } PH_END
                PH_BEGIN(18) { pg8::ProbDense P{W_HID, ws + WS_FDN + (size_t)(l >> 1) * DM * DFF * 2, DFF}; pg8::Order S; S.init(NTOK / 256, 4, F.G, F.cid, 0);
                    pg8::EpiResid<false> E{W_XS, W_XS, W_MODL + 5120, 1.0f / (SC8_HID * SC8_W)}; pg8::gemm_phase<pg8::EpiResid<false>, pg8::ProbDense, false, true>(F.lds, F.tid, P, S, E); } PH_END
            } else {
                PH_BEGIN(10) { pg8::ProbDense P{W_HB, (const bf16_t*)(ws + WS_FGU) + (size_t)(l >> 1) * 6144 * DM, DM * 2}; pg8::Order S; S.init(NTOK / 256, 24, F.G, F.cid, 0);
                    pg8::EpiSwiglu<false> E{W_HID, DFF, 1.0f}; pg8::gemm_phase<pg8::EpiSwiglu<false>, pg8::ProbDense, false>(F.lds, F.tid, P, S, E); } PH_END
                PH_BEGIN(11) { pg8::ProbDense P{W_HID, (const bf16_t*)(ws + WS_FDN) + (size_t)(l >> 1) * DM * DFF, DFF * 2}; pg8::Order S; S.init(NTOK / 256, 4, F.G, F.cid, 0);
                    pg8::EpiResid<false> E{W_XS, W_XS, W_MODL + 5120, 1.0f}; pg8::gemm_phase<pg8::EpiResid<false>, pg8::ProbDense, false>(F.lds, F.tid, P, S, E); } PH_END
            }
        } else {
            PH_BEGIN(12) if (FP8_OF(l)) norm_phase<false, true, true>(F, W_XS, W_PAR + PAR_FFNN + l * DM, W_MODL + 3072, W_MODL + 4096, W_HB, nullptr, nullptr, nullptr, nullptr, W_PAR + PAR_ROUTER + (l >> 1) * DM * 8, W_E12, W_W1, W_CNT);
                         else norm_phase<false, true, false>(F, W_XS, W_PAR + PAR_FFNN + l * DM, W_MODL + 3072, W_MODL + 4096, W_HB, nullptr, nullptr, nullptr, nullptr, W_PAR + PAR_ROUTER + (l >> 1) * DM * 8, W_E12, W_W1, W_CNT); PH_END
            PH_BEGIN(13) moe_scatter(F, W_CNT, W_E12, W_W1, W_TOS, W_WOS, W_TILE); PH_END
            if (FP8_OF(l_)) {
                PH_BEGIN(16) {
                    LAS int* texp = (LAS int*)(F.lds + LDS_TEXP);
                    for (int i = F.tid; i < MAXTILES + 16; i += 512) texp[i] = W_TILE[i];
                    __syncthreads();
                    const int ntot = texp[1];
                    pg8::Order S; S.init(ntot, 28, F.G, F.cid, 0);
                    pg8::ProbGrouped P{W_HB, ws + WS_MGU + (size_t)(l >> 1) * 8 * 7168 * DM * 2, DM, 7168, texp + 16, W_TOS};
                    pg8::EpiSwiglu<true> E{W_HID, DFE, 1.0f / (SC8_H * SC8_W)}; pg8::gemm_phase<pg8::EpiSwiglu<true>, pg8::ProbGrouped, true, true>(F.lds, F.tid, P, S, E); } PH_END
            } else {
                PH_BEGIN(14) {
                    LAS int* texp = (LAS int*)(F.lds + LDS_TEXP);
                    for (int i = F.tid; i < MAXTILES + 16; i += 512) texp[i] = W_TILE[i];
                    __syncthreads();
                    const int ntot = texp[1];
                    pg8::Order S; S.init(ntot, 28, F.G, F.cid, 0);
                    pg8::ProbGrouped P{W_HB, (const bf16_t*)(ws + WS_MGU) + (size_t)(l >> 1) * 8 * 7168 * DM, DM * 2, 7168, texp + 16, W_TOS};
                    pg8::EpiSwiglu<false> E{W_HID, DFE, 1.0f}; pg8::gemm_phase<pg8::EpiSwiglu<false>, pg8::ProbGrouped, true, false>(F.lds, F.tid, P, S, E); } PH_END
            }
#pragma unroll 1
            for (int pass = 0; pass < 2; ++pass) {
                if (l_ == 3 && pass == 1) {
                    PH_BEGIN(19) {
                        LAS int* texp = (LAS int*)(F.lds + LDS_TEXP);
                        for (int i = F.tid; i < MAXTILES + 16; i += 512) texp[i] = W_TILE[i];
                        __syncthreads();
                        const int nA = texp[0], ntot = texp[1];
                        pg8::Order S; S.init(ntot - nA, 4, F.G, F.cid, nA);
                        if (FP8_OF(3)) { pg8::ProbGrouped P{W_HID, ws + WS_MDN + (size_t)8 * DM * DFE * 2, DFE, DM, texp + 16, W_TOS};
                            pg8::EpiMoeDown<true> E{W_XS, xo, W_MODL + 5120, W_TOS, W_WOS, 1.0f / (SC8_HID * SC8_W)}; pg8::gemm_phase<pg8::EpiMoeDown<true>, pg8::ProbGrouped, false, true>(F.lds, F.tid, P, S, E); }
                        else { pg8::ProbGrouped P{W_HID, (const bf16_t*)(ws + WS_MDN) + (size_t)8 * DM * DFE, DFE * 2, DM, texp + 16, W_TOS};
                            pg8::EpiMoeDown<true> E{W_XS, xo, W_MODL + 5120, W_TOS, W_WOS, 1.0f}; pg8::gemm_phase<pg8::EpiMoeDown<true>, pg8::ProbGrouped, false, false>(F.lds, F.tid, P, S, E); } } PH_END
                } else {
                    PH_BEGIN(15) {
                        LAS int* texp = (LAS int*)(F.lds + LDS_TEXP);
                        for (int i = F.tid; i < MAXTILES + 16; i += 512) texp[i] = W_TILE[i];
                        __syncthreads();
                        const int nA = texp[0], ntot = texp[1];
                        pg8::Order S; S.init(pass ? ntot - nA : nA, 4, F.G, F.cid, pass ? nA : 0);
                        if (FP8_OF(l)) { pg8::ProbGrouped P{W_HID, ws + WS_MDN + (size_t)(l >> 1) * 8 * DM * DFE * 2, DFE, DM, texp + 16, W_TOS};
                            pg8::EpiMoeDown<false> E{W_XS, W_XS, W_MODL + 5120, W_TOS, W_WOS, 1.0f / (SC8_HID * SC8_W)}; pg8::gemm_phase<pg8::EpiMoeDown<false>, pg8::ProbGrouped, false, true>(F.lds, F.tid, P, S, E); }
                        else { pg8::ProbGrouped P{W_HID, (const bf16_t*)(ws + WS_MDN) + (size_t)(l >> 1) * 8 * DM * DFE, DFE * 2, DM, texp + 16, W_TOS};
                            pg8::EpiMoeDown<false> E{W_XS, W_XS, W_MODL + 5120, W_TOS, W_WOS, 1.0f}; pg8::gemm_phase<pg8::EpiMoeDown<false>, pg8::ProbGrouped, false, false>(F.lds, F.tid, P, S, E); } } PH_END
                }
            }
        }
    }
#undef PH_BEGIN
#undef PH_END
}

extern "C" void kernel_launch(void* const* d_in, const int* in_sizes, int n_in, void* d_out, int out_size, void* d_ws, size_t ws_size, hipStream_t stream) {
    static int grid = 0;
    if (grid == 0) {
        if (n_in != 30 || in_sizes[0] != NTOK * DM || out_size != NTOK * DM || ws_size < WS_END) { fprintf(stderr, "kernel_launch: unexpected shapes (n_in %d, in0 %d, out %d, ws %zu < %zu)\n", n_in, n_in > 0 ? in_sizes[0] : -1, out_size, ws_size, (size_t)WS_END); grid = -1; return; }
        int dev = 0, cus = 0, per_cu = 0;
        if (hipGetDevice(&dev) != hipSuccess || hipDeviceGetAttribute(&cus, hipDeviceAttributeMultiprocessorCount, dev) != hipSuccess) { grid = -1; return; }
        if (hipFuncSetAttribute((const void*)fwd_kernel, hipFuncAttributeMaxDynamicSharedMemorySize, LDS_BYTES) != hipSuccess) { fprintf(stderr, "kernel_launch: hipFuncSetAttribute failed\n"); grid = -1; return; }
        if (hipOccupancyMaxActiveBlocksPerMultiprocessor(&per_cu, (const void*)fwd_kernel, 512, LDS_BYTES) != hipSuccess || per_cu < 1) fprintf(stderr, "kernel_launch: occupancy query reports %d\n", per_cu);
        (void)hipGetLastError();
        grid = cus;
    }
    if (grid < 0) return;
    if (hipMemsetAsync((char*)d_ws + WS_CTL, 0, CTL_ZERO_BYTES, stream) != hipSuccess) return;
    Args a{};
    const float** fp = (const float**)&a;
    for (int i = 0; i < 30; ++i) fp[i] = (const float*)d_in[i];
    a.out = (float*)d_out; a.ws = (unsigned char*)d_ws;
#if MK_MULTI
    for (int p = 0; p < NPHASE; ++p) { a.ph_lo = p; a.ph_hi = p + 1; hipLaunchKernelGGL(fwd_kernel, dim3(grid), dim3(512), LDS_BYTES, stream, a); }
#else
    a.ph_lo = 0; a.ph_hi = NPHASE; hipLaunchKernelGGL(fwd_kernel, dim3(grid), dim3(512), LDS_BYTES, stream, a);
#endif
}
```

```cpp
#include <hip/hip_runtime.h>
#include <cstdio>
#include <cstdint>

#ifndef FP8MASK
#define FP8MASK 14
#endif
#define FP8_OF(l) (((FP8MASK) >> (l)) & 1)
#define FP8_MOE(l)   ((FP8_OF(1) && FP8_OF(3)) || ((FP8_OF(1) || FP8_OF(3)) && FP8_OF(l)))
#define FP8_DENSE(l) ((FP8_OF(0) && FP8_OF(2)) || ((FP8_OF(0) || FP8_OF(2)) && FP8_OF(l)))
#ifndef STAGGER_TICKS
#define STAGGER_TICKS 0
#endif
#ifndef DEFER_L3
#define DEFER_L3 1
#endif
#ifndef DUPMASK
#define DUPMASK 0
#endif
#ifndef DUP_SCANPAIR
#define DUP_SCANPAIR 0
#endif
#ifndef PHSEL
#define PHSEL 0xFFFFFFFFu
#endif
#ifndef MK_MULTI
#define MK_MULTI 0
#endif

#define LAS __attribute__((address_space(3)))
#define GAS __attribute__((address_space(1)))
typedef unsigned short bf16_t;
typedef short bf16x8 __attribute__((ext_vector_type(8)));
typedef short s16x4 __attribute__((ext_vector_type(4)));
typedef float f32x2 __attribute__((ext_vector_type(2)));
typedef float f32x4 __attribute__((ext_vector_type(4)));
typedef float f32x16 __attribute__((ext_vector_type(16)));
typedef unsigned u32x2 __attribute__((ext_vector_type(2)));
typedef unsigned u32x4 __attribute__((ext_vector_type(4)));
typedef __bf16 bf16x2_t __attribute__((ext_vector_type(2)));
typedef int i32x4 __attribute__((ext_vector_type(4)));
typedef int i32x8 __attribute__((ext_vector_type(8)));
constexpr float SC8_H = 4.0f, SC8_W = 64.0f, SC8_HID = 8.0f;

constexpr int DM = 1024, BATCH = 16, SEQ = 4096, NTOK = BATCH * SEQ;
constexpr int DFF = 3072, NEXP = 8, DFE = 3584;
constexpr int NSLOT = 135168;
constexpr int MAXTILES = NSLOT / 256;
constexpr float EPS = 1e-6f;
constexpr float LOG2E = 1.4426950408889634f;

constexpr size_t MiB = 1u << 20;
constexpr size_t WS_CTL = 0, CTL_ZERO_BYTES = 1 * MiB;
constexpr size_t WS_MODV = 1 * MiB;
constexpr size_t WS_KVMOD = 3 * MiB;
constexpr size_t WS_PAR = 3 * MiB + 512 * 1024;
constexpr int PAR_MIXN = 0, PAR_FFNN = 4096, PAR_CONVW = 8192, PAR_CONVB = 16384, PAR_GXB = 18432, PAR_GAB = 20480, PAR_LAM = 22528, PAR_KVN = 24576, PAR_KN = 25600, PAR_QN = 25664, PAR_SINK = 25792, PAR_ROUTER = 25856, PAR_END = 42240;
constexpr size_t WS_E12 = 4 * MiB;
constexpr size_t WS_W1 = 5 * MiB;
constexpr size_t WS_CNT = 6 * MiB;
constexpr size_t WS_TILE = 6 * MiB + 65536;
constexpr size_t WS_TOS = 7 * MiB;
constexpr size_t WS_WOS = 8 * MiB;
constexpr size_t WS_GW = 9 * MiB;
constexpr size_t WS_COS = 10 * MiB;
constexpr size_t WS_SIN = 18 * MiB;
constexpr size_t WS_WIN = 26 * MiB;
constexpr size_t WS_WOUT = 34 * MiB;
constexpr size_t WS_WKV = 38 * MiB;
constexpr size_t WS_WQ = 39 * MiB;
constexpr size_t WS_WO = 43 * MiB;
constexpr size_t WS_FGU = 47 * MiB;
constexpr size_t WS_FDN = 71 * MiB;
constexpr size_t WS_MGU = 83 * MiB;
constexpr size_t WS_MDN = 307 * MiB;
constexpr size_t WS_H = 419 * MiB;
constexpr size_t WS_HKV = 547 * MiB;
constexpr size_t WS_KB = 675 * MiB;
constexpr size_t WS_VB = 707 * MiB;
constexpr size_t WS_ARENA = 739 * MiB;
constexpr size_t WS_XS = WS_ARENA + (size_t)NSLOT * DFE * 2;
constexpr size_t WS_END = WS_XS + (size_t)NTOK * DM * 2;
static_assert(WS_END <= (size_t)1792 * MiB, "workspace map");
constexpr size_t AR_XB = 0, AR_GY = 128 * MiB, AR_Q = 0, AR_O = 128 * MiB;

constexpr int CW_BAR = 4096;

constexpr int LDS_BYTES = 163840;
constexpr int RING_BYTES = 131072;
constexpr int LDS_TEXP = RING_BYTES;
constexpr int LDS_IDX = RING_BYTES + 4096;
constexpr int LDS_MISC = LDS_BYTES - 256;

__device__ __forceinline__ unsigned cvtpk(float lo, float hi) { f32x2 v = {lo, hi}; bf16x2_t b = __builtin_convertvector(v, bf16x2_t); return __builtin_bit_cast(unsigned, b); }
__device__ __forceinline__ float clamp8(float v) { return __builtin_amdgcn_fmed3f(v, -448.0f, 448.0f); }
__device__ __forceinline__ unsigned cvt4_fp8(float a, float b, float c, float d) { int p = __builtin_amdgcn_cvt_pk_fp8_f32(clamp8(a), clamp8(b), 0, false); p = __builtin_amdgcn_cvt_pk_fp8_f32(clamp8(c), clamp8(d), p, true); return (unsigned)p; }
__device__ __forceinline__ float bflo(unsigned p) { return __uint_as_float(p << 16); }
__device__ __forceinline__ float bfhi(unsigned p) { return __uint_as_float(p & 0xffff0000u); }
__device__ __forceinline__ float bf2f(unsigned short b) { return __uint_as_float(((unsigned)b) << 16); }
__device__ __forceinline__ float fast_exp2(float x) { return __builtin_amdgcn_exp2f(x); }
__device__ __forceinline__ float fast_rcp(float x) { return __builtin_amdgcn_rcpf(x); }
__device__ __forceinline__ float sigmoidf_(float x) { return fast_rcp(1.0f + fast_exp2(-x * LOG2E)); }
__device__ __forceinline__ float silu_(float x) { return x * sigmoidf_(x); }
__device__ __forceinline__ float gelu_tanh_(float x) { const float u = 0.7978845608028654f * (x + 0.044715f * x * x * x); return x * sigmoidf_(2.0f * u); }
__device__ __forceinline__ float shflx(float v, int lane, int o) { return __int_as_float(__builtin_amdgcn_ds_bpermute((lane ^ o) << 2, __float_as_int(v))); }
__device__ __forceinline__ float wave_sum(float v, int lane) {
#pragma unroll
    for (int o = 1; o < 64; o <<= 1) v += shflx(v, lane, o);
    return v;
}
template <int CTRL, int RM = 0xf, int BM = 0xf> __device__ __forceinline__ float dppf(float v) { return __int_as_float(__builtin_amdgcn_update_dpp(0, __float_as_int(v), CTRL, RM, BM, false)); }
__device__ __forceinline__ float wave_sum_dpp(float v) {
    float s = v + dppf<0x111>(v); s += dppf<0x112>(v); s += dppf<0x113>(v);
    s += dppf<0x114>(s); s += dppf<0x118>(s);
    s += dppf<0x142, 0xa>(s); s += dppf<0x143, 0xc>(s);
    return __int_as_float(__builtin_amdgcn_readlane(__float_as_int(s), 63));
}
__device__ __forceinline__ int lane_id_v() { int l; asm volatile("v_mbcnt_lo_u32_b32 %0, -1, 0\n\tv_mbcnt_hi_u32_b32 %0, -1, %0" : "=v"(l)); return l; }
#define LDS_WAIT() asm volatile("s_waitcnt lgkmcnt(0)" ::: "memory")
#define VM_WAIT() asm volatile("s_waitcnt vmcnt(0)" ::: "memory")

namespace pg8 {
constexpr int BM = 256, BK = 64, HALF = 128, HTB = HALF * BK * 2, STAGE_BYTES = 8 * HTB, NXCD = 8, WGM = 8;
__host__ __device__ __forceinline__ int lds_byte(int r, int c) { const int st = (r >> 4) * 2 + (c >> 5), rr = r & 15, cc = c & 31, ob = rr * 64 + cc * 2; return st * 1024 + (ob ^ (((ob >> 9) & 1) << 5)); }
__host__ __device__ __forceinline__ void stage_rc(int b, int& R, int& C) { const int st = b / 1024, sb = b % 1024, swz = sb ^ (((sb >> 9) & 1) << 5); R = (st >> 1) * 16 + swz / 64; C = (st & 1) * 32 + (swz % 64) / 2; }
__host__ __device__ __forceinline__ int perm32(int rho) { const int n = rho >> 4, i = rho & 15; return 8 * (i >> 2) + 4 * n + (i & 3); }

struct Unit { int pm, pn; };

struct Order {
    int nM, nN, nwg, G, c, tile0, delay, nig; unsigned mg;
    __device__ __forceinline__ void init(int nM_, int nN_, int G_, int c_, int tile0_, int delay_ = 0) { nM = nM_; nN = nN_; nwg = nM * nN; G = G_; c = c_; tile0 = tile0_; delay = ((c_ >> 3) & 1) ? delay_ : 0;
        nig = WGM * nN; mg = (unsigned)((0x100000000ull + (unsigned)nig - 1ull) / (unsigned)nig); }
    __device__ __forceinline__ bool next(int i, Unit& u) const {
        const int L = i * G + c; if (L >= nwg) return false;
        int wgid; { const int q = nwg >> 3, r = nwg & 7, xcd = L & 7, off = L >> 3; wgid = (xcd < r ? xcd * (q + 1) : r * (q + 1) + (xcd - r) * q) + off; }
        const int gid = (int)__umulhi((unsigned)wgid, mg), rem = wgid - gid * nig, fm = gid * WGM, gsz = (nM - fm) < WGM ? (nM - fm) : WGM;
        if (gsz == WGM) { u.pm = tile0 + fm + (rem & (WGM - 1)); u.pn = rem >> 3; }
        else { u.pm = tile0 + fm + rem % gsz; u.pn = rem / gsz; }
        return true;
    }
};

struct ProbDense {
    const void* A; const void* Bt; int KB;
    __device__ __forceinline__ const char* a_ptr(const Unit& u) const { return (const char*)A + (size_t)u.pm * BM * KB; }
    __device__ __forceinline__ const char* b_ptr(const Unit& u) const { return (const char*)Bt + (size_t)u.pn * BM * KB; }
};
struct ProbGrouped {
    const void* A; const void* Bt; int KB; int N; const LAS int* texp; const int* tos;
    __device__ __forceinline__ const char* a_ptr(const Unit& u) const { return (const char*)A + (size_t)u.pm * BM * KB; }
    __device__ __forceinline__ const char* b_ptr(const Unit& u) const { return (const char*)Bt + ((size_t)texp[u.pm] * N + (size_t)u.pn * BM) * KB; }
};

template <class Epi, class Prob, bool GATHER, bool FP8 = false>
__device__ __forceinline__ void gemm_phase(LAS unsigned char* lds, const int tid, const Prob P, const Order& S, const Epi& E) {
    const int wid = __builtin_amdgcn_readfirstlane(tid >> 6), lane = tid & 63, wr = wid >> 2, wc = wid & 3, fr = lane & 15, fq = lane >> 4;
    const int KB = P.KB, nt = KB / (BK * 2);
    unsigned voffA[2], voffB[2];
#pragma unroll
    for (int i = 0; i < 2; ++i) { int R, C; stage_rc(tid * 16 + i * 8192, R, C); const int Rb = Epi::PERM ? ((R & ~31) + perm32(R & 31)) : R;
        voffA[i] = GATHER ? (unsigned)(C * 2) : (unsigned)(R * KB + C * 2); voffB[i] = (unsigned)(Rb * KB + C * 2); }
    const size_t kstep = (size_t)(BK * 2);
    const size_t hstep = (size_t)HALF * KB;
    const unsigned ldsw = (unsigned)wid * 1024u;
    const int aoff = lds_byte(wr * 64 + fr, fq * 8), boff = lds_byte(wc * 32 + fr, fq * 8);
    LAS int* idxb = (LAS int*)(lds + LDS_IDX);
#define PG8_GIDX(buf) do { int ln_ = lane; asm volatile("" : "+v"(ln_)); _Pragma("unroll") for (int i = 0; i < 2; ++i) { const int R_ = 16 * ((wid + 8 * i) >> 1) + (ln_ >> 2); \
        int t0 = idxb[(buf) * 256 + R_], t1 = idxb[(buf) * 256 + 128 + R_]; t0 = t0 < 0 ? 0 : t0; t1 = t1 < 0 ? 0 : t1; \
        vC0[i] = (unsigned)t0 * (unsigned)KB + voffA[i]; vC1[i] = (unsigned)t1 * (unsigned)KB + voffA[i]; } } while (0)
#define PG8_GDMA(unit, buf) do { if (wid < 4) { int ln_ = lane; asm volatile("" : "+v"(ln_)); \
        __builtin_amdgcn_global_load_lds((const unsigned*)(P.tos + (size_t)(unit).pm * BM + wid * 64) + ln_, (LAS unsigned*)(idxb + (buf) * 256 + wid * 64), 4, 0, 0); } } while (0)
#define PG8_SA(b, h) (((b) * 2 + (h)) * HTB)
#define PG8_SB(b, h) ((4 + (b) * 2 + (h)) * HTB)
#define PG8_STAGE(bufoff, gbase, voff) do { const char* g_ = (const char*)(gbase); asm volatile("" : "+s"(g_)); _Pragma("unroll") for (int _i = 0; _i < 2; ++_i) \
        __builtin_amdgcn_global_load_lds((const unsigned*)(g_ + (voff)[_i]), (LAS unsigned*)(lds + (bufoff) + ldsw + _i * 8192), 16, 0, 0); } while (0)
#define PG8_LDA(dst, b, h) do { _Pragma("unroll") for (int m = 0; m < 4; ++m) _Pragma("unroll") for (int k = 0; k < 2; ++k) dst[m][k] = *(const LAS bf16x8*)(lds + PG8_SA(b, h) + aoff + m * 2048 + k * 1024); } while (0)
#define PG8_LDB(dst, b, h) do { _Pragma("unroll") for (int n = 0; n < 2; ++n) _Pragma("unroll") for (int k = 0; k < 2; ++k) dst[n][k] = *(const LAS bf16x8*)(lds + PG8_SB(b, h) + boff + n * 2048 + k * 1024); } while (0)
#define PG8_CAT8(v) __builtin_shufflevector(__builtin_bit_cast(i32x4, (v)[0]), __builtin_bit_cast(i32x4, (v)[1]), 0, 1, 2, 3, 4, 5, 6, 7)
#define PG8_MMA(ai, bj, At, Bt) do { __builtin_amdgcn_s_setprio(1); if constexpr (FP8) asm volatile("s_nop 1"); _Pragma("unroll") for (int m = 0; m < 4; ++m) _Pragma("unroll") for (int n = 0; n < 2; ++n) { \
        if constexpr (FP8) { const i32x8 b8_ = PG8_CAT8(Bt[n]), a8_ = PG8_CAT8(At[m]);   \
            asm volatile("v_mfma_f32_16x16x128_f8f6f4 %0, %1, %2, %0" : "+v"(acc[ai][bj][m][n]) : "v"(b8_), "v"(a8_)); }     \
        else { _Pragma("unroll") for (int k = 0; k < 2; ++k) acc[ai][bj][m][n] = __builtin_amdgcn_mfma_f32_16x16x32_bf16(Bt[n][k], At[m][k], acc[ai][bj][m][n], 0, 0, 0); } } __builtin_amdgcn_s_setprio(0); } while (0)
#define PG8_WAIT_V(n) asm volatile("s_waitcnt vmcnt(" #n ")" ::: "memory")
#define PG8_WAIT_L(n) asm volatile("s_waitcnt lgkmcnt(" #n ")" ::: "memory")
#define PG8_BAR __builtin_amdgcn_s_barrier()
#define PG8_SCHED __builtin_amdgcn_sched_barrier(0)
    Unit cur, nxt; int ui = 0;
    if (!S.next(0, cur)) return;
    if (S.delay) { const unsigned long long t0_ = __builtin_amdgcn_s_memrealtime(); while (__builtin_amdgcn_s_memrealtime() - t0_ < (unsigned long long)S.delay) __builtin_amdgcn_s_sleep(8); }
    f32x4 acc[2][2][4][2];
#pragma unroll
    for (int a = 0; a < 2; ++a)
#pragma unroll
        for (int b = 0; b < 2; ++b)
#pragma unroll
            for (int m = 0; m < 4; ++m)
#pragma unroll
                for (int n = 0; n < 2; ++n) acc[a][b][m][n] = (f32x4){0.f, 0.f, 0.f, 0.f};
    bf16x8 At[4][2], B0[2][2], B1[2][2];
    unsigned vC0[2], vC1[2];
    const char* cA; const char* cB = P.b_ptr(cur);
    if constexpr (GATHER) {
        cA = (const char*)P.A;
        PG8_GDMA(cur, 0);
        PG8_WAIT_V(0); PG8_BAR;
        PG8_GIDX(0);
        LDS_WAIT(); PG8_BAR;
    } else {
        cA = P.a_ptr(cur);
#pragma unroll
        for (int i = 0; i < 2; ++i) { vC0[i] = voffA[i]; vC1[i] = voffA[i] + (unsigned)hstep; }
    }
    PG8_STAGE(PG8_SB(0, 0), cB, voffB); PG8_STAGE(PG8_SB(0, 1), cB + hstep, voffB); PG8_STAGE(PG8_SA(0, 0), cA, vC0); PG8_STAGE(PG8_SA(0, 1), cA, vC1);
    if (wr == 1) PG8_BAR;
    PG8_WAIT_V(2); PG8_BAR;
    PG8_STAGE(PG8_SB(1, 0), cB + kstep, voffB); PG8_STAGE(PG8_SA(1, 0), cA + kstep, vC0); PG8_STAGE(PG8_SB(1, 1), cB + hstep + kstep, voffB);
    PG8_WAIT_V(6); PG8_BAR;
    for (;;) {
        const bool has_next = S.next(ui + 1, nxt);
        const char* nA = GATHER ? cA : (has_next ? P.a_ptr(nxt) : cA); const char* nB = has_next ? P.b_ptr(nxt) : cB;
        for (int t = 0; t < nt; t += 2) {
            const bool last = (t == nt - 2);
            if constexpr (GATHER) {
                if (t == 0 && has_next) PG8_GDMA(nxt, (ui + 1) & 1);
            }
            const char* a1 = cA + (size_t)(t + 1) * kstep;
            const char* a2 = last ? nA : cA + (size_t)(t + 2) * kstep; const char* b2 = last ? nB : cB + (size_t)(t + 2) * kstep;
            const char* a3 = a2 + kstep; const char* b3 = b2 + kstep;
            PG8_LDB(B0, 0, 0); PG8_LDB(B1, 0, 1); PG8_SCHED; PG8_LDA(At, 0, 0); PG8_STAGE(PG8_SA(1, 1), a1, vC1);
            if constexpr (GATHER) { if (last && has_next) PG8_GIDX((ui + 1) & 1); }
            PG8_WAIT_V(8); PG8_WAIT_L(0); PG8_BAR; PG8_MMA(0, 0, At, B0); PG8_MMA(0, 1, At, B1); PG8_BAR; PG8_SCHED;
            PG8_LDA(At, 0, 1); PG8_STAGE(PG8_SB(0, 0), b2, voffB); PG8_STAGE(PG8_SB(0, 1), b2 + hstep, voffB); PG8_STAGE(PG8_SA(0, 0), a2, vC0);
            PG8_WAIT_V(8); PG8_WAIT_L(0); PG8_BAR; PG8_MMA(1, 0, At, B0); PG8_MMA(1, 1, At, B1); PG8_BAR; PG8_SCHED;
            PG8_LDB(B0, 1, 0); PG8_LDB(B1, 1, 1); PG8_SCHED; PG8_LDA(At, 1, 0); PG8_STAGE(PG8_SA(0, 1), a2, vC1);
            PG8_WAIT_V(8); PG8_WAIT_L(0); PG8_BAR; PG8_MMA(0, 0, At, B0); PG8_MMA(0, 1, At, B1); PG8_BAR; PG8_SCHED;
            PG8_LDA(At, 1, 1); PG8_STAGE(PG8_SB(1, 0), b3, voffB); PG8_STAGE(PG8_SB(1, 1), b3 + hstep, voffB); PG8_STAGE(PG8_SA(1, 0), a3, vC0);
            PG8_WAIT_V(8); PG8_WAIT_L(0); PG8_BAR; PG8_MMA(1, 0, At, B0); PG8_MMA(1, 1, At, B1); PG8_BAR; PG8_SCHED;
        }
        if constexpr (FP8) { asm volatile("s_nop 15\n\ts_nop 15" ::: "memory"); PG8_SCHED; }
        if (wr == 0) PG8_BAR;
        { const int ln_ = lane_id_v(); int fr_ = ln_ & 15, fq_ = ln_ >> 4; asm volatile("" : "+v"(fr_), "+v"(fq_)); E(acc, cur, wr, wc, fr_, fq_); }
        if (!has_next) break;
#pragma unroll
        for (int a = 0; a < 2; ++a)
#pragma unroll
            for (int b = 0; b < 2; ++b)
#pragma unroll
                for (int m = 0; m < 4; ++m)
#pragma unroll
                    for (int n = 0; n < 2; ++n) acc[a][b][m][n] = (f32x4){0.f, 0.f, 0.f, 0.f};
        cur = nxt; cA = nA; cB = nB; ++ui;
        if (wr == 1) PG8_BAR;
    }
    PG8_WAIT_V(0);
    PG8_BAR;
#undef PG8_SA
#undef PG8_GIDX
#undef PG8_GDMA
#undef PG8_SB
#undef PG8_STAGE
#undef PG8_LDA
#undef PG8_LDB
#undef PG8_MMA
#undef PG8_CAT8
#undef PG8_WAIT_V
#undef PG8_WAIT_L
#undef PG8_BAR
#undef PG8_SCHED
}

template <bool INF32> struct EpiResid {
    static constexpr bool PERM = true;
    const void* xin; bf16_t* xout; const float* gate; float ascale;
    __device__ __forceinline__ void operator()(const f32x4 (&acc)[2][2][4][2], const Unit& u, int wr, int wc, int fr, int fq) const {
        const int row0 = u.pm * BM + wr * 64 + fr, col0 = u.pn * BM + wc * 32 + 8 * fq;
        const float* gp = gate + (size_t)((u.pm * BM) >> 12) * 6144 + col0;
        f32x4 gv[2][2];
#pragma unroll
        for (int bj = 0; bj < 2; ++bj)
#pragma unroll
            for (int n = 0; n < 2; ++n) gv[bj][n] = (*(const f32x4*)(gp + bj * HALF + 4 * n) + 1.0f) * ascale;
#pragma unroll
        for (int ai = 0; ai < 2; ++ai) {
            f32x4 xv[4][2][2];
#pragma unroll
            for (int m = 0; m < 4; ++m) { const size_t off = (size_t)(row0 + ai * HALF + m * 16) * DM + col0;
#pragma unroll
                for (int bj = 0; bj < 2; ++bj) {
                    if constexpr (INF32) { xv[m][bj][0] = *(const f32x4*)((const float*)xin + off + bj * HALF); xv[m][bj][1] = *(const f32x4*)((const float*)xin + off + bj * HALF + 4); }
                    else { const u32x4 p = *(const u32x4*)((const bf16_t*)xin + off + bj * HALF);
                        xv[m][bj][0] = (f32x4){bflo(p.x), bfhi(p.x), bflo(p.y), bfhi(p.y)}; xv[m][bj][1] = (f32x4){bflo(p.z), bfhi(p.z), bflo(p.w), bfhi(p.w)}; } } }
#pragma unroll
            for (int m = 0; m < 4; ++m) { const size_t off = (size_t)(row0 + ai * HALF + m * 16) * DM + col0;
#pragma unroll
                for (int bj = 0; bj < 2; ++bj) { const f32x4 o0 = xv[m][bj][0] + gv[bj][0] * acc[ai][bj][m][0], o1 = xv[m][bj][1] + gv[bj][1] * acc[ai][bj][m][1];
                    u32x4 w; w.x = cvtpk(o0[0], o0[1]); w.y = cvtpk(o0[2], o0[3]); w.z = cvtpk(o1[0], o1[1]); w.w = cvtpk(o1[2], o1[3]);
                    *(u32x4*)(xout + off + bj * HALF) = w; } }
            asm volatile("" ::: "memory"); }
    }
};
template <bool OUTF32> struct EpiMoeDown {
    static constexpr bool PERM = true;
    const bf16_t* xs; void* xo; const float* gate; const int* tos; const float* wos; float ascale;
    __device__ __forceinline__ void operator()(const f32x4 (&acc)[2][2][4][2], const Unit& u, int wr, int wc, int fr, int fq) const {
        const int slot0 = u.pm * BM + wr * 64 + fr, col0 = u.pn * BM + wc * 32 + 8 * fq;
        int tok[2][4]; float w[2][4];
#pragma unroll
        for (int ai = 0; ai < 2; ++ai)
#pragma unroll
            for (int m = 0; m < 4; ++m) { const int slot = slot0 + ai * HALF + m * 16; tok[ai][m] = tos[slot]; w[ai][m] = wos[slot] * ascale; }
#pragma unroll
        for (int ai = 0; ai < 2; ++ai) {
            u32x4 xv[4][2];
#pragma unroll
            for (int m = 0; m < 4; ++m) { const int t = tok[ai][m] < 0 ? 0 : tok[ai][m]; const bf16_t* xp = xs + (size_t)t * DM + col0;
#pragma unroll
                for (int bj = 0; bj < 2; ++bj) xv[m][bj] = *(const u32x4*)(xp + bj * HALF); }
#pragma unroll
            for (int m = 0; m < 4; ++m) { const int t = tok[ai][m];
                if (t >= 0) { const float* gp = gate + (size_t)(t >> 12) * 6144 + col0; const size_t off = (size_t)t * DM + col0;
#pragma unroll
                    for (int bj = 0; bj < 2; ++bj) { const u32x4 p = xv[m][bj];
                        const f32x4 g0 = (*(const f32x4*)(gp + bj * HALF) + 1.0f) * w[ai][m], g1 = (*(const f32x4*)(gp + bj * HALF + 4) + 1.0f) * w[ai][m];
                        const f32x4 o0 = (f32x4){bflo(p.x), bfhi(p.x), bflo(p.y), bfhi(p.y)} + g0 * acc[ai][bj][m][0], o1 = (f32x4){bflo(p.z), bfhi(p.z), bflo(p.w), bfhi(p.w)} + g1 * acc[ai][bj][m][1];
                        if constexpr (OUTF32) { *(f32x4*)((float*)xo + off + bj * HALF) = o0; *(f32x4*)((float*)xo + off + bj * HALF + 4) = o1; }
                        else { u32x4 q; q.x = cvtpk(o0[0], o0[1]); q.y = cvtpk(o0[2], o0[3]); q.z = cvtpk(o1[0], o1[1]); q.w = cvtpk(o1[2], o1[3]); *(u32x4*)((bf16_t*)xo + off + bj * HALF) = q; } } } }
            asm volatile("" ::: "memory"); }
    }
};
template <bool OUT8> struct EpiSwiglu {
    static constexpr bool PERM = true;
    void* O; int ldo; float ascale;
    __device__ __forceinline__ void operator()(const f32x4 (&acc)[2][2][4][2], const Unit& u, int wr, int wc, int fr, int fq) const {
        const int row0 = u.pm * BM + wr * 64 + fr, col0 = u.pn * HALF + wc * 32 + 8 * fq;
        const float nl2 = -ascale * LOG2E, ios = 1.0f / (ascale * ascale * (OUT8 ? SC8_HID : 1.0f));
        const f32x2 nl2v = {nl2, nl2}, iosv = {ios, ios};
#pragma unroll
        for (int ai = 0; ai < 2; ++ai)
#pragma unroll
            for (int m = 0; m < 4; ++m) { const size_t eo = (size_t)(row0 + ai * HALF + m * 16) * ldo + col0;
                float v[8];
#pragma unroll
                for (int n = 0; n < 2; ++n)
#pragma unroll
                    for (int h = 0; h < 2; ++h) {
                        const f32x2 g = {acc[ai][0][m][n][2 * h], acc[ai][0][m][n][2 * h + 1]}, up = {acc[ai][1][m][n][2 * h], acc[ai][1][m][n][2 * h + 1]};
                        const f32x2 t = g * nl2v; const f32x2 e = {fast_exp2(t.x), fast_exp2(t.y)};
                        const f32x2 d = e * iosv + iosv; const f32x2 r = {fast_rcp(d.x), fast_rcp(d.y)};
                        const f32x2 o = (g * up) * r; v[4 * n + 2 * h] = o.x; v[4 * n + 2 * h + 1] = o.y; }
                if constexpr (OUT8) { u32x2 w; w.x = cvt4_fp8(v[0], v[1], v[2], v[3]); w.y = cvt4_fp8(v[4], v[5], v[6], v[7]);
                    *(u32x2*)((unsigned char*)O + eo) = w; }
                else { u32x4 w; w.x = cvtpk(v[0], v[1]); w.y = cvtpk(v[2], v[3]); w.z = cvtpk(v[4], v[5]); w.w = cvtpk(v[6], v[7]);
                    *(u32x4*)((bf16_t*)O + eo) = w; } }
    }
};
struct EpiWin {
    static constexpr bool PERM = true;
    bf16_t* XB; bf16_t* GY;
    __device__ __forceinline__ void operator()(const f32x4 (&acc)[2][2][4][2], const Unit& u, int wr, int wc, int fr, int fq) const {
        const bool act = u.pn >= 4; bf16_t* base = act ? GY : XB;
        const int row0 = u.pm * BM + wr * 64 + fr, col0 = (u.pn & 3) * BM + wc * 32 + 8 * fq;
#pragma unroll
        for (int ai = 0; ai < 2; ++ai)
#pragma unroll
            for (int m = 0; m < 4; ++m) { bf16_t* rowp = base + (size_t)(row0 + ai * HALF + m * 16) * DM + col0;
#pragma unroll
                for (int bj = 0; bj < 2; ++bj) { f32x4 v0 = acc[ai][bj][m][0], v1 = acc[ai][bj][m][1];
                    if (act) {
#pragma unroll
                        for (int j = 0; j < 4; ++j) { v0[j] = gelu_tanh_(v0[j]); v1[j] = gelu_tanh_(v1[j]); } }
                    u32x4 w; w.x = cvtpk(v0[0], v0[1]); w.y = cvtpk(v0[2], v0[3]); w.z = cvtpk(v1[0], v1[1]); w.w = cvtpk(v1[2], v1[3]);
                    *(u32x4*)(rowp + bj * HALF) = w; } }
    }
};
struct EpiQK {
    static constexpr bool PERM = true;
    bf16_t* O; int ldo; const float* gain; const float* cosT; const float* sinT; float oscale; int vtile; bf16_t* OV;
    __device__ __forceinline__ void operator()(const f32x4 (&acc)[2][2][4][2], const Unit& u, int wr, int wc, int fr, int fq) const {
        const int row0 = u.pm * BM + wr * 64 + fr;
        if (u.pn == vtile) {
            const int col0 = wc * 32 + 8 * fq;
#pragma unroll
            for (int ai = 0; ai < 2; ++ai)
#pragma unroll
                for (int m = 0; m < 4; ++m) { bf16_t* rowp = OV + (size_t)(row0 + ai * HALF + m * 16) * ldo + col0;
#pragma unroll
                    for (int bj = 0; bj < 2; ++bj) { const f32x4 v0 = acc[ai][bj][m][0], v1 = acc[ai][bj][m][1];
                        u32x4 w; w.x = cvtpk(v0[0], v0[1]); w.y = cvtpk(v0[2], v0[3]); w.z = cvtpk(v1[0], v1[1]); w.w = cvtpk(v1[2], v1[3]);
                        *(u32x4*)(rowp + bj * HALF) = w; } }
            return;
        }
        const int colh = (u.pn * 4 + wc) * 64 + 8 * fq;
        f32x4 g1[2], g2[2];
#pragma unroll
        for (int n = 0; n < 2; ++n) { g1[n] = *(const f32x4*)(gain + 8 * fq + 4 * n); g2[n] = *(const f32x4*)(gain + 32 + 8 * fq + 4 * n); }
#pragma unroll
        for (int aim = 0; aim < 4; ++aim) { const int ai = aim >> 1;
            f32x4 cv[4][2], sv[4][2];
#pragma unroll
            for (int m = 2 * (aim & 1); m < 2 * (aim & 1) + 2; ++m) { const int row = row0 + ai * HALF + m * 16;
#pragma unroll
                for (int n = 0; n < 2; ++n) { cv[m][n] = *(const f32x4*)(cosT + (size_t)row * 32 + 8 * fq + 4 * n); sv[m][n] = *(const f32x4*)(sinT + (size_t)row * 32 + 8 * fq + 4 * n); } }
#pragma unroll
            for (int m = 2 * (aim & 1); m < 2 * (aim & 1) + 2; ++m) { const int row = row0 + ai * HALF + m * 16;
                float ss = 0.f;
#pragma unroll
                for (int bj = 0; bj < 2; ++bj)
#pragma unroll
                    for (int n = 0; n < 2; ++n) { const f32x4 a = acc[ai][bj][m][n]; ss += (a[0] * a[0] + a[1] * a[1]) + (a[2] * a[2] + a[3] * a[3]); }
                { const int ln_ = fq * 16 + fr; ss += shflx(ss, ln_, 16); ss += shflx(ss, ln_, 32); }
                const float r = __builtin_amdgcn_rsqf(ss * (1.0f / 64.0f) + EPS) * oscale;
                float o1[8], o2[8];
#pragma unroll
                for (int n = 0; n < 2; ++n) { const f32x4 c = cv[m][n], s = sv[m][n];
                    const f32x4 x1 = acc[ai][0][m][n] * g1[n] * r, x2 = acc[ai][1][m][n] * g2[n] * r;
                    const f32x4 a = x1 * c - x2 * s, b = x2 * c + x1 * s;
#pragma unroll
                    for (int j = 0; j < 4; ++j) { o1[4 * n + j] = a[j]; o2[4 * n + j] = b[j]; } }
                bf16_t* rowp = O + (size_t)row * ldo + colh;
                u32x4 w; w.x = cvtpk(o1[0], o1[1]); w.y = cvtpk(o1[2], o1[3]); w.z = cvtpk(o1[4], o1[5]); w.w = cvtpk(o1[6], o1[7]);
                *(u32x4*)rowp = w;
                w.x = cvtpk(o2[0], o2[1]); w.y = cvtpk(o2[2], o2[3]); w.z = cvtpk(o2[4], o2[5]); w.w = cvtpk(o2[6], o2[7]);
                *(u32x4*)(rowp + 32) = w; }
            asm volatile("" ::: "memory"); }
    }
};
}

#define XB_TMO      128
#define XB_XCNT(j)  (256  + 64 * (j))
#define XB_XSUB(j)  (1280 + 64 * (j))
#define XB_XGEN(j)  (2304 + 64 * (j))
#define XB_TOP      3328
#define XB_TOPGEN   3392
#define XCD_BAR_WORDS 3456
#define XB_SPIN_CAP (1u << 20)
__device__ __forceinline__ unsigned xb_ld(unsigned* p)              { return __hip_atomic_load(p, __ATOMIC_RELAXED, __HIP_MEMORY_SCOPE_AGENT); }
__device__ __forceinline__ unsigned xb_add(unsigned* p, unsigned v) { return __hip_atomic_fetch_add(p, v, __ATOMIC_RELAXED, __HIP_MEMORY_SCOPE_AGENT); }
__device__ __forceinline__ unsigned xb_xcc_id() { return (unsigned)__builtin_amdgcn_s_getreg((3 << 11) | 20) & 0xFu; }
#define XB_SPIN(cond, bar) do { unsigned _sp = 0; while (cond) { __builtin_amdgcn_s_sleep(1); \
    if ((++_sp & 255u) == 0u) { if (xb_ld(&(bar)[XB_TMO])) break; if (_sp > XB_SPIN_CAP) { atomicAdd(&(bar)[XB_TMO], 1u); break; } } } } while (0)
struct XcdBarrier { unsigned* bar; unsigned x; volatile LAS unsigned* st; };
__device__ __forceinline__ XcdBarrier xcd_barrier_post(unsigned* bar, volatile LAS unsigned* st, int wv) {
    XcdBarrier b; b.bar = bar; b.x = xb_xcc_id(); b.st = st;
    if (wv == 0 && lane_id_v() == 0) (void)xb_add(&bar[XB_XCNT(b.x)], 1u);
    return b;
}
__device__ __forceinline__ void xcd_barrier_complete(unsigned* bar, unsigned x, unsigned& nloc, unsigned& nx) {
    const unsigned G = gridDim.x * gridDim.y * gridDim.z;
    unsigned sum, cnt, mine, sp = 0u;
    for (;;) {
        sum = 0u; cnt = 0u; mine = 0u;
#pragma unroll
        for (unsigned j = 0; j < 16; ++j) { const unsigned c = xb_ld(&bar[XB_XCNT(j)]); sum += c; cnt += (c > 0u) ? 1u : 0u; }
        mine = xb_ld(&bar[XB_XCNT(x)]);
        if (sum == G) break;
        __builtin_amdgcn_s_sleep(1);
        if ((++sp & 255u) == 0u) { if (xb_ld(&bar[XB_TMO])) break; if (sp > XB_SPIN_CAP) { atomicAdd(&bar[XB_TMO], 1u); break; } }
    }
    nloc = mine > 0u ? mine : 1u; nx = cnt > 0u ? cnt : 1u;
}
__device__ __forceinline__ void xcd_barrier(const XcdBarrier& b, int wv) {
    asm volatile("s_waitcnt vmcnt(0)" ::: "memory");
    __syncthreads();
    if (wv == 0 && lane_id_v() == 0) {
        unsigned* bar = b.bar;
        __builtin_amdgcn_s_waitcnt(0);
        unsigned nloc = b.st[0], nx = b.st[1];
        if (nloc == 0u) { xcd_barrier_complete(bar, b.x, nloc, nx); b.st[0] = nloc; b.st[1] = nx; }
        const unsigned old = xb_add(&bar[XB_XSUB(b.x)], 1u);
        const unsigned gen = old / nloc;
        if (old + 1u == (gen + 1u) * nloc) {
            __builtin_amdgcn_fence(__ATOMIC_RELEASE, "agent");
            asm volatile("s_waitcnt vmcnt(0)" ::: "memory");
            const unsigned og = xb_add(&bar[XB_TOP], 1u);
            const unsigned tg = og / nx;
            if (og + 1u == (tg + 1u) * nx) xb_add(&bar[XB_TOPGEN], 1u);
            else XB_SPIN(xb_ld(&bar[XB_TOPGEN]) == tg, bar);
            __builtin_amdgcn_fence(__ATOMIC_ACQUIRE, "agent");
            xb_add(&bar[XB_XGEN(b.x)], 1u);
            asm volatile("s_waitcnt vmcnt(0)" ::: "memory");
        } else {
            XB_SPIN(xb_ld(&bar[XB_XGEN(b.x)]) == gen, bar);
            __builtin_amdgcn_fence(__ATOMIC_ACQUIRE, "agent");
            asm volatile("s_waitcnt vmcnt(0)" ::: "memory");
        }
    }
    __syncthreads();
}

struct Args {
    const float* x; const float* c; const int* pos; const float* ada_w; const float* ada_b; const float* mix_norm; const float* ffn_norm;
    const float* a_w_in; const float* a_conv_w; const float* a_conv_b; const float* a_gx_w; const float* a_gx_b; const float* a_ga_w; const float* a_ga_b;
    const float* a_lambda; const float* a_w_out; const float* kv_norm; const float* kv_ada_w; const float* kv_ada_b; const float* w_kv; const float* k_norm;
    const float* b_w_q; const float* b_q_norm; const float* b_sinks; const float* b_w_o; const float* f_w_gu; const float* f_w_down; const float* m_router;
    const float* m_w_gu; const float* m_w_down;
    float* out; unsigned char* ws; int ph_lo, ph_hi;
};

struct Ctx {
    LAS unsigned char* lds; int tid, lane, wave, vcu, G, cid;
};

struct TrItem { const float* src; unsigned char* dst; int N, K, d0, d1, f8; };
__device__ __forceinline__ void tr_load(const TrItem& t, f32x4 (&v)[16], int lane) {
    const int kr = lane >> 4, nq = lane & 15;
#pragma unroll
    for (int i = 0; i < 16; ++i) v[i] = *(const f32x4*)(t.src + (size_t)(4 * i + kr) * t.N + 4 * nq);
}
__device__ __forceinline__ void tr_to_lds(const f32x4 (&v)[16], LAS float* scr, int lane) {
    const int kr = lane >> 4, nq = lane & 15;
#pragma unroll
    for (int i = 0; i < 16; ++i) { const int k = 4 * i + kr; *(LAS f32x4*)(scr + k * 68 + ((4 * nq) ^ (4 * ((k >> 3) & 7)))) = v[i]; }
}
__device__ __forceinline__ void tr_finish(const TrItem& t, LAS float* scr, int lane) {
    const int c = lane & 7, r = lane >> 3;
    if (t.f8) {
#pragma unroll
        for (int j = 0; j < 8; ++j) { const int n = 8 * j + r; const LAS float* s = scr + (8 * c) * 68 + (n ^ (4 * c)); const int drow = ((n & 32) ? t.d1 : t.d0) + (n & 31);
            u32x2 o; o.x = cvt4_fp8(s[0 * 68] * SC8_W, s[1 * 68] * SC8_W, s[2 * 68] * SC8_W, s[3 * 68] * SC8_W); o.y = cvt4_fp8(s[4 * 68] * SC8_W, s[5 * 68] * SC8_W, s[6 * 68] * SC8_W, s[7 * 68] * SC8_W);
            *(u32x2*)(t.dst + (size_t)drow * t.K + 8 * c) = o; }
    } else {
#pragma unroll
        for (int j = 0; j < 8; ++j) { const int n = 8 * j + r; const LAS float* s = scr + (8 * c) * 68 + (n ^ (4 * c)); const int drow = ((n & 32) ? t.d1 : t.d0) + (n & 31);
            u32x4 o; o.x = cvtpk(s[0 * 68], s[1 * 68]); o.y = cvtpk(s[2 * 68], s[3 * 68]); o.z = cvtpk(s[4 * 68], s[5 * 68]); o.w = cvtpk(s[6 * 68], s[7 * 68]);
            *(u32x4*)(t.dst + ((size_t)drow * t.K + 8 * c) * 2) = o; }
    }
}
__device__ __forceinline__ int map_plain(int n) { return n; }
__device__ __forceinline__ int map_head(int n) { const int hd = n >> 6, d = n & 63; return 256 * (hd >> 2) + 128 * (d >> 5) + 32 * (hd & 3) + (d & 31); }
__device__ __forceinline__ int map_gu(int n, int F) { const int u = n >= F, j = u ? n - F : n; return 256 * (j >> 7) + 128 * u + (j & 127); }

__device__ __forceinline__ void p0_prologue(const Ctx& F, const Args& a) {
    unsigned char* ws = a.ws;
    {
        LAS float* cs = (LAS float*)F.lds;
        LAS float* red = (LAS float*)(F.lds + 65536);
        for (int i = F.tid; i < BATCH * DM; i += 512) { const int b = i >> 10, k = i & 1023; const float v = a.c[i]; cs[k * 16 + b] = silu_(v); }
        __syncthreads();
        float* modv = (float*)(ws + WS_MODV); float* kvmod = (float*)(ws + WS_KVMOD);
        constexpr int NC = 4 * 6144 + 2048, CPB = 104;
        for (int cb = F.vcu; cb * CPB < NC; cb += F.G) {
            const int cl = F.tid & 127, kp = F.tid >> 7, j = cb * CPB + cl;
            const bool on = (cl < CPB) && (j < NC);
            float accv[16];
#pragma unroll
            for (int b = 0; b < 16; ++b) accv[b] = 0.f;
            if (on) {
                const float* W; int ldw, jj;
                if (j < 4 * 6144) { const int l = j / 6144; jj = j - l * 6144; W = a.ada_w + (size_t)l * DM * 6144; ldw = 6144; } else { jj = j - 4 * 6144; W = a.kv_ada_w; ldw = 2048; }
                const float* wp = W + (size_t)(kp * 256) * ldw + jj;
#pragma unroll 1
                for (int k0 = 0; k0 < 256; k0 += 16) {
                    float wv[16];
#pragma unroll
                    for (int kk = 0; kk < 16; ++kk) wv[kk] = wp[(size_t)(k0 + kk) * ldw];
#pragma unroll
                    for (int kk = 0; kk < 16; ++kk) { const float w = wv[kk]; const LAS f32x4* cv = (const LAS f32x4*)(cs + (kp * 256 + k0 + kk) * 16);
#pragma unroll
                        for (int q = 0; q < 4; ++q) { const f32x4 c4 = cv[q]; accv[4 * q] += w * c4[0]; accv[4 * q + 1] += w * c4[1]; accv[4 * q + 2] += w * c4[2]; accv[4 * q + 3] += w * c4[3]; } } }
            }
#pragma unroll
            for (int b = 0; b < 16; ++b) red[(kp * 128 + cl) * 16 + b] = accv[b];
            __syncthreads();
            for (int i = F.tid; i < CPB * 16; i += 512) { const int cl2 = i >> 4, b = i & 15, j2 = cb * CPB + cl2;
                if (j2 < NC) { const float s = (red[(0 * 128 + cl2) * 16 + b] + red[(1 * 128 + cl2) * 16 + b]) + (red[(2 * 128 + cl2) * 16 + b] + red[(3 * 128 + cl2) * 16 + b]);
                    if (j2 < 4 * 6144) { const int l = j2 / 6144, jj = j2 - l * 6144; modv[((size_t)l * 16 + b) * 6144 + jj] = s + a.ada_b[l * 6144 + jj]; }
                    else { const int jj = j2 - 4 * 6144; kvmod[(size_t)b * 2048 + jj] = s + a.kv_ada_b[jj]; } } }
            __syncthreads();
        }
    }
    {
        LAS float* scr = (LAS float*)(F.lds + F.wave * 17408);
        const int gw = F.vcu * 8 + F.wave, NGW = F.G * 8;
        constexpr int I_WIN = 16 * 32, I_SQ = 16 * 16, I_KV = 16 * 8, I_FGU = 16 * 96, I_FDN = 48 * 16, I_MGU = 16 * 112, I_MDN = 56 * 16;
        constexpr int NMOE = DEFER_L3 ? 8 : 16;
        constexpr int NITEMS = 2 * I_WIN + 2 * I_SQ + I_KV + 2 * I_SQ + 2 * I_SQ + 2 * I_FGU + 2 * I_FDN + NMOE * I_MGU + NMOE * I_MDN;
        auto decode = [&](int it) -> TrItem {
            TrItem t; int r = it; const float* W; unsigned char* D; int K, N, kb, n0, f8 = 0, mapk = 0, F = 0;
            if (r < 2 * I_WIN) { const int mi = r / I_WIN, rr = r % I_WIN; n0 = 64 * (rr % 32); kb = rr / 32; K = DM; N = 2048; W = a.a_w_in + (size_t)mi * DM * 2048; D = ws + WS_WIN + (size_t)mi * 2048 * DM * 2; }
            else if ((r -= 2 * I_WIN) < 2 * I_SQ) { const int mi = r / I_SQ, rr = r % I_SQ; n0 = 64 * (rr % 16); kb = rr / 16; K = DM; N = DM; W = a.a_w_out + (size_t)mi * DM * DM; D = ws + WS_WOUT + (size_t)mi * DM * DM * 2; }
            else if ((r -= 2 * I_SQ) < I_KV) { n0 = 64 * (r % 8); kb = r / 8; K = DM; N = 512; W = a.w_kv; D = ws + WS_WKV; mapk = 3; }
            else if ((r -= I_KV) < 2 * I_SQ) { const int mi = r / I_SQ, rr = r % I_SQ; n0 = 64 * (rr % 16); kb = rr / 16; K = DM; N = DM; W = a.b_w_q + (size_t)mi * DM * DM; D = ws + WS_WQ + (size_t)mi * DM * DM * 2; mapk = 1; }
            else if ((r -= 2 * I_SQ) < 2 * I_SQ) { const int mi = r / I_SQ, rr = r % I_SQ; n0 = 64 * (rr % 16); kb = rr / 16; K = DM; N = DM; W = a.b_w_o + (size_t)mi * DM * DM; D = ws + WS_WO + (size_t)mi * DM * DM * 2; }
            else if ((r -= 2 * I_SQ) < 2 * I_FGU) { const int mi = r / I_FGU, rr = r % I_FGU; n0 = 64 * (rr % 96); kb = rr / 96; K = DM; N = 6144; W = a.f_w_gu + (size_t)mi * DM * 6144; D = ws + WS_FGU + (size_t)mi * 6144 * DM * 2; f8 = FP8_OF(2 * mi); mapk = 2; F = DFF; }
            else if ((r -= 2 * I_FGU) < 2 * I_FDN) { const int mi = r / I_FDN, rr = r % I_FDN; n0 = 64 * (rr % 16); kb = rr / 16; K = DFF; N = DM; W = a.f_w_down + (size_t)mi * DFF * DM; D = ws + WS_FDN + (size_t)mi * DM * DFF * 2; f8 = FP8_OF(2 * mi); }
            else if ((r -= 2 * I_FDN) < NMOE * I_MGU) { const int mi = r / I_MGU, rr = r % I_MGU; n0 = 64 * (rr % 112); kb = rr / 112; K = DM; N = 7168; W = a.m_w_gu + (size_t)mi * DM * 7168; f8 = FP8_OF(2 * (mi >> 3) + 1); mapk = 2; F = DFE;
                D = ws + WS_MGU + (size_t)(mi >> 3) * 8 * 7168 * DM * 2 + (size_t)(mi & 7) * 7168 * DM * (f8 ? 1 : 2); }
            else { r -= NMOE * I_MGU; const int mi = r / I_MDN, rr = r % I_MDN; n0 = 64 * (rr % 16); kb = rr / 16; K = DFE; N = DM; W = a.m_w_down + (size_t)mi * DFE * DM; f8 = FP8_OF(2 * (mi >> 3) + 1);
                D = ws + WS_MDN + (size_t)(mi >> 3) * 8 * DM * DFE * 2 + (size_t)(mi & 7) * DM * DFE * (f8 ? 1 : 2); }
            t.src = W + (size_t)(64 * kb) * N + n0; t.dst = D + (size_t)(64 * kb) * (f8 ? 1 : 2); t.N = N; t.K = K; t.f8 = f8;
            if (mapk == 1 || (mapk == 3 && n0 < 256)) { t.d0 = map_head(n0); t.d1 = map_head(n0 + 32); }
            else if (mapk == 2) { t.d0 = map_gu(n0, F); t.d1 = map_gu(n0 + 32, F); }
            else { t.d0 = n0; t.d1 = n0 + 32; }
            return t; };
        f32x4 tv[16];
        int it = gw;
        TrItem cur = decode(it < NITEMS ? it : 0);
        if (it < NITEMS) tr_load(cur, tv, F.lane);
        for (; it < NITEMS; it += NGW) {
            tr_to_lds(tv, scr, F.lane);
            const bool hn = it + NGW < NITEMS;
            const TrItem nxt = decode(hn ? it + NGW : it);
            if (hn) tr_load(nxt, tv, F.lane);
            LDS_WAIT(); asm volatile("" ::: "memory");
            tr_finish(cur, scr, F.lane);
            LDS_WAIT(); asm volatile("" ::: "memory");
            cur = nxt;
        }
        __syncthreads();
    }
    {
        float* par = (float*)(ws + WS_PAR);
        const size_t gt0 = (size_t)F.vcu * 512 + F.tid, GT0 = (size_t)F.G * 512;
        for (size_t i = gt0; i < (size_t)PAR_END; i += GT0) { const int j = (int)i; float v;
            if (j < PAR_FFNN) v = a.mix_norm[j - PAR_MIXN]; else if (j < PAR_CONVW) v = a.ffn_norm[j - PAR_FFNN]; else if (j < PAR_CONVB) v = a.a_conv_w[j - PAR_CONVW];
            else if (j < PAR_GXB) v = a.a_conv_b[j - PAR_CONVB]; else if (j < PAR_GAB) v = a.a_gx_b[j - PAR_GXB]; else if (j < PAR_LAM) v = a.a_ga_b[j - PAR_GAB];
            else if (j < PAR_KVN) v = a.a_lambda[j - PAR_LAM]; else if (j < PAR_KN) v = a.kv_norm[j - PAR_KVN]; else if (j < PAR_QN) v = a.k_norm[j - PAR_KN];
            else if (j < PAR_SINK) v = a.b_q_norm[j - PAR_QN]; else if (j < PAR_ROUTER) v = a.b_sinks[j - PAR_SINK]; else v = a.m_router[j - PAR_ROUTER];
            par[j] = v; }
    }
    {
        const size_t gt = (size_t)F.vcu * 512 + F.tid, GT = (size_t)F.G * 512;
        bf16_t* gwp = (bf16_t*)(ws + WS_GW);
        for (size_t i = gt; i < (size_t)2 * 8 * 2 * 128 * 128; i += GT) { const int k = (int)(i & 127), j = (int)((i >> 7) & 127), c2 = (int)((i >> 14) & 1), n = (int)((i >> 15) & 7), l = (int)(i >> 18);
            const float* g = (j < 64) ? a.a_ga_w : a.a_gx_w; const float v = g[((size_t)(l * 8 + n) * 128 + k) * 128 + 64 * c2 + (j & 63)];
            gwp[i] = (bf16_t)(cvtpk(v, 0.f) & 0xffffu); }
        float* ct = (float*)(ws + WS_COS); float* st = (float*)(ws + WS_SIN);
        for (size_t i = gt; i < (size_t)NTOK * 32; i += GT) { const int p = (int)(i & 31); const size_t tok = i >> 5;
            const float inv = powf(10000.0f, -(float)(2 * p) / 64.0f); const float ang = (float)a.pos[tok] * inv;
            ct[i] = cosf(ang); st[i] = sinf(ang); }
    }
}

__device__ __forceinline__ void convert_deferred(const Ctx& F, const float* m_w_gu, const float* m_w_down, unsigned char* ws, int half, int j, int nb) {
    constexpr int I_MGU = 16 * 112, I_MDN = 56 * 16, NIT = 8 * I_MGU + 8 * I_MDN;
    LAS float* scr = (LAS float*)(F.lds + F.wave * 17408);
    auto decode = [&](int it) -> TrItem {
        TrItem t; int r = it; const float* W; unsigned char* D; int K, N, kb, n0; const int f8 = FP8_OF(3);
        if (r < 8 * I_MGU) { const int e = r / I_MGU, rr = r % I_MGU; n0 = 64 * (rr % 112); kb = rr / 112; K = DM; N = 7168; W = m_w_gu + (size_t)(8 + e) * DM * 7168;
            D = ws + WS_MGU + (size_t)8 * 7168 * DM * 2 + (size_t)e * 7168 * DM * (f8 ? 1 : 2); t.d0 = map_gu(n0, DFE); t.d1 = map_gu(n0 + 32, DFE); }
        else { r -= 8 * I_MGU; const int e = r / I_MDN, rr = r % I_MDN; n0 = 64 * (rr % 16); kb = rr / 16; K = DFE; N = DM; W = m_w_down + (size_t)(8 + e) * DFE * DM;
            D = ws + WS_MDN + (size_t)8 * DM * DFE * 2 + (size_t)e * DM * DFE * (f8 ? 1 : 2); t.d0 = n0; t.d1 = n0 + 32; }
        t.src = W + (size_t)(64 * kb) * N + n0; t.dst = D + (size_t)(64 * kb) * (f8 ? 1 : 2); t.N = N; t.K = K; t.f8 = f8;
        return t; };
    const int lo = half ? NIT / 2 : 0, hi = half ? NIT : NIT / 2, step = nb * 8;
    f32x4 tv[16];
    int it = lo + j * 8 + F.wave;
    TrItem cur = decode(it < hi ? it : lo);
    if (it < hi) tr_load(cur, tv, F.lane);
    for (; it < hi; it += step) {
        tr_to_lds(tv, scr, F.lane);
        const bool hn = it + step < hi;
        const TrItem nxt = decode(hn ? it + step : it);
        if (hn) tr_load(nxt, tv, F.lane);
        LDS_WAIT(); asm volatile("" ::: "memory");
        tr_finish(cur, scr, F.lane);
        LDS_WAIT(); asm volatile("" ::: "memory");
        cur = nxt;
    }
}

template <bool DUAL, bool ROUTER, bool OUT8 = false, bool INF32 = false>
__device__ __forceinline__ void norm_phase(const Ctx& F, const void* x, const float* gain1, const float* sh1, const float* sc1, void* out1,
                                           const float* gain2, const float* sh2, const float* sc2, bf16_t* out2,
                                           const float* wrouter, int* e12, float* w1o, int* cnt) {
    LAS int* lcnt = (LAS int*)F.lds;
    for (int rb = F.vcu; rb < NTOK / 256; rb += F.G) {
        const int b = rb >> 4;
        if (ROUTER) { if (F.tid < 16) lcnt[F.tid] = 0; __syncthreads(); }
        float ca[16], cs[16], ca2[16], cs2[16];
#pragma unroll
        for (int j = 0; j < 4; ++j) { const int col = 4 * F.lane + 256 * j;
            const f32x4 g = *(const f32x4*)(gain1 + col), s = *(const f32x4*)(sc1 + (size_t)b * 6144 + col), h = *(const f32x4*)(sh1 + (size_t)b * 6144 + col);
#pragma unroll
            for (int q = 0; q < 4; ++q) { ca[4 * j + q] = g[q] * (1.0f + s[q]); cs[4 * j + q] = h[q]; }
            if (DUAL) { const f32x4 g2 = *(const f32x4*)(gain2 + col), s2 = *(const f32x4*)(sc2 + (size_t)b * 2048 + col), h2 = *(const f32x4*)(sh2 + (size_t)b * 2048 + col);
#pragma unroll
                for (int q = 0; q < 4; ++q) { ca2[4 * j + q] = g2[q] * (1.0f + s2[q]); cs2[4 * j + q] = h2[q]; } } }
        float wr_[ROUTER ? 128 : 1];
        if (ROUTER) {
#pragma unroll
            for (int j = 0; j < 4; ++j)
#pragma unroll
                for (int q = 0; q < 4; ++q) { const int col = 4 * F.lane + 256 * j + q; const f32x4 w0 = *(const f32x4*)(wrouter + (size_t)col * 8), w1 = *(const f32x4*)(wrouter + (size_t)col * 8 + 4);
#pragma unroll
                    for (int e = 0; e < 4; ++e) { wr_[(4 * j + q) * 8 + e] = w0[e]; wr_[(4 * j + q) * 8 + 4 + e] = w1[e]; } }
        }
        int me12 = 0; float mw1 = 0.f;
        const int rowb = rb * 256 + F.wave * 32;
        f32x4 nf[INF32 ? 4 : 1]; u32x2 nb[INF32 ? 1 : 4], nc[INF32 ? 1 : 4];
        if constexpr (ROUTER) { const u32x2* xr = (const u32x2*)((const bf16_t*)x + (size_t)rowb * DM) + F.lane;
#pragma unroll
            for (int j = 0; j < 4; ++j) nb[j] = xr[64 * j]; }
        else if constexpr (INF32) { const f32x4* xr = (const f32x4*)((const float*)x + (size_t)rowb * DM) + F.lane;
#pragma unroll
            for (int j = 0; j < 4; ++j) nf[j] = xr[64 * j]; }
        else { const u32x2* xr = (const u32x2*)((const bf16_t*)x + (size_t)rowb * DM) + F.lane;
#pragma unroll
            for (int j = 0; j < 4; ++j) { nb[j] = xr[64 * j]; nc[j] = xr[64 * j + DM / 4]; } }
        for (int rr = 0; rr < 32; ++rr) {
            const size_t row = (size_t)(rowb + rr);
            f32x4 v[4]; float s = 0.f;
            if constexpr (ROUTER) {
#pragma unroll
                for (int j = 0; j < 4; ++j) { const u32x2 p = nb[j]; v[j] = (f32x4){bflo(p.x), bfhi(p.x), bflo(p.y), bfhi(p.y)}; }
                if (rr + 1 < 32) { const u32x2* xr = (const u32x2*)((const bf16_t*)x + (row + 1) * DM) + F.lane;
#pragma unroll
                    for (int j = 0; j < 4; ++j) nb[j] = xr[64 * j]; } }
            else if constexpr (INF32) {
#pragma unroll
                for (int j = 0; j < 4; ++j) v[j] = nf[j];
                if (rr + 1 < 32) { const f32x4* xr = (const f32x4*)((const float*)x + (row + 1) * DM) + F.lane;
#pragma unroll
                    for (int j = 0; j < 4; ++j) nf[j] = xr[64 * j]; } }
            else {
#pragma unroll
                for (int j = 0; j < 4; ++j) { const u32x2 p = nb[j]; v[j] = (f32x4){bflo(p.x), bfhi(p.x), bflo(p.y), bfhi(p.y)}; nb[j] = nc[j]; }
                if (rr + 2 < 32) { const u32x2* xr = (const u32x2*)((const bf16_t*)x + (row + 2) * DM) + F.lane;
#pragma unroll
                    for (int j = 0; j < 4; ++j) nc[j] = xr[64 * j]; } }
#pragma unroll
            for (int j = 0; j < 4; ++j) s += (v[j][0] * v[j][0] + v[j][1] * v[j][1]) + (v[j][2] * v[j][2] + v[j][3] * v[j][3]);
            const float r = __builtin_amdgcn_rsqf(wave_sum(s, F.lane) * (1.0f / DM) + EPS);
            float hv[16];
#pragma unroll
            for (int j = 0; j < 4; ++j)
#pragma unroll
                for (int q = 0; q < 4; ++q) hv[4 * j + q] = v[j][q] * r * ca[4 * j + q] + cs[4 * j + q];
            if constexpr (OUT8) { unsigned* o4 = (unsigned*)((unsigned char*)out1 + row * DM) + F.lane;
#pragma unroll
                for (int j = 0; j < 4; ++j) o4[64 * j] = cvt4_fp8(hv[4 * j] * SC8_H, hv[4 * j + 1] * SC8_H, hv[4 * j + 2] * SC8_H, hv[4 * j + 3] * SC8_H); }
            else { u32x2* o8 = (u32x2*)((bf16_t*)out1 + row * DM) + F.lane;
#pragma unroll
                for (int j = 0; j < 4; ++j) { u32x2 w; w.x = cvtpk(hv[4 * j], hv[4 * j + 1]); w.y = cvtpk(hv[4 * j + 2], hv[4 * j + 3]); o8[64 * j] = w; } }
            if (DUAL) { u32x2* p8 = (u32x2*)(out2 + row * DM) + F.lane;
#pragma unroll
                for (int j = 0; j < 4; ++j) { float t[4];
#pragma unroll
                    for (int q = 0; q < 4; ++q) t[q] = v[j][q] * r * ca2[4 * j + q] + cs2[4 * j + q];
                    u32x2 w; w.x = cvtpk(t[0], t[1]); w.y = cvtpk(t[2], t[3]); p8[64 * j] = w; } }
            if (ROUTER) {
                float pe[8];
#pragma unroll
                for (int e = 0; e < 8; ++e) { float p = 0.f;
#pragma unroll
                    for (int c = 0; c < 16; ++c) p += hv[c] * wr_[c * 8 + e];
                    pe[e] = p; }
                { const bool b0 = F.lane & 1, b1 = F.lane & 2, b2 = F.lane & 4;
#pragma unroll
                  for (int e = 0; e < 8; e += 2) { const float snd = b0 ? pe[e] : pe[e + 1], kp = b0 ? pe[e + 1] : pe[e]; pe[e >> 1] = kp + shflx(snd, F.lane, 1); }
#pragma unroll
                  for (int i = 0; i < 4; i += 2) { const float snd = b1 ? pe[i] : pe[i + 1], kp = b1 ? pe[i + 1] : pe[i]; pe[i >> 1] = kp + shflx(snd, F.lane, 2); }
                  { const float snd = b2 ? pe[0] : pe[1], kp = b2 ? pe[1] : pe[0]; pe[0] = kp + shflx(snd, F.lane, 4); }
                  pe[0] += shflx(pe[0], F.lane, 8); pe[0] += shflx(pe[0], F.lane, 16); pe[0] += shflx(pe[0], F.lane, 32); }
                float lg[8];
#pragma unroll
                for (int e = 0; e < 8; ++e) lg[e] = __int_as_float(__builtin_amdgcn_readlane(__float_as_int(pe[0]), e));
                int i1 = 0; float v1 = lg[0];
#pragma unroll
                for (int e = 1; e < 8; ++e) if (lg[e] > v1) { v1 = lg[e]; i1 = e; }
                int i2 = -1; float v2 = -INFINITY;
#pragma unroll
                for (int e = 0; e < 8; ++e) if (e != i1 && lg[e] > v2) { v2 = lg[e]; i2 = e; }
                const float wt = 1.0f / (1.0f + __expf(v2 - v1));
                if (F.lane == rr) { me12 = i1 | (i2 << 8); mw1 = wt; }
            }
        }
        if (ROUTER) {
            if (F.lane < 32) { e12[rowb + F.lane] = me12; w1o[rowb + F.lane] = mw1; }
            const int e1 = me12 & 255, e2 = me12 >> 8;
#pragma unroll
            for (int e = 0; e < 8; ++e) { const unsigned long long m1 = __ballot(F.lane < 32 && e1 == e), m2 = __ballot(F.lane < 32 && e2 == e);
                if (F.lane == 0) { atomicAdd((int*)&lcnt[e], (int)__popcll(m1)); atomicAdd((int*)&lcnt[8 + e], (int)__popcll(m2)); } }
            __syncthreads();
            if (F.tid < 16) cnt[rb * 16 + F.tid] = lcnt[F.tid];
            __syncthreads();
        }
    }
}

template <bool DUAL, bool ROUTER, bool OUT8 = false, bool INF32 = false>
__device__ __forceinline__ void norm_phase_pk(const Ctx& F, const void* x, const float* gain1, const float* sh1, const float* sc1, void* out1,
                                           const float* gain2, const float* sh2, const float* sc2, bf16_t* out2,
                                           const float* wrouter, int* e12, float* w1o, int* cnt) {
    LAS int* lcnt = (LAS int*)F.lds;
    constexpr float SH = OUT8 ? SC8_H : 1.0f;
    for (int rb = F.vcu; rb < NTOK / 256; rb += F.G) {
        const int b = rb >> 4;
        if (ROUTER) { if (F.tid < 16) lcnt[F.tid] = 0; __syncthreads(); }
        f32x2 ca[8], cs[8], cb[DUAL ? 8 : 1], cd[DUAL ? 8 : 1];
#pragma unroll
        for (int j = 0; j < 4; ++j) { const int col = 4 * F.lane + 256 * j;
            const f32x4 g = *(const f32x4*)(gain1 + col), sc = *(const f32x4*)(sc1 + (size_t)b * 6144 + col), h = *(const f32x4*)(sh1 + (size_t)b * 6144 + col);
#pragma unroll
            for (int hh = 0; hh < 2; ++hh) { ca[2 * j + hh] = (f32x2){g[2 * hh] * (1.0f + sc[2 * hh]) * SH, g[2 * hh + 1] * (1.0f + sc[2 * hh + 1]) * SH}; cs[2 * j + hh] = (f32x2){h[2 * hh] * SH, h[2 * hh + 1] * SH}; }
            if constexpr (DUAL) { const f32x4 g2 = *(const f32x4*)(gain2 + col), s2 = *(const f32x4*)(sc2 + (size_t)b * 2048 + col), h2 = *(const f32x4*)(sh2 + (size_t)b * 2048 + col);
#pragma unroll
                for (int hh = 0; hh < 2; ++hh) { cb[2 * j + hh] = (f32x2){g2[2 * hh] * (1.0f + s2[2 * hh]), g2[2 * hh + 1] * (1.0f + s2[2 * hh + 1])}; cd[2 * j + hh] = (f32x2){h2[2 * hh], h2[2 * hh + 1]}; } } }
        f32x2 wr2[ROUTER ? 16 : 1][4];
        if constexpr (ROUTER) {
#pragma unroll
            for (int j = 0; j < 4; ++j)
#pragma unroll
                for (int q = 0; q < 4; ++q) { const int col = 4 * F.lane + 256 * j + q; const f32x4 w0 = *(const f32x4*)(wrouter + (size_t)col * 8), w1 = *(const f32x4*)(wrouter + (size_t)col * 8 + 4);
                    wr2[4 * j + q][0] = (f32x2){w0[0], w0[1]} * (1.0f / SH); wr2[4 * j + q][1] = (f32x2){w0[2], w0[3]} * (1.0f / SH); wr2[4 * j + q][2] = (f32x2){w1[0], w1[1]} * (1.0f / SH); wr2[4 * j + q][3] = (f32x2){w1[2], w1[3]} * (1.0f / SH); }
        }
        int me12 = 0; float mw1 = 0.f;
        const int rowb = rb * 256 + F.wave * 32;
        f32x4 nf[INF32 ? 4 : 1]; u32x2 nb[INF32 ? 1 : 4], nc[INF32 ? 1 : 4];
        if constexpr (INF32) { const f32x4* xr = (const f32x4*)((const float*)x + (size_t)rowb * DM) + F.lane;
#pragma unroll
            for (int j = 0; j < 4; ++j) nf[j] = xr[64 * j]; }
        else { const u32x2* xr = (const u32x2*)((const bf16_t*)x + (size_t)rowb * DM) + F.lane;
#pragma unroll
            for (int j = 0; j < 4; ++j) { nb[j] = xr[64 * j]; nc[j] = xr[64 * j + DM / 4]; } }
        for (int rr = 0; rr < 32; ++rr) {
            const size_t row = (size_t)(rowb + rr);
            f32x2 v[8];
            if constexpr (INF32) {
#pragma unroll
                for (int j = 0; j < 4; ++j) { v[2 * j] = (f32x2){nf[j][0], nf[j][1]}; v[2 * j + 1] = (f32x2){nf[j][2], nf[j][3]}; }
                if (rr + 1 < 32) { const f32x4* xr = (const f32x4*)((const float*)x + (row + 1) * DM) + F.lane;
#pragma unroll
                    for (int j = 0; j < 4; ++j) nf[j] = xr[64 * j]; } }
            else {
#pragma unroll
                for (int j = 0; j < 4; ++j) { const u32x2 p = nb[j]; v[2 * j] = (f32x2){bflo(p.x), bfhi(p.x)}; v[2 * j + 1] = (f32x2){bflo(p.y), bfhi(p.y)}; nb[j] = nc[j]; }
                if (rr + 2 < 32) { const u32x2* xr = (const u32x2*)((const bf16_t*)x + (row + 2) * DM) + F.lane;
#pragma unroll
                    for (int j = 0; j < 4; ++j) nc[j] = xr[64 * j]; } }
            f32x2 sq = v[0] * v[0];
#pragma unroll
            for (int i = 1; i < 8; ++i) sq += v[i] * v[i];
            const float r = __builtin_amdgcn_rsqf(wave_sum_dpp(sq.x + sq.y) * (1.0f / DM) + EPS);
            const f32x2 r2 = {r, r};
            f32x2 hv[8];
#pragma unroll
            for (int i = 0; i < 8; ++i) { v[i] = v[i] * r2; hv[i] = v[i] * ca[i] + cs[i]; }
            if constexpr (OUT8) { unsigned* o4 = (unsigned*)((unsigned char*)out1 + row * DM) + F.lane;
#pragma unroll
                for (int j = 0; j < 4; ++j) o4[64 * j] = cvt4_fp8(hv[2 * j].x, hv[2 * j].y, hv[2 * j + 1].x, hv[2 * j + 1].y); }
            else { u32x2* o8 = (u32x2*)((bf16_t*)out1 + row * DM) + F.lane;
#pragma unroll
                for (int j = 0; j < 4; ++j) { u32x2 w; w.x = cvtpk(hv[2 * j].x, hv[2 * j].y); w.y = cvtpk(hv[2 * j + 1].x, hv[2 * j + 1].y); o8[64 * j] = w; } }
            if constexpr (DUAL) { u32x2* p8 = (u32x2*)(out2 + row * DM) + F.lane;
#pragma unroll
                for (int j = 0; j < 4; ++j) { const f32x2 t0 = v[2 * j] * cb[2 * j] + cd[2 * j], t1 = v[2 * j + 1] * cb[2 * j + 1] + cd[2 * j + 1];
                    u32x2 w; w.x = cvtpk(t0.x, t0.y); w.y = cvtpk(t1.x, t1.y); p8[64 * j] = w; } }
            if constexpr (ROUTER) {
                f32x2 pp[4];
#pragma unroll
                for (int k = 0; k < 4; ++k) pp[k] = (f32x2){0.f, 0.f};
#pragma unroll
                for (int c = 0; c < 16; ++c) { const float hc = (c & 1) ? hv[c >> 1].y : hv[c >> 1].x; const f32x2 h2 = {hc, hc};
#pragma unroll
                    for (int k = 0; k < 4; ++k) pp[k] += h2 * wr2[c][k]; }
                float pe[8];
#pragma unroll
                for (int k = 0; k < 4; ++k) { pe[2 * k] = pp[k].x; pe[2 * k + 1] = pp[k].y; }
                { const bool b0 = F.lane & 1, b1 = F.lane & 2, b2 = F.lane & 4;
#pragma unroll
                  for (int e = 0; e < 4; ++e) { const float snd = b2 ? pe[e] : pe[e + 4], kp = b2 ? pe[e + 4] : pe[e]; pe[e] = kp + dppf<0x141>(snd); }
#pragma unroll
                  for (int e = 0; e < 2; ++e) { const float snd = b1 ? pe[e] : pe[e + 2], kp = b1 ? pe[e + 2] : pe[e]; pe[e] = kp + dppf<0x4E>(snd); }
                  { const float snd = b0 ? pe[0] : pe[1], kp = b0 ? pe[1] : pe[0]; pe[0] = kp + dppf<0xB1>(snd); }
                  pe[0] += dppf<0x128>(pe[0]); pe[0] += shflx(pe[0], F.lane, 16); pe[0] += shflx(pe[0], F.lane, 32); }
                float lg[8];
#pragma unroll
                for (int e = 0; e < 8; ++e) lg[e] = __int_as_float(__builtin_amdgcn_readlane(__float_as_int(pe[0]), e));
                int i1 = 0; float v1 = lg[0];
#pragma unroll
                for (int e = 1; e < 8; ++e) if (lg[e] > v1) { v1 = lg[e]; i1 = e; }
                int i2 = -1; float v2 = -INFINITY;
#pragma unroll
                for (int e = 0; e < 8; ++e) if (e != i1 && lg[e] > v2) { v2 = lg[e]; i2 = e; }
                const float wt = 1.0f / (1.0f + __expf(v2 - v1));
                if (F.lane == rr) { me12 = i1 | (i2 << 8); mw1 = wt; }
            }
        }
        if (ROUTER) {
            if (F.lane < 32) { e12[rowb + F.lane] = me12; w1o[rowb + F.lane] = mw1; }
            const int e1 = me12 & 255, e2 = me12 >> 8;
#pragma unroll
            for (int e = 0; e < 8; ++e) { const unsigned long long m1 = __ballot(F.lane < 32 && e1 == e), m2 = __ballot(F.lane < 32 && e2 == e);
                if (F.lane == 0) { atomicAdd((int*)&lcnt[e], (int)__popcll(m1)); atomicAdd((int*)&lcnt[8 + e], (int)__popcll(m2)); } }
            __syncthreads();
            if (F.tid < 16) cnt[rb * 16 + F.tid] = lcnt[F.tid];
            __syncthreads();
        }
    }
}

__device__ __forceinline__ void moe_scatter(const Ctx& F, const int* cnt, const int* e12, const float* w1, int* tos, float* wos, int* tile) {
    LAS int* T1 = (LAS int*)F.lds;
    LAS int* T2 = T1 + 512;
    LAS int* tot = T2 + 512;
    LAS int* pre = tot + 16;
    LAS int* seg = pre + 16;
    LAS int* wcn = seg + 32;
    for (int rb = F.vcu; rb < NTOK / 256; rb += F.G) {
        { const int bin = F.tid & 15, part = F.tid >> 4; int st = 0, sp = 0;
#pragma unroll
            for (int j = 0; j < 8; ++j) { const int b2 = part * 8 + j; const int v = cnt[b2 * 16 + bin]; st += v; if (b2 < rb) sp += v; }
            T1[part * 16 + bin] = st; T2[part * 16 + bin] = sp; }
        __syncthreads();
        if (F.tid < 16) { int st = 0, sp = 0; for (int p = 0; p < 32; ++p) { st += T1[p * 16 + F.tid]; sp += T2[p * 16 + F.tid]; } tot[F.tid] = st; pre[F.tid] = sp; }
        __syncthreads();
        if (F.tid == 0) { int s = 0; for (int bin = 0; bin < 16; ++bin) { seg[bin] = s; s += ((tot[bin] + 255) >> 8) << 8; } seg[16] = s; }
        __syncthreads();
        int e1 = -1, e2 = -1; float wt = 0.f; int r1 = 0, r2 = 0;
        const int token = rb * 256 + F.tid;
        if (F.tid < 256) { const int v = e12[token]; e1 = v & 255; e2 = v >> 8; wt = w1[token]; }
        if (F.wave < 4) {
#pragma unroll
            for (int e = 0; e < 8; ++e) { const unsigned long long m1 = __ballot(e1 == e), m2 = __ballot(e2 == e); const unsigned long long lt = (1ull << F.lane) - 1ull;
                if (e1 == e) r1 = (int)__popcll(m1 & lt); if (e2 == e) r2 = (int)__popcll(m2 & lt);
                if (F.lane == 0) { wcn[F.wave * 16 + e] = (int)__popcll(m1); wcn[F.wave * 16 + 8 + e] = (int)__popcll(m2); } }
        }
        __syncthreads();
        if (F.tid < 256) {
            int o1 = seg[e1] + pre[e1] + r1, o2 = seg[8 + e2] + pre[8 + e2] + r2;
            for (int w = 0; w < F.wave; ++w) { o1 += wcn[w * 16 + e1]; o2 += wcn[w * 16 + 8 + e2]; }
            tos[o1] = token; wos[o1] = wt; tos[o2] = token; wos[o2] = 1.0f - wt;
        }
        if (rb < 16) { const int bin = rb; const int s0 = seg[bin] + tot[bin], s1 = seg[bin + 1]; for (int s = s0 + F.tid; s < s1; s += 512) { tos[s] = -1; wos[s] = 0.f; } }
        if (rb == 0) { if (F.tid == 0) { tile[0] = seg[8] >> 8; tile[1] = seg[16] >> 8; }
            for (int t = F.tid; t < MAXTILES; t += 512) { const int s = t << 8; int e = 0;
#pragma unroll
                for (int bin = 1; bin < 16; ++bin) if (s >= seg[bin]) e = bin;
                tile[16 + t] = e & 7; } }
        __syncthreads();
    }
}

constexpr int SC_AT = 0, SC_WT = 34816, SC_AS = 69632, SC_BS = 102400, SC_SEG = 135168, SC_CARRY = 139264, SC_CW = 139776, SC_GB = 142336;
__device__ __forceinline__ void scan_phase(const Ctx& F, const float* par, int l, const bf16_t* XB, bf16_t* GY, const bf16_t* GW) {
    LAS unsigned char* lds = F.lds;
    LAS float* AS = (LAS float*)(lds + SC_AS); LAS float* BS = (LAS float*)(lds + SC_BS);
    LAS float* SEGA = (LAS float*)(lds + SC_SEG); LAS float* SEGB = SEGA + 512;
    LAS float* CARRY = (LAS float*)(lds + SC_CARRY);
    LAS float* CW = (LAS float*)(lds + SC_CW);
    LAS float* GB = (LAS float*)(lds + SC_GB);
    const int tid = F.tid, lane = F.lane, wid = F.wave, r32 = lane & 31, hh = lane >> 5;
    for (int un = F.vcu; un < 256; un += F.G) {
        const int b = un >> 4, n = (un >> 1) & 7, c2 = un & 1;
        __syncthreads();
        for (int i = tid; i < 640; i += 512) { const int ch = i & 127, k = i >> 7; CW[i] = (k < 4) ? par[PAR_CONVW + (l * 4 + k) * DM + 128 * n + ch] : par[PAR_CONVB + l * DM + 128 * n + ch]; }
        if (tid < 64) { const int ch = l * DM + 128 * n + 64 * c2 + tid; GB[tid] = par[PAR_GAB + ch]; GB[64 + tid] = par[PAR_GXB + ch]; GB[128 + tid] = log1pf(expf(-par[PAR_LAM + ch])); CARRY[tid] = 0.f; CARRY[64 + tid] = 0.f; }
        { const bf16_t* gsrc = GW + (size_t)(((l * 8 + n) * 2 + c2) * 128) * 128;
#pragma unroll
            for (int i = 0; i < 4; ++i) { const int p = tid + 512 * i, row = p >> 4, c16 = p & 15; const u32x4 v = *(const u32x4*)(gsrc + (size_t)row * 128 + c16 * 8); *(LAS u32x4*)(lds + SC_WT + row * 272 + c16 * 16) = v; } }
        const int cp = lane, tg = wid;
        const int sc = lane, sg = wid;
        const size_t rowbase = (size_t)b * SEQ;
        const bf16_t* xbp = XB + rowbase * DM + 128 * n + 2 * cp;
        bf16_t* gyp = GY + rowbase * DM + 128 * n + 64 * c2 + sc;
        unsigned xv[19];
#pragma unroll
        for (int k = 0; k < 19; ++k) { const int t = 16 * tg - 3 + k; xv[k] = (t >= 0) ? *(const unsigned*)(xbp + (size_t)t * DM) : 0u; }
        __syncthreads();
        float w[2][4], cb[2];
#pragma unroll
        for (int q = 0; q < 2; ++q) { cb[q] = CW[512 + 2 * cp + q];
#pragma unroll
            for (int k = 0; k < 4; ++k) w[q][k] = CW[k * 128 + 2 * cp + q]; }
        const float gba = GB[32 * (wid & 1) + r32], gbx = GB[64 + 32 * (wid & 1) + r32], spv = GB[128 + 32 * (wid & 1) + r32];
        for (int ci = 0; ci < SEQ / 128; ++ci) {
            const int t0 = ci * 128;
#pragma unroll
            for (int k = 0; k < 16; ++k) {
                float o[2];
#pragma unroll
                for (int q = 0; q < 2; ++q) { float s = cb[q];
#pragma unroll
                    for (int j = 0; j < 4; ++j) { const unsigned pv = xv[k + j]; const float xf = q ? __uint_as_float(pv & 0xffff0000u) : __uint_as_float(pv << 16); s += w[q][j] * xf; }
                    o[q] = s; }
                *(LAS unsigned*)(lds + SC_AT + (16 * tg + k) * 272 + cp * 4) = cvtpk(o[0], o[1]);
            }
            if (ci + 1 < SEQ / 128) {
#pragma unroll
                for (int k = 0; k < 19; ++k) xv[k] = *(const unsigned*)(xbp + (size_t)(t0 + 128 + 16 * tg - 3 + k) * DM);
            }
            __syncthreads();
            f32x16 ga, gx;
#pragma unroll
            for (int i = 0; i < 16; ++i) { ga[i] = 0.f; gx[i] = 0.f; }
            { const int tt = wid >> 1, ct = wid & 1;
                const LAS unsigned char* ap = lds + SC_AT + (32 * tt + r32) * 272 + hh * 16;
                const LAS unsigned char* bpa = lds + SC_WT + (32 * ct + r32) * 272 + hh * 16;
                const LAS unsigned char* bpx = bpa + 64 * 272;
#pragma unroll
                for (int s = 0; s < 8; ++s) { const bf16x8 af = *(const LAS bf16x8*)(ap + s * 32), ba = *(const LAS bf16x8*)(bpa + s * 32), bx = *(const LAS bf16x8*)(bpx + s * 32);
                    ga = __builtin_amdgcn_mfma_f32_32x32x16_bf16(af, ba, ga, 0, 0, 0); gx = __builtin_amdgcn_mfma_f32_32x32x16_bf16(af, bx, gx, 0, 0, 0); }
                const f32x2 nlv = {-LOG2E, -LOG2E}, bav = {-LOG2E * gba, -LOG2E * gba}, bxv = {-LOG2E * gbx, -LOG2E * gbx}, onev = {1.0f, 1.0f}, csv = {-8.0f * LOG2E * spv, -8.0f * LOG2E * spv};
#pragma unroll
                for (int i = 0; i < 16; i += 2) { const int tok = 32 * tt + (i & 3) + 8 * (i >> 2) + 4 * hh, ch = 32 * ct + r32;
                    const f32x2 a2 = {ga[i], ga[i + 1]}, x2 = {gx[i], gx[i + 1]};
                    const f32x2 ta = a2 * nlv + bav, tx = x2 * nlv + bxv;
                    const f32x2 da = (f32x2){fast_exp2(ta.x), fast_exp2(ta.y)} + onev, dx = (f32x2){fast_exp2(tx.x), fast_exp2(tx.y)} + onev;
                    const f32x2 rg = {fast_rcp(da.x), fast_rcp(da.y)}, ig = {fast_rcp(dx.x), fast_rcp(dx.y)};
                    const f32x2 l2 = rg * csv; const f32x2 av = {fast_exp2(l2.x), fast_exp2(l2.y)};
                    const f32x2 om = onev - av * av; const f32x2 bc = {__builtin_amdgcn_sqrtf(fmaxf(om.x, 0.f)), __builtin_amdgcn_sqrtf(fmaxf(om.y, 0.f))};
                    const f32x2 xc = {bf2f(*(const LAS unsigned short*)(lds + SC_AT + tok * 272 + (64 * c2 + ch) * 2)), bf2f(*(const LAS unsigned short*)(lds + SC_AT + (tok + 1) * 272 + (64 * c2 + ch) * 2))};
                    const f32x2 bb = (bc * ig) * xc;
                    AS[tok * 64 + ch] = av.x; AS[(tok + 1) * 64 + ch] = av.y; BS[tok * 64 + ch] = bb.x; BS[(tok + 1) * 64 + ch] = bb.y; }
            }
            __syncthreads();
            unsigned short gyv[16];
#pragma unroll
            for (int k = 0; k < 16; ++k) gyv[k] = gyp[(size_t)(t0 + 16 * sg + k) * DM];
            float av[16], bv[16];
#pragma unroll
            for (int k = 0; k < 16; ++k) { av[k] = AS[(16 * sg + k) * 64 + sc]; bv[k] = BS[(16 * sg + k) * 64 + sc]; }
            { float pa = 1.f, pb = 0.f;
#pragma unroll
                for (int k = 0; k < 16; ++k) { pb = av[k] * pb + bv[k]; pa *= av[k]; }
                SEGA[sg * 64 + sc] = pa; SEGB[sg * 64 + sc] = pb; }
            __syncthreads();
            float h = CARRY[(ci & 1) * 64 + sc];
            for (int s = 0; s < sg; ++s) h = SEGA[s * 64 + sc] * h + SEGB[s * 64 + sc];
#pragma unroll
            for (int k = 0; k < 16; ++k) { h = av[k] * h + bv[k]; const float o = h * bf2f(gyv[k]); gyp[(size_t)(t0 + 16 * sg + k) * DM] = (bf16_t)(cvtpk(o, 0.f) & 0xffffu); }
            if (sg == 7) CARRY[((ci + 1) & 1) * 64 + sc] = h;
        }
    }
    __syncthreads();
}

constexpr int AT_K = 0, AT_V = 36864;
__device__ __forceinline__ void attn_phase(const Ctx& F, const bf16_t* Q, const bf16_t* Kb, const bf16_t* Vb, bf16_t* O, const float* sinks) {
    LAS unsigned char* lds = F.lds;
    const int tid = F.tid, lane = F.lane, wid = F.wave, r32 = lane & 31, hh = lane >> 5;
    const int i16 = lane & 15, tq = i16 >> 2, tp = i16 & 3, blk = (lane >> 4) & 1;
    const int g = wid & 3, half = wid >> 2;
    constexpr int NU = BATCH * 32 * 4;
    u32x4 kreg[4], vreg[4]; bf16x8 qreg[2][4];
#define AT_LOADKV(unit) do { const int kh_ = (unit) & 3, n_ = ((unit) >> 2) & 31, b_ = (unit) >> 7; \
        _Pragma("unroll") for (int i = 0; i < 4; ++i) { const int p = tid + 512 * i, row = p >> 3, c16 = p & 7; kreg[i] = (u32x4){0u, 0u, 0u, 0u}; vreg[i] = (u32x4){0u, 0u, 0u, 0u}; \
            if (n_ > 0 || row >= 128) { const size_t tok = (size_t)b_ * SEQ + (size_t)(128 * (n_ - 1) + row); kreg[i] = *(const u32x4*)(Kb + tok * 256 + kh_ * 64 + c16 * 8); vreg[i] = *(const u32x4*)(Vb + tok * 256 + kh_ * 64 + c16 * 8); } } } while (0)
#define AT_LOADQ(unit) do { const int kh_ = (unit) & 3, n_ = ((unit) >> 2) & 31, b_ = (unit) >> 7; \
        _Pragma("unroll") for (int ps = 0; ps < 2; ++ps) { const size_t qt_ = (size_t)b_ * SEQ + (size_t)(128 * n_ + 64 * half + 32 * ps + r32); \
            _Pragma("unroll") for (int s = 0; s < 4; ++s) qreg[ps][s] = *(const bf16x8*)(Q + qt_ * DM + (4 * kh_ + g) * 64 + 16 * s + 8 * hh); } } while (0)
    int un = F.vcu;
    if (un < NU) { AT_LOADKV(un); AT_LOADQ(un); }
    for (; un < NU; un += F.G) {
        const int kh = un & 3, n = (un >> 2) & 31, b = un >> 7;
        __syncthreads();
#pragma unroll
        for (int i = 0; i < 4; ++i) { const int p = tid + 512 * i, row = p >> 3, c16 = p & 7;
            *(LAS u32x4*)(lds + AT_K + row * 144 + c16 * 16) = kreg[i]; *(LAS u32x4*)(lds + AT_V + row * 192 + c16 * 16) = vreg[i]; }
        __syncthreads();
        if (un + F.G < NU) AT_LOADKV(un + F.G);
        const int hq = 4 * kh + g;
        const float sink2 = sinks[hq] * LOG2E;
#pragma unroll 1
        for (int pass = 0; pass < 2; ++pass) {
            const int i0 = 64 * half + 32 * pass, kt0 = i0 >> 5;
            const size_t qtok = (size_t)b * SEQ + (size_t)(128 * n + i0 + r32);
            bf16x8 qf[4];
#pragma unroll
            for (int s = 0; s < 4; ++s) qf[s] = pass ? qreg[1][s] : qreg[0][s];
            f32x16 sacc[5];
#pragma unroll
            for (int t = 0; t < 5; ++t) {
                const float s0 = ((n == 0) && (32 * (kt0 + t) < 128)) ? -1.0e30f : 0.f;
#pragma unroll
                for (int i = 0; i < 16; ++i) sacc[t][i] = s0;
#pragma unroll
                for (int s = 0; s < 4; ++s) { const bf16x8 kf = *(const LAS bf16x8*)(lds + AT_K + (32 * (kt0 + t) + r32) * 144 + (16 * s + 8 * hh) * 2);
                    sacc[t] = __builtin_amdgcn_mfma_f32_32x32x16_bf16(kf, qf[s], sacc[t], 0, 0, 0); } }
            float sum = 0.f;
#pragma unroll
            for (int t = 0; t < 5; ++t) {
#pragma unroll
                for (int i = 0; i < 16; ++i) { float p = fast_exp2(sacc[t][i]);
                    if (t == 0 || t == 4) { const int d = 32 * t + (i & 3) + 8 * (i >> 2) + 4 * hh - r32; p = ((d >= 1) && (d <= 128)) ? p : 0.f; }
                    sacc[t][i] = p; sum += p; } }
            sum += shflx(sum, lane, 32);
            sum += fast_exp2(sink2);
            const float inv = 1.0f / sum;
            f32x16 oacc[2];
#pragma unroll
            for (int i = 0; i < 16; ++i) { oacc[0][i] = 0.f; oacc[1][i] = 0.f; }
#pragma unroll
            for (int t = 0; t < 5; ++t)
#pragma unroll
                for (int s = 0; s < 2; ++s) {
                    u32x4 pk; pk.x = cvtpk(sacc[t][8 * s], sacc[t][8 * s + 1]); pk.y = cvtpk(sacc[t][8 * s + 2], sacc[t][8 * s + 3]); pk.z = cvtpk(sacc[t][8 * s + 4], sacc[t][8 * s + 5]); pk.w = cvtpk(sacc[t][8 * s + 6], sacc[t][8 * s + 7]);
                    const bf16x8 pb = __builtin_bit_cast(bf16x8, pk);
#pragma unroll
                    for (int dt = 0; dt < 2; ++dt) {
                        const LAS unsigned char* vp = lds + AT_V + (32 * (kt0 + t) + 16 * s + 4 * hh + tq) * 192 + (32 * dt + 16 * blk + 4 * tp) * 2;
                        const s16x4 lo = __builtin_bit_cast(s16x4, __builtin_amdgcn_ds_read_tr16_b64_v4i16((LAS s16x4*)vp));
                        const s16x4 hi = __builtin_bit_cast(s16x4, __builtin_amdgcn_ds_read_tr16_b64_v4i16((LAS s16x4*)(vp + 8 * 192)));
                        const bf16x8 va = __builtin_shufflevector(lo, hi, 0, 1, 2, 3, 4, 5, 6, 7);
                        oacc[dt] = __builtin_amdgcn_mfma_f32_32x32x16_bf16(va, pb, oacc[dt], 0, 0, 0);
                    }
                }
            bf16_t* op = O + qtok * DM + hq * 64;
#pragma unroll
            for (int dt = 0; dt < 2; ++dt)
#pragma unroll
                for (int q4 = 0; q4 < 4; ++q4) { u32x2 w; w.x = cvtpk(oacc[dt][4 * q4] * inv, oacc[dt][4 * q4 + 1] * inv); w.y = cvtpk(oacc[dt][4 * q4 + 2] * inv, oacc[dt][4 * q4 + 3] * inv);
                    *(u32x2*)(op + 32 * dt + 8 * q4 + 4 * hh) = w; }
        }
        if (un + F.G < NU) AT_LOADQ(un + F.G);
    }
#undef AT_LOADKV
#undef AT_LOADQ
    __syncthreads();
}

constexpr int NPHASE = 33 + (DUP_SCANPAIR ? 4 : 0);
__global__ void __launch_bounds__(512, 2) fwd_kernel(Args a) {
    extern __shared__ __attribute__((aligned(16))) unsigned char lds_raw[];
    volatile LAS unsigned* MISC = (volatile LAS unsigned*)((LAS unsigned char*)lds_raw + LDS_MISC);
    const int wv0 = __builtin_amdgcn_readfirstlane((int)threadIdx.x >> 6);
    if (wv0 == 0) MISC[lane_id_v()] = 0u;
    __syncthreads();
    XcdBarrier bar; bar.bar = (unsigned*)(a.ws + WS_CTL) + CW_BAR; bar.x = 0; bar.st = MISC;
    if (!MK_MULTI) bar = xcd_barrier_post((unsigned*)(a.ws + WS_CTL) + CW_BAR, MISC, wv0);
    const int lo = a.ph_lo, hi = a.ph_hi;
    int ph = 0;
#define PH_BEGIN(k) if (((PHSEL >> (k)) & 1) && (!MK_MULTI || (lo <= ph && ph < hi))) { Ctx F; { int t_ = wv0 * 64 + (int)lane_id_v(); asm volatile("" : "+v"(t_)); F.tid = t_; } F.lds = (LAS unsigned char*)lds_raw; F.lane = F.tid & 63; \
        F.wave = __builtin_amdgcn_readfirstlane(F.tid >> 6); F.G = gridDim.x; { int bx = blockIdx.x; asm volatile("" : "+s"(bx)); F.cid = bx; F.vcu = (F.G % 8 == 0) ? (bx % 8) * (F.G / 8) + bx / 8 : bx; } \
        unsigned char GAS* wsg_ = (unsigned char GAS*)a.ws; asm volatile("" : "+s"(wsg_)); unsigned char* ws = (unsigned char*)wsg_; float GAS* xog_ = (float GAS*)a.out; asm volatile("" : "+s"(xog_)); float* xo = (float*)xog_; int l = l_; asm volatile("" : "+s"(l)); (void)xo; (void)l; \
        for (int rep_ = 0; rep_ < (((DUPMASK >> (k)) & 1) ? 2 : 1); ++rep_) {
#define PH_END   } if (!MK_MULTI && ph + 1 < NPHASE) { XcdBarrier b2_ = bar; unsigned GAS* bp_ = (unsigned GAS*)b2_.bar; asm volatile("" : "+s"(bp_)); b2_.bar = (unsigned*)bp_; unsigned bx_ = b2_.x; asm volatile("" : "+s"(bx_)); b2_.x = bx_; xcd_barrier(b2_, wv0); } } ++ph;
#define W_PAR    ((const float*)(ws + WS_PAR))
#define W_XS     ((bf16_t*)(ws + WS_XS))
#define W_MODL   ((const float*)(ws + WS_MODV) + (size_t)l * 16 * 6144)
#define W_KVMOD  ((const float*)(ws + WS_KVMOD))
#define W_HB     ((bf16_t*)(ws + WS_H))
#define W_HKV    ((bf16_t*)(ws + WS_HKV))
#define W_KB     ((bf16_t*)(ws + WS_KB))
#define W_VB     ((bf16_t*)(ws + WS_VB))
#define W_XB     ((bf16_t*)(ws + WS_ARENA + AR_XB))
#define W_GY     ((bf16_t*)(ws + WS_ARENA + AR_GY))
#define W_HID    ((bf16_t*)(ws + WS_ARENA))
#define W_Q      ((bf16_t*)(ws + WS_ARENA + AR_Q))
#define W_O      ((bf16_t*)(ws + WS_ARENA + AR_O))
#define W_COS    ((const float*)(ws + WS_COS))
#define W_SIN    ((const float*)(ws + WS_SIN))
#define W_E12    ((int*)(ws + WS_E12))
#define W_W1     ((float*)(ws + WS_W1))
#define W_CNT    ((int*)(ws + WS_CNT))
#define W_TILE   ((int*)(ws + WS_TILE))
#define W_TOS    ((int*)(ws + WS_TOS))
#define W_WOS    ((float*)(ws + WS_WOS))

    { const int l_ = 0; PH_BEGIN(0) p0_prologue(F, a); PH_END }

#pragma unroll 1
    for (int l_ = 0; l_ < 4; ++l_) {
        if (l_ < 2) {
            PH_BEGIN(1) if (l == 0) norm_phase<false, false, false, true>(F, a.x, W_PAR + PAR_MIXN + l * DM, W_MODL, W_MODL + 1024, W_HB, nullptr, nullptr, nullptr, nullptr, nullptr, nullptr, nullptr, nullptr);
                        else norm_phase<false, false>(F, W_XS, W_PAR + PAR_MIXN + l * DM, W_MODL, W_MODL + 1024, W_HB, nullptr, nullptr, nullptr, nullptr, nullptr, nullptr, nullptr, nullptr); PH_END
#pragma unroll 1
            for (int sp_ = 0; sp_ < (DUP_SCANPAIR ? 2 : 1); ++sp_) {
            PH_BEGIN(2) { pg8::ProbDense P{W_HB, (const bf16_t*)(ws + WS_WIN) + (size_t)l * 2048 * DM, DM * 2}; pg8::Order S; S.init(NTOK / 256, 8, F.G, F.cid, 0);
                pg8::EpiWin E{W_XB, W_GY}; pg8::gemm_phase<pg8::EpiWin, pg8::ProbDense, false>(F.lds, F.tid, P, S, E); } PH_END
            PH_BEGIN(3) scan_phase(F, W_PAR, l, W_XB, W_GY, (const bf16_t*)(ws + WS_GW)); PH_END
            }
            if (l_ == 0) {
                PH_BEGIN(20) { pg8::ProbDense P{W_GY, (const bf16_t*)(ws + WS_WOUT), DM * 2}; pg8::Order S; S.init(NTOK / 256, 4, F.G, F.cid, 0, STAGGER_TICKS);
                    pg8::EpiResid<true> E{a.x, W_XS, W_MODL + 2048, 1.0f}; pg8::gemm_phase<pg8::EpiResid<true>, pg8::ProbDense, false>(F.lds, F.tid, P, S, E); } PH_END
            } else {
                PH_BEGIN(4) { pg8::ProbDense P{W_GY, (const bf16_t*)(ws + WS_WOUT) + (size_t)l * DM * DM, DM * 2}; pg8::Order S; S.init(NTOK / 256, 4, F.G, F.cid, 0, STAGGER_TICKS);
                    pg8::EpiResid<false> E{W_XS, W_XS, W_MODL + 2048, 1.0f}; pg8::gemm_phase<pg8::EpiResid<false>, pg8::ProbDense, false>(F.lds, F.tid, P, S, E); } PH_END
            }
        } else {
            PH_BEGIN(5) if (l == 2) norm_phase<true, false>(F, W_XS, W_PAR + PAR_MIXN + l * DM, W_MODL, W_MODL + 1024, W_HB, W_PAR + PAR_KVN, W_KVMOD, W_KVMOD + 1024, W_HKV, nullptr, nullptr, nullptr, nullptr);
                        else norm_phase<false, false>(F, W_XS, W_PAR + PAR_MIXN + l * DM, W_MODL, W_MODL + 1024, W_HB, nullptr, nullptr, nullptr, nullptr, nullptr, nullptr, nullptr, nullptr); PH_END
            if (l_ == 2) {
                PH_BEGIN(6) {
                    { pg8::ProbDense P{W_HKV, (const bf16_t*)(ws + WS_WKV), DM * 2}; pg8::Order S; S.init(NTOK / 256, 2, F.G, F.cid, 0);
                      pg8::EpiQK E{W_KB, 256, W_PAR + PAR_KN, W_COS, W_SIN, 1.0f, 1, W_VB}; pg8::gemm_phase<pg8::EpiQK, pg8::ProbDense, false>(F.lds, F.tid, P, S, E); }
                    { pg8::ProbDense P{W_HB, (const bf16_t*)(ws + WS_WQ), DM * 2}; pg8::Order S; S.init(NTOK / 256, 4, F.G, F.cid, 0);
                      pg8::EpiQK E{W_Q, DM, W_PAR + PAR_QN, W_COS, W_SIN, 0.125f * LOG2E, -1, nullptr}; pg8::gemm_phase<pg8::EpiQK, pg8::ProbDense, false>(F.lds, F.tid, P, S, E); } } PH_END
            } else {
                PH_BEGIN(21) { pg8::ProbDense P{W_HB, (const bf16_t*)(ws + WS_WQ) + (size_t)DM * DM, DM * 2}; pg8::Order S; S.init(NTOK / 256, 4, F.G, F.cid, 0);
                    pg8::EpiQK E{W_Q, DM, W_PAR + PAR_QN + 64, W_COS, W_SIN, 0.125f * LOG2E, -1, nullptr}; pg8::gemm_phase<pg8::EpiQK, pg8::ProbDense, false>(F.lds, F.tid, P, S, E); } PH_END
            }
            PH_BEGIN(7) attn_phase(F, W_Q, W_KB, W_VB, W_O, W_PAR + PAR_SINK + (l - 2) * 16); PH_END
            PH_BEGIN(8) { pg8::ProbDense P{W_O, (const bf16_t*)(ws + WS_WO) + (size_t)(l - 2) * DM * DM, DM * 2}; pg8::Order S; S.init(NTOK / 256, 4, F.G, F.cid, 0, STAGGER_TICKS);
                pg8::EpiResid<false> E{W_XS, W_XS, W_MODL + 2048, 1.0f}; pg8::gemm_phase<pg8::EpiResid<false>, pg8::ProbDense, false>(F.lds, F.tid, P, S, E); } PH_END
        }
        if (!(l_ & 1)) {
            PH_BEGIN(9) if (FP8_OF(0) | FP8_OF(2)) { if (FP8_DENSE(l)) norm_phase<false, false, true>(F, W_XS, W_PAR + PAR_FFNN + l * DM, W_MODL + 3072, W_MODL + 4096, W_HB, nullptr, nullptr, nullptr, nullptr, nullptr, nullptr, nullptr, nullptr);
                             else norm_phase<false, false, false>(F, W_XS, W_PAR + PAR_FFNN + l * DM, W_MODL + 3072, W_MODL + 4096, W_HB, nullptr, nullptr, nullptr, nullptr, nullptr, nullptr, nullptr, nullptr); }
                        else norm_phase<false, false, false>(F, W_XS, W_PAR + PAR_FFNN + l * DM, W_MODL + 3072, W_MODL + 4096, W_HB, nullptr, nullptr, nullptr, nullptr, nullptr, nullptr, nullptr, nullptr); PH_END
            if (FP8_DENSE(l_)) {
                PH_BEGIN(17) { pg8::ProbDense P{W_HB, ws + WS_FGU + (size_t)(l >> 1) * 6144 * DM * 2, DM}; pg8::Order S; S.init(NTOK / 256, 24, F.G, F.cid, 0);
                    pg8::EpiSwiglu<true> E{W_HID, DFF, 1.0f / (SC8_H * SC8_W)}; pg8::gemm_phase<pg8::EpiSwiglu<true>, pg8::ProbDense, false, true>(F.lds, F.tid, P, S, E); } PH_END
                PH_BEGIN(18) { pg8::ProbDense P{W_HID, ws + WS_FDN + (size_t)(l >> 1) * DM * DFF * 2, DFF}; pg8::Order S; S.init(NTOK / 256, 4, F.G, F.cid, 0, STAGGER_TICKS);
                    pg8::EpiResid<false> E{W_XS, W_XS, W_MODL + 5120, 1.0f / (SC8_HID * SC8_W)}; pg8::gemm_phase<pg8::EpiResid<false>, pg8::ProbDense, false, true>(F.lds, F.tid, P, S, E); } PH_END
            } else {
                PH_BEGIN(10) { pg8::ProbDense P{W_HB, (const bf16_t*)(ws + WS_FGU) + (size_t)(l >> 1) * 6144 * DM, DM * 2}; pg8::Order S; S.init(NTOK / 256, 24, F.G, F.cid, 0);
                    pg8::EpiSwiglu<false> E{W_HID, DFF, 1.0f}; pg8::gemm_phase<pg8::EpiSwiglu<false>, pg8::ProbDense, false>(F.lds, F.tid, P, S, E); } PH_END
                PH_BEGIN(11) { pg8::ProbDense P{W_HID, (const bf16_t*)(ws + WS_FDN) + (size_t)(l >> 1) * DM * DFF, DFF * 2}; pg8::Order S; S.init(NTOK / 256, 4, F.G, F.cid, 0, STAGGER_TICKS);
                    pg8::EpiResid<false> E{W_XS, W_XS, W_MODL + 5120, 1.0f}; pg8::gemm_phase<pg8::EpiResid<false>, pg8::ProbDense, false>(F.lds, F.tid, P, S, E); } PH_END
            }
        } else {
            PH_BEGIN(12) if (FP8_MOE(l)) norm_phase_pk<false, true, true>(F, W_XS, W_PAR + PAR_FFNN + l * DM, W_MODL + 3072, W_MODL + 4096, W_HB, nullptr, nullptr, nullptr, nullptr, W_PAR + PAR_ROUTER + (l >> 1) * DM * 8, W_E12, W_W1, W_CNT);
                         else norm_phase_pk<false, true, false>(F, W_XS, W_PAR + PAR_FFNN + l * DM, W_MODL + 3072, W_MODL + 4096, W_HB, nullptr, nullptr, nullptr, nullptr, W_PAR + PAR_ROUTER + (l >> 1) * DM * 8, W_E12, W_W1, W_CNT); PH_END
            PH_BEGIN(13) moe_scatter(F, W_CNT, W_E12, W_W1, W_TOS, W_WOS, W_TILE); PH_END
            if (FP8_MOE(l_)) {
                PH_BEGIN(16) {
                    LAS int* texp = (LAS int*)(F.lds + LDS_TEXP);
                    for (int i = F.tid; i < MAXTILES + 16; i += 512) texp[i] = W_TILE[i];
                    __syncthreads();
                    const int ntot = texp[1];
                    pg8::Order S; S.init(ntot, 28, F.G, F.cid, 0);
                    pg8::ProbGrouped P{W_HB, ws + WS_MGU + (size_t)(l >> 1) * 8 * 7168 * DM * 2, DM, 7168, texp + 16, W_TOS};
                    pg8::EpiSwiglu<true> E{W_HID, DFE, 1.0f / (SC8_H * SC8_W)}; pg8::gemm_phase<pg8::EpiSwiglu<true>, pg8::ProbGrouped, true, true>(F.lds, F.tid, P, S, E); } PH_END
            } else {
                PH_BEGIN(14) {
                    LAS int* texp = (LAS int*)(F.lds + LDS_TEXP);
                    for (int i = F.tid; i < MAXTILES + 16; i += 512) texp[i] = W_TILE[i];
                    __syncthreads();
                    const int ntot = texp[1];
                    pg8::Order S; S.init(ntot, 28, F.G, F.cid, 0);
                    pg8::ProbGrouped P{W_HB, (const bf16_t*)(ws + WS_MGU) + (size_t)(l >> 1) * 8 * 7168 * DM, DM * 2, 7168, texp + 16, W_TOS};
                    pg8::EpiSwiglu<false> E{W_HID, DFE, 1.0f}; pg8::gemm_phase<pg8::EpiSwiglu<false>, pg8::ProbGrouped, true, false>(F.lds, F.tid, P, S, E); } PH_END
            }
#pragma unroll 1
            for (int pass = 0; pass < 2; ++pass) {
                if (l_ == 3 && pass == 1) {
                    PH_BEGIN(19) {
                        LAS int* texp = (LAS int*)(F.lds + LDS_TEXP);
                        for (int i = F.tid; i < MAXTILES + 16; i += 512) texp[i] = W_TILE[i];
                        __syncthreads();
                        const int nA = texp[0], ntot = texp[1];
                        pg8::Order S; S.init(ntot - nA, 4, F.G, F.cid, nA, STAGGER_TICKS);
                        if (FP8_MOE(3)) { pg8::ProbGrouped P{W_HID, ws + WS_MDN + (size_t)8 * DM * DFE * 2, DFE, DM, texp + 16, W_TOS};
                            pg8::EpiMoeDown<true> E{W_XS, xo, W_MODL + 5120, W_TOS, W_WOS, 1.0f / (SC8_HID * SC8_W)}; pg8::gemm_phase<pg8::EpiMoeDown<true>, pg8::ProbGrouped, false, true>(F.lds, F.tid, P, S, E); }
                        else { pg8::ProbGrouped P{W_HID, (const bf16_t*)(ws + WS_MDN) + (size_t)8 * DM * DFE, DFE * 2, DM, texp + 16, W_TOS};
                            pg8::EpiMoeDown<true> E{W_XS, xo, W_MODL + 5120, W_TOS, W_WOS, 1.0f}; pg8::gemm_phase<pg8::EpiMoeDown<true>, pg8::ProbGrouped, false, false>(F.lds, F.tid, P, S, E); } } PH_END
                } else {
                    PH_BEGIN(15) {
                        LAS int* texp = (LAS int*)(F.lds + LDS_TEXP);
                        for (int i = F.tid; i < MAXTILES + 16; i += 512) texp[i] = W_TILE[i];
                        __syncthreads();
                        const int nA = texp[0], ntot = texp[1];
                        pg8::Order S; S.init(pass ? ntot - nA : nA, 4, F.G, F.cid, pass ? nA : 0, STAGGER_TICKS);
                        if (FP8_MOE(l)) { pg8::ProbGrouped P{W_HID, ws + WS_MDN + (size_t)(l >> 1) * 8 * DM * DFE * 2, DFE, DM, texp + 16, W_TOS};
                            pg8::EpiMoeDown<false> E{W_XS, W_XS, W_MODL + 5120, W_TOS, W_WOS, 1.0f / (SC8_HID * SC8_W)}; pg8::gemm_phase<pg8::EpiMoeDown<false>, pg8::ProbGrouped, false, true>(F.lds, F.tid, P, S, E); }
                        else { pg8::ProbGrouped P{W_HID, (const bf16_t*)(ws + WS_MDN) + (size_t)(l >> 1) * 8 * DM * DFE, DFE * 2, DM, texp + 16, W_TOS};
                            pg8::EpiMoeDown<false> E{W_XS, W_XS, W_MODL + 5120, W_TOS, W_WOS, 1.0f}; pg8::gemm_phase<pg8::EpiMoeDown<false>, pg8::ProbGrouped, false, false>(F.lds, F.tid, P, S, E); }
                        if (DEFER_L3 && l == 1) {
                            const int tail = S.nwg % F.G; const bool part = (tail > 0) && (2 * tail < F.G);
                            __syncthreads();
                            if (!part || F.cid >= tail) convert_deferred(F, a.m_w_gu, a.m_w_down, ws, pass, part ? F.cid - tail : F.cid, part ? F.G - tail : F.G);
                        } } PH_END
                }
            }
        }
    }
#undef PH_BEGIN
#undef PH_END
}

extern "C" void kernel_launch(void* const* d_in, const int* in_sizes, int n_in, void* d_out, int out_size, void* d_ws, size_t ws_size, hipStream_t stream) {
    static int grid = 0;
    if (grid == 0) {
        if (n_in != 30 || in_sizes[0] != NTOK * DM || out_size != NTOK * DM || ws_size < WS_END) { fprintf(stderr, "kernel_launch: unexpected shapes (n_in %d, in0 %d, out %d, ws %zu < %zu)\n", n_in, n_in > 0 ? in_sizes[0] : -1, out_size, ws_size, (size_t)WS_END); grid = -1; return; }
        int dev = 0, cus = 0, per_cu = 0;
        if (hipGetDevice(&dev) != hipSuccess || hipDeviceGetAttribute(&cus, hipDeviceAttributeMultiprocessorCount, dev) != hipSuccess) { grid = -1; return; }
        if (hipFuncSetAttribute((const void*)fwd_kernel, hipFuncAttributeMaxDynamicSharedMemorySize, LDS_BYTES) != hipSuccess) { fprintf(stderr, "kernel_launch: hipFuncSetAttribute failed\n"); grid = -1; return; }
        if (hipOccupancyMaxActiveBlocksPerMultiprocessor(&per_cu, (const void*)fwd_kernel, 512, LDS_BYTES) != hipSuccess || per_cu < 1) fprintf(stderr, "kernel_launch: occupancy query reports %d\n", per_cu);
        (void)hipGetLastError();
        grid = cus;
    }
    if (grid < 0) return;
    if (hipMemsetAsync((char*)d_ws + WS_CTL, 0, CTL_ZERO_BYTES, stream) != hipSuccess) return;
    Args a{};
    const float** fp = (const float**)&a;
    for (int i = 0; i < 30; ++i) fp[i] = (const float*)d_in[i];
    a.out = (float*)d_out; a.ws = (unsigned char*)d_ws;
#if MK_MULTI
    for (int p = 0; p < NPHASE; ++p) { a.ph_lo = p; a.ph_hi = p + 1; hipLaunchKernelGGL(fwd_kernel, dim3(grid), dim3(512), LDS_BYTES, stream, a); }
#else
    a.ph_lo = 0; a.ph_hi = NPHASE; hipLaunchKernelGGL(fwd_kernel, dim3(grid), dim3(512), LDS_BYTES, stream, a);
#endif
}
```

```cpp
#include <hip/hip_runtime.h>
#include <cstdio>
#include <cstdint>

#ifndef FP8MASK
#define FP8MASK 14
#endif
#define FP8_OF(l) (((FP8MASK) >> (l)) & 1)
#define FP8_MOE(l)   ((FP8_OF(1) && FP8_OF(3)) || ((FP8_OF(1) || FP8_OF(3)) && FP8_OF(l)))
#define FP8_DENSE(l) ((FP8_OF(0) && FP8_OF(2)) || ((FP8_OF(0) || FP8_OF(2)) && FP8_OF(l)))
#ifndef STAGGER_TICKS
#define STAGGER_TICKS 0
#endif
#ifndef DEFER_L3
#define DEFER_L3 1
#endif
#ifndef DUPMASK
#define DUPMASK 0
#endif
#ifndef DUP_SCANPAIR
#define DUP_SCANPAIR 0
#endif
#ifndef PHSEL
#define PHSEL 0xFFFFFFFFu
#endif
#ifndef MK_MULTI
#define MK_MULTI 0
#endif

#define LAS __attribute__((address_space(3)))
#define GAS __attribute__((address_space(1)))
typedef unsigned short bf16_t;
typedef short bf16x8 __attribute__((ext_vector_type(8)));
typedef short s16x4 __attribute__((ext_vector_type(4)));
typedef _Float16 h16x8 __attribute__((ext_vector_type(8)));
typedef float f32x2 __attribute__((ext_vector_type(2)));
typedef float f32x4 __attribute__((ext_vector_type(4)));
typedef float f32x16 __attribute__((ext_vector_type(16)));
typedef unsigned u32x2 __attribute__((ext_vector_type(2)));
typedef unsigned u32x4 __attribute__((ext_vector_type(4)));
typedef __bf16 bf16x2_t __attribute__((ext_vector_type(2)));
typedef int i32x4 __attribute__((ext_vector_type(4)));
typedef int i32x8 __attribute__((ext_vector_type(8)));
constexpr float SC8_H = 4.0f, SC8_W = 64.0f, SC8_HID = 8.0f;

constexpr int DM = 1024, BATCH = 16, SEQ = 4096, NTOK = BATCH * SEQ;
constexpr int DFF = 3072, NEXP = 8, DFE = 3584;
constexpr int NSLOT = 135168;
constexpr int MAXTILES = NSLOT / 256;
constexpr float EPS = 1e-6f;
constexpr float LOG2E = 1.4426950408889634f;

constexpr size_t MiB = 1u << 20;
constexpr size_t WS_CTL = 0, CTL_ZERO_BYTES = 1 * MiB;
constexpr size_t WS_MODV = 1 * MiB;
constexpr size_t WS_KVMOD = 3 * MiB;
constexpr size_t WS_PAR = 3 * MiB + 512 * 1024;
constexpr int PAR_MIXN = 0, PAR_FFNN = 4096, PAR_CONVW = 8192, PAR_CONVB = 16384, PAR_GXB = 18432, PAR_GAB = 20480, PAR_LAM = 22528, PAR_KVN = 24576, PAR_KN = 25600, PAR_QN = 25664, PAR_SINK = 25792, PAR_ROUTER = 25856, PAR_END = 42240;
constexpr size_t WS_E12 = 4 * MiB;
constexpr size_t WS_W1 = 5 * MiB;
constexpr size_t WS_CNT = 6 * MiB;
constexpr size_t WS_TILE = 6 * MiB + 65536;
constexpr size_t WS_TOS = 7 * MiB;
constexpr size_t WS_WOS = 8 * MiB;
constexpr size_t WS_GW = 9 * MiB;
constexpr size_t WS_COS = 10 * MiB;
constexpr size_t WS_SIN = 18 * MiB;
constexpr size_t WS_WIN = 26 * MiB;
constexpr size_t WS_WOUT = 34 * MiB;
constexpr size_t WS_WKV = 38 * MiB;
constexpr size_t WS_WQ = 39 * MiB;
constexpr size_t WS_WO = 43 * MiB;
constexpr size_t WS_FGU = 47 * MiB;
constexpr size_t WS_FDN = 71 * MiB;
constexpr size_t WS_MGU = 83 * MiB;
constexpr size_t WS_MDN = 307 * MiB;
constexpr size_t WS_H = 419 * MiB;
constexpr size_t WS_HKV = 547 * MiB;
constexpr size_t WS_KB = 675 * MiB;
constexpr size_t WS_VB = 707 * MiB;
constexpr size_t WS_ARENA = 739 * MiB;
constexpr size_t WS_XS = WS_ARENA + (size_t)NSLOT * DFE * 2;
constexpr size_t WS_END = WS_XS + (size_t)NTOK * DM * 2;
static_assert(WS_END <= (size_t)1792 * MiB, "workspace map");
constexpr size_t AR_XB = 0, AR_GY = 128 * MiB, AR_Q = 0, AR_O = 128 * MiB;

constexpr int CW_BAR = 4096;

constexpr int LDS_BYTES = 163840;
constexpr int RING_BYTES = 131072;
constexpr int LDS_TEXP = RING_BYTES;
constexpr int LDS_IDX = RING_BYTES + 4096;
constexpr int LDS_MISC = LDS_BYTES - 256;

__device__ __forceinline__ unsigned cvtpk(float lo, float hi) { f32x2 v = {lo, hi}; bf16x2_t b = __builtin_convertvector(v, bf16x2_t); return __builtin_bit_cast(unsigned, b); }
__device__ __forceinline__ float clamp8(float v) { return __builtin_amdgcn_fmed3f(v, -448.0f, 448.0f); }
__device__ __forceinline__ unsigned cvt4_fp8(float a, float b, float c, float d) { int p = __builtin_amdgcn_cvt_pk_fp8_f32(clamp8(a), clamp8(b), 0, false); p = __builtin_amdgcn_cvt_pk_fp8_f32(clamp8(c), clamp8(d), p, true); return (unsigned)p; }
__device__ __forceinline__ float bflo(unsigned p) { return __uint_as_float(p << 16); }
__device__ __forceinline__ float bfhi(unsigned p) { return __uint_as_float(p & 0xffff0000u); }
__device__ __forceinline__ float bf2f(unsigned short b) { return __uint_as_float(((unsigned)b) << 16); }
__device__ __forceinline__ float fast_exp2(float x) { return __builtin_amdgcn_exp2f(x); }
__device__ __forceinline__ float fast_rcp(float x) { return __builtin_amdgcn_rcpf(x); }
__device__ __forceinline__ float sigmoidf_(float x) { return fast_rcp(1.0f + fast_exp2(-x * LOG2E)); }
__device__ __forceinline__ float silu_(float x) { return x * sigmoidf_(x); }
__device__ __forceinline__ float gelu_tanh_(float x) { const float u = 0.7978845608028654f * (x + 0.044715f * x * x * x); return x * sigmoidf_(2.0f * u); }
__device__ __forceinline__ float shflx(float v, int lane, int o) { return __int_as_float(__builtin_amdgcn_ds_bpermute((lane ^ o) << 2, __float_as_int(v))); }
__device__ __forceinline__ float wave_sum(float v, int lane) {
#pragma unroll
    for (int o = 1; o < 64; o <<= 1) v += shflx(v, lane, o);
    return v;
}
template <int CTRL, int RM = 0xf, int BM = 0xf> __device__ __forceinline__ float dppf(float v) { return __int_as_float(__builtin_amdgcn_update_dpp(0, __float_as_int(v), CTRL, RM, BM, false)); }
__device__ __forceinline__ float wave_sum_dpp(float v) {
    float s = v + dppf<0x111>(v); s += dppf<0x112>(v); s += dppf<0x113>(v);
    s += dppf<0x114>(s); s += dppf<0x118>(s);
    s += dppf<0x142, 0xa>(s); s += dppf<0x143, 0xc>(s);
    return __int_as_float(__builtin_amdgcn_readlane(__float_as_int(s), 63));
}
__device__ __forceinline__ int lane_id_v() { int l; asm volatile("v_mbcnt_lo_u32_b32 %0, -1, 0\n\tv_mbcnt_hi_u32_b32 %0, -1, %0" : "=v"(l)); return l; }
#define LDS_WAIT() asm volatile("s_waitcnt lgkmcnt(0)" ::: "memory")
#define VM_WAIT() asm volatile("s_waitcnt vmcnt(0)" ::: "memory")

namespace pg8 {
constexpr int BM = 256, BK = 64, HALF = 128, HTB = HALF * BK * 2, STAGE_BYTES = 8 * HTB, NXCD = 8, WGM = 8;
__host__ __device__ __forceinline__ int lds_byte(int r, int c) { const int st = (r >> 4) * 2 + (c >> 5), rr = r & 15, cc = c & 31, ob = rr * 64 + cc * 2; return st * 1024 + (ob ^ (((ob >> 9) & 1) << 5)); }
__host__ __device__ __forceinline__ void stage_rc(int b, int& R, int& C) { const int st = b / 1024, sb = b % 1024, swz = sb ^ (((sb >> 9) & 1) << 5); R = (st >> 1) * 16 + swz / 64; C = (st & 1) * 32 + (swz % 64) / 2; }
__host__ __device__ __forceinline__ int perm32(int rho) { const int n = rho >> 4, i = rho & 15; return 8 * (i >> 2) + 4 * n + (i & 3); }

struct Unit { int pm, pn; };

struct Order {
    int nM, nN, nwg, G, c, tile0, delay, nig; unsigned mg;
    __device__ __forceinline__ void init(int nM_, int nN_, int G_, int c_, int tile0_, int delay_ = 0) { nM = nM_; nN = nN_; nwg = nM * nN; G = G_; c = c_; tile0 = tile0_; delay = ((c_ >> 3) & 1) ? delay_ : 0;
        nig = WGM * nN; mg = (unsigned)((0x100000000ull + (unsigned)nig - 1ull) / (unsigned)nig); }
    __device__ __forceinline__ bool next(int i, Unit& u) const {
        const int L = i * G + c; if (L >= nwg) return false;
        int wgid; { const int q = nwg >> 3, r = nwg & 7, xcd = L & 7, off = L >> 3; wgid = (xcd < r ? xcd * (q + 1) : r * (q + 1) + (xcd - r) * q) + off; }
        const int gid = (int)__umulhi((unsigned)wgid, mg), rem = wgid - gid * nig, fm = gid * WGM, gsz = (nM - fm) < WGM ? (nM - fm) : WGM;
        if (gsz == WGM) { u.pm = tile0 + fm + (rem & (WGM - 1)); u.pn = rem >> 3; }
        else { u.pm = tile0 + fm + rem % gsz; u.pn = rem / gsz; }
        return true;
    }
};

struct ProbDense {
    const void* A; const void* Bt; int KB;
    __device__ __forceinline__ const char* a_ptr(const Unit& u) const { return (const char*)A + (size_t)u.pm * BM * KB; }
    __device__ __forceinline__ const char* b_ptr(const Unit& u) const { return (const char*)Bt + (size_t)u.pn * BM * KB; }
};
struct ProbGrouped {
    const void* A; const void* Bt; int KB; int N; const LAS int* texp; const int* tos;
    __device__ __forceinline__ const char* a_ptr(const Unit& u) const { return (const char*)A + (size_t)u.pm * BM * KB; }
    __device__ __forceinline__ const char* b_ptr(const Unit& u) const { return (const char*)Bt + ((size_t)texp[u.pm] * N + (size_t)u.pn * BM) * KB; }
};

template <class Epi, class Prob, bool GATHER, bool FP8 = false>
__device__ __forceinline__ void gemm_phase(LAS unsigned char* lds, const int tid, const Prob P, const Order& S, const Epi& E) {
    const int wid = __builtin_amdgcn_readfirstlane(tid >> 6), lane = tid & 63, wr = wid >> 2, wc = wid & 3, fr = lane & 15, fq = lane >> 4;
    const int KB = P.KB, nt = KB / (BK * 2);
    unsigned voffA[2], voffB[2];
#pragma unroll
    for (int i = 0; i < 2; ++i) { int R, C; stage_rc(tid * 16 + i * 8192, R, C); const int Rb = Epi::PERM ? ((R & ~31) + perm32(R & 31)) : R;
        voffA[i] = GATHER ? (unsigned)(C * 2) : (unsigned)(R * KB + C * 2); voffB[i] = (unsigned)(Rb * KB + C * 2); }
    const size_t kstep = (size_t)(BK * 2);
    const size_t hstep = (size_t)HALF * KB;
    const unsigned ldsw = (unsigned)wid * 1024u;
    const int aoff = lds_byte(wr * 64 + fr, fq * 8), boff = lds_byte(wc * 32 + fr, fq * 8);
    LAS int* idxb = (LAS int*)(lds + LDS_IDX);
#define PG8_GIDX(buf) do { int ln_ = lane; asm volatile("" : "+v"(ln_)); _Pragma("unroll") for (int i = 0; i < 2; ++i) { const int R_ = 16 * ((wid + 8 * i) >> 1) + (ln_ >> 2); \
        int t0 = idxb[(buf) * 256 + R_], t1 = idxb[(buf) * 256 + 128 + R_]; t0 = t0 < 0 ? 0 : t0; t1 = t1 < 0 ? 0 : t1; \
        vC0[i] = (unsigned)t0 * (unsigned)KB + voffA[i]; vC1[i] = (unsigned)t1 * (unsigned)KB + voffA[i]; } } while (0)
#define PG8_GDMA(unit, buf) do { if (wid < 4) { int ln_ = lane; asm volatile("" : "+v"(ln_)); \
        __builtin_amdgcn_global_load_lds((const unsigned*)(P.tos + (size_t)(unit).pm * BM + wid * 64) + ln_, (LAS unsigned*)(idxb + (buf) * 256 + wid * 64), 4, 0, 0); } } while (0)
#define PG8_SA(b, h) (((b) * 2 + (h)) * HTB)
#define PG8_SB(b, h) ((4 + (b) * 2 + (h)) * HTB)
#define PG8_STAGE(bufoff, gbase, voff) do { const char* g_ = (const char*)(gbase); asm volatile("" : "+s"(g_)); _Pragma("unroll") for (int _i = 0; _i < 2; ++_i) \
        __builtin_amdgcn_global_load_lds((const unsigned*)(g_ + (voff)[_i]), (LAS unsigned*)(lds + (bufoff) + ldsw + _i * 8192), 16, 0, 0); } while (0)
#define PG8_LDA(dst, b, h) do { _Pragma("unroll") for (int m = 0; m < 4; ++m) _Pragma("unroll") for (int k = 0; k < 2; ++k) dst[m][k] = *(const LAS bf16x8*)(lds + PG8_SA(b, h) + aoff + m * 2048 + k * 1024); } while (0)
#define PG8_LDB(dst, b, h) do { _Pragma("unroll") for (int n = 0; n < 2; ++n) _Pragma("unroll") for (int k = 0; k < 2; ++k) dst[n][k] = *(const LAS bf16x8*)(lds + PG8_SB(b, h) + boff + n * 2048 + k * 1024); } while (0)
#define PG8_CAT8(v) __builtin_shufflevector(__builtin_bit_cast(i32x4, (v)[0]), __builtin_bit_cast(i32x4, (v)[1]), 0, 1, 2, 3, 4, 5, 6, 7)
#define PG8_MMA(ai, bj, At, Bt) do { __builtin_amdgcn_s_setprio(1); if constexpr (FP8) asm volatile("s_nop 1"); _Pragma("unroll") for (int m = 0; m < 4; ++m) _Pragma("unroll") for (int n = 0; n < 2; ++n) { \
        if constexpr (FP8) { const i32x8 b8_ = PG8_CAT8(Bt[n]), a8_ = PG8_CAT8(At[m]);   \
            asm volatile("v_mfma_f32_16x16x128_f8f6f4 %0, %1, %2, %0" : "+v"(acc[ai][bj][m][n]) : "v"(b8_), "v"(a8_)); }     \
        else { _Pragma("unroll") for (int k = 0; k < 2; ++k) acc[ai][bj][m][n] = __builtin_amdgcn_mfma_f32_16x16x32_bf16(Bt[n][k], At[m][k], acc[ai][bj][m][n], 0, 0, 0); } } __builtin_amdgcn_s_setprio(0); } while (0)
#define PG8_WAIT_V(n) asm volatile("s_waitcnt vmcnt(" #n ")" ::: "memory")
#define PG8_WAIT_L(n) asm volatile("s_waitcnt lgkmcnt(" #n ")" ::: "memory")
#define PG8_BAR __builtin_amdgcn_s_barrier()
#define PG8_SCHED __builtin_amdgcn_sched_barrier(0)
    Unit cur, nxt; int ui = 0;
    if (!S.next(0, cur)) return;
    if (S.delay) { const unsigned long long t0_ = __builtin_amdgcn_s_memrealtime(); while (__builtin_amdgcn_s_memrealtime() - t0_ < (unsigned long long)S.delay) __builtin_amdgcn_s_sleep(8); }
    f32x4 acc[2][2][4][2];
#pragma unroll
    for (int a = 0; a < 2; ++a)
#pragma unroll
        for (int b = 0; b < 2; ++b)
#pragma unroll
            for (int m = 0; m < 4; ++m)
#pragma unroll
                for (int n = 0; n < 2; ++n) acc[a][b][m][n] = (f32x4){0.f, 0.f, 0.f, 0.f};
    bf16x8 At[4][2], B0[2][2], B1[2][2];
    unsigned vC0[2], vC1[2];
    const char* cA; const char* cB = P.b_ptr(cur);
    if constexpr (GATHER) {
        cA = (const char*)P.A;
        PG8_GDMA(cur, 0);
        PG8_WAIT_V(0); PG8_BAR;
        PG8_GIDX(0);
        LDS_WAIT(); PG8_BAR;
    } else {
        cA = P.a_ptr(cur);
#pragma unroll
        for (int i = 0; i < 2; ++i) { vC0[i] = voffA[i]; vC1[i] = voffA[i] + (unsigned)hstep; }
    }
    PG8_STAGE(PG8_SB(0, 0), cB, voffB); PG8_STAGE(PG8_SB(0, 1), cB + hstep, voffB); PG8_STAGE(PG8_SA(0, 0), cA, vC0); PG8_STAGE(PG8_SA(0, 1), cA, vC1);
    if (wr == 1) PG8_BAR;
    PG8_WAIT_V(2); PG8_BAR;
    PG8_STAGE(PG8_SB(1, 0), cB + kstep, voffB); PG8_STAGE(PG8_SA(1, 0), cA + kstep, vC0); PG8_STAGE(PG8_SB(1, 1), cB + hstep + kstep, voffB);
    PG8_WAIT_V(6); PG8_BAR;
    for (;;) {
        const bool has_next = S.next(ui + 1, nxt);
        const char* nA = GATHER ? cA : (has_next ? P.a_ptr(nxt) : cA); const char* nB = has_next ? P.b_ptr(nxt) : cB;
        for (int t = 0; t < nt; t += 2) {
            const bool last = (t == nt - 2);
            if constexpr (GATHER) {
                if (t == 0 && has_next) PG8_GDMA(nxt, (ui + 1) & 1);
            }
            const char* a1 = cA + (size_t)(t + 1) * kstep;
            const char* a2 = last ? nA : cA + (size_t)(t + 2) * kstep; const char* b2 = last ? nB : cB + (size_t)(t + 2) * kstep;
            const char* a3 = a2 + kstep; const char* b3 = b2 + kstep;
            PG8_LDB(B0, 0, 0); PG8_LDB(B1, 0, 1); PG8_SCHED; PG8_LDA(At, 0, 0); PG8_STAGE(PG8_SA(1, 1), a1, vC1);
            if constexpr (GATHER) { if (last && has_next) PG8_GIDX((ui + 1) & 1); }
            PG8_WAIT_V(8); PG8_WAIT_L(0); PG8_BAR; PG8_MMA(0, 0, At, B0); PG8_MMA(0, 1, At, B1); PG8_BAR; PG8_SCHED;
            PG8_LDA(At, 0, 1); PG8_STAGE(PG8_SB(0, 0), b2, voffB); PG8_STAGE(PG8_SB(0, 1), b2 + hstep, voffB); PG8_STAGE(PG8_SA(0, 0), a2, vC0);
            PG8_WAIT_V(8); PG8_WAIT_L(0); PG8_BAR; PG8_MMA(1, 0, At, B0); PG8_MMA(1, 1, At, B1); PG8_BAR; PG8_SCHED;
            PG8_LDB(B0, 1, 0); PG8_LDB(B1, 1, 1); PG8_SCHED; PG8_LDA(At, 1, 0); PG8_STAGE(PG8_SA(0, 1), a2, vC1);
            PG8_WAIT_V(8); PG8_WAIT_L(0); PG8_BAR; PG8_MMA(0, 0, At, B0); PG8_MMA(0, 1, At, B1); PG8_BAR; PG8_SCHED;
            PG8_LDA(At, 1, 1); PG8_STAGE(PG8_SB(1, 0), b3, voffB); PG8_STAGE(PG8_SB(1, 1), b3 + hstep, voffB); PG8_STAGE(PG8_SA(1, 0), a3, vC0);
            PG8_WAIT_V(8); PG8_WAIT_L(0); PG8_BAR; PG8_MMA(1, 0, At, B0); PG8_MMA(1, 1, At, B1); PG8_BAR; PG8_SCHED;
        }
        if constexpr (FP8) { asm volatile("s_nop 15\n\ts_nop 15" ::: "memory"); PG8_SCHED; }
        if (wr == 0) PG8_BAR;
        { const int ln_ = lane_id_v(); int fr_ = ln_ & 15, fq_ = ln_ >> 4; asm volatile("" : "+v"(fr_), "+v"(fq_)); E(acc, cur, wr, wc, fr_, fq_); }
        if (!has_next) break;
#pragma unroll
        for (int a = 0; a < 2; ++a)
#pragma unroll
            for (int b = 0; b < 2; ++b)
#pragma unroll
                for (int m = 0; m < 4; ++m)
#pragma unroll
                    for (int n = 0; n < 2; ++n) acc[a][b][m][n] = (f32x4){0.f, 0.f, 0.f, 0.f};
        cur = nxt; cA = nA; cB = nB; ++ui;
        if (wr == 1) PG8_BAR;
    }
    PG8_WAIT_V(0);
    PG8_BAR;
#undef PG8_SA
#undef PG8_GIDX
#undef PG8_GDMA
#undef PG8_SB
#undef PG8_STAGE
#undef PG8_LDA
#undef PG8_LDB
#undef PG8_MMA
#undef PG8_CAT8
#undef PG8_WAIT_V
#undef PG8_WAIT_L
#undef PG8_BAR
#undef PG8_SCHED
}

template <bool INF32> struct EpiResid {
    static constexpr bool PERM = true;
    const void* xin; bf16_t* xout; const float* gate; float ascale;
    __device__ __forceinline__ void operator()(const f32x4 (&acc)[2][2][4][2], const Unit& u, int wr, int wc, int fr, int fq) const {
        const int row0 = u.pm * BM + wr * 64 + fr, col0 = u.pn * BM + wc * 32 + 8 * fq;
        const float* gp = gate + (size_t)((u.pm * BM) >> 12) * 6144 + col0;
        f32x4 gv[2][2];
#pragma unroll
        for (int bj = 0; bj < 2; ++bj)
#pragma unroll
            for (int n = 0; n < 2; ++n) gv[bj][n] = (*(const f32x4*)(gp + bj * HALF + 4 * n) + 1.0f) * ascale;
#pragma unroll
        for (int ai = 0; ai < 2; ++ai) {
            f32x4 xv[4][2][2];
#pragma unroll
            for (int m = 0; m < 4; ++m) { const size_t off = (size_t)(row0 + ai * HALF + m * 16) * DM + col0;
#pragma unroll
                for (int bj = 0; bj < 2; ++bj) {
                    if constexpr (INF32) { xv[m][bj][0] = *(const f32x4*)((const float*)xin + off + bj * HALF); xv[m][bj][1] = *(const f32x4*)((const float*)xin + off + bj * HALF + 4); }
                    else { const u32x4 p = *(const u32x4*)((const bf16_t*)xin + off + bj * HALF);
                        xv[m][bj][0] = (f32x4){bflo(p.x), bfhi(p.x), bflo(p.y), bfhi(p.y)}; xv[m][bj][1] = (f32x4){bflo(p.z), bfhi(p.z), bflo(p.w), bfhi(p.w)}; } } }
#pragma unroll
            for (int m = 0; m < 4; ++m) { const size_t off = (size_t)(row0 + ai * HALF + m * 16) * DM + col0;
#pragma unroll
                for (int bj = 0; bj < 2; ++bj) { const f32x4 o0 = xv[m][bj][0] + gv[bj][0] * acc[ai][bj][m][0], o1 = xv[m][bj][1] + gv[bj][1] * acc[ai][bj][m][1];
                    u32x4 w; w.x = cvtpk(o0[0], o0[1]); w.y = cvtpk(o0[2], o0[3]); w.z = cvtpk(o1[0], o1[1]); w.w = cvtpk(o1[2], o1[3]);
                    *(u32x4*)(xout + off + bj * HALF) = w; } }
            asm volatile("" ::: "memory"); }
    }
};
template <bool OUTF32> struct EpiMoeDown {
    static constexpr bool PERM = true;
    const bf16_t* xs; void* xo; const float* gate; const int* tos; const float* wos; float ascale;
    __device__ __forceinline__ void operator()(const f32x4 (&acc)[2][2][4][2], const Unit& u, int wr, int wc, int fr, int fq) const {
        const int slot0 = u.pm * BM + wr * 64 + fr, col0 = u.pn * BM + wc * 32 + 8 * fq;
        int tok[2][4]; float w[2][4];
#pragma unroll
        for (int ai = 0; ai < 2; ++ai)
#pragma unroll
            for (int m = 0; m < 4; ++m) { const int slot = slot0 + ai * HALF + m * 16; tok[ai][m] = tos[slot]; w[ai][m] = wos[slot] * ascale; }
#pragma unroll
        for (int ai = 0; ai < 2; ++ai) {
            u32x4 xv[4][2];
#pragma unroll
            for (int m = 0; m < 4; ++m) { const int t = tok[ai][m] < 0 ? 0 : tok[ai][m]; const bf16_t* xp = xs + (size_t)t * DM + col0;
#pragma unroll
                for (int bj = 0; bj < 2; ++bj) xv[m][bj] = *(const u32x4*)(xp + bj * HALF); }
#pragma unroll
            for (int m = 0; m < 4; ++m) { const int t = tok[ai][m];
                if (t >= 0) { const float* gp = gate + (size_t)(t >> 12) * 6144 + col0; const size_t off = (size_t)t * DM + col0;
#pragma unroll
                    for (int bj = 0; bj < 2; ++bj) { const u32x4 p = xv[m][bj];
                        const f32x4 g0 = (*(const f32x4*)(gp + bj * HALF) + 1.0f) * w[ai][m], g1 = (*(const f32x4*)(gp + bj * HALF + 4) + 1.0f) * w[ai][m];
                        const f32x4 o0 = (f32x4){bflo(p.x), bfhi(p.x), bflo(p.y), bfhi(p.y)} + g0 * acc[ai][bj][m][0], o1 = (f32x4){bflo(p.z), bfhi(p.z), bflo(p.w), bfhi(p.w)} + g1 * acc[ai][bj][m][1];
                        if constexpr (OUTF32) { *(f32x4*)((float*)xo + off + bj * HALF) = o0; *(f32x4*)((float*)xo + off + bj * HALF + 4) = o1; }
                        else { u32x4 q; q.x = cvtpk(o0[0], o0[1]); q.y = cvtpk(o0[2], o0[3]); q.z = cvtpk(o1[0], o1[1]); q.w = cvtpk(o1[2], o1[3]); *(u32x4*)((bf16_t*)xo + off + bj * HALF) = q; } } } }
            asm volatile("" ::: "memory"); }
    }
};
template <bool OUT8> struct EpiSwiglu {
    static constexpr bool PERM = true;
    void* O; int ldo; float ascale;
    __device__ __forceinline__ void operator()(const f32x4 (&acc)[2][2][4][2], const Unit& u, int wr, int wc, int fr, int fq) const {
        const int row0 = u.pm * BM + wr * 64 + fr, col0 = u.pn * HALF + wc * 32 + 8 * fq;
        const float nl2 = -ascale * LOG2E, ios = 1.0f / (ascale * ascale * (OUT8 ? SC8_HID : 1.0f));
        const f32x2 nl2v = {nl2, nl2}, iosv = {ios, ios};
#pragma unroll
        for (int ai = 0; ai < 2; ++ai)
#pragma unroll
            for (int m = 0; m < 4; ++m) { const size_t eo = (size_t)(row0 + ai * HALF + m * 16) * ldo + col0;
                float v[8];
#pragma unroll
                for (int n = 0; n < 2; ++n)
#pragma unroll
                    for (int h = 0; h < 2; ++h) {
                        const f32x2 g = {acc[ai][0][m][n][2 * h], acc[ai][0][m][n][2 * h + 1]}, up = {acc[ai][1][m][n][2 * h], acc[ai][1][m][n][2 * h + 1]};
                        const f32x2 t = g * nl2v; const f32x2 e = {fast_exp2(t.x), fast_exp2(t.y)};
                        const f32x2 d = e * iosv + iosv; const f32x2 r = {fast_rcp(d.x), fast_rcp(d.y)};
                        const f32x2 o = (g * up) * r; v[4 * n + 2 * h] = o.x; v[4 * n + 2 * h + 1] = o.y; }
                if constexpr (OUT8) { u32x2 w; w.x = cvt4_fp8(v[0], v[1], v[2], v[3]); w.y = cvt4_fp8(v[4], v[5], v[6], v[7]);
                    *(u32x2*)((unsigned char*)O + eo) = w; }
                else { u32x4 w; w.x = cvtpk(v[0], v[1]); w.y = cvtpk(v[2], v[3]); w.z = cvtpk(v[4], v[5]); w.w = cvtpk(v[6], v[7]);
                    *(u32x4*)((bf16_t*)O + eo) = w; } }
    }
};
struct EpiWin {
    static constexpr bool PERM = true;
    bf16_t* XB; bf16_t* GY;
    __device__ __forceinline__ void operator()(const f32x4 (&acc)[2][2][4][2], const Unit& u, int wr, int wc, int fr, int fq) const {
        const bool act = u.pn >= 4; bf16_t* base = act ? GY : XB;
        const int row0 = u.pm * BM + wr * 64 + fr, col0 = (u.pn & 3) * BM + wc * 32 + 8 * fq;
#pragma unroll
        for (int ai = 0; ai < 2; ++ai)
#pragma unroll
            for (int m = 0; m < 4; ++m) { bf16_t* rowp = base + (size_t)(row0 + ai * HALF + m * 16) * DM + col0;
#pragma unroll
                for (int bj = 0; bj < 2; ++bj) { f32x4 v0 = acc[ai][bj][m][0], v1 = acc[ai][bj][m][1];
                    if (act) {
#pragma unroll
                        for (int j = 0; j < 4; ++j) { v0[j] = gelu_tanh_(v0[j]); v1[j] = gelu_tanh_(v1[j]); } }
                    u32x4 w; w.x = cvtpk(v0[0], v0[1]); w.y = cvtpk(v0[2], v0[3]); w.z = cvtpk(v1[0], v1[1]); w.w = cvtpk(v1[2], v1[3]);
                    *(u32x4*)(rowp + bj * HALF) = w; } }
    }
};
struct EpiQK {
    static constexpr bool PERM = true;
    bf16_t* O; int ldo; const float* gain; const _Float16* tab; float oscale; int vtile; bf16_t* OV;
    __device__ __forceinline__ void operator()(const f32x4 (&acc)[2][2][4][2], const Unit& u, int wr, int wc, int fr, int fq) const {
        const int row0 = u.pm * BM + wr * 64 + fr;
        if (u.pn == vtile) {
            const int col0 = wc * 32 + 8 * fq;
#pragma unroll
            for (int ai = 0; ai < 2; ++ai)
#pragma unroll
                for (int m = 0; m < 4; ++m) { bf16_t* rowp = OV + (size_t)(row0 + ai * HALF + m * 16) * ldo + col0;
#pragma unroll
                    for (int bj = 0; bj < 2; ++bj) { const f32x4 v0 = acc[ai][bj][m][0], v1 = acc[ai][bj][m][1];
                        u32x4 w; w.x = cvtpk(v0[0], v0[1]); w.y = cvtpk(v0[2], v0[3]); w.z = cvtpk(v1[0], v1[1]); w.w = cvtpk(v1[2], v1[3]);
                        *(u32x4*)(rowp + bj * HALF) = w; } }
            return;
        }
        const int colh = (u.pn * 4 + wc) * 64 + 8 * fq;
        f32x4 g1[2], g2[2];
#pragma unroll
        for (int n = 0; n < 2; ++n) { g1[n] = *(const f32x4*)(gain + 8 * fq + 4 * n); g2[n] = *(const f32x4*)(gain + 32 + 8 * fq + 4 * n); }
#pragma unroll
        for (int ai = 0; ai < 2; ++ai) {
            h16x8 tc[4], ts[4];
#pragma unroll
            for (int m = 0; m < 4; ++m) { const _Float16* tp = tab + (size_t)(row0 + ai * HALF + m * 16) * 64 + 8 * fq; tc[m] = *(const h16x8*)tp; ts[m] = *(const h16x8*)(tp + 32); }
#pragma unroll
            for (int m = 0; m < 4; ++m) { const int row = row0 + ai * HALF + m * 16;
                float ss = 0.f;
#pragma unroll
                for (int bj = 0; bj < 2; ++bj)
#pragma unroll
                    for (int n = 0; n < 2; ++n) { const f32x4 a = acc[ai][bj][m][n]; ss += (a[0] * a[0] + a[1] * a[1]) + (a[2] * a[2] + a[3] * a[3]); }
                { const int ln_ = fq * 16 + fr; ss += shflx(ss, ln_, 16); ss += shflx(ss, ln_, 32); }
                const float r = __builtin_amdgcn_rsqf(ss * (1.0f / 64.0f) + EPS) * oscale;
                float o1[8], o2[8];
#pragma unroll
                for (int n = 0; n < 2; ++n) {
                    const f32x4 c = {(float)tc[m][4 * n], (float)tc[m][4 * n + 1], (float)tc[m][4 * n + 2], (float)tc[m][4 * n + 3]}, sn = {(float)ts[m][4 * n], (float)ts[m][4 * n + 1], (float)ts[m][4 * n + 2], (float)ts[m][4 * n + 3]};
                    const f32x4 x1 = acc[ai][0][m][n] * g1[n] * r, x2 = acc[ai][1][m][n] * g2[n] * r;
                    const f32x4 a = x1 * c - x2 * sn, b = x2 * c + x1 * sn;
#pragma unroll
                    for (int j = 0; j < 4; ++j) { o1[4 * n + j] = a[j]; o2[4 * n + j] = b[j]; } }
                bf16_t* rowp = O + (size_t)row * ldo + colh;
                u32x4 w; w.x = cvtpk(o1[0], o1[1]); w.y = cvtpk(o1[2], o1[3]); w.z = cvtpk(o1[4], o1[5]); w.w = cvtpk(o1[6], o1[7]);
                *(u32x4*)rowp = w;
                w.x = cvtpk(o2[0], o2[1]); w.y = cvtpk(o2[2], o2[3]); w.z = cvtpk(o2[4], o2[5]); w.w = cvtpk(o2[6], o2[7]);
                *(u32x4*)(rowp + 32) = w; }
            asm volatile("" ::: "memory"); }
    }
};
}

#define XB_TMO      128
#define XB_XCNT(j)  (256  + 64 * (j))
#define XB_XSUB(j)  (1280 + 64 * (j))
#define XB_XGEN(j)  (2304 + 64 * (j))
#define XB_TOP      3328
#define XB_TOPGEN   3392
#define XCD_BAR_WORDS 3456
#define XB_SPIN_CAP (1u << 20)
__device__ __forceinline__ unsigned xb_ld(unsigned* p)              { return __hip_atomic_load(p, __ATOMIC_RELAXED, __HIP_MEMORY_SCOPE_AGENT); }
__device__ __forceinline__ unsigned xb_add(unsigned* p, unsigned v) { return __hip_atomic_fetch_add(p, v, __ATOMIC_RELAXED, __HIP_MEMORY_SCOPE_AGENT); }
__device__ __forceinline__ unsigned xb_xcc_id() { return (unsigned)__builtin_amdgcn_s_getreg((3 << 11) | 20) & 0xFu; }
#define XB_SPIN(cond, bar) do { unsigned _sp = 0; while (cond) { __builtin_amdgcn_s_sleep(1); \
    if ((++_sp & 255u) == 0u) { if (xb_ld(&(bar)[XB_TMO])) break; if (_sp > XB_SPIN_CAP) { atomicAdd(&(bar)[XB_TMO], 1u); break; } } } } while (0)
struct XcdBarrier { unsigned* bar; unsigned x; volatile LAS unsigned* st; };
__device__ __forceinline__ XcdBarrier xcd_barrier_post(unsigned* bar, volatile LAS unsigned* st, int wv) {
    XcdBarrier b; b.bar = bar; b.x = xb_xcc_id(); b.st = st;
    if (wv == 0 && lane_id_v() == 0) (void)xb_add(&bar[XB_XCNT(b.x)], 1u);
    return b;
}
__device__ __forceinline__ void xcd_barrier_complete(unsigned* bar, unsigned x, unsigned& nloc, unsigned& nx) {
    const unsigned G = gridDim.x * gridDim.y * gridDim.z;
    unsigned sum, cnt, mine, sp = 0u;
    for (;;) {
        sum = 0u; cnt = 0u; mine = 0u;
#pragma unroll
        for (unsigned j = 0; j < 16; ++j) { const unsigned c = xb_ld(&bar[XB_XCNT(j)]); sum += c; cnt += (c > 0u) ? 1u : 0u; }
        mine = xb_ld(&bar[XB_XCNT(x)]);
        if (sum == G) break;
        __builtin_amdgcn_s_sleep(1);
        if ((++sp & 255u) == 0u) { if (xb_ld(&bar[XB_TMO])) break; if (sp > XB_SPIN_CAP) { atomicAdd(&bar[XB_TMO], 1u); break; } }
    }
    nloc = mine > 0u ? mine : 1u; nx = cnt > 0u ? cnt : 1u;
}
__device__ __forceinline__ void xcd_barrier(const XcdBarrier& b, int wv) {
    asm volatile("s_waitcnt vmcnt(0)" ::: "memory");
    __syncthreads();
    if (wv == 0 && lane_id_v() == 0) {
        unsigned* bar = b.bar;
        __builtin_amdgcn_s_waitcnt(0);
        unsigned nloc = b.st[0], nx = b.st[1];
        if (nloc == 0u) { xcd_barrier_complete(bar, b.x, nloc, nx); b.st[0] = nloc; b.st[1] = nx; }
        const unsigned old = xb_add(&bar[XB_XSUB(b.x)], 1u);
        const unsigned gen = old / nloc;
        if (old + 1u == (gen + 1u) * nloc) {
            __builtin_amdgcn_fence(__ATOMIC_RELEASE, "agent");
            asm volatile("s_waitcnt vmcnt(0)" ::: "memory");
            const unsigned og = xb_add(&bar[XB_TOP], 1u);
            const unsigned tg = og / nx;
            if (og + 1u == (tg + 1u) * nx) xb_add(&bar[XB_TOPGEN], 1u);
            else XB_SPIN(xb_ld(&bar[XB_TOPGEN]) == tg, bar);
            __builtin_amdgcn_fence(__ATOMIC_ACQUIRE, "agent");
            xb_add(&bar[XB_XGEN(b.x)], 1u);
            asm volatile("s_waitcnt vmcnt(0)" ::: "memory");
        } else {
            XB_SPIN(xb_ld(&bar[XB_XGEN(b.x)]) == gen, bar);
            __builtin_amdgcn_fence(__ATOMIC_ACQUIRE, "agent");
            asm volatile("s_waitcnt vmcnt(0)" ::: "memory");
        }
    }
    __syncthreads();
}

struct Args {
    const float* x; const float* c; const int* pos; const float* ada_w; const float* ada_b; const float* mix_norm; const float* ffn_norm;
    const float* a_w_in; const float* a_conv_w; const float* a_conv_b; const float* a_gx_w; const float* a_gx_b; const float* a_ga_w; const float* a_ga_b;
    const float* a_lambda; const float* a_w_out; const float* kv_norm; const float* kv_ada_w; const float* kv_ada_b; const float* w_kv; const float* k_norm;
    const float* b_w_q; const float* b_q_norm; const float* b_sinks; const float* b_w_o; const float* f_w_gu; const float* f_w_down; const float* m_router;
    const float* m_w_gu; const float* m_w_down;
    float* out; unsigned char* ws; int ph_lo, ph_hi;
};

struct Ctx {
    LAS unsigned char* lds; int tid, lane, wave, vcu, G, cid;
};

struct TrItem { const float* src; unsigned char* dst; int N, K, d0, d1, f8; };
__device__ __forceinline__ void tr_load(const TrItem& t, f32x4 (&v)[16], int lane) {
    const int kr = lane >> 4, nq = lane & 15;
#pragma unroll
    for (int i = 0; i < 16; ++i) v[i] = *(const f32x4*)(t.src + (size_t)(4 * i + kr) * t.N + 4 * nq);
}
__device__ __forceinline__ void tr_to_lds(const f32x4 (&v)[16], LAS float* scr, int lane) {
    const int kr = lane >> 4, nq = lane & 15;
#pragma unroll
    for (int i = 0; i < 16; ++i) { const int k = 4 * i + kr; *(LAS f32x4*)(scr + k * 68 + ((4 * nq) ^ (4 * ((k >> 3) & 7)))) = v[i]; }
}
__device__ __forceinline__ void tr_finish(const TrItem& t, LAS float* scr, int lane) {
    const int c = lane & 7, r = lane >> 3;
    if (t.f8) {
#pragma unroll
        for (int j = 0; j < 8; ++j) { const int n = 8 * j + r; const LAS float* s = scr + (8 * c) * 68 + (n ^ (4 * c)); const int drow = ((n & 32) ? t.d1 : t.d0) + (n & 31);
            u32x2 o; o.x = cvt4_fp8(s[0 * 68] * SC8_W, s[1 * 68] * SC8_W, s[2 * 68] * SC8_W, s[3 * 68] * SC8_W); o.y = cvt4_fp8(s[4 * 68] * SC8_W, s[5 * 68] * SC8_W, s[6 * 68] * SC8_W, s[7 * 68] * SC8_W);
            *(u32x2*)(t.dst + (size_t)drow * t.K + 8 * c) = o; }
    } else {
#pragma unroll
        for (int j = 0; j < 8; ++j) { const int n = 8 * j + r; const LAS float* s = scr + (8 * c) * 68 + (n ^ (4 * c)); const int drow = ((n & 32) ? t.d1 : t.d0) + (n & 31);
            u32x4 o; o.x = cvtpk(s[0 * 68], s[1 * 68]); o.y = cvtpk(s[2 * 68], s[3 * 68]); o.z = cvtpk(s[4 * 68], s[5 * 68]); o.w = cvtpk(s[6 * 68], s[7 * 68]);
            *(u32x4*)(t.dst + ((size_t)drow * t.K + 8 * c) * 2) = o; }
    }
}
__device__ __forceinline__ int map_plain(int n) { return n; }
__device__ __forceinline__ int map_head(int n) { const int hd = n >> 6, d = n & 63; return 256 * (hd >> 2) + 128 * (d >> 5) + 32 * (hd & 3) + (d & 31); }
__device__ __forceinline__ int map_gu(int n, int F) { const int u = n >= F, j = u ? n - F : n; return 256 * (j >> 7) + 128 * u + (j & 127); }

__device__ __forceinline__ void p0_prologue(const Ctx& F, const Args& a) {
    unsigned char* ws = a.ws;
    {
        LAS float* cs = (LAS float*)F.lds;
        LAS float* red = (LAS float*)(F.lds + 65536);
        for (int i = F.tid; i < BATCH * DM; i += 512) { const int b = i >> 10, k = i & 1023; const float v = a.c[i]; cs[k * 16 + b] = silu_(v); }
        __syncthreads();
        float* modv = (float*)(ws + WS_MODV); float* kvmod = (float*)(ws + WS_KVMOD);
        constexpr int NC = 4 * 6144 + 2048, CPB = 104;
        for (int cb = F.vcu; cb * CPB < NC; cb += F.G) {
            const int cl = F.tid & 127, kp = F.tid >> 7, j = cb * CPB + cl;
            const bool on = (cl < CPB) && (j < NC);
            float accv[16];
#pragma unroll
            for (int b = 0; b < 16; ++b) accv[b] = 0.f;
            if (on) {
                const float* W; int ldw, jj;
                if (j < 4 * 6144) { const int l = j / 6144; jj = j - l * 6144; W = a.ada_w + (size_t)l * DM * 6144; ldw = 6144; } else { jj = j - 4 * 6144; W = a.kv_ada_w; ldw = 2048; }
                const float* wp = W + (size_t)(kp * 256) * ldw + jj;
#pragma unroll 1
                for (int k0 = 0; k0 < 256; k0 += 16) {
                    float wv[16];
#pragma unroll
                    for (int kk = 0; kk < 16; ++kk) wv[kk] = wp[(size_t)(k0 + kk) * ldw];
#pragma unroll
                    for (int kk = 0; kk < 16; ++kk) { const float w = wv[kk]; const LAS f32x4* cv = (const LAS f32x4*)(cs + (kp * 256 + k0 + kk) * 16);
#pragma unroll
                        for (int q = 0; q < 4; ++q) { const f32x4 c4 = cv[q]; accv[4 * q] += w * c4[0]; accv[4 * q + 1] += w * c4[1]; accv[4 * q + 2] += w * c4[2]; accv[4 * q + 3] += w * c4[3]; } } }
            }
#pragma unroll
            for (int b = 0; b < 16; ++b) red[(kp * 128 + cl) * 16 + b] = accv[b];
            __syncthreads();
            for (int i = F.tid; i < CPB * 16; i += 512) { const int cl2 = i >> 4, b = i & 15, j2 = cb * CPB + cl2;
                if (j2 < NC) { const float s = (red[(0 * 128 + cl2) * 16 + b] + red[(1 * 128 + cl2) * 16 + b]) + (red[(2 * 128 + cl2) * 16 + b] + red[(3 * 128 + cl2) * 16 + b]);
                    if (j2 < 4 * 6144) { const int l = j2 / 6144, jj = j2 - l * 6144; modv[((size_t)l * 16 + b) * 6144 + jj] = s + a.ada_b[l * 6144 + jj]; }
                    else { const int jj = j2 - 4 * 6144; kvmod[(size_t)b * 2048 + jj] = s + a.kv_ada_b[jj]; } } }
            __syncthreads();
        }
    }
    {
        LAS float* scr = (LAS float*)(F.lds + F.wave * 17408);
        const int gw = F.vcu * 8 + F.wave, NGW = F.G * 8;
        constexpr int I_WIN = 16 * 32, I_SQ = 16 * 16, I_KV = 16 * 8, I_FGU = 16 * 96, I_FDN = 48 * 16, I_MGU = 16 * 112, I_MDN = 56 * 16;
        constexpr int NMOE = DEFER_L3 ? 8 : 16;
        constexpr int NITEMS = 2 * I_WIN + 2 * I_SQ + I_KV + 2 * I_SQ + 2 * I_SQ + 2 * I_FGU + 2 * I_FDN + NMOE * I_MGU + NMOE * I_MDN;
        auto decode = [&](int it) -> TrItem {
            TrItem t; int r = it; const float* W; unsigned char* D; int K, N, kb, n0, f8 = 0, mapk = 0, F = 0;
            if (r < 2 * I_WIN) { const int mi = r / I_WIN, rr = r % I_WIN; n0 = 64 * (rr % 32); kb = rr / 32; K = DM; N = 2048; W = a.a_w_in + (size_t)mi * DM * 2048; D = ws + WS_WIN + (size_t)mi * 2048 * DM * 2; }
            else if ((r -= 2 * I_WIN) < 2 * I_SQ) { const int mi = r / I_SQ, rr = r % I_SQ; n0 = 64 * (rr % 16); kb = rr / 16; K = DM; N = DM; W = a.a_w_out + (size_t)mi * DM * DM; D = ws + WS_WOUT + (size_t)mi * DM * DM * 2; }
            else if ((r -= 2 * I_SQ) < I_KV) { n0 = 64 * (r % 8); kb = r / 8; K = DM; N = 512; W = a.w_kv; D = ws + WS_WKV; mapk = 3; }
            else if ((r -= I_KV) < 2 * I_SQ) { const int mi = r / I_SQ, rr = r % I_SQ; n0 = 64 * (rr % 16); kb = rr / 16; K = DM; N = DM; W = a.b_w_q + (size_t)mi * DM * DM; D = ws + WS_WQ + (size_t)mi * DM * DM * 2; mapk = 1; }
            else if ((r -= 2 * I_SQ) < 2 * I_SQ) { const int mi = r / I_SQ, rr = r % I_SQ; n0 = 64 * (rr % 16); kb = rr / 16; K = DM; N = DM; W = a.b_w_o + (size_t)mi * DM * DM; D = ws + WS_WO + (size_t)mi * DM * DM * 2; }
            else if ((r -= 2 * I_SQ) < 2 * I_FGU) { const int mi = r / I_FGU, rr = r % I_FGU; n0 = 64 * (rr % 96); kb = rr / 96; K = DM; N = 6144; W = a.f_w_gu + (size_t)mi * DM * 6144; D = ws + WS_FGU + (size_t)mi * 6144 * DM * 2; f8 = FP8_OF(2 * mi); mapk = 2; F = DFF; }
            else if ((r -= 2 * I_FGU) < 2 * I_FDN) { const int mi = r / I_FDN, rr = r % I_FDN; n0 = 64 * (rr % 16); kb = rr / 16; K = DFF; N = DM; W = a.f_w_down + (size_t)mi * DFF * DM; D = ws + WS_FDN + (size_t)mi * DM * DFF * 2; f8 = FP8_OF(2 * mi); }
            else if ((r -= 2 * I_FDN) < NMOE * I_MGU) { const int mi = r / I_MGU, rr = r % I_MGU; n0 = 64 * (rr % 112); kb = rr / 112; K = DM; N = 7168; W = a.m_w_gu + (size_t)mi * DM * 7168; f8 = FP8_OF(2 * (mi >> 3) + 1); mapk = 2; F = DFE;
                D = ws + WS_MGU + (size_t)(mi >> 3) * 8 * 7168 * DM * 2 + (size_t)(mi & 7) * 7168 * DM * (f8 ? 1 : 2); }
            else { r -= NMOE * I_MGU; const int mi = r / I_MDN, rr = r % I_MDN; n0 = 64 * (rr % 16); kb = rr / 16; K = DFE; N = DM; W = a.m_w_down + (size_t)mi * DFE * DM; f8 = FP8_OF(2 * (mi >> 3) + 1);
                D = ws + WS_MDN + (size_t)(mi >> 3) * 8 * DM * DFE * 2 + (size_t)(mi & 7) * DM * DFE * (f8 ? 1 : 2); }
            t.src = W + (size_t)(64 * kb) * N + n0; t.dst = D + (size_t)(64 * kb) * (f8 ? 1 : 2); t.N = N; t.K = K; t.f8 = f8;
            if (mapk == 1 || (mapk == 3 && n0 < 256)) { t.d0 = map_head(n0); t.d1 = map_head(n0 + 32); }
            else if (mapk == 2) { t.d0 = map_gu(n0, F); t.d1 = map_gu(n0 + 32, F); }
            else { t.d0 = n0; t.d1 = n0 + 32; }
            return t; };
        f32x4 tv[16];
        int it = gw;
        TrItem cur = decode(it < NITEMS ? it : 0);
        if (it < NITEMS) tr_load(cur, tv, F.lane);
        for (; it < NITEMS; it += NGW) {
            tr_to_lds(tv, scr, F.lane);
            const bool hn = it + NGW < NITEMS;
            const TrItem nxt = decode(hn ? it + NGW : it);
            if (hn) tr_load(nxt, tv, F.lane);
            LDS_WAIT(); asm volatile("" ::: "memory");
            tr_finish(cur, scr, F.lane);
            LDS_WAIT(); asm volatile("" ::: "memory");
            cur = nxt;
        }
        __syncthreads();
    }
    {
        float* par = (float*)(ws + WS_PAR);
        const size_t gt0 = (size_t)F.vcu * 512 + F.tid, GT0 = (size_t)F.G * 512;
        for (size_t i = gt0; i < (size_t)PAR_END; i += GT0) { const int j = (int)i; float v;
            if (j < PAR_FFNN) v = a.mix_norm[j - PAR_MIXN]; else if (j < PAR_CONVW) v = a.ffn_norm[j - PAR_FFNN]; else if (j < PAR_CONVB) v = a.a_conv_w[j - PAR_CONVW];
            else if (j < PAR_GXB) v = a.a_conv_b[j - PAR_CONVB]; else if (j < PAR_GAB) v = a.a_gx_b[j - PAR_GXB]; else if (j < PAR_LAM) v = a.a_ga_b[j - PAR_GAB];
            else if (j < PAR_KVN) v = a.a_lambda[j - PAR_LAM]; else if (j < PAR_KN) v = a.kv_norm[j - PAR_KVN]; else if (j < PAR_QN) v = a.k_norm[j - PAR_KN];
            else if (j < PAR_SINK) v = a.b_q_norm[j - PAR_QN]; else if (j < PAR_ROUTER) v = a.b_sinks[j - PAR_SINK]; else v = a.m_router[j - PAR_ROUTER];
            par[j] = v; }
    }
    {
        const size_t gt = (size_t)F.vcu * 512 + F.tid, GT = (size_t)F.G * 512;
        bf16_t* gwp = (bf16_t*)(ws + WS_GW);
        for (size_t i = gt; i < (size_t)2 * 8 * 2 * 128 * 128; i += GT) { const int k = (int)(i & 127), j = (int)((i >> 7) & 127), c2 = (int)((i >> 14) & 1), n = (int)((i >> 15) & 7), l = (int)(i >> 18);
            const float* g = (j < 64) ? a.a_ga_w : a.a_gx_w; const float v = g[((size_t)(l * 8 + n) * 128 + k) * 128 + 64 * c2 + (j & 63)];
            gwp[i] = (bf16_t)(cvtpk(v, 0.f) & 0xffffu); }
        _Float16* tab = (_Float16*)(ws + WS_COS);
        for (size_t i = gt; i < (size_t)NTOK * 32; i += GT) { const int p = (int)(i & 31); const size_t tok = i >> 5;
            const float inv = powf(10000.0f, -(float)(2 * p) / 64.0f); const float ang = (float)a.pos[tok] * inv;
            tab[tok * 64 + p] = (_Float16)cosf(ang); tab[tok * 64 + 32 + p] = (_Float16)sinf(ang); }
    }
}

__device__ __forceinline__ void convert_deferred(const Ctx& F, const float* m_w_gu, const float* m_w_down, unsigned char* ws, int half, int j, int nb) {
    constexpr int I_MGU = 16 * 112, I_MDN = 56 * 16, NIT = 8 * I_MGU + 8 * I_MDN;
    LAS float* scr = (LAS float*)(F.lds + F.wave * 17408);
    auto decode = [&](int it) -> TrItem {
        TrItem t; int r = it; const float* W; unsigned char* D; int K, N, kb, n0; const int f8 = FP8_OF(3);
        if (r < 8 * I_MGU) { const int e = r / I_MGU, rr = r % I_MGU; n0 = 64 * (rr % 112); kb = rr / 112; K = DM; N = 7168; W = m_w_gu + (size_t)(8 + e) * DM * 7168;
            D = ws + WS_MGU + (size_t)8 * 7168 * DM * 2 + (size_t)e * 7168 * DM * (f8 ? 1 : 2); t.d0 = map_gu(n0, DFE); t.d1 = map_gu(n0 + 32, DFE); }
        else { r -= 8 * I_MGU; const int e = r / I_MDN, rr = r % I_MDN; n0 = 64 * (rr % 16); kb = rr / 16; K = DFE; N = DM; W = m_w_down + (size_t)(8 + e) * DFE * DM;
            D = ws + WS_MDN + (size_t)8 * DM * DFE * 2 + (size_t)e * DM * DFE * (f8 ? 1 : 2); t.d0 = n0; t.d1 = n0 + 32; }
        t.src = W + (size_t)(64 * kb) * N + n0; t.dst = D + (size_t)(64 * kb) * (f8 ? 1 : 2); t.N = N; t.K = K; t.f8 = f8;
        return t; };
    const int lo = half ? NIT / 2 : 0, hi = half ? NIT : NIT / 2, step = nb * 8;
    f32x4 tv[16];
    int it = lo + j * 8 + F.wave;
    TrItem cur = decode(it < hi ? it : lo);
    if (it < hi) tr_load(cur, tv, F.lane);
    for (; it < hi; it += step) {
        tr_to_lds(tv, scr, F.lane);
        const bool hn = it + step < hi;
        const TrItem nxt = decode(hn ? it + step : it);
        if (hn) tr_load(nxt, tv, F.lane);
        LDS_WAIT(); asm volatile("" ::: "memory");
        tr_finish(cur, scr, F.lane);
        LDS_WAIT(); asm volatile("" ::: "memory");
        cur = nxt;
    }
}

template <bool DUAL, bool ROUTER, bool OUT8 = false, bool INF32 = false>
__device__ __forceinline__ void norm_phase(const Ctx& F, const void* x, const float* gain1, const float* sh1, const float* sc1, void* out1,
                                           const float* gain2, const float* sh2, const float* sc2, bf16_t* out2,
                                           const float* wrouter, int* e12, float* w1o, int* cnt) {
    LAS int* lcnt = (LAS int*)F.lds;
    for (int rb = F.vcu; rb < NTOK / 256; rb += F.G) {
        const int b = rb >> 4;
        if (ROUTER) { if (F.tid < 16) lcnt[F.tid] = 0; __syncthreads(); }
        float ca[16], cs[16], ca2[16], cs2[16];
#pragma unroll
        for (int j = 0; j < 4; ++j) { const int col = 4 * F.lane + 256 * j;
            const f32x4 g = *(const f32x4*)(gain1 + col), s = *(const f32x4*)(sc1 + (size_t)b * 6144 + col), h = *(const f32x4*)(sh1 + (size_t)b * 6144 + col);
#pragma unroll
            for (int q = 0; q < 4; ++q) { ca[4 * j + q] = g[q] * (1.0f + s[q]); cs[4 * j + q] = h[q]; }
            if (DUAL) { const f32x4 g2 = *(const f32x4*)(gain2 + col), s2 = *(const f32x4*)(sc2 + (size_t)b * 2048 + col), h2 = *(const f32x4*)(sh2 + (size_t)b * 2048 + col);
#pragma unroll
                for (int q = 0; q < 4; ++q) { ca2[4 * j + q] = g2[q] * (1.0f + s2[q]); cs2[4 * j + q] = h2[q]; } } }
        float wr_[ROUTER ? 128 : 1];
        if (ROUTER) {
#pragma unroll
            for (int j = 0; j < 4; ++j)
#pragma unroll
                for (int q = 0; q < 4; ++q) { const int col = 4 * F.lane + 256 * j + q; const f32x4 w0 = *(const f32x4*)(wrouter + (size_t)col * 8), w1 = *(const f32x4*)(wrouter + (size_t)col * 8 + 4);
#pragma unroll
                    for (int e = 0; e < 4; ++e) { wr_[(4 * j + q) * 8 + e] = w0[e]; wr_[(4 * j + q) * 8 + 4 + e] = w1[e]; } }
        }
        int me12 = 0; float mw1 = 0.f;
        const int rowb = rb * 256 + F.wave * 32;
        f32x4 nf[INF32 ? 4 : 1]; u32x2 nb[INF32 ? 1 : 4], nc[INF32 ? 1 : 4];
        if constexpr (ROUTER) { const u32x2* xr = (const u32x2*)((const bf16_t*)x + (size_t)rowb * DM) + F.lane;
#pragma unroll
            for (int j = 0; j < 4; ++j) nb[j] = xr[64 * j]; }
        else if constexpr (INF32) { const f32x4* xr = (const f32x4*)((const float*)x + (size_t)rowb * DM) + F.lane;
#pragma unroll
            for (int j = 0; j < 4; ++j) nf[j] = xr[64 * j]; }
        else { const u32x2* xr = (const u32x2*)((const bf16_t*)x + (size_t)rowb * DM) + F.lane;
#pragma unroll
            for (int j = 0; j < 4; ++j) { nb[j] = xr[64 * j]; nc[j] = xr[64 * j + DM / 4]; } }
        for (int rr = 0; rr < 32; ++rr) {
            const size_t row = (size_t)(rowb + rr);
            f32x4 v[4]; float s = 0.f;
            if constexpr (ROUTER) {
#pragma unroll
                for (int j = 0; j < 4; ++j) { const u32x2 p = nb[j]; v[j] = (f32x4){bflo(p.x), bfhi(p.x), bflo(p.y), bfhi(p.y)}; }
                if (rr + 1 < 32) { const u32x2* xr = (const u32x2*)((const bf16_t*)x + (row + 1) * DM) + F.lane;
#pragma unroll
                    for (int j = 0; j < 4; ++j) nb[j] = xr[64 * j]; } }
            else if constexpr (INF32) {
#pragma unroll
                for (int j = 0; j < 4; ++j) v[j] = nf[j];
                if (rr + 1 < 32) { const f32x4* xr = (const f32x4*)((const float*)x + (row + 1) * DM) + F.lane;
#pragma unroll
                    for (int j = 0; j < 4; ++j) nf[j] = xr[64 * j]; } }
            else {
#pragma unroll
                for (int j = 0; j < 4; ++j) { const u32x2 p = nb[j]; v[j] = (f32x4){bflo(p.x), bfhi(p.x), bflo(p.y), bfhi(p.y)}; nb[j] = nc[j]; }
                if (rr + 2 < 32) { const u32x2* xr = (const u32x2*)((const bf16_t*)x + (row + 2) * DM) + F.lane;
#pragma unroll
                    for (int j = 0; j < 4; ++j) nc[j] = xr[64 * j]; } }
#pragma unroll
            for (int j = 0; j < 4; ++j) s += (v[j][0] * v[j][0] + v[j][1] * v[j][1]) + (v[j][2] * v[j][2] + v[j][3] * v[j][3]);
            const float r = __builtin_amdgcn_rsqf(wave_sum(s, F.lane) * (1.0f / DM) + EPS);
            float hv[16];
#pragma unroll
            for (int j = 0; j < 4; ++j)
#pragma unroll
                for (int q = 0; q < 4; ++q) hv[4 * j + q] = v[j][q] * r * ca[4 * j + q] + cs[4 * j + q];
            if constexpr (OUT8) { unsigned* o4 = (unsigned*)((unsigned char*)out1 + row * DM) + F.lane;
#pragma unroll
                for (int j = 0; j < 4; ++j) o4[64 * j] = cvt4_fp8(hv[4 * j] * SC8_H, hv[4 * j + 1] * SC8_H, hv[4 * j + 2] * SC8_H, hv[4 * j + 3] * SC8_H); }
            else { u32x2* o8 = (u32x2*)((bf16_t*)out1 + row * DM) + F.lane;
#pragma unroll
                for (int j = 0; j < 4; ++j) { u32x2 w; w.x = cvtpk(hv[4 * j], hv[4 * j + 1]); w.y = cvtpk(hv[4 * j + 2], hv[4 * j + 3]); o8[64 * j] = w; } }
            if (DUAL) { u32x2* p8 = (u32x2*)(out2 + row * DM) + F.lane;
#pragma unroll
                for (int j = 0; j < 4; ++j) { float t[4];
#pragma unroll
                    for (int q = 0; q < 4; ++q) t[q] = v[j][q] * r * ca2[4 * j + q] + cs2[4 * j + q];
                    u32x2 w; w.x = cvtpk(t[0], t[1]); w.y = cvtpk(t[2], t[3]); p8[64 * j] = w; } }
            if (ROUTER) {
                float pe[8];
#pragma unroll
                for (int e = 0; e < 8; ++e) { float p = 0.f;
#pragma unroll
                    for (int c = 0; c < 16; ++c) p += hv[c] * wr_[c * 8 + e];
                    pe[e] = p; }
                { const bool b0 = F.lane & 1, b1 = F.lane & 2, b2 = F.lane & 4;
#pragma unroll
                  for (int e = 0; e < 8; e += 2) { const float snd = b0 ? pe[e] : pe[e + 1], kp = b0 ? pe[e + 1] : pe[e]; pe[e >> 1] = kp + shflx(snd, F.lane, 1); }
#pragma unroll
                  for (int i = 0; i < 4; i += 2) { const float snd = b1 ? pe[i] : pe[i + 1], kp = b1 ? pe[i + 1] : pe[i]; pe[i >> 1] = kp + shflx(snd, F.lane, 2); }
                  { const float snd = b2 ? pe[0] : pe[1], kp = b2 ? pe[1] : pe[0]; pe[0] = kp + shflx(snd, F.lane, 4); }
                  pe[0] += shflx(pe[0], F.lane, 8); pe[0] += shflx(pe[0], F.lane, 16); pe[0] += shflx(pe[0], F.lane, 32); }
                float lg[8];
#pragma unroll
                for (int e = 0; e < 8; ++e) lg[e] = __int_as_float(__builtin_amdgcn_readlane(__float_as_int(pe[0]), e));
                int i1 = 0; float v1 = lg[0];
#pragma unroll
                for (int e = 1; e < 8; ++e) if (lg[e] > v1) { v1 = lg[e]; i1 = e; }
                int i2 = -1; float v2 = -INFINITY;
#pragma unroll
                for (int e = 0; e < 8; ++e) if (e != i1 && lg[e] > v2) { v2 = lg[e]; i2 = e; }
                const float wt = 1.0f / (1.0f + __expf(v2 - v1));
                if (F.lane == rr) { me12 = i1 | (i2 << 8); mw1 = wt; }
            }
        }
        if (ROUTER) {
            if (F.lane < 32) { e12[rowb + F.lane] = me12; w1o[rowb + F.lane] = mw1; }
            const int e1 = me12 & 255, e2 = me12 >> 8;
#pragma unroll
            for (int e = 0; e < 8; ++e) { const unsigned long long m1 = __ballot(F.lane < 32 && e1 == e), m2 = __ballot(F.lane < 32 && e2 == e);
                if (F.lane == 0) { atomicAdd((int*)&lcnt[e], (int)__popcll(m1)); atomicAdd((int*)&lcnt[8 + e], (int)__popcll(m2)); } }
            __syncthreads();
            if (F.tid < 16) cnt[rb * 16 + F.tid] = lcnt[F.tid];
            __syncthreads();
        }
    }
}

template <bool DUAL, bool ROUTER, bool OUT8 = false, bool INF32 = false>
__device__ __forceinline__ void norm_phase_pk(const Ctx& F, const void* x, const float* gain1, const float* sh1, const float* sc1, void* out1,
                                           const float* gain2, const float* sh2, const float* sc2, bf16_t* out2,
                                           const float* wrouter, int* e12, float* w1o, int* cnt) {
    LAS int* lcnt = (LAS int*)F.lds;
    constexpr float SH = OUT8 ? SC8_H : 1.0f;
    for (int rb = F.vcu; rb < NTOK / 256; rb += F.G) {
        const int b = rb >> 4;
        if (ROUTER) { if (F.tid < 16) lcnt[F.tid] = 0; __syncthreads(); }
        f32x2 ca[8], cs[8], cb[DUAL ? 8 : 1], cd[DUAL ? 8 : 1];
#pragma unroll
        for (int j = 0; j < 4; ++j) { const int col = 4 * F.lane + 256 * j;
            const f32x4 g = *(const f32x4*)(gain1 + col), sc = *(const f32x4*)(sc1 + (size_t)b * 6144 + col), h = *(const f32x4*)(sh1 + (size_t)b * 6144 + col);
#pragma unroll
            for (int hh = 0; hh < 2; ++hh) { ca[2 * j + hh] = (f32x2){g[2 * hh] * (1.0f + sc[2 * hh]) * SH, g[2 * hh + 1] * (1.0f + sc[2 * hh + 1]) * SH}; cs[2 * j + hh] = (f32x2){h[2 * hh] * SH, h[2 * hh + 1] * SH}; }
            if constexpr (DUAL) { const f32x4 g2 = *(const f32x4*)(gain2 + col), s2 = *(const f32x4*)(sc2 + (size_t)b * 2048 + col), h2 = *(const f32x4*)(sh2 + (size_t)b * 2048 + col);
#pragma unroll
                for (int hh = 0; hh < 2; ++hh) { cb[2 * j + hh] = (f32x2){g2[2 * hh] * (1.0f + s2[2 * hh]), g2[2 * hh + 1] * (1.0f + s2[2 * hh + 1])}; cd[2 * j + hh] = (f32x2){h2[2 * hh], h2[2 * hh + 1]}; } } }
        f32x2 wr2[ROUTER ? 16 : 1][4];
        if constexpr (ROUTER) {
#pragma unroll
            for (int j = 0; j < 4; ++j)
#pragma unroll
                for (int q = 0; q < 4; ++q) { const int col = 4 * F.lane + 256 * j + q; const f32x4 w0 = *(const f32x4*)(wrouter + (size_t)col * 8), w1 = *(const f32x4*)(wrouter + (size_t)col * 8 + 4);
                    wr2[4 * j + q][0] = (f32x2){w0[0], w0[1]} * (1.0f / SH); wr2[4 * j + q][1] = (f32x2){w0[2], w0[3]} * (1.0f / SH); wr2[4 * j + q][2] = (f32x2){w1[0], w1[1]} * (1.0f / SH); wr2[4 * j + q][3] = (f32x2){w1[2], w1[3]} * (1.0f / SH); }
        }
        int me12 = 0; float mw1 = 0.f;
        const int rowb = rb * 256 + F.wave * 32;
        f32x4 nf[INF32 ? 4 : 1]; u32x2 nb[INF32 ? 1 : 4], nc[INF32 ? 1 : 4];
        if constexpr (INF32) { const f32x4* xr = (const f32x4*)((const float*)x + (size_t)rowb * DM) + F.lane;
#pragma unroll
            for (int j = 0; j < 4; ++j) nf[j] = xr[64 * j]; }
        else { const u32x2* xr = (const u32x2*)((const bf16_t*)x + (size_t)rowb * DM) + F.lane;
#pragma unroll
            for (int j = 0; j < 4; ++j) { nb[j] = xr[64 * j]; nc[j] = xr[64 * j + DM / 4]; } }
        for (int rr = 0; rr < 32; ++rr) {
            const size_t row = (size_t)(rowb + rr);
            f32x2 v[8];
            if constexpr (INF32) {
#pragma unroll
                for (int j = 0; j < 4; ++j) { v[2 * j] = (f32x2){nf[j][0], nf[j][1]}; v[2 * j + 1] = (f32x2){nf[j][2], nf[j][3]}; }
                if (rr + 1 < 32) { const f32x4* xr = (const f32x4*)((const float*)x + (row + 1) * DM) + F.lane;
#pragma unroll
                    for (int j = 0; j < 4; ++j) nf[j] = xr[64 * j]; } }
            else {
#pragma unroll
                for (int j = 0; j < 4; ++j) { const u32x2 p = nb[j]; v[2 * j] = (f32x2){bflo(p.x), bfhi(p.x)}; v[2 * j + 1] = (f32x2){bflo(p.y), bfhi(p.y)}; nb[j] = nc[j]; }
                if (rr + 2 < 32) { const u32x2* xr = (const u32x2*)((const bf16_t*)x + (row + 2) * DM) + F.lane;
#pragma unroll
                    for (int j = 0; j < 4; ++j) nc[j] = xr[64 * j]; } }
            f32x2 sq = v[0] * v[0];
#pragma unroll
            for (int i = 1; i < 8; ++i) sq += v[i] * v[i];
            const float r = __builtin_amdgcn_rsqf(wave_sum_dpp(sq.x + sq.y) * (1.0f / DM) + EPS);
            const f32x2 r2 = {r, r};
            f32x2 hv[8];
#pragma unroll
            for (int i = 0; i < 8; ++i) { v[i] = v[i] * r2; hv[i] = v[i] * ca[i] + cs[i]; }
            if constexpr (OUT8) { unsigned* o4 = (unsigned*)((unsigned char*)out1 + row * DM) + F.lane;
#pragma unroll
                for (int j = 0; j < 4; ++j) o4[64 * j] = cvt4_fp8(hv[2 * j].x, hv[2 * j].y, hv[2 * j + 1].x, hv[2 * j + 1].y); }
            else { u32x2* o8 = (u32x2*)((bf16_t*)out1 + row * DM) + F.lane;
#pragma unroll
                for (int j = 0; j < 4; ++j) { u32x2 w; w.x = cvtpk(hv[2 * j].x, hv[2 * j].y); w.y = cvtpk(hv[2 * j + 1].x, hv[2 * j + 1].y); o8[64 * j] = w; } }
            if constexpr (DUAL) { u32x2* p8 = (u32x2*)(out2 + row * DM) + F.lane;
#pragma unroll
                for (int j = 0; j < 4; ++j) { const f32x2 t0 = v[2 * j] * cb[2 * j] + cd[2 * j], t1 = v[2 * j + 1] * cb[2 * j + 1] + cd[2 * j + 1];
                    u32x2 w; w.x = cvtpk(t0.x, t0.y); w.y = cvtpk(t1.x, t1.y); p8[64 * j] = w; } }
            if constexpr (ROUTER) {
                f32x2 pp[4];
#pragma unroll
                for (int k = 0; k < 4; ++k) pp[k] = (f32x2){0.f, 0.f};
#pragma unroll
                for (int c = 0; c < 16; ++c) { const float hc = (c & 1) ? hv[c >> 1].y : hv[c >> 1].x; const f32x2 h2 = {hc, hc};
#pragma unroll
                    for (int k = 0; k < 4; ++k) pp[k] += h2 * wr2[c][k]; }
                float pe[8];
#pragma unroll
                for (int k = 0; k < 4; ++k) { pe[2 * k] = pp[k].x; pe[2 * k + 1] = pp[k].y; }
                { const bool b0 = F.lane & 1, b1 = F.lane & 2, b2 = F.lane & 4;
#pragma unroll
                  for (int e = 0; e < 4; ++e) { const float snd = b2 ? pe[e] : pe[e + 4], kp = b2 ? pe[e + 4] : pe[e]; pe[e] = kp + dppf<0x141>(snd); }
#pragma unroll
                  for (int e = 0; e < 2; ++e) { const float snd = b1 ? pe[e] : pe[e + 2], kp = b1 ? pe[e + 2] : pe[e]; pe[e] = kp + dppf<0x4E>(snd); }
                  { const float snd = b0 ? pe[0] : pe[1], kp = b0 ? pe[1] : pe[0]; pe[0] = kp + dppf<0xB1>(snd); }
                  pe[0] += dppf<0x128>(pe[0]); pe[0] += shflx(pe[0], F.lane, 16); pe[0] += shflx(pe[0], F.lane, 32); }
                float lg[8];
#pragma unroll
                for (int e = 0; e < 8; ++e) lg[e] = __int_as_float(__builtin_amdgcn_readlane(__float_as_int(pe[0]), e));
                int i1 = 0; float v1 = lg[0];
#pragma unroll
                for (int e = 1; e < 8; ++e) if (lg[e] > v1) { v1 = lg[e]; i1 = e; }
                int i2 = -1; float v2 = -INFINITY;
#pragma unroll
                for (int e = 0; e < 8; ++e) if (e != i1 && lg[e] > v2) { v2 = lg[e]; i2 = e; }
                const float wt = 1.0f / (1.0f + __expf(v2 - v1));
                if (F.lane == rr) { me12 = i1 | (i2 << 8); mw1 = wt; }
            }
        }
        if (ROUTER) {
            if (F.lane < 32) { e12[rowb + F.lane] = me12; w1o[rowb + F.lane] = mw1; }
            const int e1 = me12 & 255, e2 = me12 >> 8;
#pragma unroll
            for (int e = 0; e < 8; ++e) { const unsigned long long m1 = __ballot(F.lane < 32 && e1 == e), m2 = __ballot(F.lane < 32 && e2 == e);
                if (F.lane == 0) { atomicAdd((int*)&lcnt[e], (int)__popcll(m1)); atomicAdd((int*)&lcnt[8 + e], (int)__popcll(m2)); } }
            __syncthreads();
            if (F.tid < 16) cnt[rb * 16 + F.tid] = lcnt[F.tid];
            __syncthreads();
        }
    }
}

__device__ __forceinline__ void moe_scatter(const Ctx& F, const int* cnt, const int* e12, const float* w1, int* tos, float* wos, int* tile) {
    LAS int* T1 = (LAS int*)F.lds;
    LAS int* T2 = T1 + 512;
    LAS int* tot = T2 + 512;
    LAS int* pre = tot + 16;
    LAS int* seg = pre + 16;
    LAS int* wcn = seg + 32;
    for (int rb = F.vcu; rb < NTOK / 256; rb += F.G) {
        { const int bin = F.tid & 15, part = F.tid >> 4; int st = 0, sp = 0;
#pragma unroll
            for (int j = 0; j < 8; ++j) { const int b2 = part * 8 + j; const int v = cnt[b2 * 16 + bin]; st += v; if (b2 < rb) sp += v; }
            T1[part * 16 + bin] = st; T2[part * 16 + bin] = sp; }
        __syncthreads();
        if (F.tid < 16) { int st = 0, sp = 0; for (int p = 0; p < 32; ++p) { st += T1[p * 16 + F.tid]; sp += T2[p * 16 + F.tid]; } tot[F.tid] = st; pre[F.tid] = sp; }
        __syncthreads();
        if (F.tid == 0) { int s = 0; for (int bin = 0; bin < 16; ++bin) { seg[bin] = s; s += ((tot[bin] + 255) >> 8) << 8; } seg[16] = s; }
        __syncthreads();
        int e1 = -1, e2 = -1; float wt = 0.f; int r1 = 0, r2 = 0;
        const int token = rb * 256 + F.tid;
        if (F.tid < 256) { const int v = e12[token]; e1 = v & 255; e2 = v >> 8; wt = w1[token]; }
        if (F.wave < 4) {
#pragma unroll
            for (int e = 0; e < 8; ++e) { const unsigned long long m1 = __ballot(e1 == e), m2 = __ballot(e2 == e); const unsigned long long lt = (1ull << F.lane) - 1ull;
                if (e1 == e) r1 = (int)__popcll(m1 & lt); if (e2 == e) r2 = (int)__popcll(m2 & lt);
                if (F.lane == 0) { wcn[F.wave * 16 + e] = (int)__popcll(m1); wcn[F.wave * 16 + 8 + e] = (int)__popcll(m2); } }
        }
        __syncthreads();
        if (F.tid < 256) {
            int o1 = seg[e1] + pre[e1] + r1, o2 = seg[8 + e2] + pre[8 + e2] + r2;
            for (int w = 0; w < F.wave; ++w) { o1 += wcn[w * 16 + e1]; o2 += wcn[w * 16 + 8 + e2]; }
            tos[o1] = token; wos[o1] = wt; tos[o2] = token; wos[o2] = 1.0f - wt;
        }
        if (rb < 16) { const int bin = rb; const int s0 = seg[bin] + tot[bin], s1 = seg[bin + 1]; for (int s = s0 + F.tid; s < s1; s += 512) { tos[s] = -1; wos[s] = 0.f; } }
        if (rb == 0) { if (F.tid == 0) { tile[0] = seg[8] >> 8; tile[1] = seg[16] >> 8; }
            for (int t = F.tid; t < MAXTILES; t += 512) { const int s = t << 8; int e = 0;
#pragma unroll
                for (int bin = 1; bin < 16; ++bin) if (s >= seg[bin]) e = bin;
                tile[16 + t] = e & 7; } }
        __syncthreads();
    }
}

constexpr int SC_AT = 0, SC_WT = 34816, SC_AS = 69632, SC_BS = 102400, SC_SEG = 135168, SC_CARRY = 139264, SC_CW = 139776, SC_GB = 142336;
__device__ __forceinline__ void scan_phase(const Ctx& F, const float* par, int l, const bf16_t* XB, bf16_t* GY, const bf16_t* GW) {
    LAS unsigned char* lds = F.lds;
    LAS float* AS = (LAS float*)(lds + SC_AS); LAS float* BS = (LAS float*)(lds + SC_BS);
    LAS float* SEGA = (LAS float*)(lds + SC_SEG); LAS float* SEGB = SEGA + 512;
    LAS float* CARRY = (LAS float*)(lds + SC_CARRY);
    LAS float* CW = (LAS float*)(lds + SC_CW);
    LAS float* GB = (LAS float*)(lds + SC_GB);
    const int tid = F.tid, lane = F.lane, wid = F.wave, r32 = lane & 31, hh = lane >> 5;
    for (int un = F.vcu; un < 256; un += F.G) {
        const int b = un >> 4, n = (un >> 1) & 7, c2 = un & 1;
        __syncthreads();
        for (int i = tid; i < 640; i += 512) { const int ch = i & 127, k = i >> 7; CW[i] = (k < 4) ? par[PAR_CONVW + (l * 4 + k) * DM + 128 * n + ch] : par[PAR_CONVB + l * DM + 128 * n + ch]; }
        if (tid < 64) { const int ch = l * DM + 128 * n + 64 * c2 + tid; GB[tid] = par[PAR_GAB + ch]; GB[64 + tid] = par[PAR_GXB + ch]; GB[128 + tid] = log1pf(expf(-par[PAR_LAM + ch])); CARRY[tid] = 0.f; CARRY[64 + tid] = 0.f; }
        { const bf16_t* gsrc = GW + (size_t)(((l * 8 + n) * 2 + c2) * 128) * 128;
#pragma unroll
            for (int i = 0; i < 4; ++i) { const int p = tid + 512 * i, row = p >> 4, c16 = p & 15; const u32x4 v = *(const u32x4*)(gsrc + (size_t)row * 128 + c16 * 8); *(LAS u32x4*)(lds + SC_WT + row * 272 + c16 * 16) = v; } }
        const int cp = lane, tg = wid;
        const int sc = lane, sg = wid;
        const size_t rowbase = (size_t)b * SEQ;
        const bf16_t* xbp = XB + rowbase * DM + 128 * n + 2 * cp;
        bf16_t* gyp = GY + rowbase * DM + 128 * n + 64 * c2 + sc;
        unsigned xv[19];
#pragma unroll
        for (int k = 0; k < 19; ++k) { const int t = 16 * tg - 3 + k; xv[k] = (t >= 0) ? *(const unsigned*)(xbp + (size_t)t * DM) : 0u; }
        __syncthreads();
        float w[2][4], cb[2];
#pragma unroll
        for (int q = 0; q < 2; ++q) { cb[q] = CW[512 + 2 * cp + q];
#pragma unroll
            for (int k = 0; k < 4; ++k) w[q][k] = CW[k * 128 + 2 * cp + q]; }
        const float gba = GB[32 * (wid & 1) + r32], gbx = GB[64 + 32 * (wid & 1) + r32], spv = GB[128 + 32 * (wid & 1) + r32];
        for (int ci = 0; ci < SEQ / 128; ++ci) {
            const int t0 = ci * 128;
#pragma unroll
            for (int k = 0; k < 16; ++k) {
                float o[2];
#pragma unroll
                for (int q = 0; q < 2; ++q) { float s = cb[q];
#pragma unroll
                    for (int j = 0; j < 4; ++j) { const unsigned pv = xv[k + j]; const float xf = q ? __uint_as_float(pv & 0xffff0000u) : __uint_as_float(pv << 16); s += w[q][j] * xf; }
                    o[q] = s; }
                *(LAS unsigned*)(lds + SC_AT + (16 * tg + k) * 272 + cp * 4) = cvtpk(o[0], o[1]);
            }
            if (ci + 1 < SEQ / 128) {
#pragma unroll
                for (int k = 0; k < 19; ++k) xv[k] = *(const unsigned*)(xbp + (size_t)(t0 + 128 + 16 * tg - 3 + k) * DM);
            }
            __syncthreads();
            f32x16 ga, gx;
#pragma unroll
            for (int i = 0; i < 16; ++i) { ga[i] = 0.f; gx[i] = 0.f; }
            { const int tt = wid >> 1, ct = wid & 1;
                const LAS unsigned char* ap = lds + SC_AT + (32 * tt + r32) * 272 + hh * 16;
                const LAS unsigned char* bpa = lds + SC_WT + (32 * ct + r32) * 272 + hh * 16;
                const LAS unsigned char* bpx = bpa + 64 * 272;
#pragma unroll
                for (int s = 0; s < 8; ++s) { const bf16x8 af = *(const LAS bf16x8*)(ap + s * 32), ba = *(const LAS bf16x8*)(bpa + s * 32), bx = *(const LAS bf16x8*)(bpx + s * 32);
                    ga = __builtin_amdgcn_mfma_f32_32x32x16_bf16(af, ba, ga, 0, 0, 0); gx = __builtin_amdgcn_mfma_f32_32x32x16_bf16(af, bx, gx, 0, 0, 0); }
                const f32x2 nlv = {-LOG2E, -LOG2E}, bav = {-LOG2E * gba, -LOG2E * gba}, bxv = {-LOG2E * gbx, -LOG2E * gbx}, onev = {1.0f, 1.0f}, csv = {-8.0f * LOG2E * spv, -8.0f * LOG2E * spv};
#pragma unroll
                for (int i = 0; i < 16; i += 2) { const int tok = 32 * tt + (i & 3) + 8 * (i >> 2) + 4 * hh, ch = 32 * ct + r32;
                    const f32x2 a2 = {ga[i], ga[i + 1]}, x2 = {gx[i], gx[i + 1]};
                    const f32x2 ta = a2 * nlv + bav, tx = x2 * nlv + bxv;
                    const f32x2 da = (f32x2){fast_exp2(ta.x), fast_exp2(ta.y)} + onev, dx = (f32x2){fast_exp2(tx.x), fast_exp2(tx.y)} + onev;
                    const f32x2 rg = {fast_rcp(da.x), fast_rcp(da.y)}, ig = {fast_rcp(dx.x), fast_rcp(dx.y)};
                    const f32x2 l2 = rg * csv; const f32x2 av = {fast_exp2(l2.x), fast_exp2(l2.y)};
                    const f32x2 om = onev - av * av; const f32x2 bc = {__builtin_amdgcn_sqrtf(fmaxf(om.x, 0.f)), __builtin_amdgcn_sqrtf(fmaxf(om.y, 0.f))};
                    const f32x2 xc = {bf2f(*(const LAS unsigned short*)(lds + SC_AT + tok * 272 + (64 * c2 + ch) * 2)), bf2f(*(const LAS unsigned short*)(lds + SC_AT + (tok + 1) * 272 + (64 * c2 + ch) * 2))};
                    const f32x2 bb = (bc * ig) * xc;
                    AS[tok * 64 + ch] = av.x; AS[(tok + 1) * 64 + ch] = av.y; BS[tok * 64 + ch] = bb.x; BS[(tok + 1) * 64 + ch] = bb.y; }
            }
            __syncthreads();
            unsigned short gyv[16];
#pragma unroll
            for (int k = 0; k < 16; ++k) gyv[k] = gyp[(size_t)(t0 + 16 * sg + k) * DM];
            float av[16], bv[16];
#pragma unroll
            for (int k = 0; k < 16; ++k) { av[k] = AS[(16 * sg + k) * 64 + sc]; bv[k] = BS[(16 * sg + k) * 64 + sc]; }
            { float pa = 1.f, pb = 0.f;
#pragma unroll
                for (int k = 0; k < 16; ++k) { pb = av[k] * pb + bv[k]; pa *= av[k]; }
                SEGA[sg * 64 + sc] = pa; SEGB[sg * 64 + sc] = pb; }
            __syncthreads();
            float h = CARRY[(ci & 1) * 64 + sc];
            for (int s = 0; s < sg; ++s) h = SEGA[s * 64 + sc] * h + SEGB[s * 64 + sc];
#pragma unroll
            for (int k = 0; k < 16; ++k) { h = av[k] * h + bv[k]; const float o = h * bf2f(gyv[k]); gyp[(size_t)(t0 + 16 * sg + k) * DM] = (bf16_t)(cvtpk(o, 0.f) & 0xffffu); }
            if (sg == 7) CARRY[((ci + 1) & 1) * 64 + sc] = h;
        }
    }
    __syncthreads();
}

constexpr int AT_K = 0, AT_V = 36864;
__device__ __forceinline__ void attn_phase(const Ctx& F, const bf16_t* Q, const bf16_t* Kb, const bf16_t* Vb, bf16_t* O, const float* sinks) {
    LAS unsigned char* lds = F.lds;
    const int tid = F.tid, lane = F.lane, wid = F.wave, r32 = lane & 31, hh = lane >> 5;
    const int i16 = lane & 15, tq = i16 >> 2, tp = i16 & 3, blk = (lane >> 4) & 1;
    const int g = wid & 3, half = wid >> 2;
    constexpr int NU = BATCH * 32 * 4;
    u32x4 kreg[4], vreg[4]; bf16x8 qreg[2][4];
#define AT_LOADKV(unit) do { const int kh_ = (unit) & 3, n_ = ((unit) >> 2) & 31, b_ = (unit) >> 7; \
        _Pragma("unroll") for (int i = 0; i < 4; ++i) { const int p = tid + 512 * i, row = p >> 3, c16 = p & 7; kreg[i] = (u32x4){0u, 0u, 0u, 0u}; vreg[i] = (u32x4){0u, 0u, 0u, 0u}; \
            if (n_ > 0 || row >= 128) { const size_t tok = (size_t)b_ * SEQ + (size_t)(128 * (n_ - 1) + row); kreg[i] = *(const u32x4*)(Kb + tok * 256 + kh_ * 64 + c16 * 8); vreg[i] = *(const u32x4*)(Vb + tok * 256 + kh_ * 64 + c16 * 8); } } } while (0)
#define AT_LOADQ(unit) do { const int kh_ = (unit) & 3, n_ = ((unit) >> 2) & 31, b_ = (unit) >> 7; \
        _Pragma("unroll") for (int ps = 0; ps < 2; ++ps) { const size_t qt_ = (size_t)b_ * SEQ + (size_t)(128 * n_ + 64 * half + 32 * ps + r32); \
            _Pragma("unroll") for (int s = 0; s < 4; ++s) qreg[ps][s] = *(const bf16x8*)(Q + qt_ * DM + (4 * kh_ + g) * 64 + 16 * s + 8 * hh); } } while (0)
    int un = F.vcu;
    if (un < NU) { AT_LOADKV(un); AT_LOADQ(un); }
    for (; un < NU; un += F.G) {
        const int kh = un & 3, n = (un >> 2) & 31, b = un >> 7;
        __syncthreads();
#pragma unroll
        for (int i = 0; i < 4; ++i) { const int p = tid + 512 * i, row = p >> 3, c16 = p & 7;
            *(LAS u32x4*)(lds + AT_K + row * 144 + c16 * 16) = kreg[i]; *(LAS u32x4*)(lds + AT_V + row * 192 + c16 * 16) = vreg[i]; }
        __syncthreads();
        if (un + F.G < NU) AT_LOADKV(un + F.G);
        const int hq = 4 * kh + g;
        const float sink2 = sinks[hq] * LOG2E;
#pragma unroll 1
        for (int pass = 0; pass < 2; ++pass) {
            const int i0 = 64 * half + 32 * pass, kt0 = i0 >> 5;
            const size_t qtok = (size_t)b * SEQ + (size_t)(128 * n + i0 + r32);
            bf16x8 qf[4];
#pragma unroll
            for (int s = 0; s < 4; ++s) qf[s] = pass ? qreg[1][s] : qreg[0][s];
            f32x16 sacc[5];
#pragma unroll
            for (int t = 0; t < 5; ++t) {
#pragma unroll
                for (int i = 0; i < 16; ++i) sacc[t][i] = 0.f;
#pragma unroll
                for (int s = 0; s < 4; ++s) { const bf16x8 kf = *(const LAS bf16x8*)(lds + AT_K + (32 * (kt0 + t) + r32) * 144 + (16 * s + 8 * hh) * 2);
                    sacc[t] = __builtin_amdgcn_mfma_f32_32x32x16_bf16(kf, qf[s], sacc[t], 0, 0, 0); } }
            float sum = 0.f;
#pragma unroll
            for (int t = 0; t < 5; ++t) {
                const bool dead = (n == 0) && (32 * (kt0 + t) < 128);
#pragma unroll
                for (int i = 0; i < 16; ++i) { float p = fast_exp2(sacc[t][i]);
                    if (t == 0 || t == 4) { const int d = 32 * t + (i & 3) + 8 * (i >> 2) + 4 * hh - r32; p = ((d >= 1) && (d <= 128)) ? p : 0.f; }
                    if (dead) p = 0.f; sacc[t][i] = p; sum += p; } }
            sum += shflx(sum, lane, 32);
            sum += fast_exp2(sink2);
            const float inv = 1.0f / sum;
            f32x16 oacc[2];
#pragma unroll
            for (int i = 0; i < 16; ++i) { oacc[0][i] = 0.f; oacc[1][i] = 0.f; }
#pragma unroll
            for (int t = 0; t < 5; ++t)
#pragma unroll
                for (int s = 0; s < 2; ++s) {
                    u32x4 pk; pk.x = cvtpk(sacc[t][8 * s], sacc[t][8 * s + 1]); pk.y = cvtpk(sacc[t][8 * s + 2], sacc[t][8 * s + 3]); pk.z = cvtpk(sacc[t][8 * s + 4], sacc[t][8 * s + 5]); pk.w = cvtpk(sacc[t][8 * s + 6], sacc[t][8 * s + 7]);
                    const bf16x8 pb = __builtin_bit_cast(bf16x8, pk);
#pragma unroll
                    for (int dt = 0; dt < 2; ++dt) {
                        const LAS unsigned char* vp = lds + AT_V + (32 * (kt0 + t) + 16 * s + 4 * hh + tq) * 192 + (32 * dt + 16 * blk + 4 * tp) * 2;
                        const s16x4 lo = __builtin_bit_cast(s16x4, __builtin_amdgcn_ds_read_tr16_b64_v4i16((LAS s16x4*)vp));
                        const s16x4 hi = __builtin_bit_cast(s16x4, __builtin_amdgcn_ds_read_tr16_b64_v4i16((LAS s16x4*)(vp + 8 * 192)));
                        const bf16x8 va = __builtin_shufflevector(lo, hi, 0, 1, 2, 3, 4, 5, 6, 7);
                        oacc[dt] = __builtin_amdgcn_mfma_f32_32x32x16_bf16(va, pb, oacc[dt], 0, 0, 0);
                    }
                }
            bf16_t* op = O + qtok * DM + hq * 64;
#pragma unroll
            for (int dt = 0; dt < 2; ++dt)
#pragma unroll
                for (int q4 = 0; q4 < 4; ++q4) { u32x2 w; w.x = cvtpk(oacc[dt][4 * q4] * inv, oacc[dt][4 * q4 + 1] * inv); w.y = cvtpk(oacc[dt][4 * q4 + 2] * inv, oacc[dt][4 * q4 + 3] * inv);
                    *(u32x2*)(op + 32 * dt + 8 * q4 + 4 * hh) = w; }
        }
        if (un + F.G < NU) AT_LOADQ(un + F.G);
    }
#undef AT_LOADKV
#undef AT_LOADQ
    __syncthreads();
}

constexpr int NPHASE = 33 + (DUP_SCANPAIR ? 4 : 0);
__global__ void __launch_bounds__(512, 2) fwd_kernel(Args a) {
    extern __shared__ __attribute__((aligned(16))) unsigned char lds_raw[];
    volatile LAS unsigned* MISC = (volatile LAS unsigned*)((LAS unsigned char*)lds_raw + LDS_MISC);
    const int wv0 = __builtin_amdgcn_readfirstlane((int)threadIdx.x >> 6);
    if (wv0 == 0) MISC[lane_id_v()] = 0u;
    __syncthreads();
    XcdBarrier bar; bar.bar = (unsigned*)(a.ws + WS_CTL) + CW_BAR; bar.x = 0; bar.st = MISC;
    if (!MK_MULTI) bar = xcd_barrier_post((unsigned*)(a.ws + WS_CTL) + CW_BAR, MISC, wv0);
    const int lo = a.ph_lo, hi = a.ph_hi;
    int ph = 0;
#define PH_BEGIN(k) if (((PHSEL >> (k)) & 1) && (!MK_MULTI || (lo <= ph && ph < hi))) { Ctx F; { int t_ = wv0 * 64 + (int)lane_id_v(); asm volatile("" : "+v"(t_)); F.tid = t_; } F.lds = (LAS unsigned char*)lds_raw; F.lane = F.tid & 63; \
        F.wave = __builtin_amdgcn_readfirstlane(F.tid >> 6); F.G = gridDim.x; { int bx = blockIdx.x; asm volatile("" : "+s"(bx)); F.cid = bx; F.vcu = (F.G % 8 == 0) ? (bx % 8) * (F.G / 8) + bx / 8 : bx; } \
        unsigned char GAS* wsg_ = (unsigned char GAS*)a.ws; asm volatile("" : "+s"(wsg_)); unsigned char* ws = (unsigned char*)wsg_; float GAS* xog_ = (float GAS*)a.out; asm volatile("" : "+s"(xog_)); float* xo = (float*)xog_; int l = l_; asm volatile("" : "+s"(l)); (void)xo; (void)l; \
        for (int rep_ = 0; rep_ < (((DUPMASK >> (k)) & 1) ? 2 : 1); ++rep_) {
#define PH_END   } if (!MK_MULTI && ph + 1 < NPHASE) { XcdBarrier b2_ = bar; unsigned GAS* bp_ = (unsigned GAS*)b2_.bar; asm volatile("" : "+s"(bp_)); b2_.bar = (unsigned*)bp_; unsigned bx_ = b2_.x; asm volatile("" : "+s"(bx_)); b2_.x = bx_; xcd_barrier(b2_, wv0); } } ++ph;
#define W_PAR    ((const float*)(ws + WS_PAR))
#define W_XS     ((bf16_t*)(ws + WS_XS))
#define W_MODL   ((const float*)(ws + WS_MODV) + (size_t)l * 16 * 6144)
#define W_KVMOD  ((const float*)(ws + WS_KVMOD))
#define W_HB     ((bf16_t*)(ws + WS_H))
#define W_HKV    ((bf16_t*)(ws + WS_HKV))
#define W_KB     ((bf16_t*)(ws + WS_KB))
#define W_VB     ((bf16_t*)(ws + WS_VB))
#define W_XB     ((bf16_t*)(ws + WS_ARENA + AR_XB))
#define W_GY     ((bf16_t*)(ws + WS_ARENA + AR_GY))
#define W_HID    ((bf16_t*)(ws + WS_ARENA))
#define W_Q      ((bf16_t*)(ws + WS_ARENA + AR_Q))
#define W_O      ((bf16_t*)(ws + WS_ARENA + AR_O))
#define W_ROT    ((const _Float16*)(ws + WS_COS))
#define W_E12    ((int*)(ws + WS_E12))
#define W_W1     ((float*)(ws + WS_W1))
#define W_CNT    ((int*)(ws + WS_CNT))
#define W_TILE   ((int*)(ws + WS_TILE))
#define W_TOS    ((int*)(ws + WS_TOS))
#define W_WOS    ((float*)(ws + WS_WOS))

    { const int l_ = 0; PH_BEGIN(0) p0_prologue(F, a); PH_END }

#pragma unroll 1
    for (int l_ = 0; l_ < 4; ++l_) {
        if (l_ < 2) {
            PH_BEGIN(1) if (l == 0) norm_phase<false, false, false, true>(F, a.x, W_PAR + PAR_MIXN + l * DM, W_MODL, W_MODL + 1024, W_HB, nullptr, nullptr, nullptr, nullptr, nullptr, nullptr, nullptr, nullptr);
                        else norm_phase<false, false>(F, W_XS, W_PAR + PAR_MIXN + l * DM, W_MODL, W_MODL + 1024, W_HB, nullptr, nullptr, nullptr, nullptr, nullptr, nullptr, nullptr, nullptr); PH_END
#pragma unroll 1
            for (int sp_ = 0; sp_ < (DUP_SCANPAIR ? 2 : 1); ++sp_) {
            PH_BEGIN(2) { pg8::ProbDense P{W_HB, (const bf16_t*)(ws + WS_WIN) + (size_t)l * 2048 * DM, DM * 2}; pg8::Order S; S.init(NTOK / 256, 8, F.G, F.cid, 0);
                pg8::EpiWin E{W_XB, W_GY}; pg8::gemm_phase<pg8::EpiWin, pg8::ProbDense, false>(F.lds, F.tid, P, S, E); } PH_END
            PH_BEGIN(3) scan_phase(F, W_PAR, l, W_XB, W_GY, (const bf16_t*)(ws + WS_GW)); PH_END
            }
            if (l_ == 0) {
                PH_BEGIN(20) { pg8::ProbDense P{W_GY, (const bf16_t*)(ws + WS_WOUT), DM * 2}; pg8::Order S; S.init(NTOK / 256, 4, F.G, F.cid, 0, STAGGER_TICKS);
                    pg8::EpiResid<true> E{a.x, W_XS, W_MODL + 2048, 1.0f}; pg8::gemm_phase<pg8::EpiResid<true>, pg8::ProbDense, false>(F.lds, F.tid, P, S, E); } PH_END
            } else {
                PH_BEGIN(4) { pg8::ProbDense P{W_GY, (const bf16_t*)(ws + WS_WOUT) + (size_t)l * DM * DM, DM * 2}; pg8::Order S; S.init(NTOK / 256, 4, F.G, F.cid, 0, STAGGER_TICKS);
                    pg8::EpiResid<false> E{W_XS, W_XS, W_MODL + 2048, 1.0f}; pg8::gemm_phase<pg8::EpiResid<false>, pg8::ProbDense, false>(F.lds, F.tid, P, S, E); } PH_END
            }
        } else {
            PH_BEGIN(5) if (l == 2) norm_phase<true, false>(F, W_XS, W_PAR + PAR_MIXN + l * DM, W_MODL, W_MODL + 1024, W_HB, W_PAR + PAR_KVN, W_KVMOD, W_KVMOD + 1024, W_HKV, nullptr, nullptr, nullptr, nullptr);
                        else norm_phase<false, false>(F, W_XS, W_PAR + PAR_MIXN + l * DM, W_MODL, W_MODL + 1024, W_HB, nullptr, nullptr, nullptr, nullptr, nullptr, nullptr, nullptr, nullptr); PH_END
            if (l_ == 2) {
                PH_BEGIN(6) {
                    { pg8::ProbDense P{W_HKV, (const bf16_t*)(ws + WS_WKV), DM * 2}; pg8::Order S; S.init(NTOK / 256, 2, F.G, F.cid, 0);
                      pg8::EpiQK E{W_KB, 256, W_PAR + PAR_KN, W_ROT, 1.0f, 1, W_VB}; pg8::gemm_phase<pg8::EpiQK, pg8::ProbDense, false>(F.lds, F.tid, P, S, E); }
                    { pg8::ProbDense P{W_HB, (const bf16_t*)(ws + WS_WQ), DM * 2}; pg8::Order S; S.init(NTOK / 256, 4, F.G, F.cid, 0);
                      pg8::EpiQK E{W_Q, DM, W_PAR + PAR_QN, W_ROT, 0.125f * LOG2E, -1, nullptr}; pg8::gemm_phase<pg8::EpiQK, pg8::ProbDense, false>(F.lds, F.tid, P, S, E); } } PH_END
            } else {
                PH_BEGIN(21) { pg8::ProbDense P{W_HB, (const bf16_t*)(ws + WS_WQ) + (size_t)DM * DM, DM * 2}; pg8::Order S; S.init(NTOK / 256, 4, F.G, F.cid, 0);
                    pg8::EpiQK E{W_Q, DM, W_PAR + PAR_QN + 64, W_ROT, 0.125f * LOG2E, -1, nullptr}; pg8::gemm_phase<pg8::EpiQK, pg8::ProbDense, false>(F.lds, F.tid, P, S, E); } PH_END
            }
            PH_BEGIN(7) attn_phase(F, W_Q, W_KB, W_VB, W_O, W_PAR + PAR_SINK + (l - 2) * 16); PH_END
            PH_BEGIN(8) { pg8::ProbDense P{W_O, (const bf16_t*)(ws + WS_WO) + (size_t)(l - 2) * DM * DM, DM * 2}; pg8::Order S; S.init(NTOK / 256, 4, F.G, F.cid, 0, STAGGER_TICKS);
                pg8::EpiResid<false> E{W_XS, W_XS, W_MODL + 2048, 1.0f}; pg8::gemm_phase<pg8::EpiResid<false>, pg8::ProbDense, false>(F.lds, F.tid, P, S, E); } PH_END
        }
        if (!(l_ & 1)) {
            PH_BEGIN(9) if (FP8_OF(0) | FP8_OF(2)) { if (FP8_DENSE(l)) norm_phase<false, false, true>(F, W_XS, W_PAR + PAR_FFNN + l * DM, W_MODL + 3072, W_MODL + 4096, W_HB, nullptr, nullptr, nullptr, nullptr, nullptr, nullptr, nullptr, nullptr);
                             else norm_phase<false, false, false>(F, W_XS, W_PAR + PAR_FFNN + l * DM, W_MODL + 3072, W_MODL + 4096, W_HB, nullptr, nullptr, nullptr, nullptr, nullptr, nullptr, nullptr, nullptr); }
                        else norm_phase<false, false, false>(F, W_XS, W_PAR + PAR_FFNN + l * DM, W_MODL + 3072, W_MODL + 4096, W_HB, nullptr, nullptr, nullptr, nullptr, nullptr, nullptr, nullptr, nullptr); PH_END
            if (FP8_DENSE(l_)) {
                PH_BEGIN(17) { pg8::ProbDense P{W_HB, ws + WS_FGU + (size_t)(l >> 1) * 6144 * DM * 2, DM}; pg8::Order S; S.init(NTOK / 256, 24, F.G, F.cid, 0);
                    pg8::EpiSwiglu<true> E{W_HID, DFF, 1.0f / (SC8_H * SC8_W)}; pg8::gemm_phase<pg8::EpiSwiglu<true>, pg8::ProbDense, false, true>(F.lds, F.tid, P, S, E); } PH_END
                PH_BEGIN(18) { pg8::ProbDense P{W_HID, ws + WS_FDN + (size_t)(l >> 1) * DM * DFF * 2, DFF}; pg8::Order S; S.init(NTOK / 256, 4, F.G, F.cid, 0, STAGGER_TICKS);
                    pg8::EpiResid<false> E{W_XS, W_XS, W_MODL + 5120, 1.0f / (SC8_HID * SC8_W)}; pg8::gemm_phase<pg8::EpiResid<false>, pg8::ProbDense, false, true>(F.lds, F.tid, P, S, E); } PH_END
            } else {
                PH_BEGIN(10) { pg8::ProbDense P{W_HB, (const bf16_t*)(ws + WS_FGU) + (size_t)(l >> 1) * 6144 * DM, DM * 2}; pg8::Order S; S.init(NTOK / 256, 24, F.G, F.cid, 0);
                    pg8::EpiSwiglu<false> E{W_HID, DFF, 1.0f}; pg8::gemm_phase<pg8::EpiSwiglu<false>, pg8::ProbDense, false>(F.lds, F.tid, P, S, E); } PH_END
                PH_BEGIN(11) { pg8::ProbDense P{W_HID, (const bf16_t*)(ws + WS_FDN) + (size_t)(l >> 1) * DM * DFF, DFF * 2}; pg8::Order S; S.init(NTOK / 256, 4, F.G, F.cid, 0, STAGGER_TICKS);
                    pg8::EpiResid<false> E{W_XS, W_XS, W_MODL + 5120, 1.0f}; pg8::gemm_phase<pg8::EpiResid<false>, pg8::ProbDense, false>(F.lds, F.tid, P, S, E); } PH_END
            }
        } else {
            PH_BEGIN(12) if (FP8_MOE(l)) norm_phase_pk<false, true, true>(F, W_XS, W_PAR + PAR_FFNN + l * DM, W_MODL + 3072, W_MODL + 4096, W_HB, nullptr, nullptr, nullptr, nullptr, W_PAR + PAR_ROUTER + (l >> 1) * DM * 8, W_E12, W_W1, W_CNT);
                         else norm_phase_pk<false, true, false>(F, W_XS, W_PAR + PAR_FFNN + l * DM, W_MODL + 3072, W_MODL + 4096, W_HB, nullptr, nullptr, nullptr, nullptr, W_PAR + PAR_ROUTER + (l >> 1) * DM * 8, W_E12, W_W1, W_CNT); PH_END
            PH_BEGIN(13) moe_scatter(F, W_CNT, W_E12, W_W1, W_TOS, W_WOS, W_TILE); PH_END
            if (FP8_MOE(l_)) {
                PH_BEGIN(16) {
                    LAS int* texp = (LAS int*)(F.lds + LDS_TEXP);
                    for (int i = F.tid; i < MAXTILES + 16; i += 512) texp[i] = W_TILE[i];
                    __syncthreads();
                    const int ntot = texp[1];
                    pg8::Order S; S.init(ntot, 28, F.G, F.cid, 0);
                    pg8::ProbGrouped P{W_HB, ws + WS_MGU + (size_t)(l >> 1) * 8 * 7168 * DM * 2, DM, 7168, texp + 16, W_TOS};
                    pg8::EpiSwiglu<true> E{W_HID, DFE, 1.0f / (SC8_H * SC8_W)}; pg8::gemm_phase<pg8::EpiSwiglu<true>, pg8::ProbGrouped, true, true>(F.lds, F.tid, P, S, E); } PH_END
            } else {
                PH_BEGIN(14) {
                    LAS int* texp = (LAS int*)(F.lds + LDS_TEXP);
                    for (int i = F.tid; i < MAXTILES + 16; i += 512) texp[i] = W_TILE[i];
                    __syncthreads();
                    const int ntot = texp[1];
                    pg8::Order S; S.init(ntot, 28, F.G, F.cid, 0);
                    pg8::ProbGrouped P{W_HB, (const bf16_t*)(ws + WS_MGU) + (size_t)(l >> 1) * 8 * 7168 * DM, DM * 2, 7168, texp + 16, W_TOS};
                    pg8::EpiSwiglu<false> E{W_HID, DFE, 1.0f}; pg8::gemm_phase<pg8::EpiSwiglu<false>, pg8::ProbGrouped, true, false>(F.lds, F.tid, P, S, E); } PH_END
            }
#pragma unroll 1
            for (int pass = 0; pass < 2; ++pass) {
                if (l_ == 3 && pass == 1) {
                    PH_BEGIN(19) {
                        LAS int* texp = (LAS int*)(F.lds + LDS_TEXP);
                        for (int i = F.tid; i < MAXTILES + 16; i += 512) texp[i] = W_TILE[i];
                        __syncthreads();
                        const int nA = texp[0], ntot = texp[1];
                        pg8::Order S; S.init(ntot - nA, 4, F.G, F.cid, nA, STAGGER_TICKS);
                        if (FP8_MOE(3)) { pg8::ProbGrouped P{W_HID, ws + WS_MDN + (size_t)8 * DM * DFE * 2, DFE, DM, texp + 16, W_TOS};
                            pg8::EpiMoeDown<true> E{W_XS, xo, W_MODL + 5120, W_TOS, W_WOS, 1.0f / (SC8_HID * SC8_W)}; pg8::gemm_phase<pg8::EpiMoeDown<true>, pg8::ProbGrouped, false, true>(F.lds, F.tid, P, S, E); }
                        else { pg8::ProbGrouped P{W_HID, (const bf16_t*)(ws + WS_MDN) + (size_t)8 * DM * DFE, DFE * 2, DM, texp + 16, W_TOS};
                            pg8::EpiMoeDown<true> E{W_XS, xo, W_MODL + 5120, W_TOS, W_WOS, 1.0f}; pg8::gemm_phase<pg8::EpiMoeDown<true>, pg8::ProbGrouped, false, false>(F.lds, F.tid, P, S, E); } } PH_END
                } else {
                    PH_BEGIN(15) {
                        LAS int* texp = (LAS int*)(F.lds + LDS_TEXP);
                        for (int i = F.tid; i < MAXTILES + 16; i += 512) texp[i] = W_TILE[i];
                        __syncthreads();
                        const int nA = texp[0], ntot = texp[1];
                        pg8::Order S; S.init(pass ? ntot - nA : nA, 4, F.G, F.cid, pass ? nA : 0, STAGGER_TICKS);
                        if (FP8_MOE(l)) { pg8::ProbGrouped P{W_HID, ws + WS_MDN + (size_t)(l >> 1) * 8 * DM * DFE * 2, DFE, DM, texp + 16, W_TOS};
                            pg8::EpiMoeDown<false> E{W_XS, W_XS, W_MODL + 5120, W_TOS, W_WOS, 1.0f / (SC8_HID * SC8_W)}; pg8::gemm_phase<pg8::EpiMoeDown<false>, pg8::ProbGrouped, false, true>(F.lds, F.tid, P, S, E); }
                        else { pg8::ProbGrouped P{W_HID, (const bf16_t*)(ws + WS_MDN) + (size_t)(l >> 1) * 8 * DM * DFE, DFE * 2, DM, texp + 16, W_TOS};
                            pg8::EpiMoeDown<false> E{W_XS, W_XS, W_MODL + 5120, W_TOS, W_WOS, 1.0f}; pg8::gemm_phase<pg8::EpiMoeDown<false>, pg8::ProbGrouped, false, false>(F.lds, F.tid, P, S, E); }
                        if (DEFER_L3 && l == 1) {
                            const int tail = S.nwg % F.G; const bool part = (tail > 0) && (2 * tail < F.G);
                            __syncthreads();
                            if (!part || F.cid >= tail) convert_deferred(F, a.m_w_gu, a.m_w_down, ws, pass, part ? F.cid - tail : F.cid, part ? F.G - tail : F.G);
                        } } PH_END
                }
            }
        }
    }
#undef PH_BEGIN
#undef PH_END
}

extern "C" void kernel_launch(void* const* d_in, const int* in_sizes, int n_in, void* d_out, int out_size, void* d_ws, size_t ws_size, hipStream_t stream) {
    static int grid = 0;
    if (grid == 0) {
        if (n_in != 30 || in_sizes[0] != NTOK * DM || out_size != NTOK * DM || ws_size < WS_END) { fprintf(stderr, "kernel_launch: unexpected shapes (n_in %d, in0 %d, out %d, ws %zu < %zu)\n", n_in, n_in > 0 ? in_sizes[0] : -1, out_size, ws_size, (size_t)WS_END); grid = -1; return; }
        int dev = 0, cus = 0, per_cu = 0;
        if (hipGetDevice(&dev) != hipSuccess || hipDeviceGetAttribute(&cus, hipDeviceAttributeMultiprocessorCount, dev) != hipSuccess) { grid = -1; return; }
        if (hipFuncSetAttribute((const void*)fwd_kernel, hipFuncAttributeMaxDynamicSharedMemorySize, LDS_BYTES) != hipSuccess) { fprintf(stderr, "kernel_launch: hipFuncSetAttribute failed\n"); grid = -1; return; }
        if (hipOccupancyMaxActiveBlocksPerMultiprocessor(&per_cu, (const void*)fwd_kernel, 512, LDS_BYTES) != hipSuccess || per_cu < 1) fprintf(stderr, "kernel_launch: occupancy query reports %d\n", per_cu);
        (void)hipGetLastError();
        grid = cus;
    }
    if (grid < 0) return;
    if (hipMemsetAsync((char*)d_ws + WS_CTL, 0, CTL_ZERO_BYTES, stream) != hipSuccess) return;
    Args a{};
    const float** fp = (const float**)&a;
    for (int i = 0; i < 30; ++i) fp[i] = (const float*)d_in[i];
    a.out = (float*)d_out; a.ws = (unsigned char*)d_ws;
#if MK_MULTI
    for (int p = 0; p < NPHASE; ++p) { a.ph_lo = p; a.ph_hi = p + 1; hipLaunchKernelGGL(fwd_kernel, dim3(grid), dim3(512), LDS_BYTES, stream, a); }
#else
    a.ph_lo = 0; a.ph_hi = NPHASE; hipLaunchKernelGGL(fwd_kernel, dim3(grid), dim3(512), LDS_BYTES, stream, a);
#endif
}
```

```cpp
#include <hip/hip_runtime.h>
#include <cstdio>
#include <cstdint>

#ifndef FP8MASK
#define FP8MASK 14
#endif
#define FP8_OF(l) (((FP8MASK) >> (l)) & 1)
#define FP8_MOE(l)   ((FP8_OF(1) && FP8_OF(3)) || ((FP8_OF(1) || FP8_OF(3)) && FP8_OF(l)))
#define FP8_DENSE(l) ((FP8_OF(0) && FP8_OF(2)) || ((FP8_OF(0) || FP8_OF(2)) && FP8_OF(l)))
#ifndef STAGGER_TICKS
#define STAGGER_TICKS 0
#endif
#ifndef DEFER_L3
#define DEFER_L3 1
#endif
#ifndef FP8_WO
#define FP8_WO 1
#endif
#ifndef DUPMASK
#define DUPMASK 0
#endif
#ifndef DUP_SCANPAIR
#define DUP_SCANPAIR 0
#endif
#ifndef PHSEL
#define PHSEL 0xFFFFFFFFu
#endif
#ifndef MK_MULTI
#define MK_MULTI 0
#endif

#define LAS __attribute__((address_space(3)))
#define GAS __attribute__((address_space(1)))
typedef unsigned short bf16_t;
typedef short bf16x8 __attribute__((ext_vector_type(8)));
typedef short s16x4 __attribute__((ext_vector_type(4)));
typedef float f32x2 __attribute__((ext_vector_type(2)));
typedef float f32x4 __attribute__((ext_vector_type(4)));
typedef float f32x16 __attribute__((ext_vector_type(16)));
typedef unsigned u32x2 __attribute__((ext_vector_type(2)));
typedef unsigned u32x4 __attribute__((ext_vector_type(4)));
typedef __bf16 bf16x2_t __attribute__((ext_vector_type(2)));
typedef int i32x4 __attribute__((ext_vector_type(4)));
typedef int i32x8 __attribute__((ext_vector_type(8)));
constexpr float SC8_H = 4.0f, SC8_W = 64.0f, SC8_HID = 8.0f, SC8_O = 64.0f;

constexpr int DM = 1024, BATCH = 16, SEQ = 4096, NTOK = BATCH * SEQ;
constexpr int DFF = 3072, NEXP = 8, DFE = 3584;
constexpr int NSLOT = 135168;
constexpr int MAXTILES = NSLOT / 256;
constexpr float EPS = 1e-6f;
constexpr float LOG2E = 1.4426950408889634f;

constexpr size_t MiB = 1u << 20;
constexpr size_t WS_CTL = 0, CTL_ZERO_BYTES = 1 * MiB;
constexpr size_t WS_MODV = 1 * MiB;
constexpr size_t WS_KVMOD = 3 * MiB;
constexpr size_t WS_PAR = 3 * MiB + 512 * 1024;
constexpr int PAR_MIXN = 0, PAR_FFNN = 4096, PAR_CONVW = 8192, PAR_CONVB = 16384, PAR_GXB = 18432, PAR_GAB = 20480, PAR_LAM = 22528, PAR_KVN = 24576, PAR_KN = 25600, PAR_QN = 25664, PAR_SINK = 25792, PAR_ROUTER = 25856, PAR_END = 42240;
constexpr size_t WS_E12 = 4 * MiB;
constexpr size_t WS_W1 = 5 * MiB;
constexpr size_t WS_CNT = 6 * MiB;
constexpr size_t WS_TILE = 6 * MiB + 65536;
constexpr size_t WS_TOS = 7 * MiB;
constexpr size_t WS_WOS = 8 * MiB;
constexpr size_t WS_GW = 9 * MiB;
constexpr size_t WS_COS = 10 * MiB;
constexpr size_t WS_SIN = 18 * MiB;
constexpr size_t WS_WIN = 26 * MiB;
constexpr size_t WS_WOUT = 34 * MiB;
constexpr size_t WS_WKV = 38 * MiB;
constexpr size_t WS_WQ = 39 * MiB;
constexpr size_t WS_WO = 43 * MiB;
constexpr size_t WS_FGU = 47 * MiB;
constexpr size_t WS_FDN = 71 * MiB;
constexpr size_t WS_MGU = 83 * MiB;
constexpr size_t WS_MDN = 307 * MiB;
constexpr size_t WS_H = 419 * MiB;
constexpr size_t WS_HKV = 547 * MiB;
constexpr size_t WS_KB = 675 * MiB;
constexpr size_t WS_VB = 707 * MiB;
constexpr size_t WS_ARENA = 739 * MiB;
constexpr size_t WS_XS = WS_ARENA + (size_t)NSLOT * DFE * 2;
constexpr size_t WS_END = WS_XS + (size_t)NTOK * DM * 2;
static_assert(WS_END <= (size_t)1792 * MiB, "workspace map");
constexpr size_t AR_XB = 0, AR_GY = 128 * MiB, AR_Q = 0, AR_O = 128 * MiB;

constexpr int CW_BAR = 4096;

constexpr int LDS_BYTES = 163840;
constexpr int RING_BYTES = 131072;
constexpr int LDS_TEXP = RING_BYTES;
constexpr int LDS_IDX = RING_BYTES + 4096;
constexpr int LDS_MISC = LDS_BYTES - 256;

__device__ __forceinline__ unsigned cvtpk(float lo, float hi) { f32x2 v = {lo, hi}; bf16x2_t b = __builtin_convertvector(v, bf16x2_t); return __builtin_bit_cast(unsigned, b); }
__device__ __forceinline__ float clamp8(float v) { return __builtin_amdgcn_fmed3f(v, -448.0f, 448.0f); }
__device__ __forceinline__ unsigned cvt4_fp8(float a, float b, float c, float d) { int p = __builtin_amdgcn_cvt_pk_fp8_f32(clamp8(a), clamp8(b), 0, false); p = __builtin_amdgcn_cvt_pk_fp8_f32(clamp8(c), clamp8(d), p, true); return (unsigned)p; }
__device__ __forceinline__ float bflo(unsigned p) { return __uint_as_float(p << 16); }
__device__ __forceinline__ float bfhi(unsigned p) { return __uint_as_float(p & 0xffff0000u); }
__device__ __forceinline__ float bf2f(unsigned short b) { return __uint_as_float(((unsigned)b) << 16); }
__device__ __forceinline__ float fast_exp2(float x) { return __builtin_amdgcn_exp2f(x); }
__device__ __forceinline__ float fast_rcp(float x) { return __builtin_amdgcn_rcpf(x); }
__device__ __forceinline__ float sigmoidf_(float x) { return fast_rcp(1.0f + fast_exp2(-x * LOG2E)); }
__device__ __forceinline__ float silu_(float x) { return x * sigmoidf_(x); }
__device__ __forceinline__ float gelu_tanh_(float x) { const float u = 0.7978845608028654f * (x + 0.044715f * x * x * x); return x * sigmoidf_(2.0f * u); }
__device__ __forceinline__ float shflx(float v, int lane, int o) { return __int_as_float(__builtin_amdgcn_ds_bpermute((lane ^ o) << 2, __float_as_int(v))); }
__device__ __forceinline__ float wave_sum(float v, int lane) {
#pragma unroll
    for (int o = 1; o < 64; o <<= 1) v += shflx(v, lane, o);
    return v;
}
template <int CTRL, int RM = 0xf, int BM = 0xf> __device__ __forceinline__ float dppf(float v) { return __int_as_float(__builtin_amdgcn_update_dpp(0, __float_as_int(v), CTRL, RM, BM, false)); }
__device__ __forceinline__ float wave_sum_dpp(float v) {
    float s = v + dppf<0x111>(v); s += dppf<0x112>(v); s += dppf<0x113>(v);
    s += dppf<0x114>(s); s += dppf<0x118>(s);
    s += dppf<0x142, 0xa>(s); s += dppf<0x143, 0xc>(s);
    return __int_as_float(__builtin_amdgcn_readlane(__float_as_int(s), 63));
}
__device__ __forceinline__ int lane_id_v() { int l; asm volatile("v_mbcnt_lo_u32_b32 %0, -1, 0\n\tv_mbcnt_hi_u32_b32 %0, -1, %0" : "=v"(l)); return l; }
#define LDS_WAIT() asm volatile("s_waitcnt lgkmcnt(0)" ::: "memory")
#define VM_WAIT() asm volatile("s_waitcnt vmcnt(0)" ::: "memory")

namespace pg8 {
constexpr int BM = 256, BK = 64, HALF = 128, HTB = HALF * BK * 2, STAGE_BYTES = 8 * HTB, NXCD = 8, WGM = 8;
__host__ __device__ __forceinline__ int lds_byte(int r, int c) { const int st = (r >> 4) * 2 + (c >> 5), rr = r & 15, cc = c & 31, ob = rr * 64 + cc * 2; return st * 1024 + (ob ^ (((ob >> 9) & 1) << 5)); }
__host__ __device__ __forceinline__ void stage_rc(int b, int& R, int& C) { const int st = b / 1024, sb = b % 1024, swz = sb ^ (((sb >> 9) & 1) << 5); R = (st >> 1) * 16 + swz / 64; C = (st & 1) * 32 + (swz % 64) / 2; }
__host__ __device__ __forceinline__ int perm32(int rho) { const int n = rho >> 4, i = rho & 15; return 8 * (i >> 2) + 4 * n + (i & 3); }

struct Unit { int pm, pn; };

struct Order {
    int nM, nN, nwg, G, c, tile0, delay, nig; unsigned mg;
    __device__ __forceinline__ void init(int nM_, int nN_, int G_, int c_, int tile0_, int delay_ = 0) { nM = nM_; nN = nN_; nwg = nM * nN; G = G_; c = c_; tile0 = tile0_; delay = ((c_ >> 3) & 1) ? delay_ : 0;
        nig = WGM * nN; mg = (unsigned)((0x100000000ull + (unsigned)nig - 1ull) / (unsigned)nig); }
    __device__ __forceinline__ bool next(int i, Unit& u) const {
        const int L = i * G + c; if (L >= nwg) return false;
        int wgid; { const int q = nwg >> 3, r = nwg & 7, xcd = L & 7, off = L >> 3; wgid = (xcd < r ? xcd * (q + 1) : r * (q + 1) + (xcd - r) * q) + off; }
        const int gid = (int)__umulhi((unsigned)wgid, mg), rem = wgid - gid * nig, fm = gid * WGM, gsz = (nM - fm) < WGM ? (nM - fm) : WGM;
        if (gsz == WGM) { u.pm = tile0 + fm + (rem & (WGM - 1)); u.pn = rem >> 3; }
        else { u.pm = tile0 + fm + rem % gsz; u.pn = rem / gsz; }
        return true;
    }
};

struct ProbDense {
    const void* A; const void* Bt; int KB;
    __device__ __forceinline__ const char* a_ptr(const Unit& u) const { return (const char*)A + (size_t)u.pm * BM * KB; }
    __device__ __forceinline__ const char* b_ptr(const Unit& u) const { return (const char*)Bt + (size_t)u.pn * BM * KB; }
};
struct ProbGrouped {
    const void* A; const void* Bt; int KB; int N; const LAS int* texp; const int* tos;
    __device__ __forceinline__ const char* a_ptr(const Unit& u) const { return (const char*)A + (size_t)u.pm * BM * KB; }
    __device__ __forceinline__ const char* b_ptr(const Unit& u) const { return (const char*)Bt + ((size_t)texp[u.pm] * N + (size_t)u.pn * BM) * KB; }
};

template <class Epi, class Prob, bool GATHER, bool FP8 = false>
__device__ __forceinline__ void gemm_phase(LAS unsigned char* lds, const int tid, const Prob P, const Order& S, const Epi& E) {
    const int wid = __builtin_amdgcn_readfirstlane(tid >> 6), lane = tid & 63, wr = wid >> 2, wc = wid & 3, fr = lane & 15, fq = lane >> 4;
    const int KB = P.KB, nt = KB / (BK * 2);
    unsigned voffA[2], voffB[2];
#pragma unroll
    for (int i = 0; i < 2; ++i) { int R, C; stage_rc(tid * 16 + i * 8192, R, C); const int Rb = Epi::PERM ? ((R & ~31) + perm32(R & 31)) : R;
        voffA[i] = GATHER ? (unsigned)(C * 2) : (unsigned)(R * KB + C * 2); voffB[i] = (unsigned)(Rb * KB + C * 2); }
    const size_t kstep = (size_t)(BK * 2);
    const size_t hstep = (size_t)HALF * KB;
    const unsigned ldsw = (unsigned)wid * 1024u;
    const int aoff = lds_byte(wr * 64 + fr, fq * 8), boff = lds_byte(wc * 32 + fr, fq * 8);
    LAS int* idxb = (LAS int*)(lds + LDS_IDX);
#define PG8_GIDX(buf) do { int ln_ = lane; asm volatile("" : "+v"(ln_)); _Pragma("unroll") for (int i = 0; i < 2; ++i) { const int R_ = 16 * ((wid + 8 * i) >> 1) + (ln_ >> 2); \
        int t0 = idxb[(buf) * 256 + R_], t1 = idxb[(buf) * 256 + 128 + R_]; t0 = t0 < 0 ? 0 : t0; t1 = t1 < 0 ? 0 : t1; \
        vC0[i] = (unsigned)t0 * (unsigned)KB + voffA[i]; vC1[i] = (unsigned)t1 * (unsigned)KB + voffA[i]; } } while (0)
#define PG8_GDMA(unit, buf) do { if (wid < 4) { int ln_ = lane; asm volatile("" : "+v"(ln_)); \
        __builtin_amdgcn_global_load_lds((const unsigned*)(P.tos + (size_t)(unit).pm * BM + wid * 64) + ln_, (LAS unsigned*)(idxb + (buf) * 256 + wid * 64), 4, 0, 0); } } while (0)
#define PG8_SA(b, h) (((b) * 2 + (h)) * HTB)
#define PG8_SB(b, h) ((4 + (b) * 2 + (h)) * HTB)
#define PG8_STAGE(bufoff, gbase, voff) do { const char* g_ = (const char*)(gbase); asm volatile("" : "+s"(g_)); _Pragma("unroll") for (int _i = 0; _i < 2; ++_i) \
        __builtin_amdgcn_global_load_lds((const unsigned*)(g_ + (voff)[_i]), (LAS unsigned*)(lds + (bufoff) + ldsw + _i * 8192), 16, 0, 0); } while (0)
#define PG8_LDA(dst, b, h) do { _Pragma("unroll") for (int m = 0; m < 4; ++m) _Pragma("unroll") for (int k = 0; k < 2; ++k) dst[m][k] = *(const LAS bf16x8*)(lds + PG8_SA(b, h) + aoff + m * 2048 + k * 1024); } while (0)
#define PG8_LDB(dst, b, h) do { _Pragma("unroll") for (int n = 0; n < 2; ++n) _Pragma("unroll") for (int k = 0; k < 2; ++k) dst[n][k] = *(const LAS bf16x8*)(lds + PG8_SB(b, h) + boff + n * 2048 + k * 1024); } while (0)
#define PG8_CAT8(v) __builtin_shufflevector(__builtin_bit_cast(i32x4, (v)[0]), __builtin_bit_cast(i32x4, (v)[1]), 0, 1, 2, 3, 4, 5, 6, 7)
#define PG8_MMA(ai, bj, At, Bt) do { __builtin_amdgcn_s_setprio(1); if constexpr (FP8) asm volatile("s_nop 1"); _Pragma("unroll") for (int m = 0; m < 4; ++m) _Pragma("unroll") for (int n = 0; n < 2; ++n) { \
        if constexpr (FP8) { const i32x8 b8_ = PG8_CAT8(Bt[n]), a8_ = PG8_CAT8(At[m]);   \
            asm volatile("v_mfma_f32_16x16x128_f8f6f4 %0, %1, %2, %0" : "+v"(acc[ai][bj][m][n]) : "v"(b8_), "v"(a8_)); }     \
        else { _Pragma("unroll") for (int k = 0; k < 2; ++k) acc[ai][bj][m][n] = __builtin_amdgcn_mfma_f32_16x16x32_bf16(Bt[n][k], At[m][k], acc[ai][bj][m][n], 0, 0, 0); } } __builtin_amdgcn_s_setprio(0); } while (0)
#define PG8_WAIT_V(n) asm volatile("s_waitcnt vmcnt(" #n ")" ::: "memory")
#define PG8_WAIT_L(n) asm volatile("s_waitcnt lgkmcnt(" #n ")" ::: "memory")
#define PG8_BAR __builtin_amdgcn_s_barrier()
#define PG8_SCHED __builtin_amdgcn_sched_barrier(0)
    Unit cur, nxt; int ui = 0;
    if (!S.next(0, cur)) return;
    if (S.delay) { const unsigned long long t0_ = __builtin_amdgcn_s_memrealtime(); while (__builtin_amdgcn_s_memrealtime() - t0_ < (unsigned long long)S.delay) __builtin_amdgcn_s_sleep(8); }
    f32x4 acc[2][2][4][2];
#pragma unroll
    for (int a = 0; a < 2; ++a)
#pragma unroll
        for (int b = 0; b < 2; ++b)
#pragma unroll
            for (int m = 0; m < 4; ++m)
#pragma unroll
                for (int n = 0; n < 2; ++n) acc[a][b][m][n] = (f32x4){0.f, 0.f, 0.f, 0.f};
    bf16x8 At[4][2], B0[2][2], B1[2][2];
    unsigned vC0[2], vC1[2];
    const char* cA; const char* cB = P.b_ptr(cur);
    if constexpr (GATHER) {
        cA = (const char*)P.A;
        PG8_GDMA(cur, 0);
        PG8_WAIT_V(0); PG8_BAR;
        PG8_GIDX(0);
        LDS_WAIT(); PG8_BAR;
    } else {
        cA = P.a_ptr(cur);
#pragma unroll
        for (int i = 0; i < 2; ++i) { vC0[i] = voffA[i]; vC1[i] = voffA[i] + (unsigned)hstep; }
    }
    PG8_STAGE(PG8_SB(0, 0), cB, voffB); PG8_STAGE(PG8_SB(0, 1), cB + hstep, voffB); PG8_STAGE(PG8_SA(0, 0), cA, vC0); PG8_STAGE(PG8_SA(0, 1), cA, vC1);
    if (wr == 1) PG8_BAR;
    PG8_WAIT_V(2); PG8_BAR;
    PG8_STAGE(PG8_SB(1, 0), cB + kstep, voffB); PG8_STAGE(PG8_SA(1, 0), cA + kstep, vC0); PG8_STAGE(PG8_SB(1, 1), cB + hstep + kstep, voffB);
    PG8_WAIT_V(6); PG8_BAR;
    for (;;) {
        const bool has_next = S.next(ui + 1, nxt);
        const char* nA = GATHER ? cA : (has_next ? P.a_ptr(nxt) : cA); const char* nB = has_next ? P.b_ptr(nxt) : cB;
        for (int t = 0; t < nt; t += 2) {
            const bool last = (t == nt - 2);
            if constexpr (GATHER) {
                if (t == 0 && has_next) PG8_GDMA(nxt, (ui + 1) & 1);
            }
            const char* a1 = cA + (size_t)(t + 1) * kstep;
            const char* a2 = last ? nA : cA + (size_t)(t + 2) * kstep; const char* b2 = last ? nB : cB + (size_t)(t + 2) * kstep;
            const char* a3 = a2 + kstep; const char* b3 = b2 + kstep;
            PG8_LDB(B0, 0, 0); PG8_LDB(B1, 0, 1); PG8_SCHED; PG8_LDA(At, 0, 0); PG8_STAGE(PG8_SA(1, 1), a1, vC1);
            if constexpr (GATHER) { if (last && has_next) PG8_GIDX((ui + 1) & 1); }
            PG8_WAIT_V(8); PG8_WAIT_L(0); PG8_BAR; PG8_MMA(0, 0, At, B0); PG8_MMA(0, 1, At, B1); PG8_BAR; PG8_SCHED;
            PG8_LDA(At, 0, 1); PG8_STAGE(PG8_SB(0, 0), b2, voffB); PG8_STAGE(PG8_SB(0, 1), b2 + hstep, voffB); PG8_STAGE(PG8_SA(0, 0), a2, vC0);
            PG8_WAIT_V(8); PG8_WAIT_L(0); PG8_BAR; PG8_MMA(1, 0, At, B0); PG8_MMA(1, 1, At, B1); PG8_BAR; PG8_SCHED;
            PG8_LDB(B0, 1, 0); PG8_LDB(B1, 1, 1); PG8_SCHED; PG8_LDA(At, 1, 0); PG8_STAGE(PG8_SA(0, 1), a2, vC1);
            PG8_WAIT_V(8); PG8_WAIT_L(0); PG8_BAR; PG8_MMA(0, 0, At, B0); PG8_MMA(0, 1, At, B1); PG8_BAR; PG8_SCHED;
            PG8_LDA(At, 1, 1); PG8_STAGE(PG8_SB(1, 0), b3, voffB); PG8_STAGE(PG8_SB(1, 1), b3 + hstep, voffB); PG8_STAGE(PG8_SA(1, 0), a3, vC0);
            PG8_WAIT_V(8); PG8_WAIT_L(0); PG8_BAR; PG8_MMA(1, 0, At, B0); PG8_MMA(1, 1, At, B1); PG8_BAR; PG8_SCHED;
        }
        if constexpr (FP8) { asm volatile("s_nop 15\n\ts_nop 15" ::: "memory"); PG8_SCHED; }
        if (wr == 0) PG8_BAR;
        { const int ln_ = lane_id_v(); int fr_ = ln_ & 15, fq_ = ln_ >> 4; asm volatile("" : "+v"(fr_), "+v"(fq_)); E(acc, cur, wr, wc, fr_, fq_); }
        if (!has_next) break;
#pragma unroll
        for (int a = 0; a < 2; ++a)
#pragma unroll
            for (int b = 0; b < 2; ++b)
#pragma unroll
                for (int m = 0; m < 4; ++m)
#pragma unroll
                    for (int n = 0; n < 2; ++n) acc[a][b][m][n] = (f32x4){0.f, 0.f, 0.f, 0.f};
        cur = nxt; cA = nA; cB = nB; ++ui;
        if (wr == 1) PG8_BAR;
    }
    PG8_WAIT_V(0);
    PG8_BAR;
#undef PG8_SA
#undef PG8_GIDX
#undef PG8_GDMA
#undef PG8_SB
#undef PG8_STAGE
#undef PG8_LDA
#undef PG8_LDB
#undef PG8_MMA
#undef PG8_CAT8
#undef PG8_WAIT_V
#undef PG8_WAIT_L
#undef PG8_BAR
#undef PG8_SCHED
}

template <bool INF32> struct EpiResid {
    static constexpr bool PERM = true;
    const void* xin; bf16_t* xout; const float* gate; float ascale;
    __device__ __forceinline__ void operator()(const f32x4 (&acc)[2][2][4][2], const Unit& u, int wr, int wc, int fr, int fq) const {
        const int row0 = u.pm * BM + wr * 64 + fr, col0 = u.pn * BM + wc * 32 + 8 * fq;
        const float* gp = gate + (size_t)((u.pm * BM) >> 12) * 6144 + col0;
        f32x4 gv[2][2];
#pragma unroll
        for (int bj = 0; bj < 2; ++bj)
#pragma unroll
            for (int n = 0; n < 2; ++n) gv[bj][n] = (*(const f32x4*)(gp + bj * HALF + 4 * n) + 1.0f) * ascale;
#pragma unroll
        for (int ai = 0; ai < 2; ++ai) {
            f32x4 xv[4][2][2];
#pragma unroll
            for (int m = 0; m < 4; ++m) { const size_t off = (size_t)(row0 + ai * HALF + m * 16) * DM + col0;
#pragma unroll
                for (int bj = 0; bj < 2; ++bj) {
                    if constexpr (INF32) { xv[m][bj][0] = *(const f32x4*)((const float*)xin + off + bj * HALF); xv[m][bj][1] = *(const f32x4*)((const float*)xin + off + bj * HALF + 4); }
                    else { const u32x4 p = *(const u32x4*)((const bf16_t*)xin + off + bj * HALF);
                        xv[m][bj][0] = (f32x4){bflo(p.x), bfhi(p.x), bflo(p.y), bfhi(p.y)}; xv[m][bj][1] = (f32x4){bflo(p.z), bfhi(p.z), bflo(p.w), bfhi(p.w)}; } } }
#pragma unroll
            for (int m = 0; m < 4; ++m) { const size_t off = (size_t)(row0 + ai * HALF + m * 16) * DM + col0;
#pragma unroll
                for (int bj = 0; bj < 2; ++bj) { const f32x4 o0 = xv[m][bj][0] + gv[bj][0] * acc[ai][bj][m][0], o1 = xv[m][bj][1] + gv[bj][1] * acc[ai][bj][m][1];
                    u32x4 w; w.x = cvtpk(o0[0], o0[1]); w.y = cvtpk(o0[2], o0[3]); w.z = cvtpk(o1[0], o1[1]); w.w = cvtpk(o1[2], o1[3]);
                    *(u32x4*)(xout + off + bj * HALF) = w; } }
            asm volatile("" ::: "memory"); }
    }
};
template <bool OUTF32> struct EpiMoeDown {
    static constexpr bool PERM = true;
    const bf16_t* xs; void* xo; const float* gate; const int* tos; const float* wos; float ascale;
    __device__ __forceinline__ void operator()(const f32x4 (&acc)[2][2][4][2], const Unit& u, int wr, int wc, int fr, int fq) const {
        const int slot0 = u.pm * BM + wr * 64 + fr, col0 = u.pn * BM + wc * 32 + 8 * fq;
        int tok[2][4]; float w[2][4];
#pragma unroll
        for (int ai = 0; ai < 2; ++ai)
#pragma unroll
            for (int m = 0; m < 4; ++m) { const int slot = slot0 + ai * HALF + m * 16; tok[ai][m] = tos[slot]; w[ai][m] = wos[slot] * ascale; }
#pragma unroll
        for (int ai = 0; ai < 2; ++ai) {
            u32x4 xv[4][2];
#pragma unroll
            for (int m = 0; m < 4; ++m) { const int t = tok[ai][m] < 0 ? 0 : tok[ai][m]; const bf16_t* xp = xs + (size_t)t * DM + col0;
#pragma unroll
                for (int bj = 0; bj < 2; ++bj) xv[m][bj] = *(const u32x4*)(xp + bj * HALF); }
#pragma unroll
            for (int m = 0; m < 4; ++m) { const int t = tok[ai][m];
                if (t >= 0) { const float* gp = gate + (size_t)(t >> 12) * 6144 + col0; const size_t off = (size_t)t * DM + col0;
#pragma unroll
                    for (int bj = 0; bj < 2; ++bj) { const u32x4 p = xv[m][bj];
                        const f32x4 g0 = (*(const f32x4*)(gp + bj * HALF) + 1.0f) * w[ai][m], g1 = (*(const f32x4*)(gp + bj * HALF + 4) + 1.0f) * w[ai][m];
                        const f32x4 o0 = (f32x4){bflo(p.x), bfhi(p.x), bflo(p.y), bfhi(p.y)} + g0 * acc[ai][bj][m][0], o1 = (f32x4){bflo(p.z), bfhi(p.z), bflo(p.w), bfhi(p.w)} + g1 * acc[ai][bj][m][1];
                        if constexpr (OUTF32) { *(f32x4*)((float*)xo + off + bj * HALF) = o0; *(f32x4*)((float*)xo + off + bj * HALF + 4) = o1; }
                        else { u32x4 q; q.x = cvtpk(o0[0], o0[1]); q.y = cvtpk(o0[2], o0[3]); q.z = cvtpk(o1[0], o1[1]); q.w = cvtpk(o1[2], o1[3]); *(u32x4*)((bf16_t*)xo + off + bj * HALF) = q; } } } }
            asm volatile("" ::: "memory"); }
    }
};
template <bool OUT8> struct EpiSwiglu {
    static constexpr bool PERM = true;
    void* O; int ldo; float ascale;
    __device__ __forceinline__ void operator()(const f32x4 (&acc)[2][2][4][2], const Unit& u, int wr, int wc, int fr, int fq) const {
        const int row0 = u.pm * BM + wr * 64 + fr, col0 = u.pn * HALF + wc * 32 + 8 * fq;
        const float nl2 = -ascale * LOG2E, ios = 1.0f / (ascale * ascale * (OUT8 ? SC8_HID : 1.0f));
        const f32x2 nl2v = {nl2, nl2}, iosv = {ios, ios};
#pragma unroll
        for (int ai = 0; ai < 2; ++ai)
#pragma unroll
            for (int m = 0; m < 4; ++m) { const size_t eo = (size_t)(row0 + ai * HALF + m * 16) * ldo + col0;
                float v[8];
#pragma unroll
                for (int n = 0; n < 2; ++n)
#pragma unroll
                    for (int h = 0; h < 2; ++h) {
                        const f32x2 g = {acc[ai][0][m][n][2 * h], acc[ai][0][m][n][2 * h + 1]}, up = {acc[ai][1][m][n][2 * h], acc[ai][1][m][n][2 * h + 1]};
                        const f32x2 t = g * nl2v; const f32x2 e = {fast_exp2(t.x), fast_exp2(t.y)};
                        const f32x2 d = e * iosv + iosv; const f32x2 r = {fast_rcp(d.x), fast_rcp(d.y)};
                        const f32x2 o = (g * up) * r; v[4 * n + 2 * h] = o.x; v[4 * n + 2 * h + 1] = o.y; }
                if constexpr (OUT8) { u32x2 w; w.x = cvt4_fp8(v[0], v[1], v[2], v[3]); w.y = cvt4_fp8(v[4], v[5], v[6], v[7]);
                    *(u32x2*)((unsigned char*)O + eo) = w; }
                else { u32x4 w; w.x = cvtpk(v[0], v[1]); w.y = cvtpk(v[2], v[3]); w.z = cvtpk(v[4], v[5]); w.w = cvtpk(v[6], v[7]);
                    *(u32x4*)((bf16_t*)O + eo) = w; } }
    }
};
struct EpiWin {
    static constexpr bool PERM = true;
    bf16_t* XB; bf16_t* GY;
    __device__ __forceinline__ void operator()(const f32x4 (&acc)[2][2][4][2], const Unit& u, int wr, int wc, int fr, int fq) const {
        const bool act = u.pn >= 4; bf16_t* base = act ? GY : XB;
        const int row0 = u.pm * BM + wr * 64 + fr, col0 = (u.pn & 3) * BM + wc * 32 + 8 * fq;
#pragma unroll
        for (int ai = 0; ai < 2; ++ai)
#pragma unroll
            for (int m = 0; m < 4; ++m) { bf16_t* rowp = base + (size_t)(row0 + ai * HALF + m * 16) * DM + col0;
#pragma unroll
                for (int bj = 0; bj < 2; ++bj) { f32x4 v0 = acc[ai][bj][m][0], v1 = acc[ai][bj][m][1];
                    if (act) {
#pragma unroll
                        for (int j = 0; j < 4; ++j) { v0[j] = gelu_tanh_(v0[j]); v1[j] = gelu_tanh_(v1[j]); } }
                    u32x4 w; w.x = cvtpk(v0[0], v0[1]); w.y = cvtpk(v0[2], v0[3]); w.z = cvtpk(v1[0], v1[1]); w.w = cvtpk(v1[2], v1[3]);
                    *(u32x4*)(rowp + bj * HALF) = w; } }
    }
};
struct EpiQK {
    static constexpr bool PERM = true;
    bf16_t* O; int ldo; const float* gain; const float* cosT; const float* sinT; float oscale; int vtile; bf16_t* OV;
    __device__ __forceinline__ void operator()(const f32x4 (&acc)[2][2][4][2], const Unit& u, int wr, int wc, int fr, int fq) const {
        const int row0 = u.pm * BM + wr * 64 + fr;
        if (u.pn == vtile) {
            const int col0 = wc * 32 + 8 * fq;
#pragma unroll
            for (int ai = 0; ai < 2; ++ai)
#pragma unroll
                for (int m = 0; m < 4; ++m) { bf16_t* rowp = OV + (size_t)(row0 + ai * HALF + m * 16) * ldo + col0;
#pragma unroll
                    for (int bj = 0; bj < 2; ++bj) { const f32x4 v0 = acc[ai][bj][m][0], v1 = acc[ai][bj][m][1];
                        u32x4 w; w.x = cvtpk(v0[0], v0[1]); w.y = cvtpk(v0[2], v0[3]); w.z = cvtpk(v1[0], v1[1]); w.w = cvtpk(v1[2], v1[3]);
                        *(u32x4*)(rowp + bj * HALF) = w; } }
            return;
        }
        const int colh = (u.pn * 4 + wc) * 64 + 8 * fq;
        f32x4 g1[2], g2[2];
#pragma unroll
        for (int n = 0; n < 2; ++n) { g1[n] = *(const f32x4*)(gain + 8 * fq + 4 * n); g2[n] = *(const f32x4*)(gain + 32 + 8 * fq + 4 * n); }
#pragma unroll
        for (int aim = 0; aim < 4; ++aim) { const int ai = aim >> 1;
            f32x4 cv[4][2], sv[4][2];
#pragma unroll
            for (int m = 2 * (aim & 1); m < 2 * (aim & 1) + 2; ++m) { const int row = row0 + ai * HALF + m * 16;
#pragma unroll
                for (int n = 0; n < 2; ++n) { cv[m][n] = *(const f32x4*)(cosT + (size_t)row * 32 + 8 * fq + 4 * n); sv[m][n] = *(const f32x4*)(sinT + (size_t)row * 32 + 8 * fq + 4 * n); } }
#pragma unroll
            for (int m = 2 * (aim & 1); m < 2 * (aim & 1) + 2; ++m) { const int row = row0 + ai * HALF + m * 16;
                float ss = 0.f;
#pragma unroll
                for (int bj = 0; bj < 2; ++bj)
#pragma unroll
                    for (int n = 0; n < 2; ++n) { const f32x4 a = acc[ai][bj][m][n]; ss += (a[0] * a[0] + a[1] * a[1]) + (a[2] * a[2] + a[3] * a[3]); }
                { const int ln_ = fq * 16 + fr; ss += shflx(ss, ln_, 16); ss += shflx(ss, ln_, 32); }
                const float r = __builtin_amdgcn_rsqf(ss * (1.0f / 64.0f) + EPS) * oscale;
                float o1[8], o2[8];
#pragma unroll
                for (int n = 0; n < 2; ++n) { const f32x4 c = cv[m][n], s = sv[m][n];
                    const f32x4 x1 = acc[ai][0][m][n] * g1[n] * r, x2 = acc[ai][1][m][n] * g2[n] * r;
                    const f32x4 a = x1 * c - x2 * s, b = x2 * c + x1 * s;
#pragma unroll
                    for (int j = 0; j < 4; ++j) { o1[4 * n + j] = a[j]; o2[4 * n + j] = b[j]; } }
                bf16_t* rowp = O + (size_t)row * ldo + colh;
                u32x4 w; w.x = cvtpk(o1[0], o1[1]); w.y = cvtpk(o1[2], o1[3]); w.z = cvtpk(o1[4], o1[5]); w.w = cvtpk(o1[6], o1[7]);
                *(u32x4*)rowp = w;
                w.x = cvtpk(o2[0], o2[1]); w.y = cvtpk(o2[2], o2[3]); w.z = cvtpk(o2[4], o2[5]); w.w = cvtpk(o2[6], o2[7]);
                *(u32x4*)(rowp + 32) = w; }
            asm volatile("" ::: "memory"); }
    }
};
}

#define XB_TMO      128
#define XB_XCNT(j)  (256  + 64 * (j))
#define XB_XSUB(j)  (1280 + 64 * (j))
#define XB_XGEN(j)  (2304 + 64 * (j))
#define XB_TOP      3328
#define XB_TOPGEN   3392
#define XCD_BAR_WORDS 3456
#define XB_SPIN_CAP (1u << 20)
__device__ __forceinline__ unsigned xb_ld(unsigned* p)              { return __hip_atomic_load(p, __ATOMIC_RELAXED, __HIP_MEMORY_SCOPE_AGENT); }
__device__ __forceinline__ unsigned xb_add(unsigned* p, unsigned v) { return __hip_atomic_fetch_add(p, v, __ATOMIC_RELAXED, __HIP_MEMORY_SCOPE_AGENT); }
__device__ __forceinline__ unsigned xb_xcc_id() { return (unsigned)__builtin_amdgcn_s_getreg((3 << 11) | 20) & 0xFu; }
#define XB_SPIN(cond, bar) do { unsigned _sp = 0; while (cond) { __builtin_amdgcn_s_sleep(1); \
    if ((++_sp & 255u) == 0u) { if (xb_ld(&(bar)[XB_TMO])) break; if (_sp > XB_SPIN_CAP) { atomicAdd(&(bar)[XB_TMO], 1u); break; } } } } while (0)
struct XcdBarrier { unsigned* bar; unsigned x; volatile LAS unsigned* st; };
__device__ __forceinline__ XcdBarrier xcd_barrier_post(unsigned* bar, volatile LAS unsigned* st, int wv) {
    XcdBarrier b; b.bar = bar; b.x = xb_xcc_id(); b.st = st;
    if (wv == 0 && lane_id_v() == 0) (void)xb_add(&bar[XB_XCNT(b.x)], 1u);
    return b;
}
__device__ __forceinline__ void xcd_barrier_complete(unsigned* bar, unsigned x, unsigned& nloc, unsigned& nx) {
    const unsigned G = gridDim.x * gridDim.y * gridDim.z;
    unsigned sum, cnt, mine, sp = 0u;
    for (;;) {
        sum = 0u; cnt = 0u; mine = 0u;
#pragma unroll
        for (unsigned j = 0; j < 16; ++j) { const unsigned c = xb_ld(&bar[XB_XCNT(j)]); sum += c; cnt += (c > 0u) ? 1u : 0u; }
        mine = xb_ld(&bar[XB_XCNT(x)]);
        if (sum == G) break;
        __builtin_amdgcn_s_sleep(1);
        if ((++sp & 255u) == 0u) { if (xb_ld(&bar[XB_TMO])) break; if (sp > XB_SPIN_CAP) { atomicAdd(&bar[XB_TMO], 1u); break; } }
    }
    nloc = mine > 0u ? mine : 1u; nx = cnt > 0u ? cnt : 1u;
}
__device__ __forceinline__ void xcd_barrier(const XcdBarrier& b, int wv) {
    asm volatile("s_waitcnt vmcnt(0)" ::: "memory");
    __syncthreads();
    if (wv == 0 && lane_id_v() == 0) {
        unsigned* bar = b.bar;
        __builtin_amdgcn_s_waitcnt(0);
        unsigned nloc = b.st[0], nx = b.st[1];
        if (nloc == 0u) { xcd_barrier_complete(bar, b.x, nloc, nx); b.st[0] = nloc; b.st[1] = nx; }
        const unsigned old = xb_add(&bar[XB_XSUB(b.x)], 1u);
        const unsigned gen = old / nloc;
        if (old + 1u == (gen + 1u) * nloc) {
            __builtin_amdgcn_fence(__ATOMIC_RELEASE, "agent");
            asm volatile("s_waitcnt vmcnt(0)" ::: "memory");
            const unsigned og = xb_add(&bar[XB_TOP], 1u);
            const unsigned tg = og / nx;
            if (og + 1u == (tg + 1u) * nx) xb_add(&bar[XB_TOPGEN], 1u);
            else XB_SPIN(xb_ld(&bar[XB_TOPGEN]) == tg, bar);
            __builtin_amdgcn_fence(__ATOMIC_ACQUIRE, "agent");
            xb_add(&bar[XB_XGEN(b.x)], 1u);
            asm volatile("s_waitcnt vmcnt(0)" ::: "memory");
        } else {
            XB_SPIN(xb_ld(&bar[XB_XGEN(b.x)]) == gen, bar);
            __builtin_amdgcn_fence(__ATOMIC_ACQUIRE, "agent");
            asm volatile("s_waitcnt vmcnt(0)" ::: "memory");
        }
    }
    __syncthreads();
}

struct Args {
    const float* x; const float* c; const int* pos; const float* ada_w; const float* ada_b; const float* mix_norm; const float* ffn_norm;
    const float* a_w_in; const float* a_conv_w; const float* a_conv_b; const float* a_gx_w; const float* a_gx_b; const float* a_ga_w; const float* a_ga_b;
    const float* a_lambda; const float* a_w_out; const float* kv_norm; const float* kv_ada_w; const float* kv_ada_b; const float* w_kv; const float* k_norm;
    const float* b_w_q; const float* b_q_norm; const float* b_sinks; const float* b_w_o; const float* f_w_gu; const float* f_w_down; const float* m_router;
    const float* m_w_gu; const float* m_w_down;
    float* out; unsigned char* ws; int ph_lo, ph_hi;
};

struct Ctx {
    LAS unsigned char* lds; int tid, lane, wave, vcu, G, cid;
};

struct TrItem { const float* src; unsigned char* dst; int N, K, d0, d1, f8; };
__device__ __forceinline__ void tr_load(const TrItem& t, f32x4 (&v)[16], int lane) {
    const int kr = lane >> 4, nq = lane & 15;
#pragma unroll
    for (int i = 0; i < 16; ++i) v[i] = *(const f32x4*)(t.src + (size_t)(4 * i + kr) * t.N + 4 * nq);
}
__device__ __forceinline__ void tr_to_lds(const f32x4 (&v)[16], LAS float* scr, int lane) {
    const int kr = lane >> 4, nq = lane & 15;
#pragma unroll
    for (int i = 0; i < 16; ++i) { const int k = 4 * i + kr; *(LAS f32x4*)(scr + k * 68 + ((4 * nq) ^ (4 * ((k >> 3) & 7)))) = v[i]; }
}
__device__ __forceinline__ void tr_finish(const TrItem& t, LAS float* scr, int lane) {
    const int c = lane & 7, r = lane >> 3;
    if (t.f8) {
#pragma unroll
        for (int j = 0; j < 8; ++j) { const int n = 8 * j + r; const LAS float* s = scr + (8 * c) * 68 + (n ^ (4 * c)); const int drow = ((n & 32) ? t.d1 : t.d0) + (n & 31);
            u32x2 o; o.x = cvt4_fp8(s[0 * 68] * SC8_W, s[1 * 68] * SC8_W, s[2 * 68] * SC8_W, s[3 * 68] * SC8_W); o.y = cvt4_fp8(s[4 * 68] * SC8_W, s[5 * 68] * SC8_W, s[6 * 68] * SC8_W, s[7 * 68] * SC8_W);
            *(u32x2*)(t.dst + (size_t)drow * t.K + 8 * c) = o; }
    } else {
#pragma unroll
        for (int j = 0; j < 8; ++j) { const int n = 8 * j + r; const LAS float* s = scr + (8 * c) * 68 + (n ^ (4 * c)); const int drow = ((n & 32) ? t.d1 : t.d0) + (n & 31);
            u32x4 o; o.x = cvtpk(s[0 * 68], s[1 * 68]); o.y = cvtpk(s[2 * 68], s[3 * 68]); o.z = cvtpk(s[4 * 68], s[5 * 68]); o.w = cvtpk(s[6 * 68], s[7 * 68]);
            *(u32x4*)(t.dst + ((size_t)drow * t.K + 8 * c) * 2) = o; }
    }
}
__device__ __forceinline__ int map_plain(int n) { return n; }
__device__ __forceinline__ int map_head(int n) { const int hd = n >> 6, d = n & 63; return 256 * (hd >> 2) + 128 * (d >> 5) + 32 * (hd & 3) + (d & 31); }
__device__ __forceinline__ int map_gu(int n, int F) { const int u = n >= F, j = u ? n - F : n; return 256 * (j >> 7) + 128 * u + (j & 127); }

__device__ __forceinline__ void p0_prologue(const Ctx& F, const Args& a) {
    unsigned char* ws = a.ws;
    {
        LAS float* cs = (LAS float*)F.lds;
        LAS float* red = (LAS float*)(F.lds + 65536);
        for (int i = F.tid; i < BATCH * DM; i += 512) { const int b = i >> 10, k = i & 1023; const float v = a.c[i]; cs[k * 16 + b] = silu_(v); }
        __syncthreads();
        float* modv = (float*)(ws + WS_MODV); float* kvmod = (float*)(ws + WS_KVMOD);
        constexpr int NC = 4 * 6144 + 2048, CPB = 104;
        for (int cb = F.vcu; cb * CPB < NC; cb += F.G) {
            const int cl = F.tid & 127, kp = F.tid >> 7, j = cb * CPB + cl;
            const bool on = (cl < CPB) && (j < NC);
            float accv[16];
#pragma unroll
            for (int b = 0; b < 16; ++b) accv[b] = 0.f;
            if (on) {
                const float* W; int ldw, jj;
                if (j < 4 * 6144) { const int l = j / 6144; jj = j - l * 6144; W = a.ada_w + (size_t)l * DM * 6144; ldw = 6144; } else { jj = j - 4 * 6144; W = a.kv_ada_w; ldw = 2048; }
                const float* wp = W + (size_t)(kp * 256) * ldw + jj;
#pragma unroll 1
                for (int k0 = 0; k0 < 256; k0 += 16) {
                    float wv[16];
#pragma unroll
                    for (int kk = 0; kk < 16; ++kk) wv[kk] = wp[(size_t)(k0 + kk) * ldw];
#pragma unroll
                    for (int kk = 0; kk < 16; ++kk) { const float w = wv[kk]; const LAS f32x4* cv = (const LAS f32x4*)(cs + (kp * 256 + k0 + kk) * 16);
#pragma unroll
                        for (int q = 0; q < 4; ++q) { const f32x4 c4 = cv[q]; accv[4 * q] += w * c4[0]; accv[4 * q + 1] += w * c4[1]; accv[4 * q + 2] += w * c4[2]; accv[4 * q + 3] += w * c4[3]; } } }
            }
#pragma unroll
            for (int b = 0; b < 16; ++b) red[(kp * 128 + cl) * 16 + b] = accv[b];
            __syncthreads();
            for (int i = F.tid; i < CPB * 16; i += 512) { const int cl2 = i >> 4, b = i & 15, j2 = cb * CPB + cl2;
                if (j2 < NC) { const float s = (red[(0 * 128 + cl2) * 16 + b] + red[(1 * 128 + cl2) * 16 + b]) + (red[(2 * 128 + cl2) * 16 + b] + red[(3 * 128 + cl2) * 16 + b]);
                    if (j2 < 4 * 6144) { const int l = j2 / 6144, jj = j2 - l * 6144; modv[((size_t)l * 16 + b) * 6144 + jj] = s + a.ada_b[l * 6144 + jj]; }
                    else { const int jj = j2 - 4 * 6144; kvmod[(size_t)b * 2048 + jj] = s + a.kv_ada_b[jj]; } } }
            __syncthreads();
        }
    }
    {
        LAS float* scr = (LAS float*)(F.lds + F.wave * 17408);
        const int gw = F.vcu * 8 + F.wave, NGW = F.G * 8;
        constexpr int I_WIN = 16 * 32, I_SQ = 16 * 16, I_KV = 16 * 8, I_FGU = 16 * 96, I_FDN = 48 * 16, I_MGU = 16 * 112, I_MDN = 56 * 16;
        constexpr int NMOE = DEFER_L3 ? 8 : 16;
        constexpr int NITEMS = 2 * I_WIN + 2 * I_SQ + I_KV + 2 * I_SQ + 2 * I_SQ + 2 * I_FGU + 2 * I_FDN + NMOE * I_MGU + NMOE * I_MDN;
        auto decode = [&](int it) -> TrItem {
            TrItem t; int r = it; const float* W; unsigned char* D; int K, N, kb, n0, f8 = 0, mapk = 0, F = 0;
            if (r < 2 * I_WIN) { const int mi = r / I_WIN, rr = r % I_WIN; n0 = 64 * (rr % 32); kb = rr / 32; K = DM; N = 2048; W = a.a_w_in + (size_t)mi * DM * 2048; D = ws + WS_WIN + (size_t)mi * 2048 * DM * 2; }
            else if ((r -= 2 * I_WIN) < 2 * I_SQ) { const int mi = r / I_SQ, rr = r % I_SQ; n0 = 64 * (rr % 16); kb = rr / 16; K = DM; N = DM; W = a.a_w_out + (size_t)mi * DM * DM; D = ws + WS_WOUT + (size_t)mi * DM * DM * 2; }
            else if ((r -= 2 * I_SQ) < I_KV) { n0 = 64 * (r % 8); kb = r / 8; K = DM; N = 512; W = a.w_kv; D = ws + WS_WKV; mapk = 3; }
            else if ((r -= I_KV) < 2 * I_SQ) { const int mi = r / I_SQ, rr = r % I_SQ; n0 = 64 * (rr % 16); kb = rr / 16; K = DM; N = DM; W = a.b_w_q + (size_t)mi * DM * DM; D = ws + WS_WQ + (size_t)mi * DM * DM * 2; mapk = 1; }
            else if ((r -= 2 * I_SQ) < 2 * I_SQ) { const int mi = r / I_SQ, rr = r % I_SQ; n0 = 64 * (rr % 16); kb = rr / 16; K = DM; N = DM; W = a.b_w_o + (size_t)mi * DM * DM; D = ws + WS_WO + (size_t)mi * DM * DM * 2; f8 = FP8_WO; }
            else if ((r -= 2 * I_SQ) < 2 * I_FGU) { const int mi = r / I_FGU, rr = r % I_FGU; n0 = 64 * (rr % 96); kb = rr / 96; K = DM; N = 6144; W = a.f_w_gu + (size_t)mi * DM * 6144; D = ws + WS_FGU + (size_t)mi * 6144 * DM * 2; f8 = FP8_OF(2 * mi); mapk = 2; F = DFF; }
            else if ((r -= 2 * I_FGU) < 2 * I_FDN) { const int mi = r / I_FDN, rr = r % I_FDN; n0 = 64 * (rr % 16); kb = rr / 16; K = DFF; N = DM; W = a.f_w_down + (size_t)mi * DFF * DM; D = ws + WS_FDN + (size_t)mi * DM * DFF * 2; f8 = FP8_OF(2 * mi); }
            else if ((r -= 2 * I_FDN) < NMOE * I_MGU) { const int mi = r / I_MGU, rr = r % I_MGU; n0 = 64 * (rr % 112); kb = rr / 112; K = DM; N = 7168; W = a.m_w_gu + (size_t)mi * DM * 7168; f8 = FP8_OF(2 * (mi >> 3) + 1); mapk = 2; F = DFE;
                D = ws + WS_MGU + (size_t)(mi >> 3) * 8 * 7168 * DM * 2 + (size_t)(mi & 7) * 7168 * DM * (f8 ? 1 : 2); }
            else { r -= NMOE * I_MGU; const int mi = r / I_MDN, rr = r % I_MDN; n0 = 64 * (rr % 16); kb = rr / 16; K = DFE; N = DM; W = a.m_w_down + (size_t)mi * DFE * DM; f8 = FP8_OF(2 * (mi >> 3) + 1);
                D = ws + WS_MDN + (size_t)(mi >> 3) * 8 * DM * DFE * 2 + (size_t)(mi & 7) * DM * DFE * (f8 ? 1 : 2); }
            t.src = W + (size_t)(64 * kb) * N + n0; t.dst = D + (size_t)(64 * kb) * (f8 ? 1 : 2); t.N = N; t.K = K; t.f8 = f8;
            if (mapk == 1 || (mapk == 3 && n0 < 256)) { t.d0 = map_head(n0); t.d1 = map_head(n0 + 32); }
            else if (mapk == 2) { t.d0 = map_gu(n0, F); t.d1 = map_gu(n0 + 32, F); }
            else { t.d0 = n0; t.d1 = n0 + 32; }
            return t; };
        f32x4 tv[16];
        int it = gw;
        TrItem cur = decode(it < NITEMS ? it : 0);
        if (it < NITEMS) tr_load(cur, tv, F.lane);
        for (; it < NITEMS; it += NGW) {
            tr_to_lds(tv, scr, F.lane);
            const bool hn = it + NGW < NITEMS;
            const TrItem nxt = decode(hn ? it + NGW : it);
            if (hn) tr_load(nxt, tv, F.lane);
            LDS_WAIT(); asm volatile("" ::: "memory");
            tr_finish(cur, scr, F.lane);
            LDS_WAIT(); asm volatile("" ::: "memory");
            cur = nxt;
        }
        __syncthreads();
    }
    {
        float* par = (float*)(ws + WS_PAR);
        const size_t gt0 = (size_t)F.vcu * 512 + F.tid, GT0 = (size_t)F.G * 512;
        for (size_t i = gt0; i < (size_t)PAR_END; i += GT0) { const int j = (int)i; float v;
            if (j < PAR_FFNN) v = a.mix_norm[j - PAR_MIXN]; else if (j < PAR_CONVW) v = a.ffn_norm[j - PAR_FFNN]; else if (j < PAR_CONVB) v = a.a_conv_w[j - PAR_CONVW];
            else if (j < PAR_GXB) v = a.a_conv_b[j - PAR_CONVB]; else if (j < PAR_GAB) v = a.a_gx_b[j - PAR_GXB]; else if (j < PAR_LAM) v = a.a_ga_b[j - PAR_GAB];
            else if (j < PAR_KVN) v = a.a_lambda[j - PAR_LAM]; else if (j < PAR_KN) v = a.kv_norm[j - PAR_KVN]; else if (j < PAR_QN) v = a.k_norm[j - PAR_KN];
            else if (j < PAR_SINK) v = a.b_q_norm[j - PAR_QN]; else if (j < PAR_ROUTER) v = a.b_sinks[j - PAR_SINK]; else v = a.m_router[j - PAR_ROUTER];
            par[j] = v; }
    }
    {
        const size_t gt = (size_t)F.vcu * 512 + F.tid, GT = (size_t)F.G * 512;
        bf16_t* gwp = (bf16_t*)(ws + WS_GW);
        for (size_t i = gt; i < (size_t)2 * 8 * 2 * 128 * 128; i += GT) { const int k = (int)(i & 127), j = (int)((i >> 7) & 127), c2 = (int)((i >> 14) & 1), n = (int)((i >> 15) & 7), l = (int)(i >> 18);
            const float* g = (j < 64) ? a.a_ga_w : a.a_gx_w; const float v = g[((size_t)(l * 8 + n) * 128 + k) * 128 + 64 * c2 + (j & 63)];
            gwp[i] = (bf16_t)(cvtpk(v, 0.f) & 0xffffu); }
        float* ct = (float*)(ws + WS_COS); float* st = (float*)(ws + WS_SIN);
        for (size_t i = gt; i < (size_t)NTOK * 32; i += GT) { const int p = (int)(i & 31); const size_t tok = i >> 5;
            const float inv = powf(10000.0f, -(float)(2 * p) / 64.0f); const float ang = (float)a.pos[tok] * inv;
            ct[i] = cosf(ang); st[i] = sinf(ang); }
    }
}

__device__ __forceinline__ void convert_deferred(const Ctx& F, const float* m_w_gu, const float* m_w_down, unsigned char* ws, int half, int j, int nb) {
    constexpr int I_MGU = 16 * 112, I_MDN = 56 * 16, NIT = 8 * I_MGU + 8 * I_MDN;
    LAS float* scr = (LAS float*)(F.lds + F.wave * 17408);
    auto decode = [&](int it) -> TrItem {
        TrItem t; int r = it; const float* W; unsigned char* D; int K, N, kb, n0; const int f8 = FP8_OF(3);
        if (r < 8 * I_MGU) { const int e = r / I_MGU, rr = r % I_MGU; n0 = 64 * (rr % 112); kb = rr / 112; K = DM; N = 7168; W = m_w_gu + (size_t)(8 + e) * DM * 7168;
            D = ws + WS_MGU + (size_t)8 * 7168 * DM * 2 + (size_t)e * 7168 * DM * (f8 ? 1 : 2); t.d0 = map_gu(n0, DFE); t.d1 = map_gu(n0 + 32, DFE); }
        else { r -= 8 * I_MGU; const int e = r / I_MDN, rr = r % I_MDN; n0 = 64 * (rr % 16); kb = rr / 16; K = DFE; N = DM; W = m_w_down + (size_t)(8 + e) * DFE * DM;
            D = ws + WS_MDN + (size_t)8 * DM * DFE * 2 + (size_t)e * DM * DFE * (f8 ? 1 : 2); t.d0 = n0; t.d1 = n0 + 32; }
        t.src = W + (size_t)(64 * kb) * N + n0; t.dst = D + (size_t)(64 * kb) * (f8 ? 1 : 2); t.N = N; t.K = K; t.f8 = f8;
        return t; };
    const int lo = half ? NIT / 2 : 0, hi = half ? NIT : NIT / 2, step = nb * 8;
    f32x4 tv[16];
    int it = lo + j * 8 + F.wave;
    TrItem cur = decode(it < hi ? it : lo);
    if (it < hi) tr_load(cur, tv, F.lane);
    for (; it < hi; it += step) {
        tr_to_lds(tv, scr, F.lane);
        const bool hn = it + step < hi;
        const TrItem nxt = decode(hn ? it + step : it);
        if (hn) tr_load(nxt, tv, F.lane);
        LDS_WAIT(); asm volatile("" ::: "memory");
        tr_finish(cur, scr, F.lane);
        LDS_WAIT(); asm volatile("" ::: "memory");
        cur = nxt;
    }
}

template <bool DUAL, bool ROUTER, bool OUT8 = false, bool INF32 = false>
__device__ __forceinline__ void norm_phase(const Ctx& F, const void* x, const float* gain1, const float* sh1, const float* sc1, void* out1,
                                           const float* gain2, const float* sh2, const float* sc2, bf16_t* out2,
                                           const float* wrouter, int* e12, float* w1o, int* cnt) {
    LAS int* lcnt = (LAS int*)F.lds;
    for (int rb = F.vcu; rb < NTOK / 256; rb += F.G) {
        const int b = rb >> 4;
        if (ROUTER) { if (F.tid < 16) lcnt[F.tid] = 0; __syncthreads(); }
        float ca[16], cs[16], ca2[16], cs2[16];
#pragma unroll
        for (int j = 0; j < 4; ++j) { const int col = 4 * F.lane + 256 * j;
            const f32x4 g = *(const f32x4*)(gain1 + col), s = *(const f32x4*)(sc1 + (size_t)b * 6144 + col), h = *(const f32x4*)(sh1 + (size_t)b * 6144 + col);
#pragma unroll
            for (int q = 0; q < 4; ++q) { ca[4 * j + q] = g[q] * (1.0f + s[q]); cs[4 * j + q] = h[q]; }
            if (DUAL) { const f32x4 g2 = *(const f32x4*)(gain2 + col), s2 = *(const f32x4*)(sc2 + (size_t)b * 2048 + col), h2 = *(const f32x4*)(sh2 + (size_t)b * 2048 + col);
#pragma unroll
                for (int q = 0; q < 4; ++q) { ca2[4 * j + q] = g2[q] * (1.0f + s2[q]); cs2[4 * j + q] = h2[q]; } } }
        float wr_[ROUTER ? 128 : 1];
        if (ROUTER) {
#pragma unroll
            for (int j = 0; j < 4; ++j)
#pragma unroll
                for (int q = 0; q < 4; ++q) { const int col = 4 * F.lane + 256 * j + q; const f32x4 w0 = *(const f32x4*)(wrouter + (size_t)col * 8), w1 = *(const f32x4*)(wrouter + (size_t)col * 8 + 4);
#pragma unroll
                    for (int e = 0; e < 4; ++e) { wr_[(4 * j + q) * 8 + e] = w0[e]; wr_[(4 * j + q) * 8 + 4 + e] = w1[e]; } }
        }
        int me12 = 0; float mw1 = 0.f;
        const int rowb = rb * 256 + F.wave * 32;
        f32x4 nf[INF32 ? 4 : 1]; u32x2 nb[INF32 ? 1 : 4], nc[INF32 ? 1 : 4];
        if constexpr (ROUTER) { const u32x2* xr = (const u32x2*)((const bf16_t*)x + (size_t)rowb * DM) + F.lane;
#pragma unroll
            for (int j = 0; j < 4; ++j) nb[j] = xr[64 * j]; }
        else if constexpr (INF32) { const f32x4* xr = (const f32x4*)((const float*)x + (size_t)rowb * DM) + F.lane;
#pragma unroll
            for (int j = 0; j < 4; ++j) nf[j] = xr[64 * j]; }
        else { const u32x2* xr = (const u32x2*)((const bf16_t*)x + (size_t)rowb * DM) + F.lane;
#pragma unroll
            for (int j = 0; j < 4; ++j) { nb[j] = xr[64 * j]; nc[j] = xr[64 * j + DM / 4]; } }
        for (int rr = 0; rr < 32; ++rr) {
            const size_t row = (size_t)(rowb + rr);
            f32x4 v[4]; float s = 0.f;
            if constexpr (ROUTER) {
#pragma unroll
                for (int j = 0; j < 4; ++j) { const u32x2 p = nb[j]; v[j] = (f32x4){bflo(p.x), bfhi(p.x), bflo(p.y), bfhi(p.y)}; }
                if (rr + 1 < 32) { const u32x2* xr = (const u32x2*)((const bf16_t*)x + (row + 1) * DM) + F.lane;
#pragma unroll
                    for (int j = 0; j < 4; ++j) nb[j] = xr[64 * j]; } }
            else if constexpr (INF32) {
#pragma unroll
                for (int j = 0; j < 4; ++j) v[j] = nf[j];
                if (rr + 1 < 32) { const f32x4* xr = (const f32x4*)((const float*)x + (row + 1) * DM) + F.lane;
#pragma unroll
                    for (int j = 0; j < 4; ++j) nf[j] = xr[64 * j]; } }
            else {
#pragma unroll
                for (int j = 0; j < 4; ++j) { const u32x2 p = nb[j]; v[j] = (f32x4){bflo(p.x), bfhi(p.x), bflo(p.y), bfhi(p.y)}; nb[j] = nc[j]; }
                if (rr + 2 < 32) { const u32x2* xr = (const u32x2*)((const bf16_t*)x + (row + 2) * DM) + F.lane;
#pragma unroll
                    for (int j = 0; j < 4; ++j) nc[j] = xr[64 * j]; } }
#pragma unroll
            for (int j = 0; j < 4; ++j) s += (v[j][0] * v[j][0] + v[j][1] * v[j][1]) + (v[j][2] * v[j][2] + v[j][3] * v[j][3]);
            const float r = __builtin_amdgcn_rsqf(wave_sum(s, F.lane) * (1.0f / DM) + EPS);
            float hv[16];
#pragma unroll
            for (int j = 0; j < 4; ++j)
#pragma unroll
                for (int q = 0; q < 4; ++q) hv[4 * j + q] = v[j][q] * r * ca[4 * j + q] + cs[4 * j + q];
            if constexpr (OUT8) { unsigned* o4 = (unsigned*)((unsigned char*)out1 + row * DM) + F.lane;
#pragma unroll
                for (int j = 0; j < 4; ++j) o4[64 * j] = cvt4_fp8(hv[4 * j] * SC8_H, hv[4 * j + 1] * SC8_H, hv[4 * j + 2] * SC8_H, hv[4 * j + 3] * SC8_H); }
            else { u32x2* o8 = (u32x2*)((bf16_t*)out1 + row * DM) + F.lane;
#pragma unroll
                for (int j = 0; j < 4; ++j) { u32x2 w; w.x = cvtpk(hv[4 * j], hv[4 * j + 1]); w.y = cvtpk(hv[4 * j + 2], hv[4 * j + 3]); o8[64 * j] = w; } }
            if (DUAL) { u32x2* p8 = (u32x2*)(out2 + row * DM) + F.lane;
#pragma unroll
                for (int j = 0; j < 4; ++j) { float t[4];
#pragma unroll
                    for (int q = 0; q < 4; ++q) t[q] = v[j][q] * r * ca2[4 * j + q] + cs2[4 * j + q];
                    u32x2 w; w.x = cvtpk(t[0], t[1]); w.y = cvtpk(t[2], t[3]); p8[64 * j] = w; } }
            if (ROUTER) {
                float pe[8];
#pragma unroll
                for (int e = 0; e < 8; ++e) { float p = 0.f;
#pragma unroll
                    for (int c = 0; c < 16; ++c) p += hv[c] * wr_[c * 8 + e];
                    pe[e] = p; }
                { const bool b0 = F.lane & 1, b1 = F.lane & 2, b2 = F.lane & 4;
#pragma unroll
                  for (int e = 0; e < 8; e += 2) { const float snd = b0 ? pe[e] : pe[e + 1], kp = b0 ? pe[e + 1] : pe[e]; pe[e >> 1] = kp + shflx(snd, F.lane, 1); }
#pragma unroll
                  for (int i = 0; i < 4; i += 2) { const float snd = b1 ? pe[i] : pe[i + 1], kp = b1 ? pe[i + 1] : pe[i]; pe[i >> 1] = kp + shflx(snd, F.lane, 2); }
                  { const float snd = b2 ? pe[0] : pe[1], kp = b2 ? pe[1] : pe[0]; pe[0] = kp + shflx(snd, F.lane, 4); }
                  pe[0] += shflx(pe[0], F.lane, 8); pe[0] += shflx(pe[0], F.lane, 16); pe[0] += shflx(pe[0], F.lane, 32); }
                float lg[8];
#pragma unroll
                for (int e = 0; e < 8; ++e) lg[e] = __int_as_float(__builtin_amdgcn_readlane(__float_as_int(pe[0]), e));
                int i1 = 0; float v1 = lg[0];
#pragma unroll
                for (int e = 1; e < 8; ++e) if (lg[e] > v1) { v1 = lg[e]; i1 = e; }
                int i2 = -1; float v2 = -INFINITY;
#pragma unroll
                for (int e = 0; e < 8; ++e) if (e != i1 && lg[e] > v2) { v2 = lg[e]; i2 = e; }
                const float wt = 1.0f / (1.0f + __expf(v2 - v1));
                if (F.lane == rr) { me12 = i1 | (i2 << 8); mw1 = wt; }
            }
        }
        if (ROUTER) {
            if (F.lane < 32) { e12[rowb + F.lane] = me12; w1o[rowb + F.lane] = mw1; }
            const int e1 = me12 & 255, e2 = me12 >> 8;
#pragma unroll
            for (int e = 0; e < 8; ++e) { const unsigned long long m1 = __ballot(F.lane < 32 && e1 == e), m2 = __ballot(F.lane < 32 && e2 == e);
                if (F.lane == 0) { atomicAdd((int*)&lcnt[e], (int)__popcll(m1)); atomicAdd((int*)&lcnt[8 + e], (int)__popcll(m2)); } }
            __syncthreads();
            if (F.tid < 16) cnt[rb * 16 + F.tid] = lcnt[F.tid];
            __syncthreads();
        }
    }
}

template <bool DUAL, bool ROUTER, bool OUT8 = false, bool INF32 = false>
__device__ __forceinline__ void norm_phase_pk(const Ctx& F, const void* x, const float* gain1, const float* sh1, const float* sc1, void* out1,
                                           const float* gain2, const float* sh2, const float* sc2, bf16_t* out2,
                                           const float* wrouter, int* e12, float* w1o, int* cnt) {
    LAS int* lcnt = (LAS int*)F.lds;
    constexpr float SH = OUT8 ? SC8_H : 1.0f;
    for (int rb = F.vcu; rb < NTOK / 256; rb += F.G) {
        const int b = rb >> 4;
        if (ROUTER) { if (F.tid < 16) lcnt[F.tid] = 0; __syncthreads(); }
        f32x2 ca[8], cs[8], cb[DUAL ? 8 : 1], cd[DUAL ? 8 : 1];
#pragma unroll
        for (int j = 0; j < 4; ++j) { const int col = 4 * F.lane + 256 * j;
            const f32x4 g = *(const f32x4*)(gain1 + col), sc = *(const f32x4*)(sc1 + (size_t)b * 6144 + col), h = *(const f32x4*)(sh1 + (size_t)b * 6144 + col);
#pragma unroll
            for (int hh = 0; hh < 2; ++hh) { ca[2 * j + hh] = (f32x2){g[2 * hh] * (1.0f + sc[2 * hh]) * SH, g[2 * hh + 1] * (1.0f + sc[2 * hh + 1]) * SH}; cs[2 * j + hh] = (f32x2){h[2 * hh] * SH, h[2 * hh + 1] * SH}; }
            if constexpr (DUAL) { const f32x4 g2 = *(const f32x4*)(gain2 + col), s2 = *(const f32x4*)(sc2 + (size_t)b * 2048 + col), h2 = *(const f32x4*)(sh2 + (size_t)b * 2048 + col);
#pragma unroll
                for (int hh = 0; hh < 2; ++hh) { cb[2 * j + hh] = (f32x2){g2[2 * hh] * (1.0f + s2[2 * hh]), g2[2 * hh + 1] * (1.0f + s2[2 * hh + 1])}; cd[2 * j + hh] = (f32x2){h2[2 * hh], h2[2 * hh + 1]}; } } }
        f32x2 wr2[ROUTER ? 16 : 1][4];
        if constexpr (ROUTER) {
#pragma unroll
            for (int j = 0; j < 4; ++j)
#pragma unroll
                for (int q = 0; q < 4; ++q) { const int col = 4 * F.lane + 256 * j + q; const f32x4 w0 = *(const f32x4*)(wrouter + (size_t)col * 8), w1 = *(const f32x4*)(wrouter + (size_t)col * 8 + 4);
                    wr2[4 * j + q][0] = (f32x2){w0[0], w0[1]} * (1.0f / SH); wr2[4 * j + q][1] = (f32x2){w0[2], w0[3]} * (1.0f / SH); wr2[4 * j + q][2] = (f32x2){w1[0], w1[1]} * (1.0f / SH); wr2[4 * j + q][3] = (f32x2){w1[2], w1[3]} * (1.0f / SH); }
        }
        int me12 = 0; float mw1 = 0.f;
        const int rowb = rb * 256 + F.wave * 32;
        f32x4 nf[INF32 ? 4 : 1]; u32x2 nb[INF32 ? 1 : 4], nc[INF32 ? 1 : 4];
        if constexpr (INF32) { const f32x4* xr = (const f32x4*)((const float*)x + (size_t)rowb * DM) + F.lane;
#pragma unroll
            for (int j = 0; j < 4; ++j) nf[j] = xr[64 * j]; }
        else { const u32x2* xr = (const u32x2*)((const bf16_t*)x + (size_t)rowb * DM) + F.lane;
#pragma unroll
            for (int j = 0; j < 4; ++j) { nb[j] = xr[64 * j]; nc[j] = xr[64 * j + DM / 4]; } }
        for (int rr = 0; rr < 32; ++rr) {
            const size_t row = (size_t)(rowb + rr);
            f32x2 v[8];
            if constexpr (INF32) {
#pragma unroll
                for (int j = 0; j < 4; ++j) { v[2 * j] = (f32x2){nf[j][0], nf[j][1]}; v[2 * j + 1] = (f32x2){nf[j][2], nf[j][3]}; }
                if (rr + 1 < 32) { const f32x4* xr = (const f32x4*)((const float*)x + (row + 1) * DM) + F.lane;
#pragma unroll
                    for (int j = 0; j < 4; ++j) nf[j] = xr[64 * j]; } }
            else {
#pragma unroll
                for (int j = 0; j < 4; ++j) { const u32x2 p = nb[j]; v[2 * j] = (f32x2){bflo(p.x), bfhi(p.x)}; v[2 * j + 1] = (f32x2){bflo(p.y), bfhi(p.y)}; nb[j] = nc[j]; }
                if (rr + 2 < 32) { const u32x2* xr = (const u32x2*)((const bf16_t*)x + (row + 2) * DM) + F.lane;
#pragma unroll
                    for (int j = 0; j < 4; ++j) nc[j] = xr[64 * j]; } }
            f32x2 sq = v[0] * v[0];
#pragma unroll
            for (int i = 1; i < 8; ++i) sq += v[i] * v[i];
            const float r = __builtin_amdgcn_rsqf(wave_sum_dpp(sq.x + sq.y) * (1.0f / DM) + EPS);
            const f32x2 r2 = {r, r};
            f32x2 hv[8];
#pragma unroll
            for (int i = 0; i < 8; ++i) { v[i] = v[i] * r2; hv[i] = v[i] * ca[i] + cs[i]; }
            if constexpr (OUT8) { unsigned* o4 = (unsigned*)((unsigned char*)out1 + row * DM) + F.lane;
#pragma unroll
                for (int j = 0; j < 4; ++j) o4[64 * j] = cvt4_fp8(hv[2 * j].x, hv[2 * j].y, hv[2 * j + 1].x, hv[2 * j + 1].y); }
            else { u32x2* o8 = (u32x2*)((bf16_t*)out1 + row * DM) + F.lane;
#pragma unroll
                for (int j = 0; j < 4; ++j) { u32x2 w; w.x = cvtpk(hv[2 * j].x, hv[2 * j].y); w.y = cvtpk(hv[2 * j + 1].x, hv[2 * j + 1].y); o8[64 * j] = w; } }
            if constexpr (DUAL) { u32x2* p8 = (u32x2*)(out2 + row * DM) + F.lane;
#pragma unroll
                for (int j = 0; j < 4; ++j) { const f32x2 t0 = v[2 * j] * cb[2 * j] + cd[2 * j], t1 = v[2 * j + 1] * cb[2 * j + 1] + cd[2 * j + 1];
                    u32x2 w; w.x = cvtpk(t0.x, t0.y); w.y = cvtpk(t1.x, t1.y); p8[64 * j] = w; } }
            if constexpr (ROUTER) {
                f32x2 pp[4];
#pragma unroll
                for (int k = 0; k < 4; ++k) pp[k] = (f32x2){0.f, 0.f};
#pragma unroll
                for (int c = 0; c < 16; ++c) { const float hc = (c & 1) ? hv[c >> 1].y : hv[c >> 1].x; const f32x2 h2 = {hc, hc};
#pragma unroll
                    for (int k = 0; k < 4; ++k) pp[k] += h2 * wr2[c][k]; }
                float pe[8];
#pragma unroll
                for (int k = 0; k < 4; ++k) { pe[2 * k] = pp[k].x; pe[2 * k + 1] = pp[k].y; }
                { const bool b0 = F.lane & 1, b1 = F.lane & 2, b2 = F.lane & 4;
#pragma unroll
                  for (int e = 0; e < 4; ++e) { const float snd = b2 ? pe[e] : pe[e + 4], kp = b2 ? pe[e + 4] : pe[e]; pe[e] = kp + dppf<0x141>(snd); }
#pragma unroll
                  for (int e = 0; e < 2; ++e) { const float snd = b1 ? pe[e] : pe[e + 2], kp = b1 ? pe[e + 2] : pe[e]; pe[e] = kp + dppf<0x4E>(snd); }
                  { const float snd = b0 ? pe[0] : pe[1], kp = b0 ? pe[1] : pe[0]; pe[0] = kp + dppf<0xB1>(snd); }
                  pe[0] += dppf<0x128>(pe[0]); pe[0] += shflx(pe[0], F.lane, 16); pe[0] += shflx(pe[0], F.lane, 32); }
                float lg[8];
#pragma unroll
                for (int e = 0; e < 8; ++e) lg[e] = __int_as_float(__builtin_amdgcn_readlane(__float_as_int(pe[0]), e));
                int i1 = 0; float v1 = lg[0];
#pragma unroll
                for (int e = 1; e < 8; ++e) if (lg[e] > v1) { v1 = lg[e]; i1 = e; }
                int i2 = -1; float v2 = -INFINITY;
#pragma unroll
                for (int e = 0; e < 8; ++e) if (e != i1 && lg[e] > v2) { v2 = lg[e]; i2 = e; }
                const float wt = 1.0f / (1.0f + __expf(v2 - v1));
                if (F.lane == rr) { me12 = i1 | (i2 << 8); mw1 = wt; }
            }
        }
        if (ROUTER) {
            if (F.lane < 32) { e12[rowb + F.lane] = me12; w1o[rowb + F.lane] = mw1; }
            const int e1 = me12 & 255, e2 = me12 >> 8;
#pragma unroll
            for (int e = 0; e < 8; ++e) { const unsigned long long m1 = __ballot(F.lane < 32 && e1 == e), m2 = __ballot(F.lane < 32 && e2 == e);
                if (F.lane == 0) { atomicAdd((int*)&lcnt[e], (int)__popcll(m1)); atomicAdd((int*)&lcnt[8 + e], (int)__popcll(m2)); } }
            __syncthreads();
            if (F.tid < 16) cnt[rb * 16 + F.tid] = lcnt[F.tid];
            __syncthreads();
        }
    }
}

__device__ __forceinline__ void moe_scatter(const Ctx& F, const int* cnt, const int* e12, const float* w1, int* tos, float* wos, int* tile) {
    LAS int* T1 = (LAS int*)F.lds;
    LAS int* T2 = T1 + 512;
    LAS int* tot = T2 + 512;
    LAS int* pre = tot + 16;
    LAS int* seg = pre + 16;
    LAS int* wcn = seg + 32;
    for (int rb = F.vcu; rb < NTOK / 256; rb += F.G) {
        { const int bin = F.tid & 15, part = F.tid >> 4; int st = 0, sp = 0;
#pragma unroll
            for (int j = 0; j < 8; ++j) { const int b2 = part * 8 + j; const int v = cnt[b2 * 16 + bin]; st += v; if (b2 < rb) sp += v; }
            T1[part * 16 + bin] = st; T2[part * 16 + bin] = sp; }
        __syncthreads();
        if (F.tid < 16) { int st = 0, sp = 0; for (int p = 0; p < 32; ++p) { st += T1[p * 16 + F.tid]; sp += T2[p * 16 + F.tid]; } tot[F.tid] = st; pre[F.tid] = sp; }
        __syncthreads();
        if (F.tid == 0) { int s = 0; for (int bin = 0; bin < 16; ++bin) { seg[bin] = s; s += ((tot[bin] + 255) >> 8) << 8; } seg[16] = s; }
        __syncthreads();
        int e1 = -1, e2 = -1; float wt = 0.f; int r1 = 0, r2 = 0;
        const int token = rb * 256 + F.tid;
        if (F.tid < 256) { const int v = e12[token]; e1 = v & 255; e2 = v >> 8; wt = w1[token]; }
        if (F.wave < 4) {
#pragma unroll
            for (int e = 0; e < 8; ++e) { const unsigned long long m1 = __ballot(e1 == e), m2 = __ballot(e2 == e); const unsigned long long lt = (1ull << F.lane) - 1ull;
                if (e1 == e) r1 = (int)__popcll(m1 & lt); if (e2 == e) r2 = (int)__popcll(m2 & lt);
                if (F.lane == 0) { wcn[F.wave * 16 + e] = (int)__popcll(m1); wcn[F.wave * 16 + 8 + e] = (int)__popcll(m2); } }
        }
        __syncthreads();
        if (F.tid < 256) {
            int o1 = seg[e1] + pre[e1] + r1, o2 = seg[8 + e2] + pre[8 + e2] + r2;
            for (int w = 0; w < F.wave; ++w) { o1 += wcn[w * 16 + e1]; o2 += wcn[w * 16 + 8 + e2]; }
            tos[o1] = token; wos[o1] = wt; tos[o2] = token; wos[o2] = 1.0f - wt;
        }
        if (rb < 16) { const int bin = rb; const int s0 = seg[bin] + tot[bin], s1 = seg[bin + 1]; for (int s = s0 + F.tid; s < s1; s += 512) { tos[s] = -1; wos[s] = 0.f; } }
        if (rb == 0) { if (F.tid == 0) { tile[0] = seg[8] >> 8; tile[1] = seg[16] >> 8; }
            for (int t = F.tid; t < MAXTILES; t += 512) { const int s = t << 8; int e = 0;
#pragma unroll
                for (int bin = 1; bin < 16; ++bin) if (s >= seg[bin]) e = bin;
                tile[16 + t] = e & 7; } }
        __syncthreads();
    }
}

constexpr int SC_AT = 0, SC_WT = 34816, SC_AS = 69632, SC_BS = 102400, SC_SEG = 135168, SC_CARRY = 139264, SC_CW = 139776, SC_GB = 142336;
__device__ __forceinline__ void scan_phase(const Ctx& F, const float* par, int l, const bf16_t* XB, bf16_t* GY, const bf16_t* GW) {
    LAS unsigned char* lds = F.lds;
    LAS float* AS = (LAS float*)(lds + SC_AS); LAS float* BS = (LAS float*)(lds + SC_BS);
    LAS float* SEGA = (LAS float*)(lds + SC_SEG); LAS float* SEGB = SEGA + 512;
    LAS float* CARRY = (LAS float*)(lds + SC_CARRY);
    LAS float* CW = (LAS float*)(lds + SC_CW);
    LAS float* GB = (LAS float*)(lds + SC_GB);
    const int tid = F.tid, lane = F.lane, wid = F.wave, r32 = lane & 31, hh = lane >> 5;
    for (int un = F.vcu; un < 256; un += F.G) {
        const int b = un >> 4, n = (un >> 1) & 7, c2 = un & 1;
        __syncthreads();
        for (int i = tid; i < 640; i += 512) { const int ch = i & 127, k = i >> 7; CW[i] = (k < 4) ? par[PAR_CONVW + (l * 4 + k) * DM + 128 * n + ch] : par[PAR_CONVB + l * DM + 128 * n + ch]; }
        if (tid < 64) { const int ch = l * DM + 128 * n + 64 * c2 + tid; GB[tid] = par[PAR_GAB + ch]; GB[64 + tid] = par[PAR_GXB + ch]; GB[128 + tid] = log1pf(expf(-par[PAR_LAM + ch])); CARRY[tid] = 0.f; CARRY[64 + tid] = 0.f; }
        { const bf16_t* gsrc = GW + (size_t)(((l * 8 + n) * 2 + c2) * 128) * 128;
#pragma unroll
            for (int i = 0; i < 4; ++i) { const int p = tid + 512 * i, row = p >> 4, c16 = p & 15; const u32x4 v = *(const u32x4*)(gsrc + (size_t)row * 128 + c16 * 8); *(LAS u32x4*)(lds + SC_WT + row * 272 + c16 * 16) = v; } }
        const int cp = lane, tg = wid;
        const int sc = lane, sg = wid;
        const size_t rowbase = (size_t)b * SEQ;
        const bf16_t* xbp = XB + rowbase * DM + 128 * n + 2 * cp;
        bf16_t* gyp = GY + rowbase * DM + 128 * n + 64 * c2 + sc;
        unsigned xv[19];
#pragma unroll
        for (int k = 0; k < 19; ++k) { const int t = 16 * tg - 3 + k; xv[k] = (t >= 0) ? *(const unsigned*)(xbp + (size_t)t * DM) : 0u; }
        __syncthreads();
        float w[2][4], cb[2];
#pragma unroll
        for (int q = 0; q < 2; ++q) { cb[q] = CW[512 + 2 * cp + q];
#pragma unroll
            for (int k = 0; k < 4; ++k) w[q][k] = CW[k * 128 + 2 * cp + q]; }
        const float gba = GB[32 * (wid & 1) + r32], gbx = GB[64 + 32 * (wid & 1) + r32], spv = GB[128 + 32 * (wid & 1) + r32];
        for (int ci = 0; ci < SEQ / 128; ++ci) {
            const int t0 = ci * 128;
#pragma unroll
            for (int k = 0; k < 16; ++k) {
                float o[2];
#pragma unroll
                for (int q = 0; q < 2; ++q) { float s = cb[q];
#pragma unroll
                    for (int j = 0; j < 4; ++j) { const unsigned pv = xv[k + j]; const float xf = q ? __uint_as_float(pv & 0xffff0000u) : __uint_as_float(pv << 16); s += w[q][j] * xf; }
                    o[q] = s; }
                *(LAS unsigned*)(lds + SC_AT + (16 * tg + k) * 272 + cp * 4) = cvtpk(o[0], o[1]);
            }
            if (ci + 1 < SEQ / 128) {
#pragma unroll
                for (int k = 0; k < 19; ++k) xv[k] = *(const unsigned*)(xbp + (size_t)(t0 + 128 + 16 * tg - 3 + k) * DM);
            }
            __syncthreads();
            f32x16 ga, gx;
#pragma unroll
            for (int i = 0; i < 16; ++i) { ga[i] = 0.f; gx[i] = 0.f; }
            { const int tt = wid >> 1, ct = wid & 1;
                const LAS unsigned char* ap = lds + SC_AT + (32 * tt + r32) * 272 + hh * 16;
                const LAS unsigned char* bpa = lds + SC_WT + (32 * ct + r32) * 272 + hh * 16;
                const LAS unsigned char* bpx = bpa + 64 * 272;
#pragma unroll
                for (int s = 0; s < 8; ++s) { const bf16x8 af = *(const LAS bf16x8*)(ap + s * 32), ba = *(const LAS bf16x8*)(bpa + s * 32), bx = *(const LAS bf16x8*)(bpx + s * 32);
                    ga = __builtin_amdgcn_mfma_f32_32x32x16_bf16(af, ba, ga, 0, 0, 0); gx = __builtin_amdgcn_mfma_f32_32x32x16_bf16(af, bx, gx, 0, 0, 0); }
                const f32x2 nlv = {-LOG2E, -LOG2E}, bav = {-LOG2E * gba, -LOG2E * gba}, bxv = {-LOG2E * gbx, -LOG2E * gbx}, onev = {1.0f, 1.0f}, csv = {-8.0f * LOG2E * spv, -8.0f * LOG2E * spv};
#pragma unroll
                for (int i = 0; i < 16; i += 2) { const int tok = 32 * tt + (i & 3) + 8 * (i >> 2) + 4 * hh, ch = 32 * ct + r32;
                    const f32x2 a2 = {ga[i], ga[i + 1]}, x2 = {gx[i], gx[i + 1]};
                    const f32x2 ta = a2 * nlv + bav, tx = x2 * nlv + bxv;
                    const f32x2 da = (f32x2){fast_exp2(ta.x), fast_exp2(ta.y)} + onev, dx = (f32x2){fast_exp2(tx.x), fast_exp2(tx.y)} + onev;
                    const f32x2 rg = {fast_rcp(da.x), fast_rcp(da.y)}, ig = {fast_rcp(dx.x), fast_rcp(dx.y)};
                    const f32x2 l2 = rg * csv; const f32x2 av = {fast_exp2(l2.x), fast_exp2(l2.y)};
                    const f32x2 om = onev - av * av; const f32x2 bc = {__builtin_amdgcn_sqrtf(fmaxf(om.x, 0.f)), __builtin_amdgcn_sqrtf(fmaxf(om.y, 0.f))};
                    const f32x2 xc = {bf2f(*(const LAS unsigned short*)(lds + SC_AT + tok * 272 + (64 * c2 + ch) * 2)), bf2f(*(const LAS unsigned short*)(lds + SC_AT + (tok + 1) * 272 + (64 * c2 + ch) * 2))};
                    const f32x2 bb = (bc * ig) * xc;
                    AS[tok * 64 + ch] = av.x; AS[(tok + 1) * 64 + ch] = av.y; BS[tok * 64 + ch] = bb.x; BS[(tok + 1) * 64 + ch] = bb.y; }
            }
            __syncthreads();
            unsigned short gyv[16];
#pragma unroll
            for (int k = 0; k < 16; ++k) gyv[k] = gyp[(size_t)(t0 + 16 * sg + k) * DM];
            float av[16], bv[16];
#pragma unroll
            for (int k = 0; k < 16; ++k) { av[k] = AS[(16 * sg + k) * 64 + sc]; bv[k] = BS[(16 * sg + k) * 64 + sc]; }
            { float pa = 1.f, pb = 0.f;
#pragma unroll
                for (int k = 0; k < 16; ++k) { pb = av[k] * pb + bv[k]; pa *= av[k]; }
                SEGA[sg * 64 + sc] = pa; SEGB[sg * 64 + sc] = pb; }
            __syncthreads();
            float h = CARRY[(ci & 1) * 64 + sc];
            for (int s = 0; s < sg; ++s) h = SEGA[s * 64 + sc] * h + SEGB[s * 64 + sc];
#pragma unroll
            for (int k = 0; k < 16; ++k) { h = av[k] * h + bv[k]; const float o = h * bf2f(gyv[k]); gyp[(size_t)(t0 + 16 * sg + k) * DM] = (bf16_t)(cvtpk(o, 0.f) & 0xffffu); }
            if (sg == 7) CARRY[((ci + 1) & 1) * 64 + sc] = h;
        }
    }
    __syncthreads();
}

constexpr int AT_K = 0, AT_V = 36864;
__device__ __forceinline__ void attn_phase(const Ctx& F, const bf16_t* Q, const bf16_t* Kb, const bf16_t* Vb, bf16_t* O, const float* sinks) {
    LAS unsigned char* lds = F.lds;
    const int tid = F.tid, lane = F.lane, wid = F.wave, r32 = lane & 31, hh = lane >> 5;
    const int i16 = lane & 15, tq = i16 >> 2, tp = i16 & 3, blk = (lane >> 4) & 1;
    const int g = wid & 3, half = wid >> 2;
    constexpr int NU = BATCH * 32 * 4;
    u32x4 kreg[4], vreg[4]; bf16x8 qreg[2][4];
#define AT_LOADKV(unit) do { const int kh_ = (unit) & 3, n_ = ((unit) >> 2) & 31, b_ = (unit) >> 7; \
        _Pragma("unroll") for (int i = 0; i < 4; ++i) { const int p = tid + 512 * i, row = p >> 3, c16 = p & 7; kreg[i] = (u32x4){0u, 0u, 0u, 0u}; vreg[i] = (u32x4){0u, 0u, 0u, 0u}; \
            if (n_ > 0 || row >= 128) { const size_t tok = (size_t)b_ * SEQ + (size_t)(128 * (n_ - 1) + row); kreg[i] = *(const u32x4*)(Kb + tok * 256 + kh_ * 64 + c16 * 8); vreg[i] = *(const u32x4*)(Vb + tok * 256 + kh_ * 64 + c16 * 8); } } } while (0)
#define AT_LOADQ(unit) do { const int kh_ = (unit) & 3, n_ = ((unit) >> 2) & 31, b_ = (unit) >> 7; \
        _Pragma("unroll") for (int ps = 0; ps < 2; ++ps) { const size_t qt_ = (size_t)b_ * SEQ + (size_t)(128 * n_ + 64 * half + 32 * ps + r32); \
            _Pragma("unroll") for (int s = 0; s < 4; ++s) qreg[ps][s] = *(const bf16x8*)(Q + qt_ * DM + (4 * kh_ + g) * 64 + 16 * s + 8 * hh); } } while (0)
    int un = F.vcu;
    if (un < NU) { AT_LOADKV(un); AT_LOADQ(un); }
    for (; un < NU; un += F.G) {
        const int kh = un & 3, n = (un >> 2) & 31, b = un >> 7;
        __syncthreads();
#pragma unroll
        for (int i = 0; i < 4; ++i) { const int p = tid + 512 * i, row = p >> 3, c16 = p & 7;
            *(LAS u32x4*)(lds + AT_K + row * 144 + c16 * 16) = kreg[i]; *(LAS u32x4*)(lds + AT_V + row * 192 + c16 * 16) = vreg[i]; }
        __syncthreads();
        if (un + F.G < NU) AT_LOADKV(un + F.G);
        const int hq = 4 * kh + g;
        const float sink2 = sinks[hq] * LOG2E;
#pragma unroll 1
        for (int pass = 0; pass < 2; ++pass) {
            const int i0 = 64 * half + 32 * pass, kt0 = i0 >> 5;
            const size_t qtok = (size_t)b * SEQ + (size_t)(128 * n + i0 + r32);
            bf16x8 qf[4];
#pragma unroll
            for (int s = 0; s < 4; ++s) qf[s] = pass ? qreg[1][s] : qreg[0][s];
            f32x16 sacc[5];
#pragma unroll
            for (int t = 0; t < 5; ++t) {
#pragma unroll
                for (int i = 0; i < 16; ++i) sacc[t][i] = 0.f;
#pragma unroll
                for (int s = 0; s < 4; ++s) { const bf16x8 kf = *(const LAS bf16x8*)(lds + AT_K + (32 * (kt0 + t) + r32) * 144 + (16 * s + 8 * hh) * 2);
                    sacc[t] = __builtin_amdgcn_mfma_f32_32x32x16_bf16(kf, qf[s], sacc[t], 0, 0, 0); } }
            float sum = 0.f;
#pragma unroll
            for (int t = 0; t < 5; ++t) {
                const bool dead = (n == 0) && (32 * (kt0 + t) < 128);
#pragma unroll
                for (int i = 0; i < 16; ++i) { float p = fast_exp2(sacc[t][i]);
                    if (t == 0 || t == 4) { const int d = 32 * t + (i & 3) + 8 * (i >> 2) + 4 * hh - r32; p = ((d >= 1) && (d <= 128)) ? p : 0.f; }
                    if (dead) p = 0.f; sacc[t][i] = p; sum += p; } }
            sum += shflx(sum, lane, 32);
            sum += fast_exp2(sink2);
            const float inv = 1.0f / sum;
            f32x16 oacc[2];
#pragma unroll
            for (int i = 0; i < 16; ++i) { oacc[0][i] = 0.f; oacc[1][i] = 0.f; }
#pragma unroll
            for (int t = 0; t < 5; ++t)
#pragma unroll
                for (int s = 0; s < 2; ++s) {
                    u32x4 pk; pk.x = cvtpk(sacc[t][8 * s], sacc[t][8 * s + 1]); pk.y = cvtpk(sacc[t][8 * s + 2], sacc[t][8 * s + 3]); pk.z = cvtpk(sacc[t][8 * s + 4], sacc[t][8 * s + 5]); pk.w = cvtpk(sacc[t][8 * s + 6], sacc[t][8 * s + 7]);
                    const bf16x8 pb = __builtin_bit_cast(bf16x8, pk);
#pragma unroll
                    for (int dt = 0; dt < 2; ++dt) {
                        const LAS unsigned char* vp = lds + AT_V + (32 * (kt0 + t) + 16 * s + 4 * hh + tq) * 192 + (32 * dt + 16 * blk + 4 * tp) * 2;
                        const s16x4 lo = __builtin_bit_cast(s16x4, __builtin_amdgcn_ds_read_tr16_b64_v4i16((LAS s16x4*)vp));
                        const s16x4 hi = __builtin_bit_cast(s16x4, __builtin_amdgcn_ds_read_tr16_b64_v4i16((LAS s16x4*)(vp + 8 * 192)));
                        const bf16x8 va = __builtin_shufflevector(lo, hi, 0, 1, 2, 3, 4, 5, 6, 7);
                        oacc[dt] = __builtin_amdgcn_mfma_f32_32x32x16_bf16(va, pb, oacc[dt], 0, 0, 0);
                    }
                }
            if constexpr (FP8_WO) {
                unsigned char* op = (unsigned char*)O + qtok * DM + hq * 64; const float sco = inv * SC8_O;
#pragma unroll
                for (int dt = 0; dt < 2; ++dt)
#pragma unroll
                    for (int q4 = 0; q4 < 4; ++q4) *(unsigned*)(op + 32 * dt + 8 * q4 + 4 * hh) = cvt4_fp8(oacc[dt][4 * q4] * sco, oacc[dt][4 * q4 + 1] * sco, oacc[dt][4 * q4 + 2] * sco, oacc[dt][4 * q4 + 3] * sco);
            } else {
                bf16_t* op = O + qtok * DM + hq * 64;
#pragma unroll
                for (int dt = 0; dt < 2; ++dt)
#pragma unroll
                    for (int q4 = 0; q4 < 4; ++q4) { u32x2 w; w.x = cvtpk(oacc[dt][4 * q4] * inv, oacc[dt][4 * q4 + 1] * inv); w.y = cvtpk(oacc[dt][4 * q4 + 2] * inv, oacc[dt][4 * q4 + 3] * inv);
                        *(u32x2*)(op + 32 * dt + 8 * q4 + 4 * hh) = w; } }
        }
        if (un + F.G < NU) AT_LOADQ(un + F.G);
    }
#undef AT_LOADKV
#undef AT_LOADQ
    __syncthreads();
}

constexpr int NPHASE = 33 + (DUP_SCANPAIR ? 4 : 0);
__global__ void __launch_bounds__(512, 2) fwd_kernel(Args a) {
    extern __shared__ __attribute__((aligned(16))) unsigned char lds_raw[];
    volatile LAS unsigned* MISC = (volatile LAS unsigned*)((LAS unsigned char*)lds_raw + LDS_MISC);
    const int wv0 = __builtin_amdgcn_readfirstlane((int)threadIdx.x >> 6);
    if (wv0 == 0) MISC[lane_id_v()] = 0u;
    __syncthreads();
    XcdBarrier bar; bar.bar = (unsigned*)(a.ws + WS_CTL) + CW_BAR; bar.x = 0; bar.st = MISC;
    if (!MK_MULTI) bar = xcd_barrier_post((unsigned*)(a.ws + WS_CTL) + CW_BAR, MISC, wv0);
    const int lo = a.ph_lo, hi = a.ph_hi;
    int ph = 0;
#define PH_BEGIN(k) if (((PHSEL >> (k)) & 1) && (!MK_MULTI || (lo <= ph && ph < hi))) { Ctx F; { int t_ = wv0 * 64 + (int)lane_id_v(); asm volatile("" : "+v"(t_)); F.tid = t_; } F.lds = (LAS unsigned char*)lds_raw; F.lane = F.tid & 63; \
        F.wave = __builtin_amdgcn_readfirstlane(F.tid >> 6); F.G = gridDim.x; { int bx = blockIdx.x; asm volatile("" : "+s"(bx)); F.cid = bx; F.vcu = (F.G % 8 == 0) ? (bx % 8) * (F.G / 8) + bx / 8 : bx; } \
        unsigned char GAS* wsg_ = (unsigned char GAS*)a.ws; asm volatile("" : "+s"(wsg_)); unsigned char* ws = (unsigned char*)wsg_; float GAS* xog_ = (float GAS*)a.out; asm volatile("" : "+s"(xog_)); float* xo = (float*)xog_; int l = l_; asm volatile("" : "+s"(l)); (void)xo; (void)l; \
        for (int rep_ = 0; rep_ < (((DUPMASK >> (k)) & 1) ? 2 : 1); ++rep_) {
#define PH_END   } if (!MK_MULTI && ph + 1 < NPHASE) { XcdBarrier b2_ = bar; unsigned GAS* bp_ = (unsigned GAS*)b2_.bar; asm volatile("" : "+s"(bp_)); b2_.bar = (unsigned*)bp_; unsigned bx_ = b2_.x; asm volatile("" : "+s"(bx_)); b2_.x = bx_; xcd_barrier(b2_, wv0); } } ++ph;
#define W_PAR    ((const float*)(ws + WS_PAR))
#define W_XS     ((bf16_t*)(ws + WS_XS))
#define W_MODL   ((const float*)(ws + WS_MODV) + (size_t)l * 16 * 6144)
#define W_KVMOD  ((const float*)(ws + WS_KVMOD))
#define W_HB     ((bf16_t*)(ws + WS_H))
#define W_HKV    ((bf16_t*)(ws + WS_HKV))
#define W_KB     ((bf16_t*)(ws + WS_KB))
#define W_VB     ((bf16_t*)(ws + WS_VB))
#define W_XB     ((bf16_t*)(ws + WS_ARENA + AR_XB))
#define W_GY     ((bf16_t*)(ws + WS_ARENA + AR_GY))
#define W_HID    ((bf16_t*)(ws + WS_ARENA))
#define W_Q      ((bf16_t*)(ws + WS_ARENA + AR_Q))
#define W_O      ((bf16_t*)(ws + WS_ARENA + AR_O))
#define W_COS    ((const float*)(ws + WS_COS))
#define W_SIN    ((const float*)(ws + WS_SIN))
#define W_E12    ((int*)(ws + WS_E12))
#define W_W1     ((float*)(ws + WS_W1))
#define W_CNT    ((int*)(ws + WS_CNT))
#define W_TILE   ((int*)(ws + WS_TILE))
#define W_TOS    ((int*)(ws + WS_TOS))
#define W_WOS    ((float*)(ws + WS_WOS))

    { const int l_ = 0; PH_BEGIN(0) p0_prologue(F, a); PH_END }

#pragma unroll 1
    for (int l_ = 0; l_ < 4; ++l_) {
        if (l_ < 2) {
            PH_BEGIN(1) if (l == 0) norm_phase<false, false, false, true>(F, a.x, W_PAR + PAR_MIXN + l * DM, W_MODL, W_MODL + 1024, W_HB, nullptr, nullptr, nullptr, nullptr, nullptr, nullptr, nullptr, nullptr);
                        else norm_phase<false, false>(F, W_XS, W_PAR + PAR_MIXN + l * DM, W_MODL, W_MODL + 1024, W_HB, nullptr, nullptr, nullptr, nullptr, nullptr, nullptr, nullptr, nullptr); PH_END
#pragma unroll 1
            for (int sp_ = 0; sp_ < (DUP_SCANPAIR ? 2 : 1); ++sp_) {
            PH_BEGIN(2) { pg8::ProbDense P{W_HB, (const bf16_t*)(ws + WS_WIN) + (size_t)l * 2048 * DM, DM * 2}; pg8::Order S; S.init(NTOK / 256, 8, F.G, F.cid, 0);
                pg8::EpiWin E{W_XB, W_GY}; pg8::gemm_phase<pg8::EpiWin, pg8::ProbDense, false>(F.lds, F.tid, P, S, E); } PH_END
            PH_BEGIN(3) scan_phase(F, W_PAR, l, W_XB, W_GY, (const bf16_t*)(ws + WS_GW)); PH_END
            }
            if (l_ == 0) {
                PH_BEGIN(20) { pg8::ProbDense P{W_GY, (const bf16_t*)(ws + WS_WOUT), DM * 2}; pg8::Order S; S.init(NTOK / 256, 4, F.G, F.cid, 0, STAGGER_TICKS);
                    pg8::EpiResid<true> E{a.x, W_XS, W_MODL + 2048, 1.0f}; pg8::gemm_phase<pg8::EpiResid<true>, pg8::ProbDense, false>(F.lds, F.tid, P, S, E); } PH_END
            } else {
                PH_BEGIN(4) { pg8::ProbDense P{W_GY, (const bf16_t*)(ws + WS_WOUT) + (size_t)l * DM * DM, DM * 2}; pg8::Order S; S.init(NTOK / 256, 4, F.G, F.cid, 0, STAGGER_TICKS);
                    pg8::EpiResid<false> E{W_XS, W_XS, W_MODL + 2048, 1.0f}; pg8::gemm_phase<pg8::EpiResid<false>, pg8::ProbDense, false>(F.lds, F.tid, P, S, E); } PH_END
            }
        } else {
            PH_BEGIN(5) if (l == 2) norm_phase<true, false>(F, W_XS, W_PAR + PAR_MIXN + l * DM, W_MODL, W_MODL + 1024, W_HB, W_PAR + PAR_KVN, W_KVMOD, W_KVMOD + 1024, W_HKV, nullptr, nullptr, nullptr, nullptr);
                        else norm_phase<false, false>(F, W_XS, W_PAR + PAR_MIXN + l * DM, W_MODL, W_MODL + 1024, W_HB, nullptr, nullptr, nullptr, nullptr, nullptr, nullptr, nullptr, nullptr); PH_END
            if (l_ == 2) {
                PH_BEGIN(6) {
                    { pg8::ProbDense P{W_HKV, (const bf16_t*)(ws + WS_WKV), DM * 2}; pg8::Order S; S.init(NTOK / 256, 2, F.G, F.cid, 0);
                      pg8::EpiQK E{W_KB, 256, W_PAR + PAR_KN, W_COS, W_SIN, 1.0f, 1, W_VB}; pg8::gemm_phase<pg8::EpiQK, pg8::ProbDense, false>(F.lds, F.tid, P, S, E); }
                    { pg8::ProbDense P{W_HB, (const bf16_t*)(ws + WS_WQ), DM * 2}; pg8::Order S; S.init(NTOK / 256, 4, F.G, F.cid, 0);
                      pg8::EpiQK E{W_Q, DM, W_PAR + PAR_QN, W_COS, W_SIN, 0.125f * LOG2E, -1, nullptr}; pg8::gemm_phase<pg8::EpiQK, pg8::ProbDense, false>(F.lds, F.tid, P, S, E); } } PH_END
            } else {
                PH_BEGIN(21) { pg8::ProbDense P{W_HB, (const bf16_t*)(ws + WS_WQ) + (size_t)DM * DM, DM * 2}; pg8::Order S; S.init(NTOK / 256, 4, F.G, F.cid, 0);
                    pg8::EpiQK E{W_Q, DM, W_PAR + PAR_QN + 64, W_COS, W_SIN, 0.125f * LOG2E, -1, nullptr}; pg8::gemm_phase<pg8::EpiQK, pg8::ProbDense, false>(F.lds, F.tid, P, S, E); } PH_END
            }
            PH_BEGIN(7) attn_phase(F, W_Q, W_KB, W_VB, W_O, W_PAR + PAR_SINK + (l - 2) * 16); PH_END
            PH_BEGIN(8) { pg8::ProbDense P{W_O, ws + WS_WO + (size_t)(l - 2) * DM * DM * 2, FP8_WO ? DM : DM * 2}; pg8::Order S; S.init(NTOK / 256, 4, F.G, F.cid, 0, STAGGER_TICKS);
                pg8::EpiResid<false> E{W_XS, W_XS, W_MODL + 2048, FP8_WO ? 1.0f / (SC8_O * SC8_W) : 1.0f}; pg8::gemm_phase<pg8::EpiResid<false>, pg8::ProbDense, false, (bool)FP8_WO>(F.lds, F.tid, P, S, E); } PH_END
        }
        if (!(l_ & 1)) {
            PH_BEGIN(9) if (FP8_OF(0) | FP8_OF(2)) { if (FP8_DENSE(l)) norm_phase<false, false, true>(F, W_XS, W_PAR + PAR_FFNN + l * DM, W_MODL + 3072, W_MODL + 4096, W_HB, nullptr, nullptr, nullptr, nullptr, nullptr, nullptr, nullptr, nullptr);
                             else norm_phase<false, false, false>(F, W_XS, W_PAR + PAR_FFNN + l * DM, W_MODL + 3072, W_MODL + 4096, W_HB, nullptr, nullptr, nullptr, nullptr, nullptr, nullptr, nullptr, nullptr); }
                        else norm_phase<false, false, false>(F, W_XS, W_PAR + PAR_FFNN + l * DM, W_MODL + 3072, W_MODL + 4096, W_HB, nullptr, nullptr, nullptr, nullptr, nullptr, nullptr, nullptr, nullptr); PH_END
            if (FP8_DENSE(l_)) {
                PH_BEGIN(17) { pg8::ProbDense P{W_HB, ws + WS_FGU + (size_t)(l >> 1) * 6144 * DM * 2, DM}; pg8::Order S; S.init(NTOK / 256, 24, F.G, F.cid, 0);
                    pg8::EpiSwiglu<true> E{W_HID, DFF, 1.0f / (SC8_H * SC8_W)}; pg8::gemm_phase<pg8::EpiSwiglu<true>, pg8::ProbDense, false, true>(F.lds, F.tid, P, S, E); } PH_END
                PH_BEGIN(18) { pg8::ProbDense P{W_HID, ws + WS_FDN + (size_t)(l >> 1) * DM * DFF * 2, DFF}; pg8::Order S; S.init(NTOK / 256, 4, F.G, F.cid, 0, STAGGER_TICKS);
                    pg8::EpiResid<false> E{W_XS, W_XS, W_MODL + 5120, 1.0f / (SC8_HID * SC8_W)}; pg8::gemm_phase<pg8::EpiResid<false>, pg8::ProbDense, false, true>(F.lds, F.tid, P, S, E); } PH_END
            } else {
                PH_BEGIN(10) { pg8::ProbDense P{W_HB, (const bf16_t*)(ws + WS_FGU) + (size_t)(l >> 1) * 6144 * DM, DM * 2}; pg8::Order S; S.init(NTOK / 256, 24, F.G, F.cid, 0);
                    pg8::EpiSwiglu<false> E{W_HID, DFF, 1.0f}; pg8::gemm_phase<pg8::EpiSwiglu<false>, pg8::ProbDense, false>(F.lds, F.tid, P, S, E); } PH_END
                PH_BEGIN(11) { pg8::ProbDense P{W_HID, (const bf16_t*)(ws + WS_FDN) + (size_t)(l >> 1) * DM * DFF, DFF * 2}; pg8::Order S; S.init(NTOK / 256, 4, F.G, F.cid, 0, STAGGER_TICKS);
                    pg8::EpiResid<false> E{W_XS, W_XS, W_MODL + 5120, 1.0f}; pg8::gemm_phase<pg8::EpiResid<false>, pg8::ProbDense, false>(F.lds, F.tid, P, S, E); } PH_END
            }
        } else {
            PH_BEGIN(12) if (FP8_MOE(l)) norm_phase_pk<false, true, true>(F, W_XS, W_PAR + PAR_FFNN + l * DM, W_MODL + 3072, W_MODL + 4096, W_HB, nullptr, nullptr, nullptr, nullptr, W_PAR + PAR_ROUTER + (l >> 1) * DM * 8, W_E12, W_W1, W_CNT);
                         else norm_phase_pk<false, true, false>(F, W_XS, W_PAR + PAR_FFNN + l * DM, W_MODL + 3072, W_MODL + 4096, W_HB, nullptr, nullptr, nullptr, nullptr, W_PAR + PAR_ROUTER + (l >> 1) * DM * 8, W_E12, W_W1, W_CNT); PH_END
            PH_BEGIN(13) moe_scatter(F, W_CNT, W_E12, W_W1, W_TOS, W_WOS, W_TILE); PH_END
            if (FP8_MOE(l_)) {
                PH_BEGIN(16) {
                    LAS int* texp = (LAS int*)(F.lds + LDS_TEXP);
                    for (int i = F.tid; i < MAXTILES + 16; i += 512) texp[i] = W_TILE[i];
                    __syncthreads();
                    const int ntot = texp[1];
                    pg8::Order S; S.init(ntot, 28, F.G, F.cid, 0);
                    pg8::ProbGrouped P{W_HB, ws + WS_MGU + (size_t)(l >> 1) * 8 * 7168 * DM * 2, DM, 7168, texp + 16, W_TOS};
                    pg8::EpiSwiglu<true> E{W_HID, DFE, 1.0f / (SC8_H * SC8_W)}; pg8::gemm_phase<pg8::EpiSwiglu<true>, pg8::ProbGrouped, true, true>(F.lds, F.tid, P, S, E); } PH_END
            } else {
                PH_BEGIN(14) {
                    LAS int* texp = (LAS int*)(F.lds + LDS_TEXP);
                    for (int i = F.tid; i < MAXTILES + 16; i += 512) texp[i] = W_TILE[i];
                    __syncthreads();
                    const int ntot = texp[1];
                    pg8::Order S; S.init(ntot, 28, F.G, F.cid, 0);
                    pg8::ProbGrouped P{W_HB, (const bf16_t*)(ws + WS_MGU) + (size_t)(l >> 1) * 8 * 7168 * DM, DM * 2, 7168, texp + 16, W_TOS};
                    pg8::EpiSwiglu<false> E{W_HID, DFE, 1.0f}; pg8::gemm_phase<pg8::EpiSwiglu<false>, pg8::ProbGrouped, true, false>(F.lds, F.tid, P, S, E); } PH_END
            }
#pragma unroll 1
            for (int pass = 0; pass < 2; ++pass) {
                if (l_ == 3 && pass == 1) {
                    PH_BEGIN(19) {
                        LAS int* texp = (LAS int*)(F.lds + LDS_TEXP);
                        for (int i = F.tid; i < MAXTILES + 16; i += 512) texp[i] = W_TILE[i];
                        __syncthreads();
                        const int nA = texp[0], ntot = texp[1];
                        pg8::Order S; S.init(ntot - nA, 4, F.G, F.cid, nA, STAGGER_TICKS);
                        if (FP8_MOE(3)) { pg8::ProbGrouped P{W_HID, ws + WS_MDN + (size_t)8 * DM * DFE * 2, DFE, DM, texp + 16, W_TOS};
                            pg8::EpiMoeDown<true> E{W_XS, xo, W_MODL + 5120, W_TOS, W_WOS, 1.0f / (SC8_HID * SC8_W)}; pg8::gemm_phase<pg8::EpiMoeDown<true>, pg8::ProbGrouped, false, true>(F.lds, F.tid, P, S, E); }
                        else { pg8::ProbGrouped P{W_HID, (const bf16_t*)(ws + WS_MDN) + (size_t)8 * DM * DFE, DFE * 2, DM, texp + 16, W_TOS};
                            pg8::EpiMoeDown<true> E{W_XS, xo, W_MODL + 5120, W_TOS, W_WOS, 1.0f}; pg8::gemm_phase<pg8::EpiMoeDown<true>, pg8::ProbGrouped, false, false>(F.lds, F.tid, P, S, E); } } PH_END
                } else {
                    PH_BEGIN(15) {
                        LAS int* texp = (LAS int*)(F.lds + LDS_TEXP);
                        for (int i = F.tid; i < MAXTILES + 16; i += 512) texp[i] = W_TILE[i];
                        __syncthreads();
                        const int nA = texp[0], ntot = texp[1];
                        pg8::Order S; S.init(pass ? ntot - nA : nA, 4, F.G, F.cid, pass ? nA : 0, STAGGER_TICKS);
                        if (FP8_MOE(l)) { pg8::ProbGrouped P{W_HID, ws + WS_MDN + (size_t)(l >> 1) * 8 * DM * DFE * 2, DFE, DM, texp + 16, W_TOS};
                            pg8::EpiMoeDown<false> E{W_XS, W_XS, W_MODL + 5120, W_TOS, W_WOS, 1.0f / (SC8_HID * SC8_W)}; pg8::gemm_phase<pg8::EpiMoeDown<false>, pg8::ProbGrouped, false, true>(F.lds, F.tid, P, S, E); }
                        else { pg8::ProbGrouped P{W_HID, (const bf16_t*)(ws + WS_MDN) + (size_t)(l >> 1) * 8 * DM * DFE, DFE * 2, DM, texp + 16, W_TOS};
                            pg8::EpiMoeDown<false> E{W_XS, W_XS, W_MODL + 5120, W_TOS, W_WOS, 1.0f}; pg8::gemm_phase<pg8::EpiMoeDown<false>, pg8::ProbGrouped, false, false>(F.lds, F.tid, P, S, E); }
                        if (DEFER_L3 && l == 1) {
                            const int tail = S.nwg % F.G; const bool part = (tail > 0) && (2 * tail < F.G);
                            __syncthreads();
                            if (!part || F.cid >= tail) convert_deferred(F, a.m_w_gu, a.m_w_down, ws, pass, part ? F.cid - tail : F.cid, part ? F.G - tail : F.G);
                        } } PH_END
                }
            }
        }
    }
#undef PH_BEGIN
#undef PH_END
}

extern "C" void kernel_launch(void* const* d_in, const int* in_sizes, int n_in, void* d_out, int out_size, void* d_ws, size_t ws_size, hipStream_t stream) {
    static int grid = 0;
    if (grid == 0) {
        if (n_in != 30 || in_sizes[0] != NTOK * DM || out_size != NTOK * DM || ws_size < WS_END) { fprintf(stderr, "kernel_launch: unexpected shapes (n_in %d, in0 %d, out %d, ws %zu < %zu)\n", n_in, n_in > 0 ? in_sizes[0] : -1, out_size, ws_size, (size_t)WS_END); grid = -1; return; }
        int dev = 0, cus = 0, per_cu = 0;
        if (hipGetDevice(&dev) != hipSuccess || hipDeviceGetAttribute(&cus, hipDeviceAttributeMultiprocessorCount, dev) != hipSuccess) { grid = -1; return; }
        if (hipFuncSetAttribute((const void*)fwd_kernel, hipFuncAttributeMaxDynamicSharedMemorySize, LDS_BYTES) != hipSuccess) { fprintf(stderr, "kernel_launch: hipFuncSetAttribute failed\n"); grid = -1; return; }
        if (hipOccupancyMaxActiveBlocksPerMultiprocessor(&per_cu, (const void*)fwd_kernel, 512, LDS_BYTES) != hipSuccess || per_cu < 1) fprintf(stderr, "kernel_launch: occupancy query reports %d\n", per_cu);
        (void)hipGetLastError();
        grid = cus;
    }
    if (grid < 0) return;
    if (hipMemsetAsync((char*)d_ws + WS_CTL, 0, CTL_ZERO_BYTES, stream) != hipSuccess) return;
    Args a{};
    const float** fp = (const float**)&a;
    for (int i = 0; i < 30; ++i) fp[i] = (const float*)d_in[i];
    a.out = (float*)d_out; a.ws = (unsigned char*)d_ws;
#if MK_MULTI
    for (int p = 0; p < NPHASE; ++p) { a.ph_lo = p; a.ph_hi = p + 1; hipLaunchKernelGGL(fwd_kernel, dim3(grid), dim3(512), LDS_BYTES, stream, a); }
#else
    a.ph_lo = 0; a.ph_hi = NPHASE; hipLaunchKernelGGL(fwd_kernel, dim3(grid), dim3(512), LDS_BYTES, stream, a);
#endif
}
```

```cpp
#include <hip/hip_runtime.h>
#include <cstdio>
#include <cstdint>

#ifndef FP8MASK
#define FP8MASK 14
#endif
#define FP8_OF(l) (((FP8MASK) >> (l)) & 1)
#define FP8_MOE(l)   ((FP8_OF(1) && FP8_OF(3)) || ((FP8_OF(1) || FP8_OF(3)) && FP8_OF(l)))
#define FP8_DENSE(l) ((FP8_OF(0) && FP8_OF(2)) || ((FP8_OF(0) || FP8_OF(2)) && FP8_OF(l)))
#ifndef STAGGER_TICKS
#define STAGGER_TICKS 0
#endif
#ifndef DEFER_L3
#define DEFER_L3 1
#endif
#ifndef FP8_WO
#define FP8_WO 1
#endif
#ifndef FP8_QKV
#define FP8_QKV 1
#endif
#ifndef DUPMASK
#define DUPMASK 0
#endif
#ifndef DUP_SCANPAIR
#define DUP_SCANPAIR 0
#endif
#ifndef PHSEL
#define PHSEL 0xFFFFFFFFu
#endif
#ifndef MK_MULTI
#define MK_MULTI 0
#endif

#define LAS __attribute__((address_space(3)))
#define GAS __attribute__((address_space(1)))
typedef unsigned short bf16_t;
typedef short bf16x8 __attribute__((ext_vector_type(8)));
typedef short s16x4 __attribute__((ext_vector_type(4)));
typedef float f32x2 __attribute__((ext_vector_type(2)));
typedef float f32x4 __attribute__((ext_vector_type(4)));
typedef float f32x16 __attribute__((ext_vector_type(16)));
typedef unsigned u32x2 __attribute__((ext_vector_type(2)));
typedef unsigned u32x4 __attribute__((ext_vector_type(4)));
typedef __bf16 bf16x2_t __attribute__((ext_vector_type(2)));
typedef int i32x4 __attribute__((ext_vector_type(4)));
typedef int i32x8 __attribute__((ext_vector_type(8)));
constexpr float SC8_H = 4.0f, SC8_W = 64.0f, SC8_HID = 8.0f, SC8_O = 64.0f;

constexpr int DM = 1024, BATCH = 16, SEQ = 4096, NTOK = BATCH * SEQ;
constexpr int DFF = 3072, NEXP = 8, DFE = 3584;
constexpr int NSLOT = 135168;
constexpr int MAXTILES = NSLOT / 256;
constexpr float EPS = 1e-6f;
constexpr float LOG2E = 1.4426950408889634f;

constexpr size_t MiB = 1u << 20;
constexpr size_t WS_CTL = 0, CTL_ZERO_BYTES = 1 * MiB;
constexpr size_t WS_MODV = 1 * MiB;
constexpr size_t WS_KVMOD = 3 * MiB;
constexpr size_t WS_PAR = 3 * MiB + 512 * 1024;
constexpr int PAR_MIXN = 0, PAR_FFNN = 4096, PAR_CONVW = 8192, PAR_CONVB = 16384, PAR_GXB = 18432, PAR_GAB = 20480, PAR_LAM = 22528, PAR_KVN = 24576, PAR_KN = 25600, PAR_QN = 25664, PAR_SINK = 25792, PAR_ROUTER = 25856, PAR_END = 42240;
constexpr size_t WS_E12 = 4 * MiB;
constexpr size_t WS_W1 = 5 * MiB;
constexpr size_t WS_CNT = 6 * MiB;
constexpr size_t WS_TILE = 6 * MiB + 65536;
constexpr size_t WS_TOS = 7 * MiB;
constexpr size_t WS_WOS = 8 * MiB;
constexpr size_t WS_GW = 9 * MiB;
constexpr size_t WS_COS = 10 * MiB;
constexpr size_t WS_SIN = 18 * MiB;
constexpr size_t WS_WIN = 26 * MiB;
constexpr size_t WS_WOUT = 34 * MiB;
constexpr size_t WS_WKV = 38 * MiB;
constexpr size_t WS_WQ = 39 * MiB;
constexpr size_t WS_WO = 43 * MiB;
constexpr size_t WS_FGU = 47 * MiB;
constexpr size_t WS_FDN = 71 * MiB;
constexpr size_t WS_MGU = 83 * MiB;
constexpr size_t WS_MDN = 307 * MiB;
constexpr size_t WS_H = 419 * MiB;
constexpr size_t WS_HKV = 547 * MiB;
constexpr size_t WS_KB = 675 * MiB;
constexpr size_t WS_VB = 707 * MiB;
constexpr size_t WS_ARENA = 739 * MiB;
constexpr size_t WS_XS = WS_ARENA + (size_t)NSLOT * DFE * 2;
constexpr size_t WS_END = WS_XS + (size_t)NTOK * DM * 2;
static_assert(WS_END <= (size_t)1792 * MiB, "workspace map");
constexpr size_t AR_XB = 0, AR_GY = 128 * MiB, AR_Q = 0, AR_O = 128 * MiB;

constexpr int CW_BAR = 4096;

constexpr int LDS_BYTES = 163840;
constexpr int RING_BYTES = 131072;
constexpr int LDS_TEXP = RING_BYTES;
constexpr int LDS_IDX = RING_BYTES + 4096;
constexpr int LDS_MISC = LDS_BYTES - 256;

__device__ __forceinline__ unsigned cvtpk(float lo, float hi) { f32x2 v = {lo, hi}; bf16x2_t b = __builtin_convertvector(v, bf16x2_t); return __builtin_bit_cast(unsigned, b); }
__device__ __forceinline__ float clamp8(float v) { return __builtin_amdgcn_fmed3f(v, -448.0f, 448.0f); }
__device__ __forceinline__ unsigned cvt4_fp8(float a, float b, float c, float d) { int p = __builtin_amdgcn_cvt_pk_fp8_f32(clamp8(a), clamp8(b), 0, false); p = __builtin_amdgcn_cvt_pk_fp8_f32(clamp8(c), clamp8(d), p, true); return (unsigned)p; }
__device__ __forceinline__ float bflo(unsigned p) { return __uint_as_float(p << 16); }
__device__ __forceinline__ float bfhi(unsigned p) { return __uint_as_float(p & 0xffff0000u); }
__device__ __forceinline__ float bf2f(unsigned short b) { return __uint_as_float(((unsigned)b) << 16); }
__device__ __forceinline__ float fast_exp2(float x) { return __builtin_amdgcn_exp2f(x); }
__device__ __forceinline__ float fast_rcp(float x) { return __builtin_amdgcn_rcpf(x); }
__device__ __forceinline__ float sigmoidf_(float x) { return fast_rcp(1.0f + fast_exp2(-x * LOG2E)); }
__device__ __forceinline__ float silu_(float x) { return x * sigmoidf_(x); }
__device__ __forceinline__ float gelu_tanh_(float x) { const float u = 0.7978845608028654f * (x + 0.044715f * x * x * x); return x * sigmoidf_(2.0f * u); }
__device__ __forceinline__ float shflx(float v, int lane, int o) { return __int_as_float(__builtin_amdgcn_ds_bpermute((lane ^ o) << 2, __float_as_int(v))); }
__device__ __forceinline__ float wave_sum(float v, int lane) {
#pragma unroll
    for (int o = 1; o < 64; o <<= 1) v += shflx(v, lane, o);
    return v;
}
template <int CTRL, int RM = 0xf, int BM = 0xf> __device__ __forceinline__ float dppf(float v) { return __int_as_float(__builtin_amdgcn_update_dpp(0, __float_as_int(v), CTRL, RM, BM, false)); }
__device__ __forceinline__ float wave_sum_dpp(float v) {
    float s = v + dppf<0x111>(v); s += dppf<0x112>(v); s += dppf<0x113>(v);
    s += dppf<0x114>(s); s += dppf<0x118>(s);
    s += dppf<0x142, 0xa>(s); s += dppf<0x143, 0xc>(s);
    return __int_as_float(__builtin_amdgcn_readlane(__float_as_int(s), 63));
}
__device__ __forceinline__ int lane_id_v() { int l; asm volatile("v_mbcnt_lo_u32_b32 %0, -1, 0\n\tv_mbcnt_hi_u32_b32 %0, -1, %0" : "=v"(l)); return l; }
#define LDS_WAIT() asm volatile("s_waitcnt lgkmcnt(0)" ::: "memory")
#define VM_WAIT() asm volatile("s_waitcnt vmcnt(0)" ::: "memory")

namespace pg8 {
constexpr int BM = 256, BK = 64, HALF = 128, HTB = HALF * BK * 2, STAGE_BYTES = 8 * HTB, NXCD = 8, WGM = 8;
__host__ __device__ __forceinline__ int lds_byte(int r, int c) { const int st = (r >> 4) * 2 + (c >> 5), rr = r & 15, cc = c & 31, ob = rr * 64 + cc * 2; return st * 1024 + (ob ^ (((ob >> 9) & 1) << 5)); }
__host__ __device__ __forceinline__ void stage_rc(int b, int& R, int& C) { const int st = b / 1024, sb = b % 1024, swz = sb ^ (((sb >> 9) & 1) << 5); R = (st >> 1) * 16 + swz / 64; C = (st & 1) * 32 + (swz % 64) / 2; }
__host__ __device__ __forceinline__ int perm32(int rho) { const int n = rho >> 4, i = rho & 15; return 8 * (i >> 2) + 4 * n + (i & 3); }

struct Unit { int pm, pn; };

struct Order {
    int nM, nN, nwg, G, c, tile0, delay, nig; unsigned mg;
    __device__ __forceinline__ void init(int nM_, int nN_, int G_, int c_, int tile0_, int delay_ = 0) { nM = nM_; nN = nN_; nwg = nM * nN; G = G_; c = c_; tile0 = tile0_; delay = ((c_ >> 3) & 1) ? delay_ : 0;
        nig = WGM * nN; mg = (unsigned)((0x100000000ull + (unsigned)nig - 1ull) / (unsigned)nig); }
    __device__ __forceinline__ bool next(int i, Unit& u) const {
        const int L = i * G + c; if (L >= nwg) return false;
        int wgid; { const int q = nwg >> 3, r = nwg & 7, xcd = L & 7, off = L >> 3; wgid = (xcd < r ? xcd * (q + 1) : r * (q + 1) + (xcd - r) * q) + off; }
        const int gid = (int)__umulhi((unsigned)wgid, mg), rem = wgid - gid * nig, fm = gid * WGM, gsz = (nM - fm) < WGM ? (nM - fm) : WGM;
        if (gsz == WGM) { u.pm = tile0 + fm + (rem & (WGM - 1)); u.pn = rem >> 3; }
        else { u.pm = tile0 + fm + rem % gsz; u.pn = rem / gsz; }
        return true;
    }
};

struct ProbDense {
    const void* A; const void* Bt; int KB;
    __device__ __forceinline__ const char* a_ptr(const Unit& u) const { return (const char*)A + (size_t)u.pm * BM * KB; }
    __device__ __forceinline__ const char* b_ptr(const Unit& u) const { return (const char*)Bt + (size_t)u.pn * BM * KB; }
};
struct ProbGrouped {
    const void* A; const void* Bt; int KB; int N; const LAS int* texp; const int* tos;
    __device__ __forceinline__ const char* a_ptr(const Unit& u) const { return (const char*)A + (size_t)u.pm * BM * KB; }
    __device__ __forceinline__ const char* b_ptr(const Unit& u) const { return (const char*)Bt + ((size_t)texp[u.pm] * N + (size_t)u.pn * BM) * KB; }
};

template <class Epi, class Prob, bool GATHER, bool FP8 = false>
__device__ __forceinline__ void gemm_phase(LAS unsigned char* lds, const int tid, const Prob P, const Order& S, const Epi& E) {
    const int wid = __builtin_amdgcn_readfirstlane(tid >> 6), lane = tid & 63, wr = wid >> 2, wc = wid & 3, fr = lane & 15, fq = lane >> 4;
    const int KB = P.KB, nt = KB / (BK * 2);
    unsigned voffA[2], voffB[2];
#pragma unroll
    for (int i = 0; i < 2; ++i) { int R, C; stage_rc(tid * 16 + i * 8192, R, C); const int Rb = Epi::PERM ? ((R & ~31) + perm32(R & 31)) : R;
        voffA[i] = GATHER ? (unsigned)(C * 2) : (unsigned)(R * KB + C * 2); voffB[i] = (unsigned)(Rb * KB + C * 2); }
    const size_t kstep = (size_t)(BK * 2);
    const size_t hstep = (size_t)HALF * KB;
    const unsigned ldsw = (unsigned)wid * 1024u;
    const int aoff = lds_byte(wr * 64 + fr, fq * 8), boff = lds_byte(wc * 32 + fr, fq * 8);
    LAS int* idxb = (LAS int*)(lds + LDS_IDX);
#define PG8_GIDX(buf) do { int ln_ = lane; asm volatile("" : "+v"(ln_)); _Pragma("unroll") for (int i = 0; i < 2; ++i) { const int R_ = 16 * ((wid + 8 * i) >> 1) + (ln_ >> 2); \
        int t0 = idxb[(buf) * 256 + R_], t1 = idxb[(buf) * 256 + 128 + R_]; t0 = t0 < 0 ? 0 : t0; t1 = t1 < 0 ? 0 : t1; \
        vC0[i] = (unsigned)t0 * (unsigned)KB + voffA[i]; vC1[i] = (unsigned)t1 * (unsigned)KB + voffA[i]; } } while (0)
#define PG8_GDMA(unit, buf) do { if (wid < 4) { int ln_ = lane; asm volatile("" : "+v"(ln_)); \
        __builtin_amdgcn_global_load_lds((const unsigned*)(P.tos + (size_t)(unit).pm * BM + wid * 64) + ln_, (LAS unsigned*)(idxb + (buf) * 256 + wid * 64), 4, 0, 0); } } while (0)
#define PG8_SA(b, h) (((b) * 2 + (h)) * HTB)
#define PG8_SB(b, h) ((4 + (b) * 2 + (h)) * HTB)
#define PG8_STAGE(bufoff, gbase, voff) do { const char* g_ = (const char*)(gbase); asm volatile("" : "+s"(g_)); _Pragma("unroll") for (int _i = 0; _i < 2; ++_i) \
        __builtin_amdgcn_global_load_lds((const unsigned*)(g_ + (voff)[_i]), (LAS unsigned*)(lds + (bufoff) + ldsw + _i * 8192), 16, 0, 0); } while (0)
#define PG8_LDA(dst, b, h) do { _Pragma("unroll") for (int m = 0; m < 4; ++m) _Pragma("unroll") for (int k = 0; k < 2; ++k) dst[m][k] = *(const LAS bf16x8*)(lds + PG8_SA(b, h) + aoff + m * 2048 + k * 1024); } while (0)
#define PG8_LDB(dst, b, h) do { _Pragma("unroll") for (int n = 0; n < 2; ++n) _Pragma("unroll") for (int k = 0; k < 2; ++k) dst[n][k] = *(const LAS bf16x8*)(lds + PG8_SB(b, h) + boff + n * 2048 + k * 1024); } while (0)
#define PG8_CAT8(v) __builtin_shufflevector(__builtin_bit_cast(i32x4, (v)[0]), __builtin_bit_cast(i32x4, (v)[1]), 0, 1, 2, 3, 4, 5, 6, 7)
#define PG8_MMA(ai, bj, At, Bt) do { __builtin_amdgcn_s_setprio(1); if constexpr (FP8) asm volatile("s_nop 1"); _Pragma("unroll") for (int m = 0; m < 4; ++m) _Pragma("unroll") for (int n = 0; n < 2; ++n) { \
        if constexpr (FP8) { const i32x8 b8_ = PG8_CAT8(Bt[n]), a8_ = PG8_CAT8(At[m]);   \
            asm volatile("v_mfma_f32_16x16x128_f8f6f4 %0, %1, %2, %0" : "+v"(acc[ai][bj][m][n]) : "v"(b8_), "v"(a8_)); }     \
        else { _Pragma("unroll") for (int k = 0; k < 2; ++k) acc[ai][bj][m][n] = __builtin_amdgcn_mfma_f32_16x16x32_bf16(Bt[n][k], At[m][k], acc[ai][bj][m][n], 0, 0, 0); } } __builtin_amdgcn_s_setprio(0); } while (0)
#define PG8_WAIT_V(n) asm volatile("s_waitcnt vmcnt(" #n ")" ::: "memory")
#define PG8_WAIT_L(n) asm volatile("s_waitcnt lgkmcnt(" #n ")" ::: "memory")
#define PG8_BAR __builtin_amdgcn_s_barrier()
#define PG8_SCHED __builtin_amdgcn_sched_barrier(0)
    Unit cur, nxt; int ui = 0;
    if (!S.next(0, cur)) return;
    if (S.delay) { const unsigned long long t0_ = __builtin_amdgcn_s_memrealtime(); while (__builtin_amdgcn_s_memrealtime() - t0_ < (unsigned long long)S.delay) __builtin_amdgcn_s_sleep(8); }
    f32x4 acc[2][2][4][2];
#pragma unroll
    for (int a = 0; a < 2; ++a)
#pragma unroll
        for (int b = 0; b < 2; ++b)
#pragma unroll
            for (int m = 0; m < 4; ++m)
#pragma unroll
                for (int n = 0; n < 2; ++n) acc[a][b][m][n] = (f32x4){0.f, 0.f, 0.f, 0.f};
    bf16x8 At[4][2], B0[2][2], B1[2][2];
    unsigned vC0[2], vC1[2];
    const char* cA; const char* cB = P.b_ptr(cur);
    if constexpr (GATHER) {
        cA = (const char*)P.A;
        PG8_GDMA(cur, 0);
        PG8_WAIT_V(0); PG8_BAR;
        PG8_GIDX(0);
        LDS_WAIT(); PG8_BAR;
    } else {
        cA = P.a_ptr(cur);
#pragma unroll
        for (int i = 0; i < 2; ++i) { vC0[i] = voffA[i]; vC1[i] = voffA[i] + (unsigned)hstep; }
    }
    PG8_STAGE(PG8_SB(0, 0), cB, voffB); PG8_STAGE(PG8_SB(0, 1), cB + hstep, voffB); PG8_STAGE(PG8_SA(0, 0), cA, vC0); PG8_STAGE(PG8_SA(0, 1), cA, vC1);
    if (wr == 1) PG8_BAR;
    PG8_WAIT_V(2); PG8_BAR;
    PG8_STAGE(PG8_SB(1, 0), cB + kstep, voffB); PG8_STAGE(PG8_SA(1, 0), cA + kstep, vC0); PG8_STAGE(PG8_SB(1, 1), cB + hstep + kstep, voffB);
    PG8_WAIT_V(6); PG8_BAR;
    for (;;) {
        const bool has_next = S.next(ui + 1, nxt);
        const char* nA = GATHER ? cA : (has_next ? P.a_ptr(nxt) : cA); const char* nB = has_next ? P.b_ptr(nxt) : cB;
        for (int t = 0; t < nt; t += 2) {
            const bool last = (t == nt - 2);
            if constexpr (GATHER) {
                if (t == 0 && has_next) PG8_GDMA(nxt, (ui + 1) & 1);
            }
            const char* a1 = cA + (size_t)(t + 1) * kstep;
            const char* a2 = last ? nA : cA + (size_t)(t + 2) * kstep; const char* b2 = last ? nB : cB + (size_t)(t + 2) * kstep;
            const char* a3 = a2 + kstep; const char* b3 = b2 + kstep;
            PG8_LDB(B0, 0, 0); PG8_LDB(B1, 0, 1); PG8_SCHED; PG8_LDA(At, 0, 0); PG8_STAGE(PG8_SA(1, 1), a1, vC1);
            if constexpr (GATHER) { if (last && has_next) PG8_GIDX((ui + 1) & 1); }
            PG8_WAIT_V(8); PG8_WAIT_L(0); PG8_BAR; PG8_MMA(0, 0, At, B0); PG8_MMA(0, 1, At, B1); PG8_BAR; PG8_SCHED;
            PG8_LDA(At, 0, 1); PG8_STAGE(PG8_SB(0, 0), b2, voffB); PG8_STAGE(PG8_SB(0, 1), b2 + hstep, voffB); PG8_STAGE(PG8_SA(0, 0), a2, vC0);
            PG8_WAIT_V(8); PG8_WAIT_L(0); PG8_BAR; PG8_MMA(1, 0, At, B0); PG8_MMA(1, 1, At, B1); PG8_BAR; PG8_SCHED;
            PG8_LDB(B0, 1, 0); PG8_LDB(B1, 1, 1); PG8_SCHED; PG8_LDA(At, 1, 0); PG8_STAGE(PG8_SA(0, 1), a2, vC1);
            PG8_WAIT_V(8); PG8_WAIT_L(0); PG8_BAR; PG8_MMA(0, 0, At, B0); PG8_MMA(0, 1, At, B1); PG8_BAR; PG8_SCHED;
            PG8_LDA(At, 1, 1); PG8_STAGE(PG8_SB(1, 0), b3, voffB); PG8_STAGE(PG8_SB(1, 1), b3 + hstep, voffB); PG8_STAGE(PG8_SA(1, 0), a3, vC0);
            PG8_WAIT_V(8); PG8_WAIT_L(0); PG8_BAR; PG8_MMA(1, 0, At, B0); PG8_MMA(1, 1, At, B1); PG8_BAR; PG8_SCHED;
        }
        if constexpr (FP8) { asm volatile("s_nop 15\n\ts_nop 15" ::: "memory"); PG8_SCHED; }
        if (wr == 0) PG8_BAR;
        { const int ln_ = lane_id_v(); int fr_ = ln_ & 15, fq_ = ln_ >> 4; asm volatile("" : "+v"(fr_), "+v"(fq_)); E(acc, cur, wr, wc, fr_, fq_); }
        if (!has_next) break;
#pragma unroll
        for (int a = 0; a < 2; ++a)
#pragma unroll
            for (int b = 0; b < 2; ++b)
#pragma unroll
                for (int m = 0; m < 4; ++m)
#pragma unroll
                    for (int n = 0; n < 2; ++n) acc[a][b][m][n] = (f32x4){0.f, 0.f, 0.f, 0.f};
        cur = nxt; cA = nA; cB = nB; ++ui;
        if (wr == 1) PG8_BAR;
    }
    PG8_WAIT_V(0);
    PG8_BAR;
#undef PG8_SA
#undef PG8_GIDX
#undef PG8_GDMA
#undef PG8_SB
#undef PG8_STAGE
#undef PG8_LDA
#undef PG8_LDB
#undef PG8_MMA
#undef PG8_CAT8
#undef PG8_WAIT_V
#undef PG8_WAIT_L
#undef PG8_BAR
#undef PG8_SCHED
}

template <bool INF32> struct EpiResid {
    static constexpr bool PERM = true;
    const void* xin; bf16_t* xout; const float* gate; float ascale;
    __device__ __forceinline__ void operator()(const f32x4 (&acc)[2][2][4][2], const Unit& u, int wr, int wc, int fr, int fq) const {
        const int row0 = u.pm * BM + wr * 64 + fr, col0 = u.pn * BM + wc * 32 + 8 * fq;
        const float* gp = gate + (size_t)((u.pm * BM) >> 12) * 6144 + col0;
        f32x4 gv[2][2];
#pragma unroll
        for (int bj = 0; bj < 2; ++bj)
#pragma unroll
            for (int n = 0; n < 2; ++n) gv[bj][n] = (*(const f32x4*)(gp + bj * HALF + 4 * n) + 1.0f) * ascale;
#pragma unroll
        for (int ai = 0; ai < 2; ++ai) {
            f32x4 xv[4][2][2];
#pragma unroll
            for (int m = 0; m < 4; ++m) { const size_t off = (size_t)(row0 + ai * HALF + m * 16) * DM + col0;
#pragma unroll
                for (int bj = 0; bj < 2; ++bj) {
                    if constexpr (INF32) { xv[m][bj][0] = *(const f32x4*)((const float*)xin + off + bj * HALF); xv[m][bj][1] = *(const f32x4*)((const float*)xin + off + bj * HALF + 4); }
                    else { const u32x4 p = *(const u32x4*)((const bf16_t*)xin + off + bj * HALF);
                        xv[m][bj][0] = (f32x4){bflo(p.x), bfhi(p.x), bflo(p.y), bfhi(p.y)}; xv[m][bj][1] = (f32x4){bflo(p.z), bfhi(p.z), bflo(p.w), bfhi(p.w)}; } } }
#pragma unroll
            for (int m = 0; m < 4; ++m) { const size_t off = (size_t)(row0 + ai * HALF + m * 16) * DM + col0;
#pragma unroll
                for (int bj = 0; bj < 2; ++bj) { const f32x4 o0 = xv[m][bj][0] + gv[bj][0] * acc[ai][bj][m][0], o1 = xv[m][bj][1] + gv[bj][1] * acc[ai][bj][m][1];
                    u32x4 w; w.x = cvtpk(o0[0], o0[1]); w.y = cvtpk(o0[2], o0[3]); w.z = cvtpk(o1[0], o1[1]); w.w = cvtpk(o1[2], o1[3]);
                    *(u32x4*)(xout + off + bj * HALF) = w; } }
            asm volatile("" ::: "memory"); }
    }
};
template <bool OUTF32> struct EpiMoeDown {
    static constexpr bool PERM = true;
    const bf16_t* xs; void* xo; const float* gate; const int* tos; const float* wos; float ascale;
    __device__ __forceinline__ void operator()(const f32x4 (&acc)[2][2][4][2], const Unit& u, int wr, int wc, int fr, int fq) const {
        const int slot0 = u.pm * BM + wr * 64 + fr, col0 = u.pn * BM + wc * 32 + 8 * fq;
        int tok[2][4]; float w[2][4];
#pragma unroll
        for (int ai = 0; ai < 2; ++ai)
#pragma unroll
            for (int m = 0; m < 4; ++m) { const int slot = slot0 + ai * HALF + m * 16; tok[ai][m] = tos[slot]; w[ai][m] = wos[slot] * ascale; }
#pragma unroll
        for (int ai = 0; ai < 2; ++ai) {
            u32x4 xv[4][2];
#pragma unroll
            for (int m = 0; m < 4; ++m) { const int t = tok[ai][m] < 0 ? 0 : tok[ai][m]; const bf16_t* xp = xs + (size_t)t * DM + col0;
#pragma unroll
                for (int bj = 0; bj < 2; ++bj) xv[m][bj] = *(const u32x4*)(xp + bj * HALF); }
#pragma unroll
            for (int m = 0; m < 4; ++m) { const int t = tok[ai][m];
                if (t >= 0) { const float* gp = gate + (size_t)(t >> 12) * 6144 + col0; const size_t off = (size_t)t * DM + col0;
#pragma unroll
                    for (int bj = 0; bj < 2; ++bj) { const u32x4 p = xv[m][bj];
                        const f32x4 g0 = (*(const f32x4*)(gp + bj * HALF) + 1.0f) * w[ai][m], g1 = (*(const f32x4*)(gp + bj * HALF + 4) + 1.0f) * w[ai][m];
                        const f32x4 o0 = (f32x4){bflo(p.x), bfhi(p.x), bflo(p.y), bfhi(p.y)} + g0 * acc[ai][bj][m][0], o1 = (f32x4){bflo(p.z), bfhi(p.z), bflo(p.w), bfhi(p.w)} + g1 * acc[ai][bj][m][1];
                        if constexpr (OUTF32) { *(f32x4*)((float*)xo + off + bj * HALF) = o0; *(f32x4*)((float*)xo + off + bj * HALF + 4) = o1; }
                        else { u32x4 q; q.x = cvtpk(o0[0], o0[1]); q.y = cvtpk(o0[2], o0[3]); q.z = cvtpk(o1[0], o1[1]); q.w = cvtpk(o1[2], o1[3]); *(u32x4*)((bf16_t*)xo + off + bj * HALF) = q; } } } }
            asm volatile("" ::: "memory"); }
    }
};
template <bool OUT8> struct EpiSwiglu {
    static constexpr bool PERM = true;
    void* O; int ldo; float ascale;
    __device__ __forceinline__ void operator()(const f32x4 (&acc)[2][2][4][2], const Unit& u, int wr, int wc, int fr, int fq) const {
        const int row0 = u.pm * BM + wr * 64 + fr, col0 = u.pn * HALF + wc * 32 + 8 * fq;
        const float nl2 = -ascale * LOG2E, ios = 1.0f / (ascale * ascale * (OUT8 ? SC8_HID : 1.0f));
        const f32x2 nl2v = {nl2, nl2}, iosv = {ios, ios};
#pragma unroll
        for (int ai = 0; ai < 2; ++ai)
#pragma unroll
            for (int m = 0; m < 4; ++m) { const size_t eo = (size_t)(row0 + ai * HALF + m * 16) * ldo + col0;
                float v[8];
#pragma unroll
                for (int n = 0; n < 2; ++n)
#pragma unroll
                    for (int h = 0; h < 2; ++h) {
                        const f32x2 g = {acc[ai][0][m][n][2 * h], acc[ai][0][m][n][2 * h + 1]}, up = {acc[ai][1][m][n][2 * h], acc[ai][1][m][n][2 * h + 1]};
                        const f32x2 t = g * nl2v; const f32x2 e = {fast_exp2(t.x), fast_exp2(t.y)};
                        const f32x2 d = e * iosv + iosv; const f32x2 r = {fast_rcp(d.x), fast_rcp(d.y)};
                        const f32x2 o = (g * up) * r; v[4 * n + 2 * h] = o.x; v[4 * n + 2 * h + 1] = o.y; }
                if constexpr (OUT8) { u32x2 w; w.x = cvt4_fp8(v[0], v[1], v[2], v[3]); w.y = cvt4_fp8(v[4], v[5], v[6], v[7]);
                    *(u32x2*)((unsigned char*)O + eo) = w; }
                else { u32x4 w; w.x = cvtpk(v[0], v[1]); w.y = cvtpk(v[2], v[3]); w.z = cvtpk(v[4], v[5]); w.w = cvtpk(v[6], v[7]);
                    *(u32x4*)((bf16_t*)O + eo) = w; } }
    }
};
struct EpiWin {
    static constexpr bool PERM = true;
    bf16_t* XB; bf16_t* GY;
    __device__ __forceinline__ void operator()(const f32x4 (&acc)[2][2][4][2], const Unit& u, int wr, int wc, int fr, int fq) const {
        const bool act = u.pn >= 4; bf16_t* base = act ? GY : XB;
        const int row0 = u.pm * BM + wr * 64 + fr, col0 = (u.pn & 3) * BM + wc * 32 + 8 * fq;
#pragma unroll
        for (int ai = 0; ai < 2; ++ai)
#pragma unroll
            for (int m = 0; m < 4; ++m) { bf16_t* rowp = base + (size_t)(row0 + ai * HALF + m * 16) * DM + col0;
#pragma unroll
                for (int bj = 0; bj < 2; ++bj) { f32x4 v0 = acc[ai][bj][m][0], v1 = acc[ai][bj][m][1];
                    if (act) {
#pragma unroll
                        for (int j = 0; j < 4; ++j) { v0[j] = gelu_tanh_(v0[j]); v1[j] = gelu_tanh_(v1[j]); } }
                    u32x4 w; w.x = cvtpk(v0[0], v0[1]); w.y = cvtpk(v0[2], v0[3]); w.z = cvtpk(v1[0], v1[1]); w.w = cvtpk(v1[2], v1[3]);
                    *(u32x4*)(rowp + bj * HALF) = w; } }
    }
};
struct EpiQK {
    static constexpr bool PERM = true;
    bf16_t* O; int ldo; const float* gain; const float* cosT; const float* sinT; float oscale; int vtile; bf16_t* OV; float as;
    __device__ __forceinline__ void operator()(const f32x4 (&acc)[2][2][4][2], const Unit& u, int wr, int wc, int fr, int fq) const {
        const int row0 = u.pm * BM + wr * 64 + fr;
        if (u.pn == vtile) {
            const int col0 = wc * 32 + 8 * fq;
#pragma unroll
            for (int ai = 0; ai < 2; ++ai)
#pragma unroll
                for (int m = 0; m < 4; ++m) { bf16_t* rowp = OV + (size_t)(row0 + ai * HALF + m * 16) * ldo + col0;
#pragma unroll
                    for (int bj = 0; bj < 2; ++bj) { const f32x4 v0 = acc[ai][bj][m][0] * as, v1 = acc[ai][bj][m][1] * as;
                        u32x4 w; w.x = cvtpk(v0[0], v0[1]); w.y = cvtpk(v0[2], v0[3]); w.z = cvtpk(v1[0], v1[1]); w.w = cvtpk(v1[2], v1[3]);
                        *(u32x4*)(rowp + bj * HALF) = w; } }
            return;
        }
        const int colh = (u.pn * 4 + wc) * 64 + 8 * fq;
        f32x4 g1[2], g2[2];
#pragma unroll
        for (int n = 0; n < 2; ++n) { g1[n] = *(const f32x4*)(gain + 8 * fq + 4 * n); g2[n] = *(const f32x4*)(gain + 32 + 8 * fq + 4 * n); }
#pragma unroll
        for (int aim = 0; aim < 4; ++aim) { const int ai = aim >> 1;
            f32x4 cv[4][2], sv[4][2];
#pragma unroll
            for (int m = 2 * (aim & 1); m < 2 * (aim & 1) + 2; ++m) { const int row = row0 + ai * HALF + m * 16;
#pragma unroll
                for (int n = 0; n < 2; ++n) { cv[m][n] = *(const f32x4*)(cosT + (size_t)row * 32 + 8 * fq + 4 * n); sv[m][n] = *(const f32x4*)(sinT + (size_t)row * 32 + 8 * fq + 4 * n); } }
#pragma unroll
            for (int m = 2 * (aim & 1); m < 2 * (aim & 1) + 2; ++m) { const int row = row0 + ai * HALF + m * 16;
                float ss = 0.f;
#pragma unroll
                for (int bj = 0; bj < 2; ++bj)
#pragma unroll
                    for (int n = 0; n < 2; ++n) { const f32x4 a = acc[ai][bj][m][n]; ss += (a[0] * a[0] + a[1] * a[1]) + (a[2] * a[2] + a[3] * a[3]); }
                { const int ln_ = fq * 16 + fr; ss += shflx(ss, ln_, 16); ss += shflx(ss, ln_, 32); }
                const float r = __builtin_amdgcn_rsqf(ss * (as * as * (1.0f / 64.0f)) + EPS) * (oscale * as);
                float o1[8], o2[8];
#pragma unroll
                for (int n = 0; n < 2; ++n) { const f32x4 c = cv[m][n], s = sv[m][n];
                    const f32x4 x1 = acc[ai][0][m][n] * g1[n] * r, x2 = acc[ai][1][m][n] * g2[n] * r;
                    const f32x4 a = x1 * c - x2 * s, b = x2 * c + x1 * s;
#pragma unroll
                    for (int j = 0; j < 4; ++j) { o1[4 * n + j] = a[j]; o2[4 * n + j] = b[j]; } }
                bf16_t* rowp = O + (size_t)row * ldo + colh;
                u32x4 w; w.x = cvtpk(o1[0], o1[1]); w.y = cvtpk(o1[2], o1[3]); w.z = cvtpk(o1[4], o1[5]); w.w = cvtpk(o1[6], o1[7]);
                *(u32x4*)rowp = w;
                w.x = cvtpk(o2[0], o2[1]); w.y = cvtpk(o2[2], o2[3]); w.z = cvtpk(o2[4], o2[5]); w.w = cvtpk(o2[6], o2[7]);
                *(u32x4*)(rowp + 32) = w; }
            asm volatile("" ::: "memory"); }
    }
};
}

#define XB_TMO      128
#define XB_XCNT(j)  (256  + 64 * (j))
#define XB_XSUB(j)  (1280 + 64 * (j))
#define XB_XGEN(j)  (2304 + 64 * (j))
#define XB_TOP      3328
#define XB_TOPGEN   3392
#define XCD_BAR_WORDS 3456
#define XB_SPIN_CAP (1u << 20)
__device__ __forceinline__ unsigned xb_ld(unsigned* p)              { return __hip_atomic_load(p, __ATOMIC_RELAXED, __HIP_MEMORY_SCOPE_AGENT); }
__device__ __forceinline__ unsigned xb_add(unsigned* p, unsigned v) { return __hip_atomic_fetch_add(p, v, __ATOMIC_RELAXED, __HIP_MEMORY_SCOPE_AGENT); }
__device__ __forceinline__ unsigned xb_xcc_id() { return (unsigned)__builtin_amdgcn_s_getreg((3 << 11) | 20) & 0xFu; }
#define XB_SPIN(cond, bar) do { unsigned _sp = 0; while (cond) { __builtin_amdgcn_s_sleep(1); \
    if ((++_sp & 255u) == 0u) { if (xb_ld(&(bar)[XB_TMO])) break; if (_sp > XB_SPIN_CAP) { atomicAdd(&(bar)[XB_TMO], 1u); break; } } } } while (0)
struct XcdBarrier { unsigned* bar; unsigned x; volatile LAS unsigned* st; };
__device__ __forceinline__ XcdBarrier xcd_barrier_post(unsigned* bar, volatile LAS unsigned* st, int wv) {
    XcdBarrier b; b.bar = bar; b.x = xb_xcc_id(); b.st = st;
    if (wv == 0 && lane_id_v() == 0) (void)xb_add(&bar[XB_XCNT(b.x)], 1u);
    return b;
}
__device__ __forceinline__ void xcd_barrier_complete(unsigned* bar, unsigned x, unsigned& nloc, unsigned& nx) {
    const unsigned G = gridDim.x * gridDim.y * gridDim.z;
    unsigned sum, cnt, mine, sp = 0u;
    for (;;) {
        sum = 0u; cnt = 0u; mine = 0u;
#pragma unroll
        for (unsigned j = 0; j < 16; ++j) { const unsigned c = xb_ld(&bar[XB_XCNT(j)]); sum += c; cnt += (c > 0u) ? 1u : 0u; }
        mine = xb_ld(&bar[XB_XCNT(x)]);
        if (sum == G) break;
        __builtin_amdgcn_s_sleep(1);
        if ((++sp & 255u) == 0u) { if (xb_ld(&bar[XB_TMO])) break; if (sp > XB_SPIN_CAP) { atomicAdd(&bar[XB_TMO], 1u); break; } }
    }
    nloc = mine > 0u ? mine : 1u; nx = cnt > 0u ? cnt : 1u;
}
__device__ __forceinline__ void xcd_barrier(const XcdBarrier& b, int wv) {
    asm volatile("s_waitcnt vmcnt(0)" ::: "memory");
    __syncthreads();
    if (wv == 0 && lane_id_v() == 0) {
        unsigned* bar = b.bar;
        __builtin_amdgcn_s_waitcnt(0);
        unsigned nloc = b.st[0], nx = b.st[1];
        if (nloc == 0u) { xcd_barrier_complete(bar, b.x, nloc, nx); b.st[0] = nloc; b.st[1] = nx; }
        const unsigned old = xb_add(&bar[XB_XSUB(b.x)], 1u);
        const unsigned gen = old / nloc;
        if (old + 1u == (gen + 1u) * nloc) {
            __builtin_amdgcn_fence(__ATOMIC_RELEASE, "agent");
            asm volatile("s_waitcnt vmcnt(0)" ::: "memory");
            const unsigned og = xb_add(&bar[XB_TOP], 1u);
            const unsigned tg = og / nx;
            if (og + 1u == (tg + 1u) * nx) xb_add(&bar[XB_TOPGEN], 1u);
            else XB_SPIN(xb_ld(&bar[XB_TOPGEN]) == tg, bar);
            __builtin_amdgcn_fence(__ATOMIC_ACQUIRE, "agent");
            xb_add(&bar[XB_XGEN(b.x)], 1u);
            asm volatile("s_waitcnt vmcnt(0)" ::: "memory");
        } else {
            XB_SPIN(xb_ld(&bar[XB_XGEN(b.x)]) == gen, bar);
            __builtin_amdgcn_fence(__ATOMIC_ACQUIRE, "agent");
            asm volatile("s_waitcnt vmcnt(0)" ::: "memory");
        }
    }
    __syncthreads();
}

struct Args {
    const float* x; const float* c; const int* pos; const float* ada_w; const float* ada_b; const float* mix_norm; const float* ffn_norm;
    const float* a_w_in; const float* a_conv_w; const float* a_conv_b; const float* a_gx_w; const float* a_gx_b; const float* a_ga_w; const float* a_ga_b;
    const float* a_lambda; const float* a_w_out; const float* kv_norm; const float* kv_ada_w; const float* kv_ada_b; const float* w_kv; const float* k_norm;
    const float* b_w_q; const float* b_q_norm; const float* b_sinks; const float* b_w_o; const float* f_w_gu; const float* f_w_down; const float* m_router;
    const float* m_w_gu; const float* m_w_down;
    float* out; unsigned char* ws; int ph_lo, ph_hi;
};

struct Ctx {
    LAS unsigned char* lds; int tid, lane, wave, vcu, G, cid;
};

struct TrItem { const float* src; unsigned char* dst; int N, K, d0, d1, f8; };
__device__ __forceinline__ void tr_load(const TrItem& t, f32x4 (&v)[16], int lane) {
    const int kr = lane >> 4, nq = lane & 15;
#pragma unroll
    for (int i = 0; i < 16; ++i) v[i] = *(const f32x4*)(t.src + (size_t)(4 * i + kr) * t.N + 4 * nq);
}
__device__ __forceinline__ void tr_to_lds(const f32x4 (&v)[16], LAS float* scr, int lane) {
    const int kr = lane >> 4, nq = lane & 15;
#pragma unroll
    for (int i = 0; i < 16; ++i) { const int k = 4 * i + kr; *(LAS f32x4*)(scr + k * 68 + ((4 * nq) ^ (4 * ((k >> 3) & 7)))) = v[i]; }
}
__device__ __forceinline__ void tr_finish(const TrItem& t, LAS float* scr, int lane) {
    const int c = lane & 7, r = lane >> 3;
    if (t.f8) {
#pragma unroll
        for (int j = 0; j < 8; ++j) { const int n = 8 * j + r; const LAS float* s = scr + (8 * c) * 68 + (n ^ (4 * c)); const int drow = ((n & 32) ? t.d1 : t.d0) + (n & 31);
            u32x2 o; o.x = cvt4_fp8(s[0 * 68] * SC8_W, s[1 * 68] * SC8_W, s[2 * 68] * SC8_W, s[3 * 68] * SC8_W); o.y = cvt4_fp8(s[4 * 68] * SC8_W, s[5 * 68] * SC8_W, s[6 * 68] * SC8_W, s[7 * 68] * SC8_W);
            *(u32x2*)(t.dst + (size_t)drow * t.K + 8 * c) = o; }
    } else {
#pragma unroll
        for (int j = 0; j < 8; ++j) { const int n = 8 * j + r; const LAS float* s = scr + (8 * c) * 68 + (n ^ (4 * c)); const int drow = ((n & 32) ? t.d1 : t.d0) + (n & 31);
            u32x4 o; o.x = cvtpk(s[0 * 68], s[1 * 68]); o.y = cvtpk(s[2 * 68], s[3 * 68]); o.z = cvtpk(s[4 * 68], s[5 * 68]); o.w = cvtpk(s[6 * 68], s[7 * 68]);
            *(u32x4*)(t.dst + ((size_t)drow * t.K + 8 * c) * 2) = o; }
    }
}
__device__ __forceinline__ int map_plain(int n) { return n; }
__device__ __forceinline__ int map_head(int n) { const int hd = n >> 6, d = n & 63; return 256 * (hd >> 2) + 128 * (d >> 5) + 32 * (hd & 3) + (d & 31); }
__device__ __forceinline__ int map_gu(int n, int F) { const int u = n >= F, j = u ? n - F : n; return 256 * (j >> 7) + 128 * u + (j & 127); }

__device__ __forceinline__ void p0_prologue(const Ctx& F, const Args& a) {
    unsigned char* ws = a.ws;
    {
        LAS float* cs = (LAS float*)F.lds;
        LAS float* red = (LAS float*)(F.lds + 65536);
        for (int i = F.tid; i < BATCH * DM; i += 512) { const int b = i >> 10, k = i & 1023; const float v = a.c[i]; cs[k * 16 + b] = silu_(v); }
        __syncthreads();
        float* modv = (float*)(ws + WS_MODV); float* kvmod = (float*)(ws + WS_KVMOD);
        constexpr int NC = 4 * 6144 + 2048, CPB = 104;
        for (int cb = F.vcu; cb * CPB < NC; cb += F.G) {
            const int cl = F.tid & 127, kp = F.tid >> 7, j = cb * CPB + cl;
            const bool on = (cl < CPB) && (j < NC);
            float accv[16];
#pragma unroll
            for (int b = 0; b < 16; ++b) accv[b] = 0.f;
            if (on) {
                const float* W; int ldw, jj;
                if (j < 4 * 6144) { const int l = j / 6144; jj = j - l * 6144; W = a.ada_w + (size_t)l * DM * 6144; ldw = 6144; } else { jj = j - 4 * 6144; W = a.kv_ada_w; ldw = 2048; }
                const float* wp = W + (size_t)(kp * 256) * ldw + jj;
#pragma unroll 1
                for (int k0 = 0; k0 < 256; k0 += 16) {
                    float wv[16];
#pragma unroll
                    for (int kk = 0; kk < 16; ++kk) wv[kk] = wp[(size_t)(k0 + kk) * ldw];
#pragma unroll
                    for (int kk = 0; kk < 16; ++kk) { const float w = wv[kk]; const LAS f32x4* cv = (const LAS f32x4*)(cs + (kp * 256 + k0 + kk) * 16);
#pragma unroll
                        for (int q = 0; q < 4; ++q) { const f32x4 c4 = cv[q]; accv[4 * q] += w * c4[0]; accv[4 * q + 1] += w * c4[1]; accv[4 * q + 2] += w * c4[2]; accv[4 * q + 3] += w * c4[3]; } } }
            }
#pragma unroll
            for (int b = 0; b < 16; ++b) red[(kp * 128 + cl) * 16 + b] = accv[b];
            __syncthreads();
            for (int i = F.tid; i < CPB * 16; i += 512) { const int cl2 = i >> 4, b = i & 15, j2 = cb * CPB + cl2;
                if (j2 < NC) { const float s = (red[(0 * 128 + cl2) * 16 + b] + red[(1 * 128 + cl2) * 16 + b]) + (red[(2 * 128 + cl2) * 16 + b] + red[(3 * 128 + cl2) * 16 + b]);
                    if (j2 < 4 * 6144) { const int l = j2 / 6144, jj = j2 - l * 6144; modv[((size_t)l * 16 + b) * 6144 + jj] = s + a.ada_b[l * 6144 + jj]; }
                    else { const int jj = j2 - 4 * 6144; kvmod[(size_t)b * 2048 + jj] = s + a.kv_ada_b[jj]; } } }
            __syncthreads();
        }
    }
    {
        LAS float* scr = (LAS float*)(F.lds + F.wave * 17408);
        const int gw = F.vcu * 8 + F.wave, NGW = F.G * 8;
        constexpr int I_WIN = 16 * 32, I_SQ = 16 * 16, I_KV = 16 * 8, I_FGU = 16 * 96, I_FDN = 48 * 16, I_MGU = 16 * 112, I_MDN = 56 * 16;
        constexpr int NMOE = DEFER_L3 ? 8 : 16;
        constexpr int NITEMS = 2 * I_WIN + 2 * I_SQ + I_KV + 2 * I_SQ + 2 * I_SQ + 2 * I_FGU + 2 * I_FDN + NMOE * I_MGU + NMOE * I_MDN;
        auto decode = [&](int it) -> TrItem {
            TrItem t; int r = it; const float* W; unsigned char* D; int K, N, kb, n0, f8 = 0, mapk = 0, F = 0;
            if (r < 2 * I_WIN) { const int mi = r / I_WIN, rr = r % I_WIN; n0 = 64 * (rr % 32); kb = rr / 32; K = DM; N = 2048; W = a.a_w_in + (size_t)mi * DM * 2048; D = ws + WS_WIN + (size_t)mi * 2048 * DM * 2; }
            else if ((r -= 2 * I_WIN) < 2 * I_SQ) { const int mi = r / I_SQ, rr = r % I_SQ; n0 = 64 * (rr % 16); kb = rr / 16; K = DM; N = DM; W = a.a_w_out + (size_t)mi * DM * DM; D = ws + WS_WOUT + (size_t)mi * DM * DM * 2; }
            else if ((r -= 2 * I_SQ) < I_KV) { n0 = 64 * (r % 8); kb = r / 8; K = DM; N = 512; W = a.w_kv; D = ws + WS_WKV; mapk = 3; f8 = FP8_QKV; }
            else if ((r -= I_KV) < 2 * I_SQ) { const int mi = r / I_SQ, rr = r % I_SQ; n0 = 64 * (rr % 16); kb = rr / 16; K = DM; N = DM; W = a.b_w_q + (size_t)mi * DM * DM; D = ws + WS_WQ + (size_t)mi * DM * DM * 2; mapk = 1; f8 = FP8_QKV; }
            else if ((r -= 2 * I_SQ) < 2 * I_SQ) { const int mi = r / I_SQ, rr = r % I_SQ; n0 = 64 * (rr % 16); kb = rr / 16; K = DM; N = DM; W = a.b_w_o + (size_t)mi * DM * DM; D = ws + WS_WO + (size_t)mi * DM * DM * 2; f8 = FP8_WO; }
            else if ((r -= 2 * I_SQ) < 2 * I_FGU) { const int mi = r / I_FGU, rr = r % I_FGU; n0 = 64 * (rr % 96); kb = rr / 96; K = DM; N = 6144; W = a.f_w_gu + (size_t)mi * DM * 6144; D = ws + WS_FGU + (size_t)mi * 6144 * DM * 2; f8 = FP8_OF(2 * mi); mapk = 2; F = DFF; }
            else if ((r -= 2 * I_FGU) < 2 * I_FDN) { const int mi = r / I_FDN, rr = r % I_FDN; n0 = 64 * (rr % 16); kb = rr / 16; K = DFF; N = DM; W = a.f_w_down + (size_t)mi * DFF * DM; D = ws + WS_FDN + (size_t)mi * DM * DFF * 2; f8 = FP8_OF(2 * mi); }
            else if ((r -= 2 * I_FDN) < NMOE * I_MGU) { const int mi = r / I_MGU, rr = r % I_MGU; n0 = 64 * (rr % 112); kb = rr / 112; K = DM; N = 7168; W = a.m_w_gu + (size_t)mi * DM * 7168; f8 = FP8_OF(2 * (mi >> 3) + 1); mapk = 2; F = DFE;
                D = ws + WS_MGU + (size_t)(mi >> 3) * 8 * 7168 * DM * 2 + (size_t)(mi & 7) * 7168 * DM * (f8 ? 1 : 2); }
            else { r -= NMOE * I_MGU; const int mi = r / I_MDN, rr = r % I_MDN; n0 = 64 * (rr % 16); kb = rr / 16; K = DFE; N = DM; W = a.m_w_down + (size_t)mi * DFE * DM; f8 = FP8_OF(2 * (mi >> 3) + 1);
                D = ws + WS_MDN + (size_t)(mi >> 3) * 8 * DM * DFE * 2 + (size_t)(mi & 7) * DM * DFE * (f8 ? 1 : 2); }
            t.src = W + (size_t)(64 * kb) * N + n0; t.dst = D + (size_t)(64 * kb) * (f8 ? 1 : 2); t.N = N; t.K = K; t.f8 = f8;
            if (mapk == 1 || (mapk == 3 && n0 < 256)) { t.d0 = map_head(n0); t.d1 = map_head(n0 + 32); }
            else if (mapk == 2) { t.d0 = map_gu(n0, F); t.d1 = map_gu(n0 + 32, F); }
            else { t.d0 = n0; t.d1 = n0 + 32; }
            return t; };
        f32x4 tv[16];
        int it = gw;
        TrItem cur = decode(it < NITEMS ? it : 0);
        if (it < NITEMS) tr_load(cur, tv, F.lane);
        for (; it < NITEMS; it += NGW) {
            tr_to_lds(tv, scr, F.lane);
            const bool hn = it + NGW < NITEMS;
            const TrItem nxt = decode(hn ? it + NGW : it);
            if (hn) tr_load(nxt, tv, F.lane);
            LDS_WAIT(); asm volatile("" ::: "memory");
            tr_finish(cur, scr, F.lane);
            LDS_WAIT(); asm volatile("" ::: "memory");
            cur = nxt;
        }
        __syncthreads();
    }
    {
        float* par = (float*)(ws + WS_PAR);
        const size_t gt0 = (size_t)F.vcu * 512 + F.tid, GT0 = (size_t)F.G * 512;
        for (size_t i = gt0; i < (size_t)PAR_END; i += GT0) { const int j = (int)i; float v;
            if (j < PAR_FFNN) v = a.mix_norm[j - PAR_MIXN]; else if (j < PAR_CONVW) v = a.ffn_norm[j - PAR_FFNN]; else if (j < PAR_CONVB) v = a.a_conv_w[j - PAR_CONVW];
            else if (j < PAR_GXB) v = a.a_conv_b[j - PAR_CONVB]; else if (j < PAR_GAB) v = a.a_gx_b[j - PAR_GXB]; else if (j < PAR_LAM) v = a.a_ga_b[j - PAR_GAB];
            else if (j < PAR_KVN) v = a.a_lambda[j - PAR_LAM]; else if (j < PAR_KN) v = a.kv_norm[j - PAR_KVN]; else if (j < PAR_QN) v = a.k_norm[j - PAR_KN];
            else if (j < PAR_SINK) v = a.b_q_norm[j - PAR_QN]; else if (j < PAR_ROUTER) v = a.b_sinks[j - PAR_SINK]; else v = a.m_router[j - PAR_ROUTER];
            par[j] = v; }
    }
    {
        const size_t gt = (size_t)F.vcu * 512 + F.tid, GT = (size_t)F.G * 512;
        bf16_t* gwp = (bf16_t*)(ws + WS_GW);
        for (size_t i = gt; i < (size_t)2 * 8 * 2 * 128 * 128; i += GT) { const int k = (int)(i & 127), j = (int)((i >> 7) & 127), c2 = (int)((i >> 14) & 1), n = (int)((i >> 15) & 7), l = (int)(i >> 18);
            const float* g = (j < 64) ? a.a_ga_w : a.a_gx_w; const float v = g[((size_t)(l * 8 + n) * 128 + k) * 128 + 64 * c2 + (j & 63)];
            gwp[i] = (bf16_t)(cvtpk(v, 0.f) & 0xffffu); }
        float* ct = (float*)(ws + WS_COS); float* st = (float*)(ws + WS_SIN);
        for (size_t i = gt; i < (size_t)NTOK * 32; i += GT) { const int p = (int)(i & 31); const size_t tok = i >> 5;
            const float inv = powf(10000.0f, -(float)(2 * p) / 64.0f); const float ang = (float)a.pos[tok] * inv;
            ct[i] = cosf(ang); st[i] = sinf(ang); }
    }
}

__device__ __forceinline__ void convert_deferred(const Ctx& F, const float* m_w_gu, const float* m_w_down, unsigned char* ws, int half, int j, int nb) {
    constexpr int I_MGU = 16 * 112, I_MDN = 56 * 16, NIT = 8 * I_MGU + 8 * I_MDN;
    LAS float* scr = (LAS float*)(F.lds + F.wave * 17408);
    auto decode = [&](int it) -> TrItem {
        TrItem t; int r = it; const float* W; unsigned char* D; int K, N, kb, n0; const int f8 = FP8_OF(3);
        if (r < 8 * I_MGU) { const int e = r / I_MGU, rr = r % I_MGU; n0 = 64 * (rr % 112); kb = rr / 112; K = DM; N = 7168; W = m_w_gu + (size_t)(8 + e) * DM * 7168;
            D = ws + WS_MGU + (size_t)8 * 7168 * DM * 2 + (size_t)e * 7168 * DM * (f8 ? 1 : 2); t.d0 = map_gu(n0, DFE); t.d1 = map_gu(n0 + 32, DFE); }
        else { r -= 8 * I_MGU; const int e = r / I_MDN, rr = r % I_MDN; n0 = 64 * (rr % 16); kb = rr / 16; K = DFE; N = DM; W = m_w_down + (size_t)(8 + e) * DFE * DM;
            D = ws + WS_MDN + (size_t)8 * DM * DFE * 2 + (size_t)e * DM * DFE * (f8 ? 1 : 2); t.d0 = n0; t.d1 = n0 + 32; }
        t.src = W + (size_t)(64 * kb) * N + n0; t.dst = D + (size_t)(64 * kb) * (f8 ? 1 : 2); t.N = N; t.K = K; t.f8 = f8;
        return t; };
    const int lo = half ? NIT / 2 : 0, hi = half ? NIT : NIT / 2, step = nb * 8;
    f32x4 tv[16];
    int it = lo + j * 8 + F.wave;
    TrItem cur = decode(it < hi ? it : lo);
    if (it < hi) tr_load(cur, tv, F.lane);
    for (; it < hi; it += step) {
        tr_to_lds(tv, scr, F.lane);
        const bool hn = it + step < hi;
        const TrItem nxt = decode(hn ? it + step : it);
        if (hn) tr_load(nxt, tv, F.lane);
        LDS_WAIT(); asm volatile("" ::: "memory");
        tr_finish(cur, scr, F.lane);
        LDS_WAIT(); asm volatile("" ::: "memory");
        cur = nxt;
    }
}

template <bool DUAL, bool ROUTER, bool OUT8 = false, bool INF32 = false>
__device__ __forceinline__ void norm_phase(const Ctx& F, const void* x, const float* gain1, const float* sh1, const float* sc1, void* out1,
                                           const float* gain2, const float* sh2, const float* sc2, bf16_t* out2,
                                           const float* wrouter, int* e12, float* w1o, int* cnt) {
    LAS int* lcnt = (LAS int*)F.lds;
    for (int rb = F.vcu; rb < NTOK / 256; rb += F.G) {
        const int b = rb >> 4;
        if (ROUTER) { if (F.tid < 16) lcnt[F.tid] = 0; __syncthreads(); }
        float ca[16], cs[16], ca2[16], cs2[16];
#pragma unroll
        for (int j = 0; j < 4; ++j) { const int col = 4 * F.lane + 256 * j;
            const f32x4 g = *(const f32x4*)(gain1 + col), s = *(const f32x4*)(sc1 + (size_t)b * 6144 + col), h = *(const f32x4*)(sh1 + (size_t)b * 6144 + col);
#pragma unroll
            for (int q = 0; q < 4; ++q) { ca[4 * j + q] = g[q] * (1.0f + s[q]); cs[4 * j + q] = h[q]; }
            if (DUAL) { const f32x4 g2 = *(const f32x4*)(gain2 + col), s2 = *(const f32x4*)(sc2 + (size_t)b * 2048 + col), h2 = *(const f32x4*)(sh2 + (size_t)b * 2048 + col);
#pragma unroll
                for (int q = 0; q < 4; ++q) { ca2[4 * j + q] = g2[q] * (1.0f + s2[q]); cs2[4 * j + q] = h2[q]; } } }
        float wr_[ROUTER ? 128 : 1];
        if (ROUTER) {
#pragma unroll
            for (int j = 0; j < 4; ++j)
#pragma unroll
                for (int q = 0; q < 4; ++q) { const int col = 4 * F.lane + 256 * j + q; const f32x4 w0 = *(const f32x4*)(wrouter + (size_t)col * 8), w1 = *(const f32x4*)(wrouter + (size_t)col * 8 + 4);
#pragma unroll
                    for (int e = 0; e < 4; ++e) { wr_[(4 * j + q) * 8 + e] = w0[e]; wr_[(4 * j + q) * 8 + 4 + e] = w1[e]; } }
        }
        int me12 = 0; float mw1 = 0.f;
        const int rowb = rb * 256 + F.wave * 32;
        f32x4 nf[INF32 ? 4 : 1]; u32x2 nb[INF32 ? 1 : 4], nc[INF32 ? 1 : 4];
        if constexpr (ROUTER) { const u32x2* xr = (const u32x2*)((const bf16_t*)x + (size_t)rowb * DM) + F.lane;
#pragma unroll
            for (int j = 0; j < 4; ++j) nb[j] = xr[64 * j]; }
        else if constexpr (INF32) { const f32x4* xr = (const f32x4*)((const float*)x + (size_t)rowb * DM) + F.lane;
#pragma unroll
            for (int j = 0; j < 4; ++j) nf[j] = xr[64 * j]; }
        else { const u32x2* xr = (const u32x2*)((const bf16_t*)x + (size_t)rowb * DM) + F.lane;
#pragma unroll
            for (int j = 0; j < 4; ++j) { nb[j] = xr[64 * j]; nc[j] = xr[64 * j + DM / 4]; } }
        for (int rr = 0; rr < 32; ++rr) {
            const size_t row = (size_t)(rowb + rr);
            f32x4 v[4]; float s = 0.f;
            if constexpr (ROUTER) {
#pragma unroll
                for (int j = 0; j < 4; ++j) { const u32x2 p = nb[j]; v[j] = (f32x4){bflo(p.x), bfhi(p.x), bflo(p.y), bfhi(p.y)}; }
                if (rr + 1 < 32) { const u32x2* xr = (const u32x2*)((const bf16_t*)x + (row + 1) * DM) + F.lane;
#pragma unroll
                    for (int j = 0; j < 4; ++j) nb[j] = xr[64 * j]; } }
            else if constexpr (INF32) {
#pragma unroll
                for (int j = 0; j < 4; ++j) v[j] = nf[j];
                if (rr + 1 < 32) { const f32x4* xr = (const f32x4*)((const float*)x + (row + 1) * DM) + F.lane;
#pragma unroll
                    for (int j = 0; j < 4; ++j) nf[j] = xr[64 * j]; } }
            else {
#pragma unroll
                for (int j = 0; j < 4; ++j) { const u32x2 p = nb[j]; v[j] = (f32x4){bflo(p.x), bfhi(p.x), bflo(p.y), bfhi(p.y)}; nb[j] = nc[j]; }
                if (rr + 2 < 32) { const u32x2* xr = (const u32x2*)((const bf16_t*)x + (row + 2) * DM) + F.lane;
#pragma unroll
                    for (int j = 0; j < 4; ++j) nc[j] = xr[64 * j]; } }
#pragma unroll
            for (int j = 0; j < 4; ++j) s += (v[j][0] * v[j][0] + v[j][1] * v[j][1]) + (v[j][2] * v[j][2] + v[j][3] * v[j][3]);
            const float r = __builtin_amdgcn_rsqf(wave_sum(s, F.lane) * (1.0f / DM) + EPS);
            float hv[16];
#pragma unroll
            for (int j = 0; j < 4; ++j)
#pragma unroll
                for (int q = 0; q < 4; ++q) hv[4 * j + q] = v[j][q] * r * ca[4 * j + q] + cs[4 * j + q];
            if constexpr (OUT8) { unsigned* o4 = (unsigned*)((unsigned char*)out1 + row * DM) + F.lane;
#pragma unroll
                for (int j = 0; j < 4; ++j) o4[64 * j] = cvt4_fp8(hv[4 * j] * SC8_H, hv[4 * j + 1] * SC8_H, hv[4 * j + 2] * SC8_H, hv[4 * j + 3] * SC8_H); }
            else { u32x2* o8 = (u32x2*)((bf16_t*)out1 + row * DM) + F.lane;
#pragma unroll
                for (int j = 0; j < 4; ++j) { u32x2 w; w.x = cvtpk(hv[4 * j], hv[4 * j + 1]); w.y = cvtpk(hv[4 * j + 2], hv[4 * j + 3]); o8[64 * j] = w; } }
            if (DUAL) { u32x2* p8 = (u32x2*)(out2 + row * DM) + F.lane; unsigned* q8 = (unsigned*)((unsigned char*)out2 + row * DM) + F.lane;
#pragma unroll
                for (int j = 0; j < 4; ++j) { float t[4];
#pragma unroll
                    for (int q = 0; q < 4; ++q) t[q] = v[j][q] * r * ca2[4 * j + q] + cs2[4 * j + q];
                    if constexpr (OUT8) q8[64 * j] = cvt4_fp8(t[0] * SC8_H, t[1] * SC8_H, t[2] * SC8_H, t[3] * SC8_H);
                    else { u32x2 w; w.x = cvtpk(t[0], t[1]); w.y = cvtpk(t[2], t[3]); p8[64 * j] = w; } } }
            if (ROUTER) {
                float pe[8];
#pragma unroll
                for (int e = 0; e < 8; ++e) { float p = 0.f;
#pragma unroll
                    for (int c = 0; c < 16; ++c) p += hv[c] * wr_[c * 8 + e];
                    pe[e] = p; }
                { const bool b0 = F.lane & 1, b1 = F.lane & 2, b2 = F.lane & 4;
#pragma unroll
                  for (int e = 0; e < 8; e += 2) { const float snd = b0 ? pe[e] : pe[e + 1], kp = b0 ? pe[e + 1] : pe[e]; pe[e >> 1] = kp + shflx(snd, F.lane, 1); }
#pragma unroll
                  for (int i = 0; i < 4; i += 2) { const float snd = b1 ? pe[i] : pe[i + 1], kp = b1 ? pe[i + 1] : pe[i]; pe[i >> 1] = kp + shflx(snd, F.lane, 2); }
                  { const float snd = b2 ? pe[0] : pe[1], kp = b2 ? pe[1] : pe[0]; pe[0] = kp + shflx(snd, F.lane, 4); }
                  pe[0] += shflx(pe[0], F.lane, 8); pe[0] += shflx(pe[0], F.lane, 16); pe[0] += shflx(pe[0], F.lane, 32); }
                float lg[8];
#pragma unroll
                for (int e = 0; e < 8; ++e) lg[e] = __int_as_float(__builtin_amdgcn_readlane(__float_as_int(pe[0]), e));
                int i1 = 0; float v1 = lg[0];
#pragma unroll
                for (int e = 1; e < 8; ++e) if (lg[e] > v1) { v1 = lg[e]; i1 = e; }
                int i2 = -1; float v2 = -INFINITY;
#pragma unroll
                for (int e = 0; e < 8; ++e) if (e != i1 && lg[e] > v2) { v2 = lg[e]; i2 = e; }
                const float wt = 1.0f / (1.0f + __expf(v2 - v1));
                if (F.lane == rr) { me12 = i1 | (i2 << 8); mw1 = wt; }
            }
        }
        if (ROUTER) {
            if (F.lane < 32) { e12[rowb + F.lane] = me12; w1o[rowb + F.lane] = mw1; }
            const int e1 = me12 & 255, e2 = me12 >> 8;
#pragma unroll
            for (int e = 0; e < 8; ++e) { const unsigned long long m1 = __ballot(F.lane < 32 && e1 == e), m2 = __ballot(F.lane < 32 && e2 == e);
                if (F.lane == 0) { atomicAdd((int*)&lcnt[e], (int)__popcll(m1)); atomicAdd((int*)&lcnt[8 + e], (int)__popcll(m2)); } }
            __syncthreads();
            if (F.tid < 16) cnt[rb * 16 + F.tid] = lcnt[F.tid];
            __syncthreads();
        }
    }
}

template <bool DUAL, bool ROUTER, bool OUT8 = false, bool INF32 = false>
__device__ __forceinline__ void norm_phase_pk(const Ctx& F, const void* x, const float* gain1, const float* sh1, const float* sc1, void* out1,
                                           const float* gain2, const float* sh2, const float* sc2, bf16_t* out2,
                                           const float* wrouter, int* e12, float* w1o, int* cnt) {
    LAS int* lcnt = (LAS int*)F.lds;
    constexpr float SH = OUT8 ? SC8_H : 1.0f;
    for (int rb = F.vcu; rb < NTOK / 256; rb += F.G) {
        const int b = rb >> 4;
        if (ROUTER) { if (F.tid < 16) lcnt[F.tid] = 0; __syncthreads(); }
        f32x2 ca[8], cs[8], cb[DUAL ? 8 : 1], cd[DUAL ? 8 : 1];
#pragma unroll
        for (int j = 0; j < 4; ++j) { const int col = 4 * F.lane + 256 * j;
            const f32x4 g = *(const f32x4*)(gain1 + col), sc = *(const f32x4*)(sc1 + (size_t)b * 6144 + col), h = *(const f32x4*)(sh1 + (size_t)b * 6144 + col);
#pragma unroll
            for (int hh = 0; hh < 2; ++hh) { ca[2 * j + hh] = (f32x2){g[2 * hh] * (1.0f + sc[2 * hh]) * SH, g[2 * hh + 1] * (1.0f + sc[2 * hh + 1]) * SH}; cs[2 * j + hh] = (f32x2){h[2 * hh] * SH, h[2 * hh + 1] * SH}; }
            if constexpr (DUAL) { const f32x4 g2 = *(const f32x4*)(gain2 + col), s2 = *(const f32x4*)(sc2 + (size_t)b * 2048 + col), h2 = *(const f32x4*)(sh2 + (size_t)b * 2048 + col);
#pragma unroll
                for (int hh = 0; hh < 2; ++hh) { cb[2 * j + hh] = (f32x2){g2[2 * hh] * (1.0f + s2[2 * hh]), g2[2 * hh + 1] * (1.0f + s2[2 * hh + 1])}; cd[2 * j + hh] = (f32x2){h2[2 * hh], h2[2 * hh + 1]}; } } }
        f32x2 wr2[ROUTER ? 16 : 1][4];
        if constexpr (ROUTER) {
#pragma unroll
            for (int j = 0; j < 4; ++j)
#pragma unroll
                for (int q = 0; q < 4; ++q) { const int col = 4 * F.lane + 256 * j + q; const f32x4 w0 = *(const f32x4*)(wrouter + (size_t)col * 8), w1 = *(const f32x4*)(wrouter + (size_t)col * 8 + 4);
                    wr2[4 * j + q][0] = (f32x2){w0[0], w0[1]} * (1.0f / SH); wr2[4 * j + q][1] = (f32x2){w0[2], w0[3]} * (1.0f / SH); wr2[4 * j + q][2] = (f32x2){w1[0], w1[1]} * (1.0f / SH); wr2[4 * j + q][3] = (f32x2){w1[2], w1[3]} * (1.0f / SH); }
        }
        int me12 = 0; float mw1 = 0.f;
        const int rowb = rb * 256 + F.wave * 32;
        f32x4 nf[INF32 ? 4 : 1]; u32x2 nb[INF32 ? 1 : 4], nc[INF32 ? 1 : 4];
        if constexpr (INF32) { const f32x4* xr = (const f32x4*)((const float*)x + (size_t)rowb * DM) + F.lane;
#pragma unroll
            for (int j = 0; j < 4; ++j) nf[j] = xr[64 * j]; }
        else { const u32x2* xr = (const u32x2*)((const bf16_t*)x + (size_t)rowb * DM) + F.lane;
#pragma unroll
            for (int j = 0; j < 4; ++j) { nb[j] = xr[64 * j]; nc[j] = xr[64 * j + DM / 4]; } }
        for (int rr = 0; rr < 32; ++rr) {
            const size_t row = (size_t)(rowb + rr);
            f32x2 v[8];
            if constexpr (INF32) {
#pragma unroll
                for (int j = 0; j < 4; ++j) { v[2 * j] = (f32x2){nf[j][0], nf[j][1]}; v[2 * j + 1] = (f32x2){nf[j][2], nf[j][3]}; }
                if (rr + 1 < 32) { const f32x4* xr = (const f32x4*)((const float*)x + (row + 1) * DM) + F.lane;
#pragma unroll
                    for (int j = 0; j < 4; ++j) nf[j] = xr[64 * j]; } }
            else {
#pragma unroll
                for (int j = 0; j < 4; ++j) { const u32x2 p = nb[j]; v[2 * j] = (f32x2){bflo(p.x), bfhi(p.x)}; v[2 * j + 1] = (f32x2){bflo(p.y), bfhi(p.y)}; nb[j] = nc[j]; }
                if (rr + 2 < 32) { const u32x2* xr = (const u32x2*)((const bf16_t*)x + (row + 2) * DM) + F.lane;
#pragma unroll
                    for (int j = 0; j < 4; ++j) nc[j] = xr[64 * j]; } }
            f32x2 sq = v[0] * v[0];
#pragma unroll
            for (int i = 1; i < 8; ++i) sq += v[i] * v[i];
            const float r = __builtin_amdgcn_rsqf(wave_sum_dpp(sq.x + sq.y) * (1.0f / DM) + EPS);
            const f32x2 r2 = {r, r};
            f32x2 hv[8];
#pragma unroll
            for (int i = 0; i < 8; ++i) { v[i] = v[i] * r2; hv[i] = v[i] * ca[i] + cs[i]; }
            if constexpr (OUT8) { unsigned* o4 = (unsigned*)((unsigned char*)out1 + row * DM) + F.lane;
#pragma unroll
                for (int j = 0; j < 4; ++j) o4[64 * j] = cvt4_fp8(hv[2 * j].x, hv[2 * j].y, hv[2 * j + 1].x, hv[2 * j + 1].y); }
            else { u32x2* o8 = (u32x2*)((bf16_t*)out1 + row * DM) + F.lane;
#pragma unroll
                for (int j = 0; j < 4; ++j) { u32x2 w; w.x = cvtpk(hv[2 * j].x, hv[2 * j].y); w.y = cvtpk(hv[2 * j + 1].x, hv[2 * j + 1].y); o8[64 * j] = w; } }
            if constexpr (DUAL) { u32x2* p8 = (u32x2*)(out2 + row * DM) + F.lane;
#pragma unroll
                for (int j = 0; j < 4; ++j) { const f32x2 t0 = v[2 * j] * cb[2 * j] + cd[2 * j], t1 = v[2 * j + 1] * cb[2 * j + 1] + cd[2 * j + 1];
                    u32x2 w; w.x = cvtpk(t0.x, t0.y); w.y = cvtpk(t1.x, t1.y); p8[64 * j] = w; } }
            if constexpr (ROUTER) {
                f32x2 pp[4];
#pragma unroll
                for (int k = 0; k < 4; ++k) pp[k] = (f32x2){0.f, 0.f};
#pragma unroll
                for (int c = 0; c < 16; ++c) { const float hc = (c & 1) ? hv[c >> 1].y : hv[c >> 1].x; const f32x2 h2 = {hc, hc};
#pragma unroll
                    for (int k = 0; k < 4; ++k) pp[k] += h2 * wr2[c][k]; }
                float pe[8];
#pragma unroll
                for (int k = 0; k < 4; ++k) { pe[2 * k] = pp[k].x; pe[2 * k + 1] = pp[k].y; }
                { const bool b0 = F.lane & 1, b1 = F.lane & 2, b2 = F.lane & 4;
#pragma unroll
                  for (int e = 0; e < 4; ++e) { const float snd = b2 ? pe[e] : pe[e + 4], kp = b2 ? pe[e + 4] : pe[e]; pe[e] = kp + dppf<0x141>(snd); }
#pragma unroll
                  for (int e = 0; e < 2; ++e) { const float snd = b1 ? pe[e] : pe[e + 2], kp = b1 ? pe[e + 2] : pe[e]; pe[e] = kp + dppf<0x4E>(snd); }
                  { const float snd = b0 ? pe[0] : pe[1], kp = b0 ? pe[1] : pe[0]; pe[0] = kp + dppf<0xB1>(snd); }
                  pe[0] += dppf<0x128>(pe[0]); pe[0] += shflx(pe[0], F.lane, 16); pe[0] += shflx(pe[0], F.lane, 32); }
                float lg[8];
#pragma unroll
                for (int e = 0; e < 8; ++e) lg[e] = __int_as_float(__builtin_amdgcn_readlane(__float_as_int(pe[0]), e));
                int i1 = 0; float v1 = lg[0];
#pragma unroll
                for (int e = 1; e < 8; ++e) if (lg[e] > v1) { v1 = lg[e]; i1 = e; }
                int i2 = -1; float v2 = -INFINITY;
#pragma unroll
                for (int e = 0; e < 8; ++e) if (e != i1 && lg[e] > v2) { v2 = lg[e]; i2 = e; }
                const float wt = 1.0f / (1.0f + __expf(v2 - v1));
                if (F.lane == rr) { me12 = i1 | (i2 << 8); mw1 = wt; }
            }
        }
        if (ROUTER) {
            if (F.lane < 32) { e12[rowb + F.lane] = me12; w1o[rowb + F.lane] = mw1; }
            const int e1 = me12 & 255, e2 = me12 >> 8;
#pragma unroll
            for (int e = 0; e < 8; ++e) { const unsigned long long m1 = __ballot(F.lane < 32 && e1 == e), m2 = __ballot(F.lane < 32 && e2 == e);
                if (F.lane == 0) { atomicAdd((int*)&lcnt[e], (int)__popcll(m1)); atomicAdd((int*)&lcnt[8 + e], (int)__popcll(m2)); } }
            __syncthreads();
            if (F.tid < 16) cnt[rb * 16 + F.tid] = lcnt[F.tid];
            __syncthreads();
        }
    }
}

__device__ __forceinline__ void moe_scatter(const Ctx& F, const int* cnt, const int* e12, const float* w1, int* tos, float* wos, int* tile) {
    LAS int* T1 = (LAS int*)F.lds;
    LAS int* T2 = T1 + 512;
    LAS int* tot = T2 + 512;
    LAS int* pre = tot + 16;
    LAS int* seg = pre + 16;
    LAS int* wcn = seg + 32;
    for (int rb = F.vcu; rb < NTOK / 256; rb += F.G) {
        { const int bin = F.tid & 15, part = F.tid >> 4; int st = 0, sp = 0;
#pragma unroll
            for (int j = 0; j < 8; ++j) { const int b2 = part * 8 + j; const int v = cnt[b2 * 16 + bin]; st += v; if (b2 < rb) sp += v; }
            T1[part * 16 + bin] = st; T2[part * 16 + bin] = sp; }
        __syncthreads();
        if (F.tid < 16) { int st = 0, sp = 0; for (int p = 0; p < 32; ++p) { st += T1[p * 16 + F.tid]; sp += T2[p * 16 + F.tid]; } tot[F.tid] = st; pre[F.tid] = sp; }
        __syncthreads();
        if (F.tid == 0) { int s = 0; for (int bin = 0; bin < 16; ++bin) { seg[bin] = s; s += ((tot[bin] + 255) >> 8) << 8; } seg[16] = s; }
        __syncthreads();
        int e1 = -1, e2 = -1; float wt = 0.f; int r1 = 0, r2 = 0;
        const int token = rb * 256 + F.tid;
        if (F.tid < 256) { const int v = e12[token]; e1 = v & 255; e2 = v >> 8; wt = w1[token]; }
        if (F.wave < 4) {
#pragma unroll
            for (int e = 0; e < 8; ++e) { const unsigned long long m1 = __ballot(e1 == e), m2 = __ballot(e2 == e); const unsigned long long lt = (1ull << F.lane) - 1ull;
                if (e1 == e) r1 = (int)__popcll(m1 & lt); if (e2 == e) r2 = (int)__popcll(m2 & lt);
                if (F.lane == 0) { wcn[F.wave * 16 + e] = (int)__popcll(m1); wcn[F.wave * 16 + 8 + e] = (int)__popcll(m2); } }
        }
        __syncthreads();
        if (F.tid < 256) {
            int o1 = seg[e1] + pre[e1] + r1, o2 = seg[8 + e2] + pre[8 + e2] + r2;
            for (int w = 0; w < F.wave; ++w) { o1 += wcn[w * 16 + e1]; o2 += wcn[w * 16 + 8 + e2]; }
            tos[o1] = token; wos[o1] = wt; tos[o2] = token; wos[o2] = 1.0f - wt;
        }
        if (rb < 16) { const int bin = rb; const int s0 = seg[bin] + tot[bin], s1 = seg[bin + 1]; for (int s = s0 + F.tid; s < s1; s += 512) { tos[s] = -1; wos[s] = 0.f; } }
        if (rb == 0) { if (F.tid == 0) { tile[0] = seg[8] >> 8; tile[1] = seg[16] >> 8; }
            for (int t = F.tid; t < MAXTILES; t += 512) { const int s = t << 8; int e = 0;
#pragma unroll
                for (int bin = 1; bin < 16; ++bin) if (s >= seg[bin]) e = bin;
                tile[16 + t] = e & 7; } }
        __syncthreads();
    }
}

constexpr int SC_AT = 0, SC_WT = 34816, SC_AS = 69632, SC_BS = 102400, SC_SEG = 135168, SC_CARRY = 139264, SC_CW = 139776, SC_GB = 142336;
__device__ __forceinline__ void scan_phase(const Ctx& F, const float* par, int l, const bf16_t* XB, bf16_t* GY, const bf16_t* GW) {
    LAS unsigned char* lds = F.lds;
    LAS float* AS = (LAS float*)(lds + SC_AS); LAS float* BS = (LAS float*)(lds + SC_BS);
    LAS float* SEGA = (LAS float*)(lds + SC_SEG); LAS float* SEGB = SEGA + 512;
    LAS float* CARRY = (LAS float*)(lds + SC_CARRY);
    LAS float* CW = (LAS float*)(lds + SC_CW);
    LAS float* GB = (LAS float*)(lds + SC_GB);
    const int tid = F.tid, lane = F.lane, wid = F.wave, r32 = lane & 31, hh = lane >> 5;
    for (int un = F.vcu; un < 256; un += F.G) {
        const int b = un >> 4, n = (un >> 1) & 7, c2 = un & 1;
        __syncthreads();
        for (int i = tid; i < 640; i += 512) { const int ch = i & 127, k = i >> 7; CW[i] = (k < 4) ? par[PAR_CONVW + (l * 4 + k) * DM + 128 * n + ch] : par[PAR_CONVB + l * DM + 128 * n + ch]; }
        if (tid < 64) { const int ch = l * DM + 128 * n + 64 * c2 + tid; GB[tid] = par[PAR_GAB + ch]; GB[64 + tid] = par[PAR_GXB + ch]; GB[128 + tid] = log1pf(expf(-par[PAR_LAM + ch])); CARRY[tid] = 0.f; CARRY[64 + tid] = 0.f; }
        { const bf16_t* gsrc = GW + (size_t)(((l * 8 + n) * 2 + c2) * 128) * 128;
#pragma unroll
            for (int i = 0; i < 4; ++i) { const int p = tid + 512 * i, row = p >> 4, c16 = p & 15; const u32x4 v = *(const u32x4*)(gsrc + (size_t)row * 128 + c16 * 8); *(LAS u32x4*)(lds + SC_WT + row * 272 + c16 * 16) = v; } }
        const int cp = lane, tg = wid;
        const int sc = lane, sg = wid;
        const size_t rowbase = (size_t)b * SEQ;
        const bf16_t* xbp = XB + rowbase * DM + 128 * n + 2 * cp;
        bf16_t* gyp = GY + rowbase * DM + 128 * n + 64 * c2 + sc;
        unsigned xv[19];
#pragma unroll
        for (int k = 0; k < 19; ++k) { const int t = 16 * tg - 3 + k; xv[k] = (t >= 0) ? *(const unsigned*)(xbp + (size_t)t * DM) : 0u; }
        __syncthreads();
        float w[2][4], cb[2];
#pragma unroll
        for (int q = 0; q < 2; ++q) { cb[q] = CW[512 + 2 * cp + q];
#pragma unroll
            for (int k = 0; k < 4; ++k) w[q][k] = CW[k * 128 + 2 * cp + q]; }
        const float gba = GB[32 * (wid & 1) + r32], gbx = GB[64 + 32 * (wid & 1) + r32], spv = GB[128 + 32 * (wid & 1) + r32];
        for (int ci = 0; ci < SEQ / 128; ++ci) {
            const int t0 = ci * 128;
#pragma unroll
            for (int k = 0; k < 16; ++k) {
                float o[2];
#pragma unroll
                for (int q = 0; q < 2; ++q) { float s = cb[q];
#pragma unroll
                    for (int j = 0; j < 4; ++j) { const unsigned pv = xv[k + j]; const float xf = q ? __uint_as_float(pv & 0xffff0000u) : __uint_as_float(pv << 16); s += w[q][j] * xf; }
                    o[q] = s; }
                *(LAS unsigned*)(lds + SC_AT + (16 * tg + k) * 272 + cp * 4) = cvtpk(o[0], o[1]);
            }
            if (ci + 1 < SEQ / 128) {
#pragma unroll
                for (int k = 0; k < 19; ++k) xv[k] = *(const unsigned*)(xbp + (size_t)(t0 + 128 + 16 * tg - 3 + k) * DM);
            }
            __syncthreads();
            f32x16 ga, gx;
#pragma unroll
            for (int i = 0; i < 16; ++i) { ga[i] = 0.f; gx[i] = 0.f; }
            { const int tt = wid >> 1, ct = wid & 1;
                const LAS unsigned char* ap = lds + SC_AT + (32 * tt + r32) * 272 + hh * 16;
                const LAS unsigned char* bpa = lds + SC_WT + (32 * ct + r32) * 272 + hh * 16;
                const LAS unsigned char* bpx = bpa + 64 * 272;
#pragma unroll
                for (int s = 0; s < 8; ++s) { const bf16x8 af = *(const LAS bf16x8*)(ap + s * 32), ba = *(const LAS bf16x8*)(bpa + s * 32), bx = *(const LAS bf16x8*)(bpx + s * 32);
                    ga = __builtin_amdgcn_mfma_f32_32x32x16_bf16(af, ba, ga, 0, 0, 0); gx = __builtin_amdgcn_mfma_f32_32x32x16_bf16(af, bx, gx, 0, 0, 0); }
                const f32x2 nlv = {-LOG2E, -LOG2E}, bav = {-LOG2E * gba, -LOG2E * gba}, bxv = {-LOG2E * gbx, -LOG2E * gbx}, onev = {1.0f, 1.0f}, csv = {-8.0f * LOG2E * spv, -8.0f * LOG2E * spv};
#pragma unroll
                for (int i = 0; i < 16; i += 2) { const int tok = 32 * tt + (i & 3) + 8 * (i >> 2) + 4 * hh, ch = 32 * ct + r32;
                    const f32x2 a2 = {ga[i], ga[i + 1]}, x2 = {gx[i], gx[i + 1]};
                    const f32x2 ta = a2 * nlv + bav, tx = x2 * nlv + bxv;
                    const f32x2 da = (f32x2){fast_exp2(ta.x), fast_exp2(ta.y)} + onev, dx = (f32x2){fast_exp2(tx.x), fast_exp2(tx.y)} + onev;
                    const f32x2 rg = {fast_rcp(da.x), fast_rcp(da.y)}, ig = {fast_rcp(dx.x), fast_rcp(dx.y)};
                    const f32x2 l2 = rg * csv; const f32x2 av = {fast_exp2(l2.x), fast_exp2(l2.y)};
                    const f32x2 om = onev - av * av; const f32x2 bc = {__builtin_amdgcn_sqrtf(fmaxf(om.x, 0.f)), __builtin_amdgcn_sqrtf(fmaxf(om.y, 0.f))};
                    const f32x2 xc = {bf2f(*(const LAS unsigned short*)(lds + SC_AT + tok * 272 + (64 * c2 + ch) * 2)), bf2f(*(const LAS unsigned short*)(lds + SC_AT + (tok + 1) * 272 + (64 * c2 + ch) * 2))};
                    const f32x2 bb = (bc * ig) * xc;
                    AS[tok * 64 + ch] = av.x; AS[(tok + 1) * 64 + ch] = av.y; BS[tok * 64 + ch] = bb.x; BS[(tok + 1) * 64 + ch] = bb.y; }
            }
            __syncthreads();
            unsigned short gyv[16];
#pragma unroll
            for (int k = 0; k < 16; ++k) gyv[k] = gyp[(size_t)(t0 + 16 * sg + k) * DM];
            float av[16], bv[16];
#pragma unroll
            for (int k = 0; k < 16; ++k) { av[k] = AS[(16 * sg + k) * 64 + sc]; bv[k] = BS[(16 * sg + k) * 64 + sc]; }
            { float pa = 1.f, pb = 0.f;
#pragma unroll
                for (int k = 0; k < 16; ++k) { pb = av[k] * pb + bv[k]; pa *= av[k]; }
                SEGA[sg * 64 + sc] = pa; SEGB[sg * 64 + sc] = pb; }
            __syncthreads();
            float h = CARRY[(ci & 1) * 64 + sc];
            for (int s = 0; s < sg; ++s) h = SEGA[s * 64 + sc] * h + SEGB[s * 64 + sc];
#pragma unroll
            for (int k = 0; k < 16; ++k) { h = av[k] * h + bv[k]; const float o = h * bf2f(gyv[k]); gyp[(size_t)(t0 + 16 * sg + k) * DM] = (bf16_t)(cvtpk(o, 0.f) & 0xffffu); }
            if (sg == 7) CARRY[((ci + 1) & 1) * 64 + sc] = h;
        }
    }
    __syncthreads();
}

constexpr int AT_K = 0, AT_V = 36864;
__device__ __forceinline__ void attn_phase(const Ctx& F, const bf16_t* Q, const bf16_t* Kb, const bf16_t* Vb, bf16_t* O, const float* sinks) {
    LAS unsigned char* lds = F.lds;
    const int tid = F.tid, lane = F.lane, wid = F.wave, r32 = lane & 31, hh = lane >> 5;
    const int i16 = lane & 15, tq = i16 >> 2, tp = i16 & 3, blk = (lane >> 4) & 1;
    const int g = wid & 3, half = wid >> 2;
    constexpr int NU = BATCH * 32 * 4;
    u32x4 kreg[4], vreg[4]; bf16x8 qreg[2][4];
#define AT_LOADKV(unit) do { const int kh_ = (unit) & 3, n_ = ((unit) >> 2) & 31, b_ = (unit) >> 7; \
        _Pragma("unroll") for (int i = 0; i < 4; ++i) { const int p = tid + 512 * i, row = p >> 3, c16 = p & 7; kreg[i] = (u32x4){0u, 0u, 0u, 0u}; vreg[i] = (u32x4){0u, 0u, 0u, 0u}; \
            if (n_ > 0 || row >= 128) { const size_t tok = (size_t)b_ * SEQ + (size_t)(128 * (n_ - 1) + row); kreg[i] = *(const u32x4*)(Kb + tok * 256 + kh_ * 64 + c16 * 8); vreg[i] = *(const u32x4*)(Vb + tok * 256 + kh_ * 64 + c16 * 8); } } } while (0)
#define AT_LOADQ(unit) do { const int kh_ = (unit) & 3, n_ = ((unit) >> 2) & 31, b_ = (unit) >> 7; \
        _Pragma("unroll") for (int ps = 0; ps < 2; ++ps) { const size_t qt_ = (size_t)b_ * SEQ + (size_t)(128 * n_ + 64 * half + 32 * ps + r32); \
            _Pragma("unroll") for (int s = 0; s < 4; ++s) qreg[ps][s] = *(const bf16x8*)(Q + qt_ * DM + (4 * kh_ + g) * 64 + 16 * s + 8 * hh); } } while (0)
    int un = F.vcu;
    if (un < NU) { AT_LOADKV(un); AT_LOADQ(un); }
    for (; un < NU; un += F.G) {
        const int kh = un & 3, n = (un >> 2) & 31, b = un >> 7;
        __syncthreads();
#pragma unroll
        for (int i = 0; i < 4; ++i) { const int p = tid + 512 * i, row = p >> 3, c16 = p & 7;
            *(LAS u32x4*)(lds + AT_K + row * 144 + c16 * 16) = kreg[i]; *(LAS u32x4*)(lds + AT_V + row * 192 + c16 * 16) = vreg[i]; }
        __syncthreads();
        if (un + F.G < NU) AT_LOADKV(un + F.G);
        const int hq = 4 * kh + g;
        const float sink2 = sinks[hq] * LOG2E;
#pragma unroll 1
        for (int pass = 0; pass < 2; ++pass) {
            const int i0 = 64 * half + 32 * pass, kt0 = i0 >> 5;
            const size_t qtok = (size_t)b * SEQ + (size_t)(128 * n + i0 + r32);
            bf16x8 qf[4];
#pragma unroll
            for (int s = 0; s < 4; ++s) qf[s] = pass ? qreg[1][s] : qreg[0][s];
            f32x16 sacc[5];
#pragma unroll
            for (int t = 0; t < 5; ++t) {
#pragma unroll
                for (int i = 0; i < 16; ++i) sacc[t][i] = 0.f;
#pragma unroll
                for (int s = 0; s < 4; ++s) { const bf16x8 kf = *(const LAS bf16x8*)(lds + AT_K + (32 * (kt0 + t) + r32) * 144 + (16 * s + 8 * hh) * 2);
                    sacc[t] = __builtin_amdgcn_mfma_f32_32x32x16_bf16(kf, qf[s], sacc[t], 0, 0, 0); } }
            float sum = 0.f;
#pragma unroll
            for (int t = 0; t < 5; ++t) {
                const bool dead = (n == 0) && (32 * (kt0 + t) < 128);
#pragma unroll
                for (int i = 0; i < 16; ++i) { float p = fast_exp2(sacc[t][i]);
                    if (t == 0 || t == 4) { const int d = 32 * t + (i & 3) + 8 * (i >> 2) + 4 * hh - r32; p = ((d >= 1) && (d <= 128)) ? p : 0.f; }
                    if (dead) p = 0.f; sacc[t][i] = p; sum += p; } }
            sum += shflx(sum, lane, 32);
            sum += fast_exp2(sink2);
            const float inv = 1.0f / sum;
            f32x16 oacc[2];
#pragma unroll
            for (int i = 0; i < 16; ++i) { oacc[0][i] = 0.f; oacc[1][i] = 0.f; }
#pragma unroll
            for (int t = 0; t < 5; ++t)
#pragma unroll
                for (int s = 0; s < 2; ++s) {
                    u32x4 pk; pk.x = cvtpk(sacc[t][8 * s], sacc[t][8 * s + 1]); pk.y = cvtpk(sacc[t][8 * s + 2], sacc[t][8 * s + 3]); pk.z = cvtpk(sacc[t][8 * s + 4], sacc[t][8 * s + 5]); pk.w = cvtpk(sacc[t][8 * s + 6], sacc[t][8 * s + 7]);
                    const bf16x8 pb = __builtin_bit_cast(bf16x8, pk);
#pragma unroll
                    for (int dt = 0; dt < 2; ++dt) {
                        const LAS unsigned char* vp = lds + AT_V + (32 * (kt0 + t) + 16 * s + 4 * hh + tq) * 192 + (32 * dt + 16 * blk + 4 * tp) * 2;
                        const s16x4 lo = __builtin_bit_cast(s16x4, __builtin_amdgcn_ds_read_tr16_b64_v4i16((LAS s16x4*)vp));
                        const s16x4 hi = __builtin_bit_cast(s16x4, __builtin_amdgcn_ds_read_tr16_b64_v4i16((LAS s16x4*)(vp + 8 * 192)));
                        const bf16x8 va = __builtin_shufflevector(lo, hi, 0, 1, 2, 3, 4, 5, 6, 7);
                        oacc[dt] = __builtin_amdgcn_mfma_f32_32x32x16_bf16(va, pb, oacc[dt], 0, 0, 0);
                    }
                }
            if constexpr (FP8_WO) {
                unsigned char* op = (unsigned char*)O + qtok * DM + hq * 64; const float sco = inv * SC8_O;
#pragma unroll
                for (int dt = 0; dt < 2; ++dt)
#pragma unroll
                    for (int q4 = 0; q4 < 4; ++q4) *(unsigned*)(op + 32 * dt + 8 * q4 + 4 * hh) = cvt4_fp8(oacc[dt][4 * q4] * sco, oacc[dt][4 * q4 + 1] * sco, oacc[dt][4 * q4 + 2] * sco, oacc[dt][4 * q4 + 3] * sco);
            } else {
                bf16_t* op = O + qtok * DM + hq * 64;
#pragma unroll
                for (int dt = 0; dt < 2; ++dt)
#pragma unroll
                    for (int q4 = 0; q4 < 4; ++q4) { u32x2 w; w.x = cvtpk(oacc[dt][4 * q4] * inv, oacc[dt][4 * q4 + 1] * inv); w.y = cvtpk(oacc[dt][4 * q4 + 2] * inv, oacc[dt][4 * q4 + 3] * inv);
                        *(u32x2*)(op + 32 * dt + 8 * q4 + 4 * hh) = w; } }
        }
        if (un + F.G < NU) AT_LOADQ(un + F.G);
    }
#undef AT_LOADKV
#undef AT_LOADQ
    __syncthreads();
}

constexpr int NPHASE = 33 + (DUP_SCANPAIR ? 4 : 0);
__global__ void __launch_bounds__(512, 2) fwd_kernel(Args a) {
    extern __shared__ __attribute__((aligned(16))) unsigned char lds_raw[];
    volatile LAS unsigned* MISC = (volatile LAS unsigned*)((LAS unsigned char*)lds_raw + LDS_MISC);
    const int wv0 = __builtin_amdgcn_readfirstlane((int)threadIdx.x >> 6);
    if (wv0 == 0) MISC[lane_id_v()] = 0u;
    __syncthreads();
    XcdBarrier bar; bar.bar = (unsigned*)(a.ws + WS_CTL) + CW_BAR; bar.x = 0; bar.st = MISC;
    if (!MK_MULTI) bar = xcd_barrier_post((unsigned*)(a.ws + WS_CTL) + CW_BAR, MISC, wv0);
    const int lo = a.ph_lo, hi = a.ph_hi;
    int ph = 0;
#define PH_BEGIN(k) if (((PHSEL >> (k)) & 1) && (!MK_MULTI || (lo <= ph && ph < hi))) { Ctx F; { int t_ = wv0 * 64 + (int)lane_id_v(); asm volatile("" : "+v"(t_)); F.tid = t_; } F.lds = (LAS unsigned char*)lds_raw; F.lane = F.tid & 63; \
        F.wave = __builtin_amdgcn_readfirstlane(F.tid >> 6); F.G = gridDim.x; { int bx = blockIdx.x; asm volatile("" : "+s"(bx)); F.cid = bx; F.vcu = (F.G % 8 == 0) ? (bx % 8) * (F.G / 8) + bx / 8 : bx; } \
        unsigned char GAS* wsg_ = (unsigned char GAS*)a.ws; asm volatile("" : "+s"(wsg_)); unsigned char* ws = (unsigned char*)wsg_; float GAS* xog_ = (float GAS*)a.out; asm volatile("" : "+s"(xog_)); float* xo = (float*)xog_; int l = l_; asm volatile("" : "+s"(l)); (void)xo; (void)l; \
        for (int rep_ = 0; rep_ < (((DUPMASK >> (k)) & 1) ? 2 : 1); ++rep_) {
#define PH_END   } if (!MK_MULTI && ph + 1 < NPHASE) { XcdBarrier b2_ = bar; unsigned GAS* bp_ = (unsigned GAS*)b2_.bar; asm volatile("" : "+s"(bp_)); b2_.bar = (unsigned*)bp_; unsigned bx_ = b2_.x; asm volatile("" : "+s"(bx_)); b2_.x = bx_; xcd_barrier(b2_, wv0); } } ++ph;
#define W_PAR    ((const float*)(ws + WS_PAR))
#define W_XS     ((bf16_t*)(ws + WS_XS))
#define W_MODL   ((const float*)(ws + WS_MODV) + (size_t)l * 16 * 6144)
#define W_KVMOD  ((const float*)(ws + WS_KVMOD))
#define W_HB     ((bf16_t*)(ws + WS_H))
#define W_HKV    ((bf16_t*)(ws + WS_HKV))
#define W_KB     ((bf16_t*)(ws + WS_KB))
#define W_VB     ((bf16_t*)(ws + WS_VB))
#define W_XB     ((bf16_t*)(ws + WS_ARENA + AR_XB))
#define W_GY     ((bf16_t*)(ws + WS_ARENA + AR_GY))
#define W_HID    ((bf16_t*)(ws + WS_ARENA))
#define W_Q      ((bf16_t*)(ws + WS_ARENA + AR_Q))
#define W_O      ((bf16_t*)(ws + WS_ARENA + AR_O))
#define W_COS    ((const float*)(ws + WS_COS))
#define W_SIN    ((const float*)(ws + WS_SIN))
#define W_E12    ((int*)(ws + WS_E12))
#define W_W1     ((float*)(ws + WS_W1))
#define W_CNT    ((int*)(ws + WS_CNT))
#define W_TILE   ((int*)(ws + WS_TILE))
#define W_TOS    ((int*)(ws + WS_TOS))
#define W_WOS    ((float*)(ws + WS_WOS))

    { const int l_ = 0; PH_BEGIN(0) p0_prologue(F, a); PH_END }

#pragma unroll 1
    for (int l_ = 0; l_ < 4; ++l_) {
        if (l_ < 2) {
            PH_BEGIN(1) if (l == 0) norm_phase<false, false, false, true>(F, a.x, W_PAR + PAR_MIXN + l * DM, W_MODL, W_MODL + 1024, W_HB, nullptr, nullptr, nullptr, nullptr, nullptr, nullptr, nullptr, nullptr);
                        else norm_phase<false, false>(F, W_XS, W_PAR + PAR_MIXN + l * DM, W_MODL, W_MODL + 1024, W_HB, nullptr, nullptr, nullptr, nullptr, nullptr, nullptr, nullptr, nullptr); PH_END
#pragma unroll 1
            for (int sp_ = 0; sp_ < (DUP_SCANPAIR ? 2 : 1); ++sp_) {
            PH_BEGIN(2) { pg8::ProbDense P{W_HB, (const bf16_t*)(ws + WS_WIN) + (size_t)l * 2048 * DM, DM * 2}; pg8::Order S; S.init(NTOK / 256, 8, F.G, F.cid, 0);
                pg8::EpiWin E{W_XB, W_GY}; pg8::gemm_phase<pg8::EpiWin, pg8::ProbDense, false>(F.lds, F.tid, P, S, E); } PH_END
            PH_BEGIN(3) scan_phase(F, W_PAR, l, W_XB, W_GY, (const bf16_t*)(ws + WS_GW)); PH_END
            }
            if (l_ == 0) {
                PH_BEGIN(20) { pg8::ProbDense P{W_GY, (const bf16_t*)(ws + WS_WOUT), DM * 2}; pg8::Order S; S.init(NTOK / 256, 4, F.G, F.cid, 0, STAGGER_TICKS);
                    pg8::EpiResid<true> E{a.x, W_XS, W_MODL + 2048, 1.0f}; pg8::gemm_phase<pg8::EpiResid<true>, pg8::ProbDense, false>(F.lds, F.tid, P, S, E); } PH_END
            } else {
                PH_BEGIN(4) { pg8::ProbDense P{W_GY, (const bf16_t*)(ws + WS_WOUT) + (size_t)l * DM * DM, DM * 2}; pg8::Order S; S.init(NTOK / 256, 4, F.G, F.cid, 0, STAGGER_TICKS);
                    pg8::EpiResid<false> E{W_XS, W_XS, W_MODL + 2048, 1.0f}; pg8::gemm_phase<pg8::EpiResid<false>, pg8::ProbDense, false>(F.lds, F.tid, P, S, E); } PH_END
            }
        } else {
            PH_BEGIN(5) if (l == 2) norm_phase<true, false, (bool)FP8_QKV>(F, W_XS, W_PAR + PAR_MIXN + l * DM, W_MODL, W_MODL + 1024, W_HB, W_PAR + PAR_KVN, W_KVMOD, W_KVMOD + 1024, W_HKV, nullptr, nullptr, nullptr, nullptr);
                        else norm_phase<false, false, (bool)FP8_QKV>(F, W_XS, W_PAR + PAR_MIXN + l * DM, W_MODL, W_MODL + 1024, W_HB, nullptr, nullptr, nullptr, nullptr, nullptr, nullptr, nullptr, nullptr); PH_END
            if (l_ == 2) {
                PH_BEGIN(6) {
                    constexpr int KBQ = FP8_QKV ? DM : DM * 2; constexpr float ASQ = FP8_QKV ? 1.0f / (SC8_H * SC8_W) : 1.0f;
                    { pg8::ProbDense P{W_HKV, ws + WS_WKV, KBQ}; pg8::Order S; S.init(NTOK / 256, 2, F.G, F.cid, 0);
                      pg8::EpiQK E{W_KB, 256, W_PAR + PAR_KN, W_COS, W_SIN, 1.0f, 1, W_VB, ASQ}; pg8::gemm_phase<pg8::EpiQK, pg8::ProbDense, false, (bool)FP8_QKV>(F.lds, F.tid, P, S, E); }
                    { pg8::ProbDense P{W_HB, ws + WS_WQ, KBQ}; pg8::Order S; S.init(NTOK / 256, 4, F.G, F.cid, 0);
                      pg8::EpiQK E{W_Q, DM, W_PAR + PAR_QN, W_COS, W_SIN, 0.125f * LOG2E, -1, nullptr, ASQ}; pg8::gemm_phase<pg8::EpiQK, pg8::ProbDense, false, (bool)FP8_QKV>(F.lds, F.tid, P, S, E); } } PH_END
            } else {
                PH_BEGIN(21) { constexpr int KBQ = FP8_QKV ? DM : DM * 2; constexpr float ASQ = FP8_QKV ? 1.0f / (SC8_H * SC8_W) : 1.0f;
                    pg8::ProbDense P{W_HB, ws + WS_WQ + (size_t)DM * DM * 2, KBQ}; pg8::Order S; S.init(NTOK / 256, 4, F.G, F.cid, 0);
                    pg8::EpiQK E{W_Q, DM, W_PAR + PAR_QN + 64, W_COS, W_SIN, 0.125f * LOG2E, -1, nullptr, ASQ}; pg8::gemm_phase<pg8::EpiQK, pg8::ProbDense, false, (bool)FP8_QKV>(F.lds, F.tid, P, S, E); } PH_END
            }
            PH_BEGIN(7) attn_phase(F, W_Q, W_KB, W_VB, W_O, W_PAR + PAR_SINK + (l - 2) * 16); PH_END
            PH_BEGIN(8) { pg8::ProbDense P{W_O, ws + WS_WO + (size_t)(l - 2) * DM * DM * 2, FP8_WO ? DM : DM * 2}; pg8::Order S; S.init(NTOK / 256, 4, F.G, F.cid, 0, STAGGER_TICKS);
                pg8::EpiResid<false> E{W_XS, W_XS, W_MODL + 2048, FP8_WO ? 1.0f / (SC8_O * SC8_W) : 1.0f}; pg8::gemm_phase<pg8::EpiResid<false>, pg8::ProbDense, false, (bool)FP8_WO>(F.lds, F.tid, P, S, E); } PH_END
        }
        if (!(l_ & 1)) {
            PH_BEGIN(9) if (FP8_OF(0) | FP8_OF(2)) { if (FP8_DENSE(l)) norm_phase<false, false, true>(F, W_XS, W_PAR + PAR_FFNN + l * DM, W_MODL + 3072, W_MODL + 4096, W_HB, nullptr, nullptr, nullptr, nullptr, nullptr, nullptr, nullptr, nullptr);
                             else norm_phase<false, false, false>(F, W_XS, W_PAR + PAR_FFNN + l * DM, W_MODL + 3072, W_MODL + 4096, W_HB, nullptr, nullptr, nullptr, nullptr, nullptr, nullptr, nullptr, nullptr); }
                        else norm_phase<false, false, false>(F, W_XS, W_PAR + PAR_FFNN + l * DM, W_MODL + 3072, W_MODL + 4096, W_HB, nullptr, nullptr, nullptr, nullptr, nullptr, nullptr, nullptr, nullptr); PH_END
            if (FP8_DENSE(l_)) {
                PH_BEGIN(17) { pg8::ProbDense P{W_HB, ws + WS_FGU + (size_t)(l >> 1) * 6144 * DM * 2, DM}; pg8::Order S; S.init(NTOK / 256, 24, F.G, F.cid, 0);
                    pg8::EpiSwiglu<true> E{W_HID, DFF, 1.0f / (SC8_H * SC8_W)}; pg8::gemm_phase<pg8::EpiSwiglu<true>, pg8::ProbDense, false, true>(F.lds, F.tid, P, S, E); } PH_END
                PH_BEGIN(18) { pg8::ProbDense P{W_HID, ws + WS_FDN + (size_t)(l >> 1) * DM * DFF * 2, DFF}; pg8::Order S; S.init(NTOK / 256, 4, F.G, F.cid, 0, STAGGER_TICKS);
                    pg8::EpiResid<false> E{W_XS, W_XS, W_MODL + 5120, 1.0f / (SC8_HID * SC8_W)}; pg8::gemm_phase<pg8::EpiResid<false>, pg8::ProbDense, false, true>(F.lds, F.tid, P, S, E); } PH_END
            } else {
                PH_BEGIN(10) { pg8::ProbDense P{W_HB, (const bf16_t*)(ws + WS_FGU) + (size_t)(l >> 1) * 6144 * DM, DM * 2}; pg8::Order S; S.init(NTOK / 256, 24, F.G, F.cid, 0);
                    pg8::EpiSwiglu<false> E{W_HID, DFF, 1.0f}; pg8::gemm_phase<pg8::EpiSwiglu<false>, pg8::ProbDense, false>(F.lds, F.tid, P, S, E); } PH_END
                PH_BEGIN(11) { pg8::ProbDense P{W_HID, (const bf16_t*)(ws + WS_FDN) + (size_t)(l >> 1) * DM * DFF, DFF * 2}; pg8::Order S; S.init(NTOK / 256, 4, F.G, F.cid, 0, STAGGER_TICKS);
                    pg8::EpiResid<false> E{W_XS, W_XS, W_MODL + 5120, 1.0f}; pg8::gemm_phase<pg8::EpiResid<false>, pg8::ProbDense, false>(F.lds, F.tid, P, S, E); } PH_END
            }
        } else {
            PH_BEGIN(12) if (FP8_MOE(l)) norm_phase_pk<false, true, true>(F, W_XS, W_PAR + PAR_FFNN + l * DM, W_MODL + 3072, W_MODL + 4096, W_HB, nullptr, nullptr, nullptr, nullptr, W_PAR + PAR_ROUTER + (l >> 1) * DM * 8, W_E12, W_W1, W_CNT);
                         else norm_phase_pk<false, true, false>(F, W_XS, W_PAR + PAR_FFNN + l * DM, W_MODL + 3072, W_MODL + 4096, W_HB, nullptr, nullptr, nullptr, nullptr, W_PAR + PAR_ROUTER + (l >> 1) * DM * 8, W_E12, W_W1, W_CNT); PH_END
            PH_BEGIN(13) moe_scatter(F, W_CNT, W_E12, W_W1, W_TOS, W_WOS, W_TILE); PH_END
            if (FP8_MOE(l_)) {
                PH_BEGIN(16) {
                    LAS int* texp = (LAS int*)(F.lds + LDS_TEXP);
                    for (int i = F.tid; i < MAXTILES + 16; i += 512) texp[i] = W_TILE[i];
                    __syncthreads();
                    const int ntot = texp[1];
                    pg8::Order S; S.init(ntot, 28, F.G, F.cid, 0);
                    pg8::ProbGrouped P{W_HB, ws + WS_MGU + (size_t)(l >> 1) * 8 * 7168 * DM * 2, DM, 7168, texp + 16, W_TOS};
                    pg8::EpiSwiglu<true> E{W_HID, DFE, 1.0f / (SC8_H * SC8_W)}; pg8::gemm_phase<pg8::EpiSwiglu<true>, pg8::ProbGrouped, true, true>(F.lds, F.tid, P, S, E); } PH_END
            } else {
                PH_BEGIN(14) {
                    LAS int* texp = (LAS int*)(F.lds + LDS_TEXP);
                    for (int i = F.tid; i < MAXTILES + 16; i += 512) texp[i] = W_TILE[i];
                    __syncthreads();
                    const int ntot = texp[1];
                    pg8::Order S; S.init(ntot, 28, F.G, F.cid, 0);
                    pg8::ProbGrouped P{W_HB, (const bf16_t*)(ws + WS_MGU) + (size_t)(l >> 1) * 8 * 7168 * DM, DM * 2, 7168, texp + 16, W_TOS};
                    pg8::EpiSwiglu<false> E{W_HID, DFE, 1.0f}; pg8::gemm_phase<pg8::EpiSwiglu<false>, pg8::ProbGrouped, true, false>(F.lds, F.tid, P, S, E); } PH_END
            }
#pragma unroll 1
            for (int pass = 0; pass < 2; ++pass) {
                if (l_ == 3 && pass == 1) {
                    PH_BEGIN(19) {
                        LAS int* texp = (LAS int*)(F.lds + LDS_TEXP);
                        for (int i = F.tid; i < MAXTILES + 16; i += 512) texp[i] = W_TILE[i];
                        __syncthreads();
                        const int nA = texp[0], ntot = texp[1];
                        pg8::Order S; S.init(ntot - nA, 4, F.G, F.cid, nA, STAGGER_TICKS);
                        if (FP8_MOE(3)) { pg8::ProbGrouped P{W_HID, ws + WS_MDN + (size_t)8 * DM * DFE * 2, DFE, DM, texp + 16, W_TOS};
                            pg8::EpiMoeDown<true> E{W_XS, xo, W_MODL + 5120, W_TOS, W_WOS, 1.0f / (SC8_HID * SC8_W)}; pg8::gemm_phase<pg8::EpiMoeDown<true>, pg8::ProbGrouped, false, true>(F.lds, F.tid, P, S, E); }
                        else { pg8::ProbGrouped P{W_HID, (const bf16_t*)(ws + WS_MDN) + (size_t)8 * DM * DFE, DFE * 2, DM, texp + 16, W_TOS};
                            pg8::EpiMoeDown<true> E{W_XS, xo, W_MODL + 5120, W_TOS, W_WOS, 1.0f}; pg8::gemm_phase<pg8::EpiMoeDown<true>, pg8::ProbGrouped, false, false>(F.lds, F.tid, P, S, E); } } PH_END
                } else {
                    PH_BEGIN(15) {
                        LAS int* texp = (LAS int*)(F.lds + LDS_TEXP);
                        for (int i = F.tid; i < MAXTILES + 16; i += 512) texp[i] = W_TILE[i];
                        __syncthreads();
                        const int nA = texp[0], ntot = texp[1];
                        pg8::Order S; S.init(pass ? ntot - nA : nA, 4, F.G, F.cid, pass ? nA : 0, STAGGER_TICKS);
                        if (FP8_MOE(l)) { pg8::ProbGrouped P{W_HID, ws + WS_MDN + (size_t)(l >> 1) * 8 * DM * DFE * 2, DFE, DM, texp + 16, W_TOS};
                            pg8::EpiMoeDown<false> E{W_XS, W_XS, W_MODL + 5120, W_TOS, W_WOS, 1.0f / (SC8_HID * SC8_W)}; pg8::gemm_phase<pg8::EpiMoeDown<false>, pg8::ProbGrouped, false, true>(F.lds, F.tid, P, S, E); }
                        else { pg8::ProbGrouped P{W_HID, (const bf16_t*)(ws + WS_MDN) + (size_t)(l >> 1) * 8 * DM * DFE, DFE * 2, DM, texp + 16, W_TOS};
                            pg8::EpiMoeDown<false> E{W_XS, W_XS, W_MODL + 5120, W_TOS, W_WOS, 1.0f}; pg8::gemm_phase<pg8::EpiMoeDown<false>, pg8::ProbGrouped, false, false>(F.lds, F.tid, P, S, E); }
                        if (DEFER_L3 && l == 1) {
                            const int tail = S.nwg % F.G; const bool part = (tail > 0) && (2 * tail < F.G);
                            __syncthreads();
                            if (!part || F.cid >= tail) convert_deferred(F, a.m_w_gu, a.m_w_down, ws, pass, part ? F.cid - tail : F.cid, part ? F.G - tail : F.G);
                        } } PH_END
                }
            }
        }
    }
#undef PH_BEGIN
#undef PH_END
}

extern "C" void kernel_launch(void* const* d_in, const int* in_sizes, int n_in, void* d_out, int out_size, void* d_ws, size_t ws_size, hipStream_t stream) {
    static int grid = 0;
    if (grid == 0) {
        if (n_in != 30 || in_sizes[0] != NTOK * DM || out_size != NTOK * DM || ws_size < WS_END) { fprintf(stderr, "kernel_launch: unexpected shapes (n_in %d, in0 %d, out %d, ws %zu < %zu)\n", n_in, n_in > 0 ? in_sizes[0] : -1, out_size, ws_size, (size_t)WS_END); grid = -1; return; }
        int dev = 0, cus = 0, per_cu = 0;
        if (hipGetDevice(&dev) != hipSuccess || hipDeviceGetAttribute(&cus, hipDeviceAttributeMultiprocessorCount, dev) != hipSuccess) { grid = -1; return; }
        if (hipFuncSetAttribute((const void*)fwd_kernel, hipFuncAttributeMaxDynamicSharedMemorySize, LDS_BYTES) != hipSuccess) { fprintf(stderr, "kernel_launch: hipFuncSetAttribute failed\n"); grid = -1; return; }
        if (hipOccupancyMaxActiveBlocksPerMultiprocessor(&per_cu, (const void*)fwd_kernel, 512, LDS_BYTES) != hipSuccess || per_cu < 1) fprintf(stderr, "kernel_launch: occupancy query reports %d\n", per_cu);
        (void)hipGetLastError();
        grid = cus;
    }
    if (grid < 0) return;
    if (hipMemsetAsync((char*)d_ws + WS_CTL, 0, CTL_ZERO_BYTES, stream) != hipSuccess) return;
    Args a{};
    const float** fp = (const float**)&a;
    for (int i = 0; i < 30; ++i) fp[i] = (const float*)d_in[i];
    a.out = (float*)d_out; a.ws = (unsigned char*)d_ws;
#if MK_MULTI
    for (int p = 0; p < NPHASE; ++p) { a.ph_lo = p; a.ph_hi = p + 1; hipLaunchKernelGGL(fwd_kernel, dim3(grid), dim3(512), LDS_BYTES, stream, a); }
#else
    a.ph_lo = 0; a.ph_hi = NPHASE; hipLaunchKernelGGL(fwd_kernel, dim3(grid), dim3(512), LDS_BYTES, stream, a);
#endif
}
```

```cpp
#include <hip/hip_runtime.h>
#include <cstdio>
#include <cstdint>

#ifndef FP8MASK
#define FP8MASK 14
#endif
#define FP8_OF(l) (((FP8MASK) >> (l)) & 1)
#define FP8_MOE(l)   ((FP8_OF(1) && FP8_OF(3)) || ((FP8_OF(1) || FP8_OF(3)) && FP8_OF(l)))
#define FP8_DENSE(l) ((FP8_OF(0) && FP8_OF(2)) || ((FP8_OF(0) || FP8_OF(2)) && FP8_OF(l)))
#ifndef STAGGER_TICKS
#define STAGGER_TICKS 0
#endif
#ifndef DEFER_L3
#define DEFER_L3 1
#endif
#ifndef FP8_WO
#define FP8_WO 1
#endif
#ifndef FP8_QKV
#define FP8_QKV 1
#endif
#ifndef DUPMASK
#define DUPMASK 0
#endif
#ifndef DUP_SCANPAIR
#define DUP_SCANPAIR 0
#endif
#ifndef PHSEL
#define PHSEL 0xFFFFFFFFu
#endif
#ifndef MK_MULTI
#define MK_MULTI 0
#endif

#define LAS __attribute__((address_space(3)))
#define GAS __attribute__((address_space(1)))
typedef unsigned short bf16_t;
typedef short bf16x8 __attribute__((ext_vector_type(8)));
typedef short s16x4 __attribute__((ext_vector_type(4)));
typedef _Float16 h16x8 __attribute__((ext_vector_type(8)));
typedef float f32x2 __attribute__((ext_vector_type(2)));
typedef float f32x4 __attribute__((ext_vector_type(4)));
typedef float f32x16 __attribute__((ext_vector_type(16)));
typedef unsigned u32x2 __attribute__((ext_vector_type(2)));
typedef unsigned u32x4 __attribute__((ext_vector_type(4)));
typedef __bf16 bf16x2_t __attribute__((ext_vector_type(2)));
typedef int i32x4 __attribute__((ext_vector_type(4)));
typedef int i32x8 __attribute__((ext_vector_type(8)));
constexpr float SC8_H = 4.0f, SC8_W = 64.0f, SC8_HID = 8.0f, SC8_O = 64.0f;

constexpr int DM = 1024, BATCH = 16, SEQ = 4096, NTOK = BATCH * SEQ;
constexpr int DFF = 3072, NEXP = 8, DFE = 3584;
constexpr int NSLOT = 135168;
constexpr int MAXTILES = NSLOT / 256;
constexpr float EPS = 1e-6f;
constexpr float LOG2E = 1.4426950408889634f;

constexpr size_t MiB = 1u << 20;
constexpr size_t WS_CTL = 0, CTL_ZERO_BYTES = 1 * MiB;
constexpr size_t WS_MODV = 1 * MiB;
constexpr size_t WS_KVMOD = 3 * MiB;
constexpr size_t WS_PAR = 3 * MiB + 512 * 1024;
constexpr int PAR_MIXN = 0, PAR_FFNN = 4096, PAR_CONVW = 8192, PAR_CONVB = 16384, PAR_GXB = 18432, PAR_GAB = 20480, PAR_LAM = 22528, PAR_KVN = 24576, PAR_KN = 25600, PAR_QN = 25664, PAR_SINK = 25792, PAR_ROUTER = 25856, PAR_END = 42240;
constexpr size_t WS_E12 = 4 * MiB;
constexpr size_t WS_W1 = 5 * MiB;
constexpr size_t WS_CNT = 6 * MiB;
constexpr size_t WS_TILE = 6 * MiB + 65536;
constexpr size_t WS_TOS = 7 * MiB;
constexpr size_t WS_WOS = 8 * MiB;
constexpr size_t WS_GW = 9 * MiB;
constexpr size_t WS_COS = 10 * MiB;
constexpr size_t WS_SIN = 18 * MiB;
constexpr size_t WS_WIN = 26 * MiB;
constexpr size_t WS_WOUT = 34 * MiB;
constexpr size_t WS_WKV = 38 * MiB;
constexpr size_t WS_WQ = 39 * MiB;
constexpr size_t WS_WO = 43 * MiB;
constexpr size_t WS_FGU = 47 * MiB;
constexpr size_t WS_FDN = 71 * MiB;
constexpr size_t WS_MGU = 83 * MiB;
constexpr size_t WS_MDN = 307 * MiB;
constexpr size_t WS_H = 419 * MiB;
constexpr size_t WS_HKV = 547 * MiB;
constexpr size_t WS_KB = 675 * MiB;
constexpr size_t WS_VB = 707 * MiB;
constexpr size_t WS_ARENA = 739 * MiB;
constexpr size_t WS_XS = WS_ARENA + (size_t)NSLOT * DFE * 2;
constexpr size_t WS_END = WS_XS + (size_t)NTOK * DM * 2;
static_assert(WS_END <= (size_t)1792 * MiB, "workspace map");
constexpr size_t AR_XB = 0, AR_GY = 128 * MiB, AR_Q = 0, AR_O = 128 * MiB;

constexpr int CW_BAR = 4096;

constexpr int LDS_BYTES = 163840;
constexpr int RING_BYTES = 131072;
constexpr int LDS_TEXP = RING_BYTES;
constexpr int LDS_IDX = RING_BYTES + 4096;
constexpr int LDS_MISC = LDS_BYTES - 256;

__device__ __forceinline__ unsigned cvtpk(float lo, float hi) { f32x2 v = {lo, hi}; bf16x2_t b = __builtin_convertvector(v, bf16x2_t); return __builtin_bit_cast(unsigned, b); }
__device__ __forceinline__ float clamp8(float v) { return __builtin_amdgcn_fmed3f(v, -448.0f, 448.0f); }
__device__ __forceinline__ unsigned cvt4_fp8(float a, float b, float c, float d) { int p = __builtin_amdgcn_cvt_pk_fp8_f32(clamp8(a), clamp8(b), 0, false); p = __builtin_amdgcn_cvt_pk_fp8_f32(clamp8(c), clamp8(d), p, true); return (unsigned)p; }
__device__ __forceinline__ float bflo(unsigned p) { return __uint_as_float(p << 16); }
__device__ __forceinline__ float bfhi(unsigned p) { return __uint_as_float(p & 0xffff0000u); }
__device__ __forceinline__ float bf2f(unsigned short b) { return __uint_as_float(((unsigned)b) << 16); }
__device__ __forceinline__ float fast_exp2(float x) { return __builtin_amdgcn_exp2f(x); }
__device__ __forceinline__ float fast_rcp(float x) { return __builtin_amdgcn_rcpf(x); }
__device__ __forceinline__ float sigmoidf_(float x) { return fast_rcp(1.0f + fast_exp2(-x * LOG2E)); }
__device__ __forceinline__ float silu_(float x) { return x * sigmoidf_(x); }
__device__ __forceinline__ float gelu_tanh_(float x) { const float u = 0.7978845608028654f * (x + 0.044715f * x * x * x); return x * sigmoidf_(2.0f * u); }
__device__ __forceinline__ float shflx(float v, int lane, int o) { return __int_as_float(__builtin_amdgcn_ds_bpermute((lane ^ o) << 2, __float_as_int(v))); }
__device__ __forceinline__ float wave_sum(float v, int lane) {
#pragma unroll
    for (int o = 1; o < 64; o <<= 1) v += shflx(v, lane, o);
    return v;
}
template <int CTRL, int RM = 0xf, int BM = 0xf> __device__ __forceinline__ float dppf(float v) { return __int_as_float(__builtin_amdgcn_update_dpp(0, __float_as_int(v), CTRL, RM, BM, false)); }
__device__ __forceinline__ float wave_sum_dpp(float v) {
    float s = v + dppf<0x111>(v); s += dppf<0x112>(v); s += dppf<0x113>(v);
    s += dppf<0x114>(s); s += dppf<0x118>(s);
    s += dppf<0x142, 0xa>(s); s += dppf<0x143, 0xc>(s);
    return __int_as_float(__builtin_amdgcn_readlane(__float_as_int(s), 63));
}
__device__ __forceinline__ int lane_id_v() { int l; asm volatile("v_mbcnt_lo_u32_b32 %0, -1, 0\n\tv_mbcnt_hi_u32_b32 %0, -1, %0" : "=v"(l)); return l; }
#define LDS_WAIT() asm volatile("s_waitcnt lgkmcnt(0)" ::: "memory")
#define VM_WAIT() asm volatile("s_waitcnt vmcnt(0)" ::: "memory")

namespace pg8 {
constexpr int BM = 256, BK = 64, HALF = 128, HTB = HALF * BK * 2, STAGE_BYTES = 8 * HTB, NXCD = 8, WGM = 8;
__host__ __device__ __forceinline__ int lds_byte(int r, int c) { const int st = (r >> 4) * 2 + (c >> 5), rr = r & 15, cc = c & 31, ob = rr * 64 + cc * 2; return st * 1024 + (ob ^ (((ob >> 9) & 1) << 5)); }
__host__ __device__ __forceinline__ void stage_rc(int b, int& R, int& C) { const int st = b / 1024, sb = b % 1024, swz = sb ^ (((sb >> 9) & 1) << 5); R = (st >> 1) * 16 + swz / 64; C = (st & 1) * 32 + (swz % 64) / 2; }
__host__ __device__ __forceinline__ int perm32(int rho) { const int n = rho >> 4, i = rho & 15; return 8 * (i >> 2) + 4 * n + (i & 3); }

struct Unit { int pm, pn; };

struct Order {
    int nM, nN, nwg, G, c, tile0, delay, nig; unsigned mg;
    __device__ __forceinline__ void init(int nM_, int nN_, int G_, int c_, int tile0_, int delay_ = 0) { nM = nM_; nN = nN_; nwg = nM * nN; G = G_; c = c_; tile0 = tile0_; delay = ((c_ >> 3) & 1) ? delay_ : 0;
        nig = WGM * nN; mg = (unsigned)((0x100000000ull + (unsigned)nig - 1ull) / (unsigned)nig); }
    __device__ __forceinline__ bool next(int i, Unit& u) const {
        const int L = i * G + c; if (L >= nwg) return false;
        int wgid; { const int q = nwg >> 3, r = nwg & 7, xcd = L & 7, off = L >> 3; wgid = (xcd < r ? xcd * (q + 1) : r * (q + 1) + (xcd - r) * q) + off; }
        const int gid = (int)__umulhi((unsigned)wgid, mg), rem = wgid - gid * nig, fm = gid * WGM, gsz = (nM - fm) < WGM ? (nM - fm) : WGM;
        if (gsz == WGM) { u.pm = tile0 + fm + (rem & (WGM - 1)); u.pn = rem >> 3; }
        else { u.pm = tile0 + fm + rem % gsz; u.pn = rem / gsz; }
        return true;
    }
};

struct ProbDense {
    const void* A; const void* Bt; int KB;
    __device__ __forceinline__ const char* a_ptr(const Unit& u) const { return (const char*)A + (size_t)u.pm * BM * KB; }
    __device__ __forceinline__ const char* b_ptr(const Unit& u) const { return (const char*)Bt + (size_t)u.pn * BM * KB; }
};
struct ProbGrouped {
    const void* A; const void* Bt; int KB; int N; const LAS int* texp; const int* tos;
    __device__ __forceinline__ const char* a_ptr(const Unit& u) const { return (const char*)A + (size_t)u.pm * BM * KB; }
    __device__ __forceinline__ const char* b_ptr(const Unit& u) const { return (const char*)Bt + ((size_t)texp[u.pm] * N + (size_t)u.pn * BM) * KB; }
};

template <class Epi, class Prob, bool GATHER, bool FP8 = false>
__device__ __forceinline__ void gemm_phase(LAS unsigned char* lds, const int tid, const Prob P, const Order& S, const Epi& E) {
    const int wid = __builtin_amdgcn_readfirstlane(tid >> 6), lane = tid & 63, wr = wid >> 2, wc = wid & 3, fr = lane & 15, fq = lane >> 4;
    const int KB = P.KB, nt = KB / (BK * 2);
    unsigned voffA[2], voffB[2];
#pragma unroll
    for (int i = 0; i < 2; ++i) { int R, C; stage_rc(tid * 16 + i * 8192, R, C); const int Rb = Epi::PERM ? ((R & ~31) + perm32(R & 31)) : R;
        voffA[i] = GATHER ? (unsigned)(C * 2) : (unsigned)(R * KB + C * 2); voffB[i] = (unsigned)(Rb * KB + C * 2); }
    const size_t kstep = (size_t)(BK * 2);
    const size_t hstep = (size_t)HALF * KB;
    const unsigned ldsw = (unsigned)wid * 1024u;
    const int aoff = lds_byte(wr * 64 + fr, fq * 8), boff = lds_byte(wc * 32 + fr, fq * 8);
    LAS int* idxb = (LAS int*)(lds + LDS_IDX);
#define PG8_GIDX(buf) do { int ln_ = lane; asm volatile("" : "+v"(ln_)); _Pragma("unroll") for (int i = 0; i < 2; ++i) { const int R_ = 16 * ((wid + 8 * i) >> 1) + (ln_ >> 2); \
        int t0 = idxb[(buf) * 256 + R_], t1 = idxb[(buf) * 256 + 128 + R_]; t0 = t0 < 0 ? 0 : t0; t1 = t1 < 0 ? 0 : t1; \
        vC0[i] = (unsigned)t0 * (unsigned)KB + voffA[i]; vC1[i] = (unsigned)t1 * (unsigned)KB + voffA[i]; } } while (0)
#define PG8_GDMA(unit, buf) do { if (wid < 4) { int ln_ = lane; asm volatile("" : "+v"(ln_)); \
        __builtin_amdgcn_global_load_lds((const unsigned*)(P.tos + (size_t)(unit).pm * BM + wid * 64) + ln_, (LAS unsigned*)(idxb + (buf) * 256 + wid * 64), 4, 0, 0); } } while (0)
#define PG8_SA(b, h) (((b) * 2 + (h)) * HTB)
#define PG8_SB(b, h) ((4 + (b) * 2 + (h)) * HTB)
#define PG8_STAGE(bufoff, gbase, voff) do { const char* g_ = (const char*)(gbase); asm volatile("" : "+s"(g_)); _Pragma("unroll") for (int _i = 0; _i < 2; ++_i) \
        __builtin_amdgcn_global_load_lds((const unsigned*)(g_ + (voff)[_i]), (LAS unsigned*)(lds + (bufoff) + ldsw + _i * 8192), 16, 0, 0); } while (0)
#define PG8_LDA(dst, b, h) do { _Pragma("unroll") for (int m = 0; m < 4; ++m) _Pragma("unroll") for (int k = 0; k < 2; ++k) dst[m][k] = *(const LAS bf16x8*)(lds + PG8_SA(b, h) + aoff + m * 2048 + k * 1024); } while (0)
#define PG8_LDB(dst, b, h) do { _Pragma("unroll") for (int n = 0; n < 2; ++n) _Pragma("unroll") for (int k = 0; k < 2; ++k) dst[n][k] = *(const LAS bf16x8*)(lds + PG8_SB(b, h) + boff + n * 2048 + k * 1024); } while (0)
#define PG8_CAT8(v) __builtin_shufflevector(__builtin_bit_cast(i32x4, (v)[0]), __builtin_bit_cast(i32x4, (v)[1]), 0, 1, 2, 3, 4, 5, 6, 7)
#define PG8_MMA(ai, bj, At, Bt) do { __builtin_amdgcn_s_setprio(1); if constexpr (FP8) asm volatile("s_nop 1"); _Pragma("unroll") for (int m = 0; m < 4; ++m) _Pragma("unroll") for (int n = 0; n < 2; ++n) { \
        if constexpr (FP8) { const i32x8 b8_ = PG8_CAT8(Bt[n]), a8_ = PG8_CAT8(At[m]);   \
            asm volatile("v_mfma_f32_16x16x128_f8f6f4 %0, %1, %2, %0" : "+v"(acc[ai][bj][m][n]) : "v"(b8_), "v"(a8_)); }     \
        else { _Pragma("unroll") for (int k = 0; k < 2; ++k) acc[ai][bj][m][n] = __builtin_amdgcn_mfma_f32_16x16x32_bf16(Bt[n][k], At[m][k], acc[ai][bj][m][n], 0, 0, 0); } } __builtin_amdgcn_s_setprio(0); } while (0)
#define PG8_WAIT_V(n) asm volatile("s_waitcnt vmcnt(" #n ")" ::: "memory")
#define PG8_WAIT_L(n) asm volatile("s_waitcnt lgkmcnt(" #n ")" ::: "memory")
#define PG8_BAR __builtin_amdgcn_s_barrier()
#define PG8_SCHED __builtin_amdgcn_sched_barrier(0)
    Unit cur, nxt; int ui = 0;
    if (!S.next(0, cur)) return;
    if (S.delay) { const unsigned long long t0_ = __builtin_amdgcn_s_memrealtime(); while (__builtin_amdgcn_s_memrealtime() - t0_ < (unsigned long long)S.delay) __builtin_amdgcn_s_sleep(8); }
    f32x4 acc[2][2][4][2];
#pragma unroll
    for (int a = 0; a < 2; ++a)
#pragma unroll
        for (int b = 0; b < 2; ++b)
#pragma unroll
            for (int m = 0; m < 4; ++m)
#pragma unroll
                for (int n = 0; n < 2; ++n) acc[a][b][m][n] = (f32x4){0.f, 0.f, 0.f, 0.f};
    bf16x8 At[4][2], B0[2][2], B1[2][2];
    unsigned vC0[2], vC1[2];
    const char* cA; const char* cB = P.b_ptr(cur);
    if constexpr (GATHER) {
        cA = (const char*)P.A;
        PG8_GDMA(cur, 0);
        PG8_WAIT_V(0); PG8_BAR;
        PG8_GIDX(0);
        LDS_WAIT(); PG8_BAR;
    } else {
        cA = P.a_ptr(cur);
#pragma unroll
        for (int i = 0; i < 2; ++i) { vC0[i] = voffA[i]; vC1[i] = voffA[i] + (unsigned)hstep; }
    }
    PG8_STAGE(PG8_SB(0, 0), cB, voffB); PG8_STAGE(PG8_SB(0, 1), cB + hstep, voffB); PG8_STAGE(PG8_SA(0, 0), cA, vC0); PG8_STAGE(PG8_SA(0, 1), cA, vC1);
    if (wr == 1) PG8_BAR;
    PG8_WAIT_V(2); PG8_BAR;
    PG8_STAGE(PG8_SB(1, 0), cB + kstep, voffB); PG8_STAGE(PG8_SA(1, 0), cA + kstep, vC0); PG8_STAGE(PG8_SB(1, 1), cB + hstep + kstep, voffB);
    PG8_WAIT_V(6); PG8_BAR;
    for (;;) {
        const bool has_next = S.next(ui + 1, nxt);
        const char* nA = GATHER ? cA : (has_next ? P.a_ptr(nxt) : cA); const char* nB = has_next ? P.b_ptr(nxt) : cB;
        for (int t = 0; t < nt; t += 2) {
            const bool last = (t == nt - 2);
            if constexpr (GATHER) {
                if (t == 0 && has_next) PG8_GDMA(nxt, (ui + 1) & 1);
            }
            const char* a1 = cA + (size_t)(t + 1) * kstep;
            const char* a2 = last ? nA : cA + (size_t)(t + 2) * kstep; const char* b2 = last ? nB : cB + (size_t)(t + 2) * kstep;
            const char* a3 = a2 + kstep; const char* b3 = b2 + kstep;
            PG8_LDB(B0, 0, 0); PG8_LDB(B1, 0, 1); PG8_SCHED; PG8_LDA(At, 0, 0); PG8_STAGE(PG8_SA(1, 1), a1, vC1);
            if constexpr (GATHER) { if (last && has_next) PG8_GIDX((ui + 1) & 1); }
            PG8_WAIT_V(8); PG8_WAIT_L(0); PG8_BAR; PG8_MMA(0, 0, At, B0); PG8_MMA(0, 1, At, B1); PG8_BAR; PG8_SCHED;
            PG8_LDA(At, 0, 1); PG8_STAGE(PG8_SB(0, 0), b2, voffB); PG8_STAGE(PG8_SB(0, 1), b2 + hstep, voffB); PG8_STAGE(PG8_SA(0, 0), a2, vC0);
            PG8_WAIT_V(8); PG8_WAIT_L(0); PG8_BAR; PG8_MMA(1, 0, At, B0); PG8_MMA(1, 1, At, B1); PG8_BAR; PG8_SCHED;
            PG8_LDB(B0, 1, 0); PG8_LDB(B1, 1, 1); PG8_SCHED; PG8_LDA(At, 1, 0); PG8_STAGE(PG8_SA(0, 1), a2, vC1);
            PG8_WAIT_V(8); PG8_WAIT_L(0); PG8_BAR; PG8_MMA(0, 0, At, B0); PG8_MMA(0, 1, At, B1); PG8_BAR; PG8_SCHED;
            PG8_LDA(At, 1, 1); PG8_STAGE(PG8_SB(1, 0), b3, voffB); PG8_STAGE(PG8_SB(1, 1), b3 + hstep, voffB); PG8_STAGE(PG8_SA(1, 0), a3, vC0);
            PG8_WAIT_V(8); PG8_WAIT_L(0); PG8_BAR; PG8_MMA(1, 0, At, B0); PG8_MMA(1, 1, At, B1); PG8_BAR; PG8_SCHED;
        }
        if constexpr (FP8) { asm volatile("s_nop 15\n\ts_nop 15" ::: "memory"); PG8_SCHED; }
        if (wr == 0) PG8_BAR;
        { const int ln_ = lane_id_v(); int fr_ = ln_ & 15, fq_ = ln_ >> 4; asm volatile("" : "+v"(fr_), "+v"(fq_)); E(acc, cur, wr, wc, fr_, fq_); }
        if (!has_next) break;
#pragma unroll
        for (int a = 0; a < 2; ++a)
#pragma unroll
            for (int b = 0; b < 2; ++b)
#pragma unroll
                for (int m = 0; m < 4; ++m)
#pragma unroll
                    for (int n = 0; n < 2; ++n) acc[a][b][m][n] = (f32x4){0.f, 0.f, 0.f, 0.f};
        cur = nxt; cA = nA; cB = nB; ++ui;
        if (wr == 1) PG8_BAR;
    }
    PG8_WAIT_V(0);
    PG8_BAR;
#undef PG8_SA
#undef PG8_GIDX
#undef PG8_GDMA
#undef PG8_SB
#undef PG8_STAGE
#undef PG8_LDA
#undef PG8_LDB
#undef PG8_MMA
#undef PG8_CAT8
#undef PG8_WAIT_V
#undef PG8_WAIT_L
#undef PG8_BAR
#undef PG8_SCHED
}

template <bool INF32> struct EpiResid {
    static constexpr bool PERM = true;
    const void* xin; bf16_t* xout; const float* gate; float ascale;
    __device__ __forceinline__ void operator()(const f32x4 (&acc)[2][2][4][2], const Unit& u, int wr, int wc, int fr, int fq) const {
        const int row0 = u.pm * BM + wr * 64 + fr, col0 = u.pn * BM + wc * 32 + 8 * fq;
        const float* gp = gate + (size_t)((u.pm * BM) >> 12) * 6144 + col0;
        f32x4 gv[2][2];
#pragma unroll
        for (int bj = 0; bj < 2; ++bj)
#pragma unroll
            for (int n = 0; n < 2; ++n) gv[bj][n] = (*(const f32x4*)(gp + bj * HALF + 4 * n) + 1.0f) * ascale;
#pragma unroll
        for (int ai = 0; ai < 2; ++ai) {
            f32x4 xv[4][2][2];
#pragma unroll
            for (int m = 0; m < 4; ++m) { const size_t off = (size_t)(row0 + ai * HALF + m * 16) * DM + col0;
#pragma unroll
                for (int bj = 0; bj < 2; ++bj) {
                    if constexpr (INF32) { xv[m][bj][0] = *(const f32x4*)((const float*)xin + off + bj * HALF); xv[m][bj][1] = *(const f32x4*)((const float*)xin + off + bj * HALF + 4); }
                    else { const u32x4 p = *(const u32x4*)((const bf16_t*)xin + off + bj * HALF);
                        xv[m][bj][0] = (f32x4){bflo(p.x), bfhi(p.x), bflo(p.y), bfhi(p.y)}; xv[m][bj][1] = (f32x4){bflo(p.z), bfhi(p.z), bflo(p.w), bfhi(p.w)}; } } }
#pragma unroll
            for (int m = 0; m < 4; ++m) { const size_t off = (size_t)(row0 + ai * HALF + m * 16) * DM + col0;
#pragma unroll
                for (int bj = 0; bj < 2; ++bj) { const f32x4 o0 = xv[m][bj][0] + gv[bj][0] * acc[ai][bj][m][0], o1 = xv[m][bj][1] + gv[bj][1] * acc[ai][bj][m][1];
                    u32x4 w; w.x = cvtpk(o0[0], o0[1]); w.y = cvtpk(o0[2], o0[3]); w.z = cvtpk(o1[0], o1[1]); w.w = cvtpk(o1[2], o1[3]);
                    *(u32x4*)(xout + off + bj * HALF) = w; } }
            asm volatile("" ::: "memory"); }
    }
};
template <bool OUTF32> struct EpiMoeDown {
    static constexpr bool PERM = true;
    const bf16_t* xs; void* xo; const float* gate; const int* tos; const float* wos; float ascale;
    __device__ __forceinline__ void operator()(const f32x4 (&acc)[2][2][4][2], const Unit& u, int wr, int wc, int fr, int fq) const {
        const int slot0 = u.pm * BM + wr * 64 + fr, col0 = u.pn * BM + wc * 32 + 8 * fq;
        int tok[2][4]; float w[2][4];
#pragma unroll
        for (int ai = 0; ai < 2; ++ai)
#pragma unroll
            for (int m = 0; m < 4; ++m) { const int slot = slot0 + ai * HALF + m * 16; tok[ai][m] = tos[slot]; w[ai][m] = wos[slot] * ascale; }
#pragma unroll
        for (int ai = 0; ai < 2; ++ai) {
            u32x4 xv[4][2];
#pragma unroll
            for (int m = 0; m < 4; ++m) { const int t = tok[ai][m] < 0 ? 0 : tok[ai][m]; const bf16_t* xp = xs + (size_t)t * DM + col0;
#pragma unroll
                for (int bj = 0; bj < 2; ++bj) xv[m][bj] = *(const u32x4*)(xp + bj * HALF); }
#pragma unroll
            for (int m = 0; m < 4; ++m) { const int t = tok[ai][m];
                if (t >= 0) { const float* gp = gate + (size_t)(t >> 12) * 6144 + col0; const size_t off = (size_t)t * DM + col0;
#pragma unroll
                    for (int bj = 0; bj < 2; ++bj) { const u32x4 p = xv[m][bj];
                        const f32x4 g0 = (*(const f32x4*)(gp + bj * HALF) + 1.0f) * w[ai][m], g1 = (*(const f32x4*)(gp + bj * HALF + 4) + 1.0f) * w[ai][m];
                        const f32x4 o0 = (f32x4){bflo(p.x), bfhi(p.x), bflo(p.y), bfhi(p.y)} + g0 * acc[ai][bj][m][0], o1 = (f32x4){bflo(p.z), bfhi(p.z), bflo(p.w), bfhi(p.w)} + g1 * acc[ai][bj][m][1];
                        if constexpr (OUTF32) { *(f32x4*)((float*)xo + off + bj * HALF) = o0; *(f32x4*)((float*)xo + off + bj * HALF + 4) = o1; }
                        else { u32x4 q; q.x = cvtpk(o0[0], o0[1]); q.y = cvtpk(o0[2], o0[3]); q.z = cvtpk(o1[0], o1[1]); q.w = cvtpk(o1[2], o1[3]); *(u32x4*)((bf16_t*)xo + off + bj * HALF) = q; } } } }
            asm volatile("" ::: "memory"); }
    }
};
template <bool OUT8> struct EpiSwiglu {
    static constexpr bool PERM = true;
    void* O; int ldo; float ascale;
    __device__ __forceinline__ void operator()(const f32x4 (&acc)[2][2][4][2], const Unit& u, int wr, int wc, int fr, int fq) const {
        const int row0 = u.pm * BM + wr * 64 + fr, col0 = u.pn * HALF + wc * 32 + 8 * fq;
        const float nl2 = -ascale * LOG2E, ios = 1.0f / (ascale * ascale * (OUT8 ? SC8_HID : 1.0f));
        const f32x2 nl2v = {nl2, nl2}, iosv = {ios, ios};
#pragma unroll
        for (int ai = 0; ai < 2; ++ai)
#pragma unroll
            for (int m = 0; m < 4; ++m) { const size_t eo = (size_t)(row0 + ai * HALF + m * 16) * ldo + col0;
                float v[8];
#pragma unroll
                for (int n = 0; n < 2; ++n)
#pragma unroll
                    for (int h = 0; h < 2; ++h) {
                        const f32x2 g = {acc[ai][0][m][n][2 * h], acc[ai][0][m][n][2 * h + 1]}, up = {acc[ai][1][m][n][2 * h], acc[ai][1][m][n][2 * h + 1]};
                        const f32x2 t = g * nl2v; const f32x2 e = {fast_exp2(t.x), fast_exp2(t.y)};
                        const f32x2 d = e * iosv + iosv; const f32x2 r = {fast_rcp(d.x), fast_rcp(d.y)};
                        const f32x2 o = (g * up) * r; v[4 * n + 2 * h] = o.x; v[4 * n + 2 * h + 1] = o.y; }
                if constexpr (OUT8) { u32x2 w; w.x = cvt4_fp8(v[0], v[1], v[2], v[3]); w.y = cvt4_fp8(v[4], v[5], v[6], v[7]);
                    *(u32x2*)((unsigned char*)O + eo) = w; }
                else { u32x4 w; w.x = cvtpk(v[0], v[1]); w.y = cvtpk(v[2], v[3]); w.z = cvtpk(v[4], v[5]); w.w = cvtpk(v[6], v[7]);
                    *(u32x4*)((bf16_t*)O + eo) = w; } }
    }
};
struct EpiWin {
    static constexpr bool PERM = true;
    bf16_t* XB; bf16_t* GY;
    __device__ __forceinline__ void operator()(const f32x4 (&acc)[2][2][4][2], const Unit& u, int wr, int wc, int fr, int fq) const {
        const bool act = u.pn >= 4; bf16_t* base = act ? GY : XB;
        const int row0 = u.pm * BM + wr * 64 + fr, col0 = (u.pn & 3) * BM + wc * 32 + 8 * fq;
#pragma unroll
        for (int ai = 0; ai < 2; ++ai)
#pragma unroll
            for (int m = 0; m < 4; ++m) { bf16_t* rowp = base + (size_t)(row0 + ai * HALF + m * 16) * DM + col0;
#pragma unroll
                for (int bj = 0; bj < 2; ++bj) { f32x4 v0 = acc[ai][bj][m][0], v1 = acc[ai][bj][m][1];
                    if (act) {
#pragma unroll
                        for (int j = 0; j < 4; ++j) { v0[j] = gelu_tanh_(v0[j]); v1[j] = gelu_tanh_(v1[j]); } }
                    u32x4 w; w.x = cvtpk(v0[0], v0[1]); w.y = cvtpk(v0[2], v0[3]); w.z = cvtpk(v1[0], v1[1]); w.w = cvtpk(v1[2], v1[3]);
                    *(u32x4*)(rowp + bj * HALF) = w; } }
    }
};
struct EpiQK {
    static constexpr bool PERM = true;
    bf16_t* O; int ldo; const float* gain; const _Float16* tab; float oscale; int vtile; bf16_t* OV; float as;
    __device__ __forceinline__ void operator()(const f32x4 (&acc)[2][2][4][2], const Unit& u, int wr, int wc, int fr, int fq) const {
        const int row0 = u.pm * BM + wr * 64 + fr;
        if (u.pn == vtile) {
            const int col0 = wc * 32 + 8 * fq;
#pragma unroll
            for (int ai = 0; ai < 2; ++ai)
#pragma unroll
                for (int m = 0; m < 4; ++m) { bf16_t* rowp = OV + (size_t)(row0 + ai * HALF + m * 16) * ldo + col0;
#pragma unroll
                    for (int bj = 0; bj < 2; ++bj) { const f32x4 v0 = acc[ai][bj][m][0] * as, v1 = acc[ai][bj][m][1] * as;
                        u32x4 w; w.x = cvtpk(v0[0], v0[1]); w.y = cvtpk(v0[2], v0[3]); w.z = cvtpk(v1[0], v1[1]); w.w = cvtpk(v1[2], v1[3]);
                        *(u32x4*)(rowp + bj * HALF) = w; } }
            return;
        }
        const int colh = (u.pn * 4 + wc) * 64 + 8 * fq;
        f32x4 g1[2], g2[2];
#pragma unroll
        for (int n = 0; n < 2; ++n) { g1[n] = *(const f32x4*)(gain + 8 * fq + 4 * n); g2[n] = *(const f32x4*)(gain + 32 + 8 * fq + 4 * n); }
#pragma unroll
        for (int ai = 0; ai < 2; ++ai) {
            h16x8 tc[4], ts[4];
#pragma unroll
            for (int m = 0; m < 4; ++m) { const _Float16* tp = tab + (size_t)(row0 + ai * HALF + m * 16) * 64 + 8 * fq; tc[m] = *(const h16x8*)tp; ts[m] = *(const h16x8*)(tp + 32); }
#pragma unroll
            for (int m = 0; m < 4; ++m) { const int row = row0 + ai * HALF + m * 16;
                float ss = 0.f;
#pragma unroll
                for (int bj = 0; bj < 2; ++bj)
#pragma unroll
                    for (int n = 0; n < 2; ++n) { const f32x4 a = acc[ai][bj][m][n]; ss += (a[0] * a[0] + a[1] * a[1]) + (a[2] * a[2] + a[3] * a[3]); }
                { const int ln_ = fq * 16 + fr; ss += shflx(ss, ln_, 16); ss += shflx(ss, ln_, 32); }
                const float r = __builtin_amdgcn_rsqf(ss * (as * as * (1.0f / 64.0f)) + EPS) * (oscale * as);
                float o1[8], o2[8];
#pragma unroll
                for (int n = 0; n < 2; ++n) { const f32x4 c = {(float)tc[m][4 * n], (float)tc[m][4 * n + 1], (float)tc[m][4 * n + 2], (float)tc[m][4 * n + 3]}, s = {(float)ts[m][4 * n], (float)ts[m][4 * n + 1], (float)ts[m][4 * n + 2], (float)ts[m][4 * n + 3]};
                    const f32x4 x1 = acc[ai][0][m][n] * g1[n] * r, x2 = acc[ai][1][m][n] * g2[n] * r;
                    const f32x4 a = x1 * c - x2 * s, b = x2 * c + x1 * s;
#pragma unroll
                    for (int j = 0; j < 4; ++j) { o1[4 * n + j] = a[j]; o2[4 * n + j] = b[j]; } }
                bf16_t* rowp = O + (size_t)row * ldo + colh;
                u32x4 w; w.x = cvtpk(o1[0], o1[1]); w.y = cvtpk(o1[2], o1[3]); w.z = cvtpk(o1[4], o1[5]); w.w = cvtpk(o1[6], o1[7]);
                *(u32x4*)rowp = w;
                w.x = cvtpk(o2[0], o2[1]); w.y = cvtpk(o2[2], o2[3]); w.z = cvtpk(o2[4], o2[5]); w.w = cvtpk(o2[6], o2[7]);
                *(u32x4*)(rowp + 32) = w; }
            asm volatile("" ::: "memory"); }
    }
};
}

#define XB_TMO      128
#define XB_XCNT(j)  (256  + 64 * (j))
#define XB_XSUB(j)  (1280 + 64 * (j))
#define XB_XGEN(j)  (2304 + 64 * (j))
#define XB_TOP      3328
#define XB_TOPGEN   3392
#define XCD_BAR_WORDS 3456
#define XB_SPIN_CAP (1u << 20)
__device__ __forceinline__ unsigned xb_ld(unsigned* p)              { return __hip_atomic_load(p, __ATOMIC_RELAXED, __HIP_MEMORY_SCOPE_AGENT); }
__device__ __forceinline__ unsigned xb_add(unsigned* p, unsigned v) { return __hip_atomic_fetch_add(p, v, __ATOMIC_RELAXED, __HIP_MEMORY_SCOPE_AGENT); }
__device__ __forceinline__ unsigned xb_xcc_id() { return (unsigned)__builtin_amdgcn_s_getreg((3 << 11) | 20) & 0xFu; }
#define XB_SPIN(cond, bar) do { unsigned _sp = 0; while (cond) { __builtin_amdgcn_s_sleep(1); \
    if ((++_sp & 255u) == 0u) { if (xb_ld(&(bar)[XB_TMO])) break; if (_sp > XB_SPIN_CAP) { atomicAdd(&(bar)[XB_TMO], 1u); break; } } } } while (0)
struct XcdBarrier { unsigned* bar; unsigned x; volatile LAS unsigned* st; };
__device__ __forceinline__ XcdBarrier xcd_barrier_post(unsigned* bar, volatile LAS unsigned* st, int wv) {
    XcdBarrier b; b.bar = bar; b.x = xb_xcc_id(); b.st = st;
    if (wv == 0 && lane_id_v() == 0) (void)xb_add(&bar[XB_XCNT(b.x)], 1u);
    return b;
}
__device__ __forceinline__ void xcd_barrier_complete(unsigned* bar, unsigned x, unsigned& nloc, unsigned& nx) {
    const unsigned G = gridDim.x * gridDim.y * gridDim.z;
    unsigned sum, cnt, mine, sp = 0u;
    for (;;) {
        sum = 0u; cnt = 0u; mine = 0u;
#pragma unroll
        for (unsigned j = 0; j < 16; ++j) { const unsigned c = xb_ld(&bar[XB_XCNT(j)]); sum += c; cnt += (c > 0u) ? 1u : 0u; }
        mine = xb_ld(&bar[XB_XCNT(x)]);
        if (sum == G) break;
        __builtin_amdgcn_s_sleep(1);
        if ((++sp & 255u) == 0u) { if (xb_ld(&bar[XB_TMO])) break; if (sp > XB_SPIN_CAP) { atomicAdd(&bar[XB_TMO], 1u); break; } }
    }
    nloc = mine > 0u ? mine : 1u; nx = cnt > 0u ? cnt : 1u;
}
__device__ __forceinline__ void xcd_barrier(const XcdBarrier& b, int wv) {
    asm volatile("s_waitcnt vmcnt(0)" ::: "memory");
    __syncthreads();
    if (wv == 0 && lane_id_v() == 0) {
        unsigned* bar = b.bar;
        __builtin_amdgcn_s_waitcnt(0);
        unsigned nloc = b.st[0], nx = b.st[1];
        if (nloc == 0u) { xcd_barrier_complete(bar, b.x, nloc, nx); b.st[0] = nloc; b.st[1] = nx; }
        const unsigned old = xb_add(&bar[XB_XSUB(b.x)], 1u);
        const unsigned gen = old / nloc;
        if (old + 1u == (gen + 1u) * nloc) {
            __builtin_amdgcn_fence(__ATOMIC_RELEASE, "agent");
            asm volatile("s_waitcnt vmcnt(0)" ::: "memory");
            const unsigned og = xb_add(&bar[XB_TOP], 1u);
            const unsigned tg = og / nx;
            if (og + 1u == (tg + 1u) * nx) xb_add(&bar[XB_TOPGEN], 1u);
            else XB_SPIN(xb_ld(&bar[XB_TOPGEN]) == tg, bar);
            __builtin_amdgcn_fence(__ATOMIC_ACQUIRE, "agent");
            xb_add(&bar[XB_XGEN(b.x)], 1u);
            asm volatile("s_waitcnt vmcnt(0)" ::: "memory");
        } else {
            XB_SPIN(xb_ld(&bar[XB_XGEN(b.x)]) == gen, bar);
            __builtin_amdgcn_fence(__ATOMIC_ACQUIRE, "agent");
            asm volatile("s_waitcnt vmcnt(0)" ::: "memory");
        }
    }
    __syncthreads();
}

struct Args {
    const float* x; const float* c; const int* pos; const float* ada_w; const float* ada_b; const float* mix_norm; const float* ffn_norm;
    const float* a_w_in; const float* a_conv_w; const float* a_conv_b; const float* a_gx_w; const float* a_gx_b; const float* a_ga_w; const float* a_ga_b;
    const float* a_lambda; const float* a_w_out; const float* kv_norm; const float* kv_ada_w; const float* kv_ada_b; const float* w_kv; const float* k_norm;
    const float* b_w_q; const float* b_q_norm; const float* b_sinks; const float* b_w_o; const float* f_w_gu; const float* f_w_down; const float* m_router;
    const float* m_w_gu; const float* m_w_down;
    float* out; unsigned char* ws; int ph_lo, ph_hi;
};

struct Ctx {
    LAS unsigned char* lds; int tid, lane, wave, vcu, G, cid;
};

struct TrItem { const float* src; unsigned char* dst; int N, K, d0, d1, f8; };
__device__ __forceinline__ void tr_load(const TrItem& t, f32x4 (&v)[16], int lane) {
    const int kr = lane >> 4, nq = lane & 15;
#pragma unroll
    for (int i = 0; i < 16; ++i) v[i] = *(const f32x4*)(t.src + (size_t)(4 * i + kr) * t.N + 4 * nq);
}
__device__ __forceinline__ void tr_to_lds(const f32x4 (&v)[16], LAS float* scr, int lane) {
    const int kr = lane >> 4, nq = lane & 15;
#pragma unroll
    for (int i = 0; i < 16; ++i) { const int k = 4 * i + kr; *(LAS f32x4*)(scr + k * 68 + ((4 * nq) ^ (4 * ((k >> 3) & 7)))) = v[i]; }
}
__device__ __forceinline__ void tr_finish(const TrItem& t, LAS float* scr, int lane) {
    const int c = lane & 7, r = lane >> 3;
    if (t.f8) {
#pragma unroll
        for (int j = 0; j < 8; ++j) { const int n = 8 * j + r; const LAS float* s = scr + (8 * c) * 68 + (n ^ (4 * c)); const int drow = ((n & 32) ? t.d1 : t.d0) + (n & 31);
            u32x2 o; o.x = cvt4_fp8(s[0 * 68] * SC8_W, s[1 * 68] * SC8_W, s[2 * 68] * SC8_W, s[3 * 68] * SC8_W); o.y = cvt4_fp8(s[4 * 68] * SC8_W, s[5 * 68] * SC8_W, s[6 * 68] * SC8_W, s[7 * 68] * SC8_W);
            *(u32x2*)(t.dst + (size_t)drow * t.K + 8 * c) = o; }
    } else {
#pragma unroll
        for (int j = 0; j < 8; ++j) { const int n = 8 * j + r; const LAS float* s = scr + (8 * c) * 68 + (n ^ (4 * c)); const int drow = ((n & 32) ? t.d1 : t.d0) + (n & 31);
            u32x4 o; o.x = cvtpk(s[0 * 68], s[1 * 68]); o.y = cvtpk(s[2 * 68], s[3 * 68]); o.z = cvtpk(s[4 * 68], s[5 * 68]); o.w = cvtpk(s[6 * 68], s[7 * 68]);
            *(u32x4*)(t.dst + ((size_t)drow * t.K + 8 * c) * 2) = o; }
    }
}
__device__ __forceinline__ int map_plain(int n) { return n; }
__device__ __forceinline__ int map_head(int n) { const int hd = n >> 6, d = n & 63; return 256 * (hd >> 2) + 128 * (d >> 5) + 32 * (hd & 3) + (d & 31); }
__device__ __forceinline__ int map_gu(int n, int F) { const int u = n >= F, j = u ? n - F : n; return 256 * (j >> 7) + 128 * u + (j & 127); }

__device__ __forceinline__ void p0_prologue(const Ctx& F, const Args& a) {
    unsigned char* ws = a.ws;
    {
        LAS float* cs = (LAS float*)F.lds;
        LAS float* red = (LAS float*)(F.lds + 65536);
        for (int i = F.tid; i < BATCH * DM; i += 512) { const int b = i >> 10, k = i & 1023; const float v = a.c[i]; cs[k * 16 + b] = silu_(v); }
        __syncthreads();
        float* modv = (float*)(ws + WS_MODV); float* kvmod = (float*)(ws + WS_KVMOD);
        constexpr int NC = 4 * 6144 + 2048, CPB = 104;
        for (int cb = F.vcu; cb * CPB < NC; cb += F.G) {
            const int cl = F.tid & 127, kp = F.tid >> 7, j = cb * CPB + cl;
            const bool on = (cl < CPB) && (j < NC);
            float accv[16];
#pragma unroll
            for (int b = 0; b < 16; ++b) accv[b] = 0.f;
            if (on) {
                const float* W; int ldw, jj;
                if (j < 4 * 6144) { const int l = j / 6144; jj = j - l * 6144; W = a.ada_w + (size_t)l * DM * 6144; ldw = 6144; } else { jj = j - 4 * 6144; W = a.kv_ada_w; ldw = 2048; }
                const float* wp = W + (size_t)(kp * 256) * ldw + jj;
#pragma unroll 1
                for (int k0 = 0; k0 < 256; k0 += 16) {
                    float wv[16];
#pragma unroll
                    for (int kk = 0; kk < 16; ++kk) wv[kk] = wp[(size_t)(k0 + kk) * ldw];
#pragma unroll
                    for (int kk = 0; kk < 16; ++kk) { const float w = wv[kk]; const LAS f32x4* cv = (const LAS f32x4*)(cs + (kp * 256 + k0 + kk) * 16);
#pragma unroll
                        for (int q = 0; q < 4; ++q) { const f32x4 c4 = cv[q]; accv[4 * q] += w * c4[0]; accv[4 * q + 1] += w * c4[1]; accv[4 * q + 2] += w * c4[2]; accv[4 * q + 3] += w * c4[3]; } } }
            }
#pragma unroll
            for (int b = 0; b < 16; ++b) red[(kp * 128 + cl) * 16 + b] = accv[b];
            __syncthreads();
            for (int i = F.tid; i < CPB * 16; i += 512) { const int cl2 = i >> 4, b = i & 15, j2 = cb * CPB + cl2;
                if (j2 < NC) { const float s = (red[(0 * 128 + cl2) * 16 + b] + red[(1 * 128 + cl2) * 16 + b]) + (red[(2 * 128 + cl2) * 16 + b] + red[(3 * 128 + cl2) * 16 + b]);
                    if (j2 < 4 * 6144) { const int l = j2 / 6144, jj = j2 - l * 6144; modv[((size_t)l * 16 + b) * 6144 + jj] = s + a.ada_b[l * 6144 + jj]; }
                    else { const int jj = j2 - 4 * 6144; kvmod[(size_t)b * 2048 + jj] = s + a.kv_ada_b[jj]; } } }
            __syncthreads();
        }
    }
    {
        LAS float* scr = (LAS float*)(F.lds + F.wave * 17408);
        const int gw = F.vcu * 8 + F.wave, NGW = F.G * 8;
        constexpr int I_WIN = 16 * 32, I_SQ = 16 * 16, I_KV = 16 * 8, I_FGU = 16 * 96, I_FDN = 48 * 16, I_MGU = 16 * 112, I_MDN = 56 * 16;
        constexpr int NMOE = DEFER_L3 ? 8 : 16;
        constexpr int NITEMS = 2 * I_WIN + 2 * I_SQ + I_KV + 2 * I_SQ + 2 * I_SQ + 2 * I_FGU + 2 * I_FDN + NMOE * I_MGU + NMOE * I_MDN;
        auto decode = [&](int it) -> TrItem {
            TrItem t; int r = it; const float* W; unsigned char* D; int K, N, kb, n0, f8 = 0, mapk = 0, F = 0;
            if (r < 2 * I_WIN) { const int mi = r / I_WIN, rr = r % I_WIN; n0 = 64 * (rr % 32); kb = rr / 32; K = DM; N = 2048; W = a.a_w_in + (size_t)mi * DM * 2048; D = ws + WS_WIN + (size_t)mi * 2048 * DM * 2; }
            else if ((r -= 2 * I_WIN) < 2 * I_SQ) { const int mi = r / I_SQ, rr = r % I_SQ; n0 = 64 * (rr % 16); kb = rr / 16; K = DM; N = DM; W = a.a_w_out + (size_t)mi * DM * DM; D = ws + WS_WOUT + (size_t)mi * DM * DM * 2; }
            else if ((r -= 2 * I_SQ) < I_KV) { n0 = 64 * (r % 8); kb = r / 8; K = DM; N = 512; W = a.w_kv; D = ws + WS_WKV; mapk = 3; f8 = FP8_QKV; }
            else if ((r -= I_KV) < 2 * I_SQ) { const int mi = r / I_SQ, rr = r % I_SQ; n0 = 64 * (rr % 16); kb = rr / 16; K = DM; N = DM; W = a.b_w_q + (size_t)mi * DM * DM; D = ws + WS_WQ + (size_t)mi * DM * DM * 2; mapk = 1; f8 = FP8_QKV; }
            else if ((r -= 2 * I_SQ) < 2 * I_SQ) { const int mi = r / I_SQ, rr = r % I_SQ; n0 = 64 * (rr % 16); kb = rr / 16; K = DM; N = DM; W = a.b_w_o + (size_t)mi * DM * DM; D = ws + WS_WO + (size_t)mi * DM * DM * 2; f8 = FP8_WO; }
            else if ((r -= 2 * I_SQ) < 2 * I_FGU) { const int mi = r / I_FGU, rr = r % I_FGU; n0 = 64 * (rr % 96); kb = rr / 96; K = DM; N = 6144; W = a.f_w_gu + (size_t)mi * DM * 6144; D = ws + WS_FGU + (size_t)mi * 6144 * DM * 2; f8 = FP8_OF(2 * mi); mapk = 2; F = DFF; }
            else if ((r -= 2 * I_FGU) < 2 * I_FDN) { const int mi = r / I_FDN, rr = r % I_FDN; n0 = 64 * (rr % 16); kb = rr / 16; K = DFF; N = DM; W = a.f_w_down + (size_t)mi * DFF * DM; D = ws + WS_FDN + (size_t)mi * DM * DFF * 2; f8 = FP8_OF(2 * mi); }
            else if ((r -= 2 * I_FDN) < NMOE * I_MGU) { const int mi = r / I_MGU, rr = r % I_MGU; n0 = 64 * (rr % 112); kb = rr / 112; K = DM; N = 7168; W = a.m_w_gu + (size_t)mi * DM * 7168; f8 = FP8_OF(2 * (mi >> 3) + 1); mapk = 2; F = DFE;
                D = ws + WS_MGU + (size_t)(mi >> 3) * 8 * 7168 * DM * 2 + (size_t)(mi & 7) * 7168 * DM * (f8 ? 1 : 2); }
            else { r -= NMOE * I_MGU; const int mi = r / I_MDN, rr = r % I_MDN; n0 = 64 * (rr % 16); kb = rr / 16; K = DFE; N = DM; W = a.m_w_down + (size_t)mi * DFE * DM; f8 = FP8_OF(2 * (mi >> 3) + 1);
                D = ws + WS_MDN + (size_t)(mi >> 3) * 8 * DM * DFE * 2 + (size_t)(mi & 7) * DM * DFE * (f8 ? 1 : 2); }
            t.src = W + (size_t)(64 * kb) * N + n0; t.dst = D + (size_t)(64 * kb) * (f8 ? 1 : 2); t.N = N; t.K = K; t.f8 = f8;
            if (mapk == 1 || (mapk == 3 && n0 < 256)) { t.d0 = map_head(n0); t.d1 = map_head(n0 + 32); }
            else if (mapk == 2) { t.d0 = map_gu(n0, F); t.d1 = map_gu(n0 + 32, F); }
            else { t.d0 = n0; t.d1 = n0 + 32; }
            return t; };
        f32x4 tv[16];
        int it = gw;
        TrItem cur = decode(it < NITEMS ? it : 0);
        if (it < NITEMS) tr_load(cur, tv, F.lane);
        for (; it < NITEMS; it += NGW) {
            tr_to_lds(tv, scr, F.lane);
            const bool hn = it + NGW < NITEMS;
            const TrItem nxt = decode(hn ? it + NGW : it);
            if (hn) tr_load(nxt, tv, F.lane);
            LDS_WAIT(); asm volatile("" ::: "memory");
            tr_finish(cur, scr, F.lane);
            LDS_WAIT(); asm volatile("" ::: "memory");
            cur = nxt;
        }
        __syncthreads();
    }
    {
        float* par = (float*)(ws + WS_PAR);
        const size_t gt0 = (size_t)F.vcu * 512 + F.tid, GT0 = (size_t)F.G * 512;
        for (size_t i = gt0; i < (size_t)PAR_END; i += GT0) { const int j = (int)i; float v;
            if (j < PAR_FFNN) v = a.mix_norm[j - PAR_MIXN]; else if (j < PAR_CONVW) v = a.ffn_norm[j - PAR_FFNN]; else if (j < PAR_CONVB) v = a.a_conv_w[j - PAR_CONVW];
            else if (j < PAR_GXB) v = a.a_conv_b[j - PAR_CONVB]; else if (j < PAR_GAB) v = a.a_gx_b[j - PAR_GXB]; else if (j < PAR_LAM) v = a.a_ga_b[j - PAR_GAB];
            else if (j < PAR_KVN) v = a.a_lambda[j - PAR_LAM]; else if (j < PAR_KN) v = a.kv_norm[j - PAR_KVN]; else if (j < PAR_QN) v = a.k_norm[j - PAR_KN];
            else if (j < PAR_SINK) v = a.b_q_norm[j - PAR_QN]; else if (j < PAR_ROUTER) v = a.b_sinks[j - PAR_SINK]; else v = a.m_router[j - PAR_ROUTER];
            par[j] = v; }
    }
    {
        const size_t gt = (size_t)F.vcu * 512 + F.tid, GT = (size_t)F.G * 512;
        bf16_t* gwp = (bf16_t*)(ws + WS_GW);
        for (size_t i = gt; i < (size_t)2 * 8 * 2 * 128 * 128; i += GT) { const int k = (int)(i & 127), j = (int)((i >> 7) & 127), c2 = (int)((i >> 14) & 1), n = (int)((i >> 15) & 7), l = (int)(i >> 18);
            const float* g = (j < 64) ? a.a_ga_w : a.a_gx_w; const float v = g[((size_t)(l * 8 + n) * 128 + k) * 128 + 64 * c2 + (j & 63)];
            gwp[i] = (bf16_t)(cvtpk(v, 0.f) & 0xffffu); }
        _Float16* tab = (_Float16*)(ws + WS_COS);
        for (size_t i = gt; i < (size_t)NTOK * 32; i += GT) { const int p = (int)(i & 31); const size_t tok = i >> 5;
            const float inv = powf(10000.0f, -(float)(2 * p) / 64.0f); const float ang = (float)a.pos[tok] * inv;
            tab[tok * 64 + p] = (_Float16)cosf(ang); tab[tok * 64 + 32 + p] = (_Float16)sinf(ang); }
    }
}

__device__ __forceinline__ void convert_deferred(const Ctx& F, const float* m_w_gu, const float* m_w_down, unsigned char* ws, int half, int j, int nb) {
    constexpr int I_MGU = 16 * 112, I_MDN = 56 * 16, NIT = 8 * I_MGU + 8 * I_MDN;
    LAS float* scr = (LAS float*)(F.lds + F.wave * 17408);
    auto decode = [&](int it) -> TrItem {
        TrItem t; int r = it; const float* W; unsigned char* D; int K, N, kb, n0; const int f8 = FP8_OF(3);
        if (r < 8 * I_MGU) { const int e = r / I_MGU, rr = r % I_MGU; n0 = 64 * (rr % 112); kb = rr / 112; K = DM; N = 7168; W = m_w_gu + (size_t)(8 + e) * DM * 7168;
            D = ws + WS_MGU + (size_t)8 * 7168 * DM * 2 + (size_t)e * 7168 * DM * (f8 ? 1 : 2); t.d0 = map_gu(n0, DFE); t.d1 = map_gu(n0 + 32, DFE); }
        else { r -= 8 * I_MGU; const int e = r / I_MDN, rr = r % I_MDN; n0 = 64 * (rr % 16); kb = rr / 16; K = DFE; N = DM; W = m_w_down + (size_t)(8 + e) * DFE * DM;
            D = ws + WS_MDN + (size_t)8 * DM * DFE * 2 + (size_t)e * DM * DFE * (f8 ? 1 : 2); t.d0 = n0; t.d1 = n0 + 32; }
        t.src = W + (size_t)(64 * kb) * N + n0; t.dst = D + (size_t)(64 * kb) * (f8 ? 1 : 2); t.N = N; t.K = K; t.f8 = f8;
        return t; };
    const int lo = half ? NIT / 2 : 0, hi = half ? NIT : NIT / 2, step = nb * 8;
    f32x4 tv[16];
    int it = lo + j * 8 + F.wave;
    TrItem cur = decode(it < hi ? it : lo);
    if (it < hi) tr_load(cur, tv, F.lane);
    for (; it < hi; it += step) {
        tr_to_lds(tv, scr, F.lane);
        const bool hn = it + step < hi;
        const TrItem nxt = decode(hn ? it + step : it);
        if (hn) tr_load(nxt, tv, F.lane);
        LDS_WAIT(); asm volatile("" ::: "memory");
        tr_finish(cur, scr, F.lane);
        LDS_WAIT(); asm volatile("" ::: "memory");
        cur = nxt;
    }
}

template <bool DUAL, bool ROUTER, bool OUT8 = false, bool INF32 = false>
__device__ __forceinline__ void norm_phase(const Ctx& F, const void* x, const float* gain1, const float* sh1, const float* sc1, void* out1,
                                           const float* gain2, const float* sh2, const float* sc2, bf16_t* out2,
                                           const float* wrouter, int* e12, float* w1o, int* cnt) {
    LAS int* lcnt = (LAS int*)F.lds;
    for (int rb = F.vcu; rb < NTOK / 256; rb += F.G) {
        const int b = rb >> 4;
        if (ROUTER) { if (F.tid < 16) lcnt[F.tid] = 0; __syncthreads(); }
        float ca[16], cs[16], ca2[16], cs2[16];
#pragma unroll
        for (int j = 0; j < 4; ++j) { const int col = 4 * F.lane + 256 * j;
            const f32x4 g = *(const f32x4*)(gain1 + col), s = *(const f32x4*)(sc1 + (size_t)b * 6144 + col), h = *(const f32x4*)(sh1 + (size_t)b * 6144 + col);
#pragma unroll
            for (int q = 0; q < 4; ++q) { ca[4 * j + q] = g[q] * (1.0f + s[q]); cs[4 * j + q] = h[q]; }
            if (DUAL) { const f32x4 g2 = *(const f32x4*)(gain2 + col), s2 = *(const f32x4*)(sc2 + (size_t)b * 2048 + col), h2 = *(const f32x4*)(sh2 + (size_t)b * 2048 + col);
#pragma unroll
                for (int q = 0; q < 4; ++q) { ca2[4 * j + q] = g2[q] * (1.0f + s2[q]); cs2[4 * j + q] = h2[q]; } } }
        float wr_[ROUTER ? 128 : 1];
        if (ROUTER) {
#pragma unroll
            for (int j = 0; j < 4; ++j)
#pragma unroll
                for (int q = 0; q < 4; ++q) { const int col = 4 * F.lane + 256 * j + q; const f32x4 w0 = *(const f32x4*)(wrouter + (size_t)col * 8), w1 = *(const f32x4*)(wrouter + (size_t)col * 8 + 4);
#pragma unroll
                    for (int e = 0; e < 4; ++e) { wr_[(4 * j + q) * 8 + e] = w0[e]; wr_[(4 * j + q) * 8 + 4 + e] = w1[e]; } }
        }
        int me12 = 0; float mw1 = 0.f;
        const int rowb = rb * 256 + F.wave * 32;
        f32x4 nf[INF32 ? 4 : 1]; u32x2 nb[INF32 ? 1 : 4], nc[INF32 ? 1 : 4];
        if constexpr (ROUTER) { const u32x2* xr = (const u32x2*)((const bf16_t*)x + (size_t)rowb * DM) + F.lane;
#pragma unroll
            for (int j = 0; j < 4; ++j) nb[j] = xr[64 * j]; }
        else if constexpr (INF32) { const f32x4* xr = (const f32x4*)((const float*)x + (size_t)rowb * DM) + F.lane;
#pragma unroll
            for (int j = 0; j < 4; ++j) nf[j] = xr[64 * j]; }
        else { const u32x2* xr = (const u32x2*)((const bf16_t*)x + (size_t)rowb * DM) + F.lane;
#pragma unroll
            for (int j = 0; j < 4; ++j) { nb[j] = xr[64 * j]; nc[j] = xr[64 * j + DM / 4]; } }
        for (int rr = 0; rr < 32; ++rr) {
            const size_t row = (size_t)(rowb + rr);
            f32x4 v[4]; float s = 0.f;
            if constexpr (ROUTER) {
#pragma unroll
                for (int j = 0; j < 4; ++j) { const u32x2 p = nb[j]; v[j] = (f32x4){bflo(p.x), bfhi(p.x), bflo(p.y), bfhi(p.y)}; }
                if (rr + 1 < 32) { const u32x2* xr = (const u32x2*)((const bf16_t*)x + (row + 1) * DM) + F.lane;
#pragma unroll
                    for (int j = 0; j < 4; ++j) nb[j] = xr[64 * j]; } }
            else if constexpr (INF32) {
#pragma unroll
                for (int j = 0; j < 4; ++j) v[j] = nf[j];
                if (rr + 1 < 32) { const f32x4* xr = (const f32x4*)((const float*)x + (row + 1) * DM) + F.lane;
#pragma unroll
                    for (int j = 0; j < 4; ++j) nf[j] = xr[64 * j]; } }
            else {
#pragma unroll
                for (int j = 0; j < 4; ++j) { const u32x2 p = nb[j]; v[j] = (f32x4){bflo(p.x), bfhi(p.x), bflo(p.y), bfhi(p.y)}; nb[j] = nc[j]; }
                if (rr + 2 < 32) { const u32x2* xr = (const u32x2*)((const bf16_t*)x + (row + 2) * DM) + F.lane;
#pragma unroll
                    for (int j = 0; j < 4; ++j) nc[j] = xr[64 * j]; } }
#pragma unroll
            for (int j = 0; j < 4; ++j) s += (v[j][0] * v[j][0] + v[j][1] * v[j][1]) + (v[j][2] * v[j][2] + v[j][3] * v[j][3]);
            const float r = __builtin_amdgcn_rsqf(wave_sum(s, F.lane) * (1.0f / DM) + EPS);
            float hv[16];
#pragma unroll
            for (int j = 0; j < 4; ++j)
#pragma unroll
                for (int q = 0; q < 4; ++q) hv[4 * j + q] = v[j][q] * r * ca[4 * j + q] + cs[4 * j + q];
            if constexpr (OUT8) { unsigned* o4 = (unsigned*)((unsigned char*)out1 + row * DM) + F.lane;
#pragma unroll
                for (int j = 0; j < 4; ++j) o4[64 * j] = cvt4_fp8(hv[4 * j] * SC8_H, hv[4 * j + 1] * SC8_H, hv[4 * j + 2] * SC8_H, hv[4 * j + 3] * SC8_H); }
            else { u32x2* o8 = (u32x2*)((bf16_t*)out1 + row * DM) + F.lane;
#pragma unroll
                for (int j = 0; j < 4; ++j) { u32x2 w; w.x = cvtpk(hv[4 * j], hv[4 * j + 1]); w.y = cvtpk(hv[4 * j + 2], hv[4 * j + 3]); o8[64 * j] = w; } }
            if (DUAL) { u32x2* p8 = (u32x2*)(out2 + row * DM) + F.lane; unsigned* q8 = (unsigned*)((unsigned char*)out2 + row * DM) + F.lane;
#pragma unroll
                for (int j = 0; j < 4; ++j) { float t[4];
#pragma unroll
                    for (int q = 0; q < 4; ++q) t[q] = v[j][q] * r * ca2[4 * j + q] + cs2[4 * j + q];
                    if constexpr (OUT8) q8[64 * j] = cvt4_fp8(t[0] * SC8_H, t[1] * SC8_H, t[2] * SC8_H, t[3] * SC8_H);
                    else { u32x2 w; w.x = cvtpk(t[0], t[1]); w.y = cvtpk(t[2], t[3]); p8[64 * j] = w; } } }
            if (ROUTER) {
                float pe[8];
#pragma unroll
                for (int e = 0; e < 8; ++e) { float p = 0.f;
#pragma unroll
                    for (int c = 0; c < 16; ++c) p += hv[c] * wr_[c * 8 + e];
                    pe[e] = p; }
                { const bool b0 = F.lane & 1, b1 = F.lane & 2, b2 = F.lane & 4;
#pragma unroll
                  for (int e = 0; e < 8; e += 2) { const float snd = b0 ? pe[e] : pe[e + 1], kp = b0 ? pe[e + 1] : pe[e]; pe[e >> 1] = kp + shflx(snd, F.lane, 1); }
#pragma unroll
                  for (int i = 0; i < 4; i += 2) { const float snd = b1 ? pe[i] : pe[i + 1], kp = b1 ? pe[i + 1] : pe[i]; pe[i >> 1] = kp + shflx(snd, F.lane, 2); }
                  { const float snd = b2 ? pe[0] : pe[1], kp = b2 ? pe[1] : pe[0]; pe[0] = kp + shflx(snd, F.lane, 4); }
                  pe[0] += shflx(pe[0], F.lane, 8); pe[0] += shflx(pe[0], F.lane, 16); pe[0] += shflx(pe[0], F.lane, 32); }
                float lg[8];
#pragma unroll
                for (int e = 0; e < 8; ++e) lg[e] = __int_as_float(__builtin_amdgcn_readlane(__float_as_int(pe[0]), e));
                int i1 = 0; float v1 = lg[0];
#pragma unroll
                for (int e = 1; e < 8; ++e) if (lg[e] > v1) { v1 = lg[e]; i1 = e; }
                int i2 = -1; float v2 = -INFINITY;
#pragma unroll
                for (int e = 0; e < 8; ++e) if (e != i1 && lg[e] > v2) { v2 = lg[e]; i2 = e; }
                const float wt = 1.0f / (1.0f + __expf(v2 - v1));
                if (F.lane == rr) { me12 = i1 | (i2 << 8); mw1 = wt; }
            }
        }
        if (ROUTER) {
            if (F.lane < 32) { e12[rowb + F.lane] = me12; w1o[rowb + F.lane] = mw1; }
            const int e1 = me12 & 255, e2 = me12 >> 8;
#pragma unroll
            for (int e = 0; e < 8; ++e) { const unsigned long long m1 = __ballot(F.lane < 32 && e1 == e), m2 = __ballot(F.lane < 32 && e2 == e);
                if (F.lane == 0) { atomicAdd((int*)&lcnt[e], (int)__popcll(m1)); atomicAdd((int*)&lcnt[8 + e], (int)__popcll(m2)); } }
            __syncthreads();
            if (F.tid < 16) cnt[rb * 16 + F.tid] = lcnt[F.tid];
            __syncthreads();
        }
    }
}

template <bool DUAL, bool ROUTER, bool OUT8 = false, bool INF32 = false>
__device__ __forceinline__ void norm_phase_pk(const Ctx& F, const void* x, const float* gain1, const float* sh1, const float* sc1, void* out1,
                                           const float* gain2, const float* sh2, const float* sc2, bf16_t* out2,
                                           const float* wrouter, int* e12, float* w1o, int* cnt) {
    LAS int* lcnt = (LAS int*)F.lds;
    constexpr float SH = OUT8 ? SC8_H : 1.0f;
    for (int rb = F.vcu; rb < NTOK / 256; rb += F.G) {
        const int b = rb >> 4;
        if (ROUTER) { if (F.tid < 16) lcnt[F.tid] = 0; __syncthreads(); }
        f32x2 ca[8], cs[8], cb[DUAL ? 8 : 1], cd[DUAL ? 8 : 1];
#pragma unroll
        for (int j = 0; j < 4; ++j) { const int col = 4 * F.lane + 256 * j;
            const f32x4 g = *(const f32x4*)(gain1 + col), sc = *(const f32x4*)(sc1 + (size_t)b * 6144 + col), h = *(const f32x4*)(sh1 + (size_t)b * 6144 + col);
#pragma unroll
            for (int hh = 0; hh < 2; ++hh) { ca[2 * j + hh] = (f32x2){g[2 * hh] * (1.0f + sc[2 * hh]) * SH, g[2 * hh + 1] * (1.0f + sc[2 * hh + 1]) * SH}; cs[2 * j + hh] = (f32x2){h[2 * hh] * SH, h[2 * hh + 1] * SH}; }
            if constexpr (DUAL) { const f32x4 g2 = *(const f32x4*)(gain2 + col), s2 = *(const f32x4*)(sc2 + (size_t)b * 2048 + col), h2 = *(const f32x4*)(sh2 + (size_t)b * 2048 + col);
#pragma unroll
                for (int hh = 0; hh < 2; ++hh) { cb[2 * j + hh] = (f32x2){g2[2 * hh] * (1.0f + s2[2 * hh]), g2[2 * hh + 1] * (1.0f + s2[2 * hh + 1])}; cd[2 * j + hh] = (f32x2){h2[2 * hh], h2[2 * hh + 1]}; } } }
        f32x2 wr2[ROUTER ? 16 : 1][4];
        if constexpr (ROUTER) {
#pragma unroll
            for (int j = 0; j < 4; ++j)
#pragma unroll
                for (int q = 0; q < 4; ++q) { const int col = 4 * F.lane + 256 * j + q; const f32x4 w0 = *(const f32x4*)(wrouter + (size_t)col * 8), w1 = *(const f32x4*)(wrouter + (size_t)col * 8 + 4);
                    wr2[4 * j + q][0] = (f32x2){w0[0], w0[1]} * (1.0f / SH); wr2[4 * j + q][1] = (f32x2){w0[2], w0[3]} * (1.0f / SH); wr2[4 * j + q][2] = (f32x2){w1[0], w1[1]} * (1.0f / SH); wr2[4 * j + q][3] = (f32x2){w1[2], w1[3]} * (1.0f / SH); }
        }
        int me12 = 0; float mw1 = 0.f;
        const int rowb = rb * 256 + F.wave * 32;
        f32x4 nf[INF32 ? 4 : 1]; u32x2 nb[INF32 ? 1 : 4], nc[INF32 ? 1 : 4];
        if constexpr (INF32) { const f32x4* xr = (const f32x4*)((const float*)x + (size_t)rowb * DM) + F.lane;
#pragma unroll
            for (int j = 0; j < 4; ++j) nf[j] = xr[64 * j]; }
        else { const u32x2* xr = (const u32x2*)((const bf16_t*)x + (size_t)rowb * DM) + F.lane;
#pragma unroll
            for (int j = 0; j < 4; ++j) { nb[j] = xr[64 * j]; nc[j] = xr[64 * j + DM / 4]; } }
        for (int rr = 0; rr < 32; ++rr) {
            const size_t row = (size_t)(rowb + rr);
            f32x2 v[8];
            if constexpr (INF32) {
#pragma unroll
                for (int j = 0; j < 4; ++j) { v[2 * j] = (f32x2){nf[j][0], nf[j][1]}; v[2 * j + 1] = (f32x2){nf[j][2], nf[j][3]}; }
                if (rr + 1 < 32) { const f32x4* xr = (const f32x4*)((const float*)x + (row + 1) * DM) + F.lane;
#pragma unroll
                    for (int j = 0; j < 4; ++j) nf[j] = xr[64 * j]; } }
            else {
#pragma unroll
                for (int j = 0; j < 4; ++j) { const u32x2 p = nb[j]; v[2 * j] = (f32x2){bflo(p.x), bfhi(p.x)}; v[2 * j + 1] = (f32x2){bflo(p.y), bfhi(p.y)}; nb[j] = nc[j]; }
                if (rr + 2 < 32) { const u32x2* xr = (const u32x2*)((const bf16_t*)x + (row + 2) * DM) + F.lane;
#pragma unroll
                    for (int j = 0; j < 4; ++j) nc[j] = xr[64 * j]; } }
            f32x2 sq = v[0] * v[0];
#pragma unroll
            for (int i = 1; i < 8; ++i) sq += v[i] * v[i];
            const float r = __builtin_amdgcn_rsqf(wave_sum_dpp(sq.x + sq.y) * (1.0f / DM) + EPS);
            const f32x2 r2 = {r, r};
            f32x2 hv[8];
#pragma unroll
            for (int i = 0; i < 8; ++i) { v[i] = v[i] * r2; hv[i] = v[i] * ca[i] + cs[i]; }
            if constexpr (OUT8) { unsigned* o4 = (unsigned*)((unsigned char*)out1 + row * DM) + F.lane;
#pragma unroll
                for (int j = 0; j < 4; ++j) o4[64 * j] = cvt4_fp8(hv[2 * j].x, hv[2 * j].y, hv[2 * j + 1].x, hv[2 * j + 1].y); }
            else { u32x2* o8 = (u32x2*)((bf16_t*)out1 + row * DM) + F.lane;
#pragma unroll
                for (int j = 0; j < 4; ++j) { u32x2 w; w.x = cvtpk(hv[2 * j].x, hv[2 * j].y); w.y = cvtpk(hv[2 * j + 1].x, hv[2 * j + 1].y); o8[64 * j] = w; } }
            if constexpr (DUAL) { u32x2* p8 = (u32x2*)(out2 + row * DM) + F.lane;
#pragma unroll
                for (int j = 0; j < 4; ++j) { const f32x2 t0 = v[2 * j] * cb[2 * j] + cd[2 * j], t1 = v[2 * j + 1] * cb[2 * j + 1] + cd[2 * j + 1];
                    u32x2 w; w.x = cvtpk(t0.x, t0.y); w.y = cvtpk(t1.x, t1.y); p8[64 * j] = w; } }
            if constexpr (ROUTER) {
                f32x2 pp[4];
#pragma unroll
                for (int k = 0; k < 4; ++k) pp[k] = (f32x2){0.f, 0.f};
#pragma unroll
                for (int c = 0; c < 16; ++c) { const float hc = (c & 1) ? hv[c >> 1].y : hv[c >> 1].x; const f32x2 h2 = {hc, hc};
#pragma unroll
                    for (int k = 0; k < 4; ++k) pp[k] += h2 * wr2[c][k]; }
                float pe[8];
#pragma unroll
                for (int k = 0; k < 4; ++k) { pe[2 * k] = pp[k].x; pe[2 * k + 1] = pp[k].y; }
                { const bool b0 = F.lane & 1, b1 = F.lane & 2, b2 = F.lane & 4;
#pragma unroll
                  for (int e = 0; e < 4; ++e) { const float snd = b2 ? pe[e] : pe[e + 4], kp = b2 ? pe[e + 4] : pe[e]; pe[e] = kp + dppf<0x141>(snd); }
#pragma unroll
                  for (int e = 0; e < 2; ++e) { const float snd = b1 ? pe[e] : pe[e + 2], kp = b1 ? pe[e + 2] : pe[e]; pe[e] = kp + dppf<0x4E>(snd); }
                  { const float snd = b0 ? pe[0] : pe[1], kp = b0 ? pe[1] : pe[0]; pe[0] = kp + dppf<0xB1>(snd); }
                  pe[0] += dppf<0x128>(pe[0]); pe[0] += shflx(pe[0], F.lane, 16); pe[0] += shflx(pe[0], F.lane, 32); }
                float lg[8];
#pragma unroll
                for (int e = 0; e < 8; ++e) lg[e] = __int_as_float(__builtin_amdgcn_readlane(__float_as_int(pe[0]), e));
                int i1 = 0; float v1 = lg[0];
#pragma unroll
                for (int e = 1; e < 8; ++e) if (lg[e] > v1) { v1 = lg[e]; i1 = e; }
                int i2 = -1; float v2 = -INFINITY;
#pragma unroll
                for (int e = 0; e < 8; ++e) if (e != i1 && lg[e] > v2) { v2 = lg[e]; i2 = e; }
                const float wt = 1.0f / (1.0f + __expf(v2 - v1));
                if (F.lane == rr) { me12 = i1 | (i2 << 8); mw1 = wt; }
            }
        }
        if (ROUTER) {
            if (F.lane < 32) { e12[rowb + F.lane] = me12; w1o[rowb + F.lane] = mw1; }
            const int e1 = me12 & 255, e2 = me12 >> 8;
#pragma unroll
            for (int e = 0; e < 8; ++e) { const unsigned long long m1 = __ballot(F.lane < 32 && e1 == e), m2 = __ballot(F.lane < 32 && e2 == e);
                if (F.lane == 0) { atomicAdd((int*)&lcnt[e], (int)__popcll(m1)); atomicAdd((int*)&lcnt[8 + e], (int)__popcll(m2)); } }
            __syncthreads();
            if (F.tid < 16) cnt[rb * 16 + F.tid] = lcnt[F.tid];
            __syncthreads();
        }
    }
}

__device__ __forceinline__ void moe_scatter(const Ctx& F, const int* cnt, const int* e12, const float* w1, int* tos, float* wos, int* tile) {
    LAS int* T1 = (LAS int*)F.lds;
    LAS int* T2 = T1 + 512;
    LAS int* tot = T2 + 512;
    LAS int* pre = tot + 16;
    LAS int* seg = pre + 16;
    LAS int* wcn = seg + 32;
    for (int rb = F.vcu; rb < NTOK / 256; rb += F.G) {
        { const int bin = F.tid & 15, part = F.tid >> 4; int st = 0, sp = 0;
#pragma unroll
            for (int j = 0; j < 8; ++j) { const int b2 = part * 8 + j; const int v = cnt[b2 * 16 + bin]; st += v; if (b2 < rb) sp += v; }
            T1[part * 16 + bin] = st; T2[part * 16 + bin] = sp; }
        __syncthreads();
        if (F.tid < 16) { int st = 0, sp = 0; for (int p = 0; p < 32; ++p) { st += T1[p * 16 + F.tid]; sp += T2[p * 16 + F.tid]; } tot[F.tid] = st; pre[F.tid] = sp; }
        __syncthreads();
        if (F.tid == 0) { int s = 0; for (int bin = 0; bin < 16; ++bin) { seg[bin] = s; s += ((tot[bin] + 255) >> 8) << 8; } seg[16] = s; }
        __syncthreads();
        int e1 = -1, e2 = -1; float wt = 0.f; int r1 = 0, r2 = 0;
        const int token = rb * 256 + F.tid;
        if (F.tid < 256) { const int v = e12[token]; e1 = v & 255; e2 = v >> 8; wt = w1[token]; }
        if (F.wave < 4) {
#pragma unroll
            for (int e = 0; e < 8; ++e) { const unsigned long long m1 = __ballot(e1 == e), m2 = __ballot(e2 == e); const unsigned long long lt = (1ull << F.lane) - 1ull;
                if (e1 == e) r1 = (int)__popcll(m1 & lt); if (e2 == e) r2 = (int)__popcll(m2 & lt);
                if (F.lane == 0) { wcn[F.wave * 16 + e] = (int)__popcll(m1); wcn[F.wave * 16 + 8 + e] = (int)__popcll(m2); } }
        }
        __syncthreads();
        if (F.tid < 256) {
            int o1 = seg[e1] + pre[e1] + r1, o2 = seg[8 + e2] + pre[8 + e2] + r2;
            for (int w = 0; w < F.wave; ++w) { o1 += wcn[w * 16 + e1]; o2 += wcn[w * 16 + 8 + e2]; }
            tos[o1] = token; wos[o1] = wt; tos[o2] = token; wos[o2] = 1.0f - wt;
        }
        if (rb < 16) { const int bin = rb; const int s0 = seg[bin] + tot[bin], s1 = seg[bin + 1]; for (int s = s0 + F.tid; s < s1; s += 512) { tos[s] = -1; wos[s] = 0.f; } }
        if (rb == 0) { if (F.tid == 0) { tile[0] = seg[8] >> 8; tile[1] = seg[16] >> 8; }
            for (int t = F.tid; t < MAXTILES; t += 512) { const int s = t << 8; int e = 0;
#pragma unroll
                for (int bin = 1; bin < 16; ++bin) if (s >= seg[bin]) e = bin;
                tile[16 + t] = e & 7; } }
        __syncthreads();
    }
}

constexpr int SC_AT = 0, SC_WT = 34816, SC_AS = 69632, SC_BS = 102400, SC_SEG = 135168, SC_CARRY = 139264, SC_CW = 139776, SC_GB = 142336;
__device__ __forceinline__ void scan_phase(const Ctx& F, const float* par, int l, const bf16_t* XB, bf16_t* GY, const bf16_t* GW) {
    LAS unsigned char* lds = F.lds;
    LAS float* AS = (LAS float*)(lds + SC_AS); LAS float* BS = (LAS float*)(lds + SC_BS);
    LAS float* SEGA = (LAS float*)(lds + SC_SEG); LAS float* SEGB = SEGA + 512;
    LAS float* CARRY = (LAS float*)(lds + SC_CARRY);
    LAS float* CW = (LAS float*)(lds + SC_CW);
    LAS float* GB = (LAS float*)(lds + SC_GB);
    const int tid = F.tid, lane = F.lane, wid = F.wave, r32 = lane & 31, hh = lane >> 5;
    for (int un = F.vcu; un < 256; un += F.G) {
        const int b = un >> 4, n = (un >> 1) & 7, c2 = un & 1;
        __syncthreads();
        for (int i = tid; i < 640; i += 512) { const int ch = i & 127, k = i >> 7; CW[i] = (k < 4) ? par[PAR_CONVW + (l * 4 + k) * DM + 128 * n + ch] : par[PAR_CONVB + l * DM + 128 * n + ch]; }
        if (tid < 64) { const int ch = l * DM + 128 * n + 64 * c2 + tid; GB[tid] = par[PAR_GAB + ch]; GB[64 + tid] = par[PAR_GXB + ch]; GB[128 + tid] = log1pf(expf(-par[PAR_LAM + ch])); CARRY[tid] = 0.f; CARRY[64 + tid] = 0.f; }
        { const bf16_t* gsrc = GW + (size_t)(((l * 8 + n) * 2 + c2) * 128) * 128;
#pragma unroll
            for (int i = 0; i < 4; ++i) { const int p = tid + 512 * i, row = p >> 4, c16 = p & 15; const u32x4 v = *(const u32x4*)(gsrc + (size_t)row * 128 + c16 * 8); *(LAS u32x4*)(lds + SC_WT + row * 272 + c16 * 16) = v; } }
        const int cp = lane, tg = wid;
        const int sc = lane, sg = wid;
        const size_t rowbase = (size_t)b * SEQ;
        const bf16_t* xbp = XB + rowbase * DM + 128 * n + 2 * cp;
        bf16_t* gyp = GY + rowbase * DM + 128 * n + 64 * c2 + sc;
        unsigned xv[19];
#pragma unroll
        for (int k = 0; k < 19; ++k) { const int t = 16 * tg - 3 + k; xv[k] = (t >= 0) ? *(const unsigned*)(xbp + (size_t)t * DM) : 0u; }
        __syncthreads();
        float w[2][4], cb[2];
#pragma unroll
        for (int q = 0; q < 2; ++q) { cb[q] = CW[512 + 2 * cp + q];
#pragma unroll
            for (int k = 0; k < 4; ++k) w[q][k] = CW[k * 128 + 2 * cp + q]; }
        const float gba = GB[32 * (wid & 1) + r32], gbx = GB[64 + 32 * (wid & 1) + r32], spv = GB[128 + 32 * (wid & 1) + r32];
        for (int ci = 0; ci < SEQ / 128; ++ci) {
            const int t0 = ci * 128;
#pragma unroll
            for (int k = 0; k < 16; ++k) {
                float o[2];
#pragma unroll
                for (int q = 0; q < 2; ++q) { float s = cb[q];
#pragma unroll
                    for (int j = 0; j < 4; ++j) { const unsigned pv = xv[k + j]; const float xf = q ? __uint_as_float(pv & 0xffff0000u) : __uint_as_float(pv << 16); s += w[q][j] * xf; }
                    o[q] = s; }
                *(LAS unsigned*)(lds + SC_AT + (16 * tg + k) * 272 + cp * 4) = cvtpk(o[0], o[1]);
            }
            if (ci + 1 < SEQ / 128) {
#pragma unroll
                for (int k = 0; k < 19; ++k) xv[k] = *(const unsigned*)(xbp + (size_t)(t0 + 128 + 16 * tg - 3 + k) * DM);
            }
            __syncthreads();
            f32x16 ga, gx;
#pragma unroll
            for (int i = 0; i < 16; ++i) { ga[i] = 0.f; gx[i] = 0.f; }
            { const int tt = wid >> 1, ct = wid & 1;
                const LAS unsigned char* ap = lds + SC_AT + (32 * tt + r32) * 272 + hh * 16;
                const LAS unsigned char* bpa = lds + SC_WT + (32 * ct + r32) * 272 + hh * 16;
                const LAS unsigned char* bpx = bpa + 64 * 272;
#pragma unroll
                for (int s = 0; s < 8; ++s) { const bf16x8 af = *(const LAS bf16x8*)(ap + s * 32), ba = *(const LAS bf16x8*)(bpa + s * 32), bx = *(const LAS bf16x8*)(bpx + s * 32);
                    ga = __builtin_amdgcn_mfma_f32_32x32x16_bf16(af, ba, ga, 0, 0, 0); gx = __builtin_amdgcn_mfma_f32_32x32x16_bf16(af, bx, gx, 0, 0, 0); }
                const f32x2 nlv = {-LOG2E, -LOG2E}, bav = {-LOG2E * gba, -LOG2E * gba}, bxv = {-LOG2E * gbx, -LOG2E * gbx}, onev = {1.0f, 1.0f}, csv = {-8.0f * LOG2E * spv, -8.0f * LOG2E * spv};
#pragma unroll
                for (int i = 0; i < 16; i += 2) { const int tok = 32 * tt + (i & 3) + 8 * (i >> 2) + 4 * hh, ch = 32 * ct + r32;
                    const f32x2 a2 = {ga[i], ga[i + 1]}, x2 = {gx[i], gx[i + 1]};
                    const f32x2 ta = a2 * nlv + bav, tx = x2 * nlv + bxv;
                    const f32x2 da = (f32x2){fast_exp2(ta.x), fast_exp2(ta.y)} + onev, dx = (f32x2){fast_exp2(tx.x), fast_exp2(tx.y)} + onev;
                    const f32x2 rg = {fast_rcp(da.x), fast_rcp(da.y)}, ig = {fast_rcp(dx.x), fast_rcp(dx.y)};
                    const f32x2 l2 = rg * csv; const f32x2 av = {fast_exp2(l2.x), fast_exp2(l2.y)};
                    const f32x2 om = onev - av * av; const f32x2 bc = {__builtin_amdgcn_sqrtf(fmaxf(om.x, 0.f)), __builtin_amdgcn_sqrtf(fmaxf(om.y, 0.f))};
                    const f32x2 xc = {bf2f(*(const LAS unsigned short*)(lds + SC_AT + tok * 272 + (64 * c2 + ch) * 2)), bf2f(*(const LAS unsigned short*)(lds + SC_AT + (tok + 1) * 272 + (64 * c2 + ch) * 2))};
                    const f32x2 bb = (bc * ig) * xc;
                    AS[tok * 64 + ch] = av.x; AS[(tok + 1) * 64 + ch] = av.y; BS[tok * 64 + ch] = bb.x; BS[(tok + 1) * 64 + ch] = bb.y; }
            }
            __syncthreads();
            unsigned short gyv[16];
#pragma unroll
            for (int k = 0; k < 16; ++k) gyv[k] = gyp[(size_t)(t0 + 16 * sg + k) * DM];
            float av[16], bv[16];
#pragma unroll
            for (int k = 0; k < 16; ++k) { av[k] = AS[(16 * sg + k) * 64 + sc]; bv[k] = BS[(16 * sg + k) * 64 + sc]; }
            { float pa = 1.f, pb = 0.f;
#pragma unroll
                for (int k = 0; k < 16; ++k) { pb = av[k] * pb + bv[k]; pa *= av[k]; }
                SEGA[sg * 64 + sc] = pa; SEGB[sg * 64 + sc] = pb; }
            __syncthreads();
            float h = CARRY[(ci & 1) * 64 + sc];
            for (int s = 0; s < sg; ++s) h = SEGA[s * 64 + sc] * h + SEGB[s * 64 + sc];
#pragma unroll
            for (int k = 0; k < 16; ++k) { h = av[k] * h + bv[k]; const float o = h * bf2f(gyv[k]); gyp[(size_t)(t0 + 16 * sg + k) * DM] = (bf16_t)(cvtpk(o, 0.f) & 0xffffu); }
            if (sg == 7) CARRY[((ci + 1) & 1) * 64 + sc] = h;
        }
    }
    __syncthreads();
}

constexpr int AT_K = 0, AT_V = 36864;
__device__ __forceinline__ void attn_phase(const Ctx& F, const bf16_t* Q, const bf16_t* Kb, const bf16_t* Vb, bf16_t* O, const float* sinks) {
    LAS unsigned char* lds = F.lds;
    const int tid = F.tid, lane = F.lane, wid = F.wave, r32 = lane & 31, hh = lane >> 5;
    const int i16 = lane & 15, tq = i16 >> 2, tp = i16 & 3, blk = (lane >> 4) & 1;
    const int g = wid & 3, half = wid >> 2;
    constexpr int NU = BATCH * 32 * 4;
    u32x4 kreg[4], vreg[4]; bf16x8 qreg[2][4];
#define AT_LOADKV(unit) do { const int kh_ = (unit) & 3, n_ = ((unit) >> 2) & 31, b_ = (unit) >> 7; \
        _Pragma("unroll") for (int i = 0; i < 4; ++i) { const int p = tid + 512 * i, row = p >> 3, c16 = p & 7; kreg[i] = (u32x4){0u, 0u, 0u, 0u}; vreg[i] = (u32x4){0u, 0u, 0u, 0u}; \
            if (n_ > 0 || row >= 128) { const size_t tok = (size_t)b_ * SEQ + (size_t)(128 * (n_ - 1) + row); kreg[i] = *(const u32x4*)(Kb + tok * 256 + kh_ * 64 + c16 * 8); vreg[i] = *(const u32x4*)(Vb + tok * 256 + kh_ * 64 + c16 * 8); } } } while (0)
#define AT_LOADQ(unit) do { const int kh_ = (unit) & 3, n_ = ((unit) >> 2) & 31, b_ = (unit) >> 7; \
        _Pragma("unroll") for (int ps = 0; ps < 2; ++ps) { const size_t qt_ = (size_t)b_ * SEQ + (size_t)(128 * n_ + 64 * half + 32 * ps + r32); \
            _Pragma("unroll") for (int s = 0; s < 4; ++s) qreg[ps][s] = *(const bf16x8*)(Q + qt_ * DM + (4 * kh_ + g) * 64 + 16 * s + 8 * hh); } } while (0)
    int un = F.vcu;
    if (un < NU) { AT_LOADKV(un); AT_LOADQ(un); }
    for (; un < NU; un += F.G) {
        const int kh = un & 3, n = (un >> 2) & 31, b = un >> 7;
        __syncthreads();
#pragma unroll
        for (int i = 0; i < 4; ++i) { const int p = tid + 512 * i, row = p >> 3, c16 = p & 7;
            *(LAS u32x4*)(lds + AT_K + row * 144 + c16 * 16) = kreg[i]; *(LAS u32x4*)(lds + AT_V + row * 192 + c16 * 16) = vreg[i]; }
        __syncthreads();
        if (un + F.G < NU) AT_LOADKV(un + F.G);
        const int hq = 4 * kh + g;
        const float sink2 = sinks[hq] * LOG2E;
#pragma unroll 1
        for (int pass = 0; pass < 2; ++pass) {
            const int i0 = 64 * half + 32 * pass, kt0 = i0 >> 5;
            const size_t qtok = (size_t)b * SEQ + (size_t)(128 * n + i0 + r32);
            bf16x8 qf[4];
#pragma unroll
            for (int s = 0; s < 4; ++s) qf[s] = pass ? qreg[1][s] : qreg[0][s];
            f32x16 sacc[5];
#pragma unroll
            for (int t = 0; t < 5; ++t) {
#pragma unroll
                for (int i = 0; i < 16; ++i) sacc[t][i] = 0.f;
#pragma unroll
                for (int s = 0; s < 4; ++s) { const bf16x8 kf = *(const LAS bf16x8*)(lds + AT_K + (32 * (kt0 + t) + r32) * 144 + (16 * s + 8 * hh) * 2);
                    sacc[t] = __builtin_amdgcn_mfma_f32_32x32x16_bf16(kf, qf[s], sacc[t], 0, 0, 0); } }
            float sum = 0.f;
#pragma unroll
            for (int t = 0; t < 5; ++t) {
                const bool dead = (n == 0) && (32 * (kt0 + t) < 128);
#pragma unroll
                for (int i = 0; i < 16; ++i) { float p = fast_exp2(sacc[t][i]);
                    if (t == 0 || t == 4) { const int d = 32 * t + (i & 3) + 8 * (i >> 2) + 4 * hh - r32; p = ((d >= 1) && (d <= 128)) ? p : 0.f; }
                    if (dead) p = 0.f; sacc[t][i] = p; sum += p; } }
            sum += shflx(sum, lane, 32);
            sum += fast_exp2(sink2);
            const float inv = 1.0f / sum;
            f32x16 oacc[2];
#pragma unroll
            for (int i = 0; i < 16; ++i) { oacc[0][i] = 0.f; oacc[1][i] = 0.f; }
#pragma unroll
            for (int t = 0; t < 5; ++t)
#pragma unroll
                for (int s = 0; s < 2; ++s) {
                    u32x4 pk; pk.x = cvtpk(sacc[t][8 * s], sacc[t][8 * s + 1]); pk.y = cvtpk(sacc[t][8 * s + 2], sacc[t][8 * s + 3]); pk.z = cvtpk(sacc[t][8 * s + 4], sacc[t][8 * s + 5]); pk.w = cvtpk(sacc[t][8 * s + 6], sacc[t][8 * s + 7]);
                    const bf16x8 pb = __builtin_bit_cast(bf16x8, pk);
#pragma unroll
                    for (int dt = 0; dt < 2; ++dt) {
                        const LAS unsigned char* vp = lds + AT_V + (32 * (kt0 + t) + 16 * s + 4 * hh + tq) * 192 + (32 * dt + 16 * blk + 4 * tp) * 2;
                        const s16x4 lo = __builtin_bit_cast(s16x4, __builtin_amdgcn_ds_read_tr16_b64_v4i16((LAS s16x4*)vp));
                        const s16x4 hi = __builtin_bit_cast(s16x4, __builtin_amdgcn_ds_read_tr16_b64_v4i16((LAS s16x4*)(vp + 8 * 192)));
                        const bf16x8 va = __builtin_shufflevector(lo, hi, 0, 1, 2, 3, 4, 5, 6, 7);
                        oacc[dt] = __builtin_amdgcn_mfma_f32_32x32x16_bf16(va, pb, oacc[dt], 0, 0, 0);
                    }
                }
            if constexpr (FP8_WO) {
                unsigned char* op = (unsigned char*)O + qtok * DM + hq * 64; const float sco = inv * SC8_O;
#pragma unroll
                for (int dt = 0; dt < 2; ++dt)
#pragma unroll
                    for (int q4 = 0; q4 < 4; ++q4) *(unsigned*)(op + 32 * dt + 8 * q4 + 4 * hh) = cvt4_fp8(oacc[dt][4 * q4] * sco, oacc[dt][4 * q4 + 1] * sco, oacc[dt][4 * q4 + 2] * sco, oacc[dt][4 * q4 + 3] * sco);
            } else {
                bf16_t* op = O + qtok * DM + hq * 64;
#pragma unroll
                for (int dt = 0; dt < 2; ++dt)
#pragma unroll
                    for (int q4 = 0; q4 < 4; ++q4) { u32x2 w; w.x = cvtpk(oacc[dt][4 * q4] * inv, oacc[dt][4 * q4 + 1] * inv); w.y = cvtpk(oacc[dt][4 * q4 + 2] * inv, oacc[dt][4 * q4 + 3] * inv);
                        *(u32x2*)(op + 32 * dt + 8 * q4 + 4 * hh) = w; } }
        }
        if (un + F.G < NU) AT_LOADQ(un + F.G);
    }
#undef AT_LOADKV
#undef AT_LOADQ
    __syncthreads();
}

constexpr int NPHASE = 33 + (DUP_SCANPAIR ? 4 : 0);
__global__ void __launch_bounds__(512, 2) fwd_kernel(Args a) {
    extern __shared__ __attribute__((aligned(16))) unsigned char lds_raw[];
    volatile LAS unsigned* MISC = (volatile LAS unsigned*)((LAS unsigned char*)lds_raw + LDS_MISC);
    const int wv0 = __builtin_amdgcn_readfirstlane((int)threadIdx.x >> 6);
    if (wv0 == 0) MISC[lane_id_v()] = 0u;
    __syncthreads();
    XcdBarrier bar; bar.bar = (unsigned*)(a.ws + WS_CTL) + CW_BAR; bar.x = 0; bar.st = MISC;
    if (!MK_MULTI) bar = xcd_barrier_post((unsigned*)(a.ws + WS_CTL) + CW_BAR, MISC, wv0);
    const int lo = a.ph_lo, hi = a.ph_hi;
    int ph = 0;
#define PH_BEGIN(k) if (((PHSEL >> (k)) & 1) && (!MK_MULTI || (lo <= ph && ph < hi))) { Ctx F; { int t_ = wv0 * 64 + (int)lane_id_v(); asm volatile("" : "+v"(t_)); F.tid = t_; } F.lds = (LAS unsigned char*)lds_raw; F.lane = F.tid & 63; \
        F.wave = __builtin_amdgcn_readfirstlane(F.tid >> 6); F.G = gridDim.x; { int bx = blockIdx.x; asm volatile("" : "+s"(bx)); F.cid = bx; F.vcu = (F.G % 8 == 0) ? (bx % 8) * (F.G / 8) + bx / 8 : bx; } \
        unsigned char GAS* wsg_ = (unsigned char GAS*)a.ws; asm volatile("" : "+s"(wsg_)); unsigned char* ws = (unsigned char*)wsg_; float GAS* xog_ = (float GAS*)a.out; asm volatile("" : "+s"(xog_)); float* xo = (float*)xog_; int l = l_; asm volatile("" : "+s"(l)); (void)xo; (void)l; \
        for (int rep_ = 0; rep_ < (((DUPMASK >> (k)) & 1) ? 2 : 1); ++rep_) {
#define PH_END   } if (!MK_MULTI && ph + 1 < NPHASE) { XcdBarrier b2_ = bar; unsigned GAS* bp_ = (unsigned GAS*)b2_.bar; asm volatile("" : "+s"(bp_)); b2_.bar = (unsigned*)bp_; unsigned bx_ = b2_.x; asm volatile("" : "+s"(bx_)); b2_.x = bx_; xcd_barrier(b2_, wv0); } } ++ph;
#define W_PAR    ((const float*)(ws + WS_PAR))
#define W_XS     ((bf16_t*)(ws + WS_XS))
#define W_MODL   ((const float*)(ws + WS_MODV) + (size_t)l * 16 * 6144)
#define W_KVMOD  ((const float*)(ws + WS_KVMOD))
#define W_HB     ((bf16_t*)(ws + WS_H))
#define W_HKV    ((bf16_t*)(ws + WS_HKV))
#define W_KB     ((bf16_t*)(ws + WS_KB))
#define W_VB     ((bf16_t*)(ws + WS_VB))
#define W_XB     ((bf16_t*)(ws + WS_ARENA + AR_XB))
#define W_GY     ((bf16_t*)(ws + WS_ARENA + AR_GY))
#define W_HID    ((bf16_t*)(ws + WS_ARENA))
#define W_Q      ((bf16_t*)(ws + WS_ARENA + AR_Q))
#define W_O      ((bf16_t*)(ws + WS_ARENA + AR_O))
#define W_ROT    ((const _Float16*)(ws + WS_COS))
#define W_E12    ((int*)(ws + WS_E12))
#define W_W1     ((float*)(ws + WS_W1))
#define W_CNT    ((int*)(ws + WS_CNT))
#define W_TILE   ((int*)(ws + WS_TILE))
#define W_TOS    ((int*)(ws + WS_TOS))
#define W_WOS    ((float*)(ws + WS_WOS))

    { const int l_ = 0; PH_BEGIN(0) p0_prologue(F, a); PH_END }

#pragma unroll 1
    for (int l_ = 0; l_ < 4; ++l_) {
        if (l_ < 2) {
            PH_BEGIN(1) if (l == 0) norm_phase<false, false, false, true>(F, a.x, W_PAR + PAR_MIXN + l * DM, W_MODL, W_MODL + 1024, W_HB, nullptr, nullptr, nullptr, nullptr, nullptr, nullptr, nullptr, nullptr);
                        else norm_phase<false, false>(F, W_XS, W_PAR + PAR_MIXN + l * DM, W_MODL, W_MODL + 1024, W_HB, nullptr, nullptr, nullptr, nullptr, nullptr, nullptr, nullptr, nullptr); PH_END
#pragma unroll 1
            for (int sp_ = 0; sp_ < (DUP_SCANPAIR ? 2 : 1); ++sp_) {
            PH_BEGIN(2) { pg8::ProbDense P{W_HB, (const bf16_t*)(ws + WS_WIN) + (size_t)l * 2048 * DM, DM * 2}; pg8::Order S; S.init(NTOK / 256, 8, F.G, F.cid, 0);
                pg8::EpiWin E{W_XB, W_GY}; pg8::gemm_phase<pg8::EpiWin, pg8::ProbDense, false>(F.lds, F.tid, P, S, E); } PH_END
            PH_BEGIN(3) scan_phase(F, W_PAR, l, W_XB, W_GY, (const bf16_t*)(ws + WS_GW)); PH_END
            }
            if (l_ == 0) {
                PH_BEGIN(20) { pg8::ProbDense P{W_GY, (const bf16_t*)(ws + WS_WOUT), DM * 2}; pg8::Order S; S.init(NTOK / 256, 4, F.G, F.cid, 0, STAGGER_TICKS);
                    pg8::EpiResid<true> E{a.x, W_XS, W_MODL + 2048, 1.0f}; pg8::gemm_phase<pg8::EpiResid<true>, pg8::ProbDense, false>(F.lds, F.tid, P, S, E); } PH_END
            } else {
                PH_BEGIN(4) { pg8::ProbDense P{W_GY, (const bf16_t*)(ws + WS_WOUT) + (size_t)l * DM * DM, DM * 2}; pg8::Order S; S.init(NTOK / 256, 4, F.G, F.cid, 0, STAGGER_TICKS);
                    pg8::EpiResid<false> E{W_XS, W_XS, W_MODL + 2048, 1.0f}; pg8::gemm_phase<pg8::EpiResid<false>, pg8::ProbDense, false>(F.lds, F.tid, P, S, E); } PH_END
            }
        } else {
            PH_BEGIN(5) if (l == 2) norm_phase<true, false, (bool)FP8_QKV>(F, W_XS, W_PAR + PAR_MIXN + l * DM, W_MODL, W_MODL + 1024, W_HB, W_PAR + PAR_KVN, W_KVMOD, W_KVMOD + 1024, W_HKV, nullptr, nullptr, nullptr, nullptr);
                        else norm_phase<false, false, (bool)FP8_QKV>(F, W_XS, W_PAR + PAR_MIXN + l * DM, W_MODL, W_MODL + 1024, W_HB, nullptr, nullptr, nullptr, nullptr, nullptr, nullptr, nullptr, nullptr); PH_END
            if (l_ == 2) {
                PH_BEGIN(6) {
                    constexpr int KBQ = FP8_QKV ? DM : DM * 2; constexpr float ASQ = FP8_QKV ? 1.0f / (SC8_H * SC8_W) : 1.0f;
                    { pg8::ProbDense P{W_HKV, ws + WS_WKV, KBQ}; pg8::Order S; S.init(NTOK / 256, 2, F.G, F.cid, 0);
                      pg8::EpiQK E{W_KB, 256, W_PAR + PAR_KN, W_ROT, 1.0f, 1, W_VB, ASQ}; pg8::gemm_phase<pg8::EpiQK, pg8::ProbDense, false, (bool)FP8_QKV>(F.lds, F.tid, P, S, E); }
                    { pg8::ProbDense P{W_HB, ws + WS_WQ, KBQ}; pg8::Order S; S.init(NTOK / 256, 4, F.G, F.cid, 0);
                      pg8::EpiQK E{W_Q, DM, W_PAR + PAR_QN, W_ROT, 0.125f * LOG2E, -1, nullptr, ASQ}; pg8::gemm_phase<pg8::EpiQK, pg8::ProbDense, false, (bool)FP8_QKV>(F.lds, F.tid, P, S, E); } } PH_END
            } else {
                PH_BEGIN(21) { constexpr int KBQ = FP8_QKV ? DM : DM * 2; constexpr float ASQ = FP8_QKV ? 1.0f / (SC8_H * SC8_W) : 1.0f;
                    pg8::ProbDense P{W_HB, ws + WS_WQ + (size_t)DM * DM * 2, KBQ}; pg8::Order S; S.init(NTOK / 256, 4, F.G, F.cid, 0);
                    pg8::EpiQK E{W_Q, DM, W_PAR + PAR_QN + 64, W_ROT, 0.125f * LOG2E, -1, nullptr, ASQ}; pg8::gemm_phase<pg8::EpiQK, pg8::ProbDense, false, (bool)FP8_QKV>(F.lds, F.tid, P, S, E); } PH_END
            }
            PH_BEGIN(7) attn_phase(F, W_Q, W_KB, W_VB, W_O, W_PAR + PAR_SINK + (l - 2) * 16); PH_END
            PH_BEGIN(8) { pg8::ProbDense P{W_O, ws + WS_WO + (size_t)(l - 2) * DM * DM * 2, FP8_WO ? DM : DM * 2}; pg8::Order S; S.init(NTOK / 256, 4, F.G, F.cid, 0, STAGGER_TICKS);
                pg8::EpiResid<false> E{W_XS, W_XS, W_MODL + 2048, FP8_WO ? 1.0f / (SC8_O * SC8_W) : 1.0f}; pg8::gemm_phase<pg8::EpiResid<false>, pg8::ProbDense, false, (bool)FP8_WO>(F.lds, F.tid, P, S, E); } PH_END
        }
        if (!(l_ & 1)) {
            PH_BEGIN(9) if (FP8_OF(0) | FP8_OF(2)) { if (FP8_DENSE(l)) norm_phase<false, false, true>(F, W_XS, W_PAR + PAR_FFNN + l * DM, W_MODL + 3072, W_MODL + 4096, W_HB, nullptr, nullptr, nullptr, nullptr, nullptr, nullptr, nullptr, nullptr);
                             else norm_phase<false, false, false>(F, W_XS, W_PAR + PAR_FFNN + l * DM, W_MODL + 3072, W_MODL + 4096, W_HB, nullptr, nullptr, nullptr, nullptr, nullptr, nullptr, nullptr, nullptr); }
                        else norm_phase<false, false, false>(F, W_XS, W_PAR + PAR_FFNN + l * DM, W_MODL + 3072, W_MODL + 4096, W_HB, nullptr, nullptr, nullptr, nullptr, nullptr, nullptr, nullptr, nullptr); PH_END
            if (FP8_DENSE(l_)) {
                PH_BEGIN(17) { pg8::ProbDense P{W_HB, ws + WS_FGU + (size_t)(l >> 1) * 6144 * DM * 2, DM}; pg8::Order S; S.init(NTOK / 256, 24, F.G, F.cid, 0);
                    pg8::EpiSwiglu<true> E{W_HID, DFF, 1.0f / (SC8_H * SC8_W)}; pg8::gemm_phase<pg8::EpiSwiglu<true>, pg8::ProbDense, false, true>(F.lds, F.tid, P, S, E); } PH_END
                PH_BEGIN(18) { pg8::ProbDense P{W_HID, ws + WS_FDN + (size_t)(l >> 1) * DM * DFF * 2, DFF}; pg8::Order S; S.init(NTOK / 256, 4, F.G, F.cid, 0, STAGGER_TICKS);
                    pg8::EpiResid<false> E{W_XS, W_XS, W_MODL + 5120, 1.0f / (SC8_HID * SC8_W)}; pg8::gemm_phase<pg8::EpiResid<false>, pg8::ProbDense, false, true>(F.lds, F.tid, P, S, E); } PH_END
            } else {
                PH_BEGIN(10) { pg8::ProbDense P{W_HB, (const bf16_t*)(ws + WS_FGU) + (size_t)(l >> 1) * 6144 * DM, DM * 2}; pg8::Order S; S.init(NTOK / 256, 24, F.G, F.cid, 0);
                    pg8::EpiSwiglu<false> E{W_HID, DFF, 1.0f}; pg8::gemm_phase<pg8::EpiSwiglu<false>, pg8::ProbDense, false>(F.lds, F.tid, P, S, E); } PH_END
                PH_BEGIN(11) { pg8::ProbDense P{W_HID, (const bf16_t*)(ws + WS_FDN) + (size_t)(l >> 1) * DM * DFF, DFF * 2}; pg8::Order S; S.init(NTOK / 256, 4, F.G, F.cid, 0, STAGGER_TICKS);
                    pg8::EpiResid<false> E{W_XS, W_XS, W_MODL + 5120, 1.0f}; pg8::gemm_phase<pg8::EpiResid<false>, pg8::ProbDense, false>(F.lds, F.tid, P, S, E); } PH_END
            }
        } else {
            PH_BEGIN(12) if (FP8_MOE(l)) norm_phase_pk<false, true, true>(F, W_XS, W_PAR + PAR_FFNN + l * DM, W_MODL + 3072, W_MODL + 4096, W_HB, nullptr, nullptr, nullptr, nullptr, W_PAR + PAR_ROUTER + (l >> 1) * DM * 8, W_E12, W_W1, W_CNT);
                         else norm_phase_pk<false, true, false>(F, W_XS, W_PAR + PAR_FFNN + l * DM, W_MODL + 3072, W_MODL + 4096, W_HB, nullptr, nullptr, nullptr, nullptr, W_PAR + PAR_ROUTER + (l >> 1) * DM * 8, W_E12, W_W1, W_CNT); PH_END
            PH_BEGIN(13) moe_scatter(F, W_CNT, W_E12, W_W1, W_TOS, W_WOS, W_TILE); PH_END
            if (FP8_MOE(l_)) {
                PH_BEGIN(16) {
                    LAS int* texp = (LAS int*)(F.lds + LDS_TEXP);
                    for (int i = F.tid; i < MAXTILES + 16; i += 512) texp[i] = W_TILE[i];
                    __syncthreads();
                    const int ntot = texp[1];
                    pg8::Order S; S.init(ntot, 28, F.G, F.cid, 0);
                    pg8::ProbGrouped P{W_HB, ws + WS_MGU + (size_t)(l >> 1) * 8 * 7168 * DM * 2, DM, 7168, texp + 16, W_TOS};
                    pg8::EpiSwiglu<true> E{W_HID, DFE, 1.0f / (SC8_H * SC8_W)}; pg8::gemm_phase<pg8::EpiSwiglu<true>, pg8::ProbGrouped, true, true>(F.lds, F.tid, P, S, E); } PH_END
            } else {
                PH_BEGIN(14) {
                    LAS int* texp = (LAS int*)(F.lds + LDS_TEXP);
                    for (int i = F.tid; i < MAXTILES + 16; i += 512) texp[i] = W_TILE[i];
                    __syncthreads();
                    const int ntot = texp[1];
                    pg8::Order S; S.init(ntot, 28, F.G, F.cid, 0);
                    pg8::ProbGrouped P{W_HB, (const bf16_t*)(ws + WS_MGU) + (size_t)(l >> 1) * 8 * 7168 * DM, DM * 2, 7168, texp + 16, W_TOS};
                    pg8::EpiSwiglu<false> E{W_HID, DFE, 1.0f}; pg8::gemm_phase<pg8::EpiSwiglu<false>, pg8::ProbGrouped, true, false>(F.lds, F.tid, P, S, E); } PH_END
            }
#pragma unroll 1
            for (int pass = 0; pass < 2; ++pass) {
                if (l_ == 3 && pass == 1) {
                    PH_BEGIN(19) {
                        LAS int* texp = (LAS int*)(F.lds + LDS_TEXP);
                        for (int i = F.tid; i < MAXTILES + 16; i += 512) texp[i] = W_TILE[i];
                        __syncthreads();
                        const int nA = texp[0], ntot = texp[1];
                        pg8::Order S; S.init(ntot - nA, 4, F.G, F.cid, nA, STAGGER_TICKS);
                        if (FP8_MOE(3)) { pg8::ProbGrouped P{W_HID, ws + WS_MDN + (size_t)8 * DM * DFE * 2, DFE, DM, texp + 16, W_TOS};
                            pg8::EpiMoeDown<true> E{W_XS, xo, W_MODL + 5120, W_TOS, W_WOS, 1.0f / (SC8_HID * SC8_W)}; pg8::gemm_phase<pg8::EpiMoeDown<true>, pg8::ProbGrouped, false, true>(F.lds, F.tid, P, S, E); }
                        else { pg8::ProbGrouped P{W_HID, (const bf16_t*)(ws + WS_MDN) + (size_t)8 * DM * DFE, DFE * 2, DM, texp + 16, W_TOS};
                            pg8::EpiMoeDown<true> E{W_XS, xo, W_MODL + 5120, W_TOS, W_WOS, 1.0f}; pg8::gemm_phase<pg8::EpiMoeDown<true>, pg8::ProbGrouped, false, false>(F.lds, F.tid, P, S, E); } } PH_END
                } else {
                    PH_BEGIN(15) {
                        LAS int* texp = (LAS int*)(F.lds + LDS_TEXP);
                        for (int i = F.tid; i < MAXTILES + 16; i += 512) texp[i] = W_TILE[i];
                        __syncthreads();
                        const int nA = texp[0], ntot = texp[1];
                        pg8::Order S; S.init(pass ? ntot - nA : nA, 4, F.G, F.cid, pass ? nA : 0, STAGGER_TICKS);
                        if (FP8_MOE(l)) { pg8::ProbGrouped P{W_HID, ws + WS_MDN + (size_t)(l >> 1) * 8 * DM * DFE * 2, DFE, DM, texp + 16, W_TOS};
                            pg8::EpiMoeDown<false> E{W_XS, W_XS, W_MODL + 5120, W_TOS, W_WOS, 1.0f / (SC8_HID * SC8_W)}; pg8::gemm_phase<pg8::EpiMoeDown<false>, pg8::ProbGrouped, false, true>(F.lds, F.tid, P, S, E); }
                        else { pg8::ProbGrouped P{W_HID, (const bf16_t*)(ws + WS_MDN) + (size_t)(l >> 1) * 8 * DM * DFE, DFE * 2, DM, texp + 16, W_TOS};
                            pg8::EpiMoeDown<false> E{W_XS, W_XS, W_MODL + 5120, W_TOS, W_WOS, 1.0f}; pg8::gemm_phase<pg8::EpiMoeDown<false>, pg8::ProbGrouped, false, false>(F.lds, F.tid, P, S, E); }
                        if (DEFER_L3 && l == 1) {
                            const int tail = S.nwg % F.G; const bool part = (tail > 0) && (2 * tail < F.G);
                            __syncthreads();
                            if (!part || F.cid >= tail) convert_deferred(F, a.m_w_gu, a.m_w_down, ws, pass, part ? F.cid - tail : F.cid, part ? F.G - tail : F.G);
                        } } PH_END
                }
            }
        }
    }
#undef PH_BEGIN
#undef PH_END
}

extern "C" void kernel_launch(void* const* d_in, const int* in_sizes, int n_in, void* d_out, int out_size, void* d_ws, size_t ws_size, hipStream_t stream) {
    static int grid = 0;
    if (grid == 0) {
        if (n_in != 30 || in_sizes[0] != NTOK * DM || out_size != NTOK * DM || ws_size < WS_END) { fprintf(stderr, "kernel_launch: unexpected shapes (n_in %d, in0 %d, out %d, ws %zu < %zu)\n", n_in, n_in > 0 ? in_sizes[0] : -1, out_size, ws_size, (size_t)WS_END); grid = -1; return; }
        int dev = 0, cus = 0, per_cu = 0;
        if (hipGetDevice(&dev) != hipSuccess || hipDeviceGetAttribute(&cus, hipDeviceAttributeMultiprocessorCount, dev) != hipSuccess) { grid = -1; return; }
        if (hipFuncSetAttribute((const void*)fwd_kernel, hipFuncAttributeMaxDynamicSharedMemorySize, LDS_BYTES) != hipSuccess) { fprintf(stderr, "kernel_launch: hipFuncSetAttribute failed\n"); grid = -1; return; }
        if (hipOccupancyMaxActiveBlocksPerMultiprocessor(&per_cu, (const void*)fwd_kernel, 512, LDS_BYTES) != hipSuccess || per_cu < 1) fprintf(stderr, "kernel_launch: occupancy query reports %d\n", per_cu);
        (void)hipGetLastError();
        grid = cus;
    }
    if (grid < 0) return;
    if (hipMemsetAsync((char*)d_ws + WS_CTL, 0, CTL_ZERO_BYTES, stream) != hipSuccess) return;
    Args a{};
    const float** fp = (const float**)&a;
    for (int i = 0; i < 30; ++i) fp[i] = (const float*)d_in[i];
    a.out = (float*)d_out; a.ws = (unsigned char*)d_ws;
#if MK_MULTI
    for (int p = 0; p < NPHASE; ++p) { a.ph_lo = p; a.ph_hi = p + 1; hipLaunchKernelGGL(fwd_kernel, dim3(grid), dim3(512), LDS_BYTES, stream, a); }
#else
    a.ph_lo = 0; a.ph_hi = NPHASE; hipLaunchKernelGGL(fwd_kernel, dim3(grid), dim3(512), LDS_BYTES, stream, a);
#endif
}
```
